# Optimizing an MI355X kernel written in HIP

```python
import jax, jax.numpy as jnp
from jax import lax
import numpy as np

D_MODEL = 1024
BATCH = 4
SEQ = 4096
DEPTH = 4
DEC_BATCH = 16
DEC_SEQ = 2048
PAST_LEN = 128

N_META = 16
GRID_W = 64
HEAD_DIM = 64
N_Q_HEADS = 16
N_KV_HEADS = 4
Q_PER_KV = N_Q_HEADS // N_KV_HEADS
ATTN_WIDTH = N_Q_HEADS * HEAD_DIM
KV_WIDTH = N_KV_HEADS * HEAD_DIM
CONV_WIDTH = D_MODEL
CONV_K = 3
D_FF = 2816
Q_BLOCK = 128
ROPE_BASE = 10000.0
NORM_EPS = 1e-6
ROPE_HALF = HEAD_DIM // 2
IN_WIDTH = ATTN_WIDTH + 2 * KV_WIDTH + 3 * CONV_WIDTH + 2 * D_MODEL

kernel_name = "hybrid_gqa_shortconv_macaron_encoder"


def rmsnorm(x, g):
    xf = x.astype(jnp.float32)
    y = xf * lax.rsqrt(jnp.mean(xf * xf, axis=-1, keepdims=True) + NORM_EPS)
    return (y * g.astype(jnp.float32)).astype(x.dtype)


def swiglu(x, w_gate, w_up, w_down):
    return (jax.nn.silu(x @ w_gate) * (x @ w_up)) @ w_down


def axial_angles(n_tok):
    rows = n_tok // GRID_W
    row = jnp.repeat(jnp.arange(rows, dtype=jnp.float32), GRID_W)
    col = jnp.tile(jnp.arange(GRID_W, dtype=jnp.float32), rows)
    meta_row = jnp.full((N_META,), -1.0, dtype=jnp.float32)
    meta_col = jnp.arange(N_META, dtype=jnp.float32)
    row = jnp.concatenate([meta_row, row])
    col = jnp.concatenate([meta_col, col])
    inv_freq = ROPE_BASE ** (-jnp.arange(0, ROPE_HALF, 2, dtype=jnp.float32) / ROPE_HALF)
    ang_r = row[:, None] * inv_freq[None, :]
    ang_c = col[:, None] * inv_freq[None, :]
    return jnp.cos(ang_r), jnp.sin(ang_r), jnp.cos(ang_c), jnp.sin(ang_c)


def rope_rotate(x, cos, sin):
    x1, x2 = jnp.split(x, 2, axis=-1)
    c = cos[None, :, None, :]
    s = sin[None, :, None, :]
    return jnp.concatenate([x1 * c - x2 * s, x2 * c + x1 * s], axis=-1)


def axial_rope(x, angles):
    cos_r, sin_r, cos_c, sin_c = angles
    xf = x.astype(jnp.float32)
    out = jnp.concatenate([rope_rotate(xf[..., :ROPE_HALF], cos_r, sin_r),
                           rope_rotate(xf[..., ROPE_HALF:], cos_c, sin_c)], axis=-1)
    return out.astype(x.dtype)


def blocked_gqa(q, k, v):
    b, l = q.shape[0], q.shape[1]

    def attend(qb):
        s = jnp.einsum('bqkgd,bskd->bkgqs', qb, k).astype(jnp.float32)
        p = jax.nn.softmax(s, axis=-1).astype(v.dtype)
        return jnp.einsum('bkgqs,bskd->bqkgd', p, v)

    meta_out = attend(q[:, :N_META])
    real = q[:, N_META:]
    n_blk = real.shape[1] // Q_BLOCK
    blocks = real.reshape(b, n_blk, Q_BLOCK, N_KV_HEADS, Q_PER_KV, HEAD_DIM).transpose(1, 0, 2, 3, 4, 5)
    out = lax.map(attend, blocks)
    out = out.transpose(1, 0, 2, 3, 4, 5).reshape(b, n_blk * Q_BLOCK, N_KV_HEADS, Q_PER_KV, HEAD_DIM)
    return jnp.concatenate([meta_out, out], axis=1).reshape(b, l, ATTN_WIDTH)


def centred_dwconv(x, w, bias):
    xp = jnp.pad(x, ((0, 0), (1, 1), (0, 0)))
    return w[0] * xp[:, :-2] + w[1] * xp[:, 1:-1] + w[2] * xp[:, 2:] + bias


def token_mixer(u, angles, w_in, conv_w, conv_b, q_norm, k_norm, w_o_attn, w_o_conv, w_merge):
    b, l, _ = u.shape
    p = u @ w_in
    splits = np.cumsum([ATTN_WIDTH, KV_WIDTH, KV_WIDTH, CONV_WIDTH, CONV_WIDTH, CONV_WIDTH, D_MODEL])
    q, k, v, cb, cc, cx, g_attn, g_conv = jnp.split(p, splits, axis=-1)
    q = q.reshape(b, l, N_Q_HEADS, HEAD_DIM)
    k = k.reshape(b, l, N_KV_HEADS, HEAD_DIM)
    v = v.reshape(b, l, N_KV_HEADS, HEAD_DIM)
    q = axial_rope(rmsnorm(q, q_norm), angles) * (HEAD_DIM ** -0.5)
    k = axial_rope(rmsnorm(k, k_norm), angles)
    q = q.reshape(b, l, N_KV_HEADS, Q_PER_KV, HEAD_DIM)
    a = blocked_gqa(q, k, v) @ w_o_attn
    c = (cb * centred_dwconv(cc * cx, conv_w, conv_b)) @ w_o_conv
    merged = jax.nn.sigmoid(g_attn) * a + jax.nn.sigmoid(g_conv) * c
    return merged @ w_merge


def trunk(x, meta_tokens, ffn1_norm, ffn1_w_gate, ffn1_w_up, ffn1_w_down, mix_norm, w_in, conv_w,
          conv_b, q_norm, k_norm, w_o_attn, w_o_conv, w_merge, ffn2_norm, ffn2_w_gate, ffn2_w_up,
          ffn2_w_down, final_norm):
    b, n_tok, _ = x.shape
    meta = jnp.broadcast_to(meta_tokens.astype(x.dtype)[None], (b, N_META, D_MODEL))
    h = jnp.concatenate([meta, x], axis=1)
    angles = axial_angles(n_tok)
    for i in range(DEPTH):
        h = h + 0.5 * swiglu(rmsnorm(h, ffn1_norm[i]), ffn1_w_gate[i], ffn1_w_up[i], ffn1_w_down[i])
        h = h + token_mixer(rmsnorm(h, mix_norm[i]), angles, w_in[i], conv_w[i], conv_b[i], q_norm[i],
                            k_norm[i], w_o_attn[i], w_o_conv[i], w_merge[i])
        h = h + 0.5 * swiglu(rmsnorm(h, ffn2_norm[i]), ffn2_w_gate[i], ffn2_w_up[i], ffn2_w_down[i])
    h = rmsnorm(h, final_norm)
    return h[:, N_META:]


def setup_inputs(seed: int = 0) -> dict:
    key = jax.random.key(seed)
    ks = jax.random.split(key, 24)

    def nrm(k, shape, scale):
        return jax.random.normal(k, shape, dtype=jnp.float32) * scale

    def gain(k, shape):
        return 1.0 + nrm(k, shape, 0.01)

    return {
        "x_prompt": nrm(ks[0], (BATCH, SEQ, D_MODEL), 1.0),
        "x_sample": nrm(ks[1], (DEC_BATCH, DEC_SEQ, D_MODEL), 1.0),
        "meta_tokens": nrm(ks[2], (N_META, D_MODEL), 1.0),
        "ffn1_norm": gain(ks[3], (DEPTH, D_MODEL)),
        "ffn1_w_gate": nrm(ks[4], (DEPTH, D_MODEL, D_FF), D_MODEL ** -0.5),
        "ffn1_w_up": nrm(ks[5], (DEPTH, D_MODEL, D_FF), D_MODEL ** -0.5),
        "ffn1_w_down": nrm(ks[6], (DEPTH, D_FF, D_MODEL), D_FF ** -0.5),
        "mix_norm": gain(ks[7], (DEPTH, D_MODEL)),
        "w_in": nrm(ks[8], (DEPTH, D_MODEL, IN_WIDTH), D_MODEL ** -0.5),
        "conv_w": nrm(ks[9], (DEPTH, CONV_K, CONV_WIDTH), CONV_K ** -0.5),
        "conv_b": nrm(ks[10], (DEPTH, CONV_WIDTH), 0.01),
        "q_norm": gain(ks[11], (DEPTH, HEAD_DIM)),
        "k_norm": gain(ks[12], (DEPTH, HEAD_DIM)),
        "w_o_attn": nrm(ks[13], (DEPTH, ATTN_WIDTH, D_MODEL), ATTN_WIDTH ** -0.5),
        "w_o_conv": nrm(ks[14], (DEPTH, CONV_WIDTH, D_MODEL), CONV_WIDTH ** -0.5),
        "w_merge": nrm(ks[15], (DEPTH, D_MODEL, D_MODEL), D_MODEL ** -0.5),
        "ffn2_norm": gain(ks[16], (DEPTH, D_MODEL)),
        "ffn2_w_gate": nrm(ks[17], (DEPTH, D_MODEL, D_FF), D_MODEL ** -0.5),
        "ffn2_w_up": nrm(ks[18], (DEPTH, D_MODEL, D_FF), D_MODEL ** -0.5),
        "ffn2_w_down": nrm(ks[19], (DEPTH, D_FF, D_MODEL), D_FF ** -0.5),
        "final_norm": gain(ks[20], (D_MODEL,)),
    }


def reference(x_prompt, x_sample, meta_tokens, ffn1_norm, ffn1_w_gate, ffn1_w_up, ffn1_w_down, mix_norm,
              w_in, conv_w, conv_b, q_norm, k_norm, w_o_attn, w_o_conv, w_merge, ffn2_norm, ffn2_w_gate,
              ffn2_w_up, ffn2_w_down, final_norm):
    y_prompt = trunk(x_prompt, meta_tokens, ffn1_norm, ffn1_w_gate, ffn1_w_up, ffn1_w_down, mix_norm, w_in,
                     conv_w, conv_b, q_norm, k_norm, w_o_attn, w_o_conv, w_merge, ffn2_norm, ffn2_w_gate,
                     ffn2_w_up, ffn2_w_down, final_norm)
    y_sample = trunk(x_sample, meta_tokens, ffn1_norm, ffn1_w_gate, ffn1_w_up, ffn1_w_down, mix_norm, w_in,
                     conv_w, conv_b, q_norm, k_norm, w_o_attn, w_o_conv, w_merge, ffn2_norm, ffn2_w_gate,
                     ffn2_w_up, ffn2_w_down, final_norm)
    return (y_prompt, y_sample)
```

```cpp
#include <hip/hip_runtime.h>
#include <hip/hip_cooperative_groups.h>
#include <hip/hip_bf16.h>
#include <cstdio>
#include <cstdint>
#include <cmath>
namespace cg = cooperative_groups;
namespace pg8 {
#define PG8_LAS __attribute__((address_space(3)))
typedef unsigned short bf16_t;
typedef short bf16x8 __attribute__((ext_vector_type(8)));
typedef float f32x4 __attribute__((ext_vector_type(4)));
typedef unsigned u32x4 __attribute__((ext_vector_type(4)));
constexpr int BM = 256, BK = 64, HALF = 128, HTB = HALF * BK * 2  , STAGE_BYTES = 8 * HTB, NXCD = 8, WGM = 8;

__host__ __device__ __forceinline__ int lds_byte(int r, int c) { const int st = (r >> 4) * 2 + (c >> 5), rr = r & 15, cc = c & 31, ob = rr * 64 + cc * 2; return st * 1024 + (ob ^ (((ob >> 9) & 1) << 5)); }
__host__ __device__ __forceinline__ void stage_rc(int b, int& R, int& C) { const int st = b / 1024, sb = b % 1024, swz = sb ^ (((sb >> 9) & 1) << 5); R = (st >> 1) * 16 + swz / 64; C = (st & 1) * 32 + (swz % 64) / 2; }
__host__ __device__ __forceinline__ int perm32(int rho) { const int n = rho >> 4, i = rho & 15; return 8 * (i >> 2) + 4 * n + (i & 3); }

struct Unit { int pm, pn, sub; };
struct Gemm { const bf16_t* A; const bf16_t* Bt; int M, N, K; };

struct StaticOrder {
    int nM, nN, nwg, G, c;
    __host__ __device__ void init(int M, int N, int G_, int c_) { nM = M / BM; nN = N / BM; nwg = nM * nN; G = G_; c = c_; }
    __host__ __device__ bool next(int i, Unit& u) const {
        const long L = (long)i * G + c; if (L >= nwg) return false;
        int wgid = (int)L; { const int q = nwg / NXCD, r = nwg % NXCD, xcd = wgid % NXCD, off = wgid / NXCD; wgid = (xcd < r ? xcd * (q + 1) : r * (q + 1) + (xcd - r) * q) + off; }
        const int nig = WGM * nN, gid = wgid / nig, fm = gid * WGM, gsz = (nM - fm) < WGM ? (nM - fm) : WGM;
        u.pm = fm + ((wgid % nig) % gsz); u.pn = (wgid % nig) / gsz; u.sub = 0; return true;
    }
    __device__ __forceinline__ void a_ready(const Unit&) const {}
    __device__ __forceinline__ void done(const Unit&) const {}
};

__device__ __forceinline__ unsigned cvt_pk_bf16(float lo, float hi) { unsigned r; asm volatile("v_cvt_pk_bf16_f32 %0, %1, %2" : "=v"(r) : "v"(lo), "v"(hi)); return r; }
typedef float f32x2 __attribute__((ext_vector_type(2)));
template <class Epi, class Sched, bool ALIGN_EPI = false, bool SP2 = false>
__device__ __forceinline__ void gemm_phase(PG8_LAS unsigned char* lds, const Gemm g, const Sched& S, const Epi& E, const int tid) {
    const int wid = __builtin_amdgcn_readfirstlane(tid >> 6), lane = tid & 63, wr = wid >> 2, wc = wid & 3, fr = lane & 15, fq = lane >> 4;
    const int K = g.K, nt = K / BK;
    unsigned voffA[2], voffB[2];
#pragma unroll
    for (int i = 0; i < 2; ++i) { int R, C; stage_rc(tid * 16 + i * 8192, R, C); const int Rb = Epi::PERM ? ((R & ~31) + perm32(R & 31)) : R;
        voffA[i] = (unsigned)(R * K + C) * 2u; voffB[i] = (unsigned)(Rb * K + C) * 2u; }
    const size_t kstep = (size_t)(BK * 2);
    const size_t hstep = (size_t)HALF * K * 2;
        const unsigned ldsw = (unsigned)wid * 1024u;
    const int aoff = lds_byte(wr * 64 + fr, fq * 8), boff = lds_byte(wc * 32 + fr, fq * 8);
#define PG8_SA(b, h) (((b) * 2 + (h)) * HTB)
#define PG8_SB(b, h) ((4 + (b) * 2 + (h)) * HTB)
#define PG8_STAGE(bufoff, gbase, voff) do { _Pragma("unroll") for (int _i = 0; _i < 2; ++_i) \
        __builtin_amdgcn_global_load_lds((const unsigned*)((const char*)(gbase) + (voff)[_i]), (PG8_LAS unsigned*)(lds + (bufoff) + ldsw + _i * 8192), 16, 0, 0); } while (0)
#define PG8_LDA(dst, b, h) do { _Pragma("unroll") for (int m = 0; m < 4; ++m) _Pragma("unroll") for (int k = 0; k < 2; ++k) dst[m][k] = *(const PG8_LAS bf16x8*)(lds + PG8_SA(b, h) + aoff + m * 2048 + k * 1024); } while (0)
#define PG8_LDB(dst, b, h) do { _Pragma("unroll") for (int n = 0; n < 2; ++n) _Pragma("unroll") for (int k = 0; k < 2; ++k) dst[n][k] = *(const PG8_LAS bf16x8*)(lds + PG8_SB(b, h) + boff + n * 2048 + k * 1024); } while (0)
#define PG8_MMA(ai, bj, At, Bt) do { __builtin_amdgcn_s_setprio(1); _Pragma("unroll") for (int m = 0; m < 4; ++m) _Pragma("unroll") for (int n = 0; n < 2; ++n) _Pragma("unroll") for (int k = 0; k < 2; ++k) \
        acc[ai][bj][m][n] = __builtin_amdgcn_mfma_f32_16x16x32_bf16(Bt[n][k], At[m][k], acc[ai][bj][m][n], 0, 0, 0); __builtin_amdgcn_s_setprio(0); } while (0)
#define PG8_WAIT_V(n) asm volatile("s_waitcnt vmcnt(" #n ")" ::: "memory")
#define PG8_WAIT_L(n) asm volatile("s_waitcnt lgkmcnt(" #n ")" ::: "memory")
#define PG8_BAR __builtin_amdgcn_s_barrier()
#define PG8_SCHED __builtin_amdgcn_sched_barrier(0)
    Unit cur, nxt; int ui = 0;
    if (!S.next(0, cur)) return;
    f32x4 acc[2][2][4][2];
#pragma unroll
    for (int a = 0; a < 2; ++a)
#pragma unroll
        for (int b = 0; b < 2; ++b)
#pragma unroll
            for (int m = 0; m < 4; ++m)
#pragma unroll
                for (int n = 0; n < 2; ++n) acc[a][b][m][n] = (f32x4){0.f, 0.f, 0.f, 0.f};
    bf16x8 At[4][2], B0[2][2], B1[2][2];
    const char* cA = S.aptr(cur); const char* cB = S.bptr(cur);
    S.a_ready(cur);
    if constexpr (SP2) {
        PG8_STAGE(PG8_SB(0, 0), cB, voffB); PG8_STAGE(PG8_SB(0, 1), cB + hstep, voffB); PG8_STAGE(PG8_SA(0, 0), cA, voffA); PG8_STAGE(PG8_SA(0, 1), cA + hstep, voffA);
        if (wr == 1) PG8_BAR;
        PG8_WAIT_V(2); PG8_BAR;
        PG8_STAGE(PG8_SB(1, 0), cB + kstep, voffB); PG8_STAGE(PG8_SA(1, 0), cA + kstep, voffA); PG8_STAGE(PG8_SB(1, 1), cB + hstep + kstep, voffB);
        PG8_WAIT_V(6); PG8_BAR;
    } else {
        PG8_STAGE(PG8_SB(0, 0), cB, voffB); PG8_STAGE(PG8_SA(0, 0), cA, voffA); PG8_STAGE(PG8_SB(0, 1), cB + hstep, voffB); PG8_STAGE(PG8_SA(0, 1), cA + hstep, voffA);
        if (wr == 1) PG8_BAR;
        PG8_WAIT_V(4); PG8_BAR;
        PG8_STAGE(PG8_SB(1, 0), cB + kstep, voffB); PG8_STAGE(PG8_SA(1, 0), cA + kstep, voffA); PG8_STAGE(PG8_SB(1, 1), cB + hstep + kstep, voffB);
        PG8_WAIT_V(6); PG8_BAR;
    }
    for (;;) {
        const bool has_next = S.next(ui + 1, nxt);
        const char* nA = has_next ? S.aptr(nxt) : cA; const char* nB = has_next ? S.bptr(nxt) : cB;
        for (int t = 0; t < nt; t += 2) {
            const bool last = (t == nt - 2);
            const char* a1 = cA + (size_t)(t + 1) * kstep;
            const char* a2 = last ? nA : cA + (size_t)(t + 2) * kstep; const char* b2 = last ? nB : cB + (size_t)(t + 2) * kstep;
            const char* a3 = a2 + kstep; const char* b3 = b2 + kstep;
            if (last && has_next) S.a_ready(nxt);
            if constexpr (SP2) {
            PG8_LDB(B0, 0, 0); PG8_LDB(B1, 0, 1); PG8_SCHED; PG8_LDA(At, 0, 0); PG8_STAGE(PG8_SA(1, 1), a1 + hstep, voffA);
            PG8_WAIT_V(8); PG8_WAIT_L(0); PG8_BAR; PG8_MMA(0, 0, At, B0); PG8_MMA(0, 1, At, B1); PG8_BAR; PG8_SCHED;
            PG8_LDA(At, 0, 1); PG8_STAGE(PG8_SB(0, 0), b2, voffB); PG8_STAGE(PG8_SB(0, 1), b2 + hstep, voffB); PG8_STAGE(PG8_SA(0, 0), a2, voffA);
            PG8_WAIT_V(8); PG8_WAIT_L(0); PG8_BAR; PG8_MMA(1, 0, At, B0); PG8_MMA(1, 1, At, B1); PG8_BAR; PG8_SCHED;
            PG8_LDB(B0, 1, 0); PG8_LDB(B1, 1, 1); PG8_SCHED; PG8_LDA(At, 1, 0); PG8_STAGE(PG8_SA(0, 1), a2 + hstep, voffA);
            PG8_WAIT_V(8); PG8_WAIT_L(0); PG8_BAR; PG8_MMA(0, 0, At, B0); PG8_MMA(0, 1, At, B1); PG8_BAR; PG8_SCHED;
            PG8_LDA(At, 1, 1); PG8_STAGE(PG8_SB(1, 0), b3, voffB); PG8_STAGE(PG8_SB(1, 1), b3 + hstep, voffB); PG8_STAGE(PG8_SA(1, 0), a3, voffA);
            PG8_WAIT_V(8); PG8_WAIT_L(0); PG8_BAR; PG8_MMA(1, 0, At, B0); PG8_MMA(1, 1, At, B1); PG8_BAR; PG8_SCHED;
            } else {
            PG8_LDB(B0, 0, 0); PG8_SCHED; PG8_LDA(At, 0, 0); PG8_STAGE(PG8_SA(1, 1), a1 + hstep, voffA);
            PG8_WAIT_L(8); PG8_BAR; PG8_WAIT_L(0); PG8_MMA(0, 0, At, B0); PG8_BAR; PG8_SCHED;
            PG8_LDB(B1, 0, 1); PG8_STAGE(PG8_SB(0, 0), b2, voffB);
            PG8_BAR; PG8_WAIT_L(0); PG8_MMA(0, 1, At, B1); PG8_BAR;
            PG8_LDA(At, 0, 1); PG8_STAGE(PG8_SA(0, 0), a2, voffA);
            PG8_BAR; PG8_WAIT_L(0); PG8_MMA(1, 0, At, B0); PG8_BAR; PG8_SCHED;
            PG8_STAGE(PG8_SB(0, 1), b2 + hstep, voffB);
            PG8_WAIT_V(6); PG8_BAR; PG8_MMA(1, 1, At, B1); PG8_BAR;
            PG8_LDB(B0, 1, 0); PG8_SCHED; PG8_LDA(At, 1, 0); PG8_STAGE(PG8_SA(0, 1), a2 + hstep, voffA);
            PG8_WAIT_L(8); PG8_BAR; PG8_WAIT_L(0); PG8_MMA(0, 0, At, B0); PG8_BAR; PG8_SCHED;
            PG8_LDB(B1, 1, 1); PG8_STAGE(PG8_SB(1, 0), b3, voffB);
            PG8_BAR; PG8_WAIT_L(0); PG8_MMA(0, 1, At, B1); PG8_BAR;
            PG8_LDA(At, 1, 1); PG8_STAGE(PG8_SA(1, 0), a3, voffA);
            PG8_BAR; PG8_WAIT_L(0); PG8_MMA(1, 0, At, B0); PG8_BAR; PG8_SCHED;
            PG8_STAGE(PG8_SB(1, 1), b3 + hstep, voffB);
            PG8_WAIT_V(6); PG8_BAR; PG8_MMA(1, 1, At, B1); PG8_BAR;
            }
        }
        if constexpr (ALIGN_EPI) { if (wr == 0) PG8_BAR; }
        if constexpr (!Epi::AFTER_DRAIN) { E(acc, cur, wr, wc, fr, fq); S.done(cur); }
        if (!has_next) break;
#pragma unroll
        for (int a = 0; a < 2; ++a)
#pragma unroll
            for (int b = 0; b < 2; ++b)
#pragma unroll
                for (int m = 0; m < 4; ++m)
#pragma unroll
                    for (int n = 0; n < 2; ++n) acc[a][b][m][n] = (f32x4){0.f, 0.f, 0.f, 0.f};
        cur = nxt; cA = nA; cB = nB; ++ui;
        if constexpr (ALIGN_EPI) { if (wr == 1) PG8_BAR; }
    }
    PG8_WAIT_V(0);
    if constexpr (!ALIGN_EPI) { if (wr == 0) PG8_BAR; }
    PG8_BAR;
    if constexpr (Epi::AFTER_DRAIN) { E.fused(acc, cur, wr, wc, fr, fq, lds, wid, lane); S.done(cur); }
#undef PG8_SA
#undef PG8_SB
#undef PG8_STAGE
#undef PG8_LDA
#undef PG8_LDB
#undef PG8_MMA
#undef PG8_WAIT_V
#undef PG8_WAIT_L
#undef PG8_BAR
#undef PG8_SCHED
}
}
namespace attn_body {
using bf16=__hip_bfloat16;
using bf16x8=__attribute__((ext_vector_type(8)))short;
using s16x4=__attribute__((ext_vector_type(4)))short;
using f32x16=__attribute__((ext_vector_type(16)))float;
using u32x4=__attribute__((ext_vector_type(4)))unsigned;
constexpr int D=64,QP=1024,KP=256;
constexpr int NW=8,QBLK=32,KVBLK=64;
__device__ __forceinline__ int crow(int r,int hi){return (r&3)+8*(r>>2)+4*hi;}
#define SBAR() __builtin_amdgcn_sched_barrier(0)
__device__ __forceinline__ void kmask(f32x16&p0,f32x16&p1,int rem,int hi){
  const float NEG=-INFINITY;
  #pragma unroll
  for(int r=0;r<16;++r){int kv=4*hi+(r&3)+8*(r>>2); if(kv>=rem)p0[r]=NEG; if(kv+32>=rem)p1[r]=NEG;}
}

constexpr int NSLOT=3, SLOTB=8192;
constexpr int LDS_K=0, LDS_V=NSLOT*SLOTB, LDS_WS=2*NSLOT*SLOTB, LDS_OST=LDS_WS+NW*64*4, LDS_BYTES=LDS_OST+NW*4096;
constexpr float C2=0.125f*1.4426950408889634f;
__device__ __forceinline__ void glds16(const void*gsrc,unsigned lds_dst){unsigned keep;
  asm volatile("s_mov_b32 %0, m0\n\ts_mov_b32 m0, %2\n\ts_nop 0\n\tglobal_load_lds_dwordx4 %1, off\n\ts_mov_b32 m0, %0":"=&s"(keep):"v"(gsrc),"s"(lds_dst):"memory");}
__device__ __forceinline__ float max3f(float a,float b,float c){float r;asm("v_max3_f32 %0, %1, %2, %3":"=v"(r):"v"(a),"v"(b),"v"(c));return r;}
__device__ __forceinline__ float max2f(float a,float b){float r;asm("v_max_f32_e32 %0, %1, %2":"=v"(r):"v"(a),"v"(b));return r;}
__device__ __forceinline__ float fadd_s(float a,float b){float r;asm("v_add_f32_e32 %0, %1, %2":"=v"(r):"v"(a),"v"(b));return r;}
__device__ __forceinline__ float fsub_s(float a,float b){float r;asm("v_sub_f32_e32 %0, %1, %2":"=v"(r):"v"(a),"v"(b));return r;}
typedef float f32x2_t __attribute__((ext_vector_type(2))); typedef __bf16 bf16x2_t __attribute__((ext_vector_type(2)));
__device__ __forceinline__ unsigned cvtpk_s(float lo,float hi){f32x2_t v={lo,hi};bf16x2_t b=__builtin_convertvector(v,bf16x2_t);return __builtin_bit_cast(unsigned,b);}
#define WAIT_BAR(N) asm volatile("s_waitcnt vmcnt(" #N ") lgkmcnt(0)\n\ts_barrier":::"memory")

__device__ __forceinline__ void qkt(f32x16&p0,f32x16&p1,const char*Kslot,const bf16x8*qr,const f32x16&negm,int r32,int hi){
  const char*kb=Kslot+hi*1024+r32*16;
  #pragma unroll
  for(int d0=0;d0<4;++d0){
    const bf16x8 b0=*reinterpret_cast<const bf16x8*>(kb+d0*2048);
    const bf16x8 b1=*reinterpret_cast<const bf16x8*>(kb+d0*2048+512);
    if(d0==0){p0=__builtin_amdgcn_mfma_f32_32x32x16_bf16(b0,qr[0],negm,0,0,0);p1=__builtin_amdgcn_mfma_f32_32x32x16_bf16(b1,qr[0],negm,0,0,0);}
    else{p0=__builtin_amdgcn_mfma_f32_32x32x16_bf16(b0,qr[d0],p0,0,0,0);p1=__builtin_amdgcn_mfma_f32_32x32x16_bf16(b1,qr[d0],p1,0,0,0);}}
}
typedef __attribute__((address_space(3))) const char* lds_cptr;
typedef short v4i16_t __attribute__((ext_vector_type(4)));
__device__ __forceinline__ void kload8(bf16x8*kf,lds_cptr kp){
  kf[0]=*(const __attribute__((address_space(3))) bf16x8*)(kp);      kf[1]=*(const __attribute__((address_space(3))) bf16x8*)(kp+512);
  kf[2]=*(const __attribute__((address_space(3))) bf16x8*)(kp+2048); kf[3]=*(const __attribute__((address_space(3))) bf16x8*)(kp+2560);
  kf[4]=*(const __attribute__((address_space(3))) bf16x8*)(kp+4096); kf[5]=*(const __attribute__((address_space(3))) bf16x8*)(kp+4608);
  kf[6]=*(const __attribute__((address_space(3))) bf16x8*)(kp+6144); kf[7]=*(const __attribute__((address_space(3))) bf16x8*)(kp+6656);
}
__device__ __forceinline__ void kload2(bf16x8*kf,lds_cptr kp,int j){ kf[2*j]=*(const __attribute__((address_space(3))) bf16x8*)(kp+j*2048); kf[2*j+1]=*(const __attribute__((address_space(3))) bf16x8*)(kp+j*2048+512); }
__device__ __forceinline__ s16x4 vtr(lds_cptr p){ return __builtin_bit_cast(s16x4,__builtin_amdgcn_ds_read_tr16_b64_v4i16((__attribute__((address_space(3))) v4i16_t*)p)); }
__device__ __forceinline__ float rowmax(const f32x16&p0,const f32x16&p1){
  float a=max3f(p0[0],p0[1],p1[0]),b=max3f(p0[2],p0[3],p1[1]);a=max3f(a,p1[2],p1[3]);
  #pragma unroll
  for(int r=4;r<16;r+=4){a=max3f(a,p0[r],p0[r+1]);b=max3f(b,p0[r+2],p0[r+3]);a=max3f(a,p1[r],p1[r+1]);b=max3f(b,p1[r+2],p1[r+3]);}
  const float m=max2f(a,b);
  auto rr=__builtin_amdgcn_permlane32_swap(__float_as_uint(m),__float_as_uint(m),false,false);
  return max2f(__uint_as_float(rr[0]),__uint_as_float(rr[1]));
}
__device__ __forceinline__ void pv(f32x16*o,int vb,bf16x8 pa0,bf16x8 pa1,bf16x8 pa2,bf16x8 pa3){
  #pragma unroll
  for(int d0=0;d0<2;++d0){s16x4 lo[4],hi[4];
    #pragma unroll
    for(int ks=0;ks<4;++ks){
      asm volatile("ds_read_b64_tr_b16 %0,%1 offset:%c2":"=&v"(lo[ks]):"v"(vb),"i"(d0*4096+ks*1024):"memory");
      asm volatile("ds_read_b64_tr_b16 %0,%1 offset:%c2":"=&v"(hi[ks]):"v"(vb),"i"(d0*4096+ks*1024+512):"memory");}
    asm volatile("s_waitcnt lgkmcnt(0)":::"memory");SBAR();
    #define PK(k) (bf16x8){lo[k][0],lo[k][1],lo[k][2],lo[k][3],hi[k][0],hi[k][1],hi[k][2],hi[k][3]}
    o[d0]=__builtin_amdgcn_mfma_f32_32x32x16_bf16(pa0,PK(0),o[d0],0,0,0);
    o[d0]=__builtin_amdgcn_mfma_f32_32x32x16_bf16(pa1,PK(1),o[d0],0,0,0);
    o[d0]=__builtin_amdgcn_mfma_f32_32x32x16_bf16(pa2,PK(2),o[d0],0,0,0);
    o[d0]=__builtin_amdgcn_mfma_f32_32x32x16_bf16(pa3,PK(3),o[d0],0,0,0);
    #undef PK
  }
}

#ifndef ATTN_STORE16
#define ATTN_STORE16(p,v) (*(u32x4*)(p)=(v))
#endif
template<int THRL,int L,int NT> __device__ __forceinline__ void attn_unit(long rowbase,int kvh,int qblk,const bf16*Q,const bf16*__restrict__ K,const bf16*__restrict__ V,bf16*O,char*shm,const int tid){
  const int lane=tid&63,r32=lane&31,hi=lane>>5; const int wid=__builtin_amdgcn_readfirstlane(tid>>6);
  const int q0=qblk*64, qh=wid>>1, rh=wid&1;
  const bf16*Qw=Q+(rowbase+q0+rh*QBLK)*QP+(4*kvh+qh)*D;
  const bf16*Kh=K+rowbase*KP+kvh*D,*Vh=V+rowbase*KP+kvh*D;
  const unsigned lds0=(unsigned)(uintptr_t)shm;
  float*wsf=(float*)(shm+LDS_WS)+wid*64;
  const bf16*ksrc=Kh+(long)lane*KP+wid*8;
  const bf16*vsrc=Vh+(long)(16*(wid&3)+(lane>>2))*KP+(wid>>2)*32+(lane&3)*8;
  const unsigned kdst=lds0+LDS_K+wid*1024, vdst=lds0+LDS_V+wid*1024;
  #define DMA_K(t,slot) glds16(ksrc+(long)(t)*KVBLK*KP,(unsigned)__builtin_amdgcn_readfirstlane(kdst+(slot)))
  #define DMA_V(t,slot) glds16(vsrc+(long)(t)*KVBLK*KP,(unsigned)__builtin_amdgcn_readfirstlane(vdst+(slot)))
  const int vb0=(int)(lds0+LDS_V)+((lane>>4)&1)*32+(lane&3)*8+(4*hi+((lane&15)>>2))*64;
  const char*Kbase=shm+LDS_K; bf16x8 kf[8];
  const lds_cptr shm3=(lds_cptr)shm; const lds_cptr kp0=shm3+LDS_K+hi*1024+r32*16; const lds_cptr vp0=shm3+LDS_V+((lane>>4)&1)*32+(lane&3)*8+(4*hi+((lane&15)>>2))*64;
  DMA_K(0,0);DMA_V(0,0);DMA_K(1,SLOTB);
  bf16x8 qr[4];
  #pragma unroll
  for(int d0=0;d0<4;++d0)qr[d0]=*reinterpret_cast<const bf16x8*>(&Qw[(long)r32*QP+d0*16+hi*8]);
  if(q0+rh*QBLK+r32>=L){
    #pragma unroll
    for(int d0=0;d0<4;++d0)qr[d0]=bf16x8{0,0,0,0,0,0,0,0}; }
  float mhat=0.f,l_reg=0.f;f32x16 o[2];o[0]=f32x16{};o[1]=f32x16{};f32x16 negm=f32x16{};asm volatile("":"+v"(negm));
  #define CMASK(P0,P1,t) do{ if((t)>=NT-2)kmask(P0,P1,L-64*(t),hi);}while(0)
  bool resc=false;
  #define START(P0,P1) do{ const float rm=rowmax(P0,P1); resc=false; \
    { const float dl=rm; mhat=fadd_s(mhat,dl); \
      _Pragma("unroll") for(int r=0;r<16;++r){P0[r]=fsub_s(P0[r],dl);P1[r]=fsub_s(P1[r],dl);} \
      _Pragma("unroll") for(int r=0;r<16;++r)negm[r]=-mhat; asm volatile("":"+v"(negm)); } \
    _Pragma("unroll") for(int r=0;r<16;++r)P0[r]=__builtin_amdgcn_exp2f(P0[r]); }while(0)
  #define RESC() do{ if(resc){ asm volatile("s_waitcnt lgkmcnt(0)":::"memory"); \
      _Pragma("unroll") for(int d_=0;d_<2;++d_) _Pragma("unroll") for(int r=0;r<16;++r)o[d_][r]*=wsf[crow(r,hi)]; } }while(0)
  f32x16 pA0,pA1,pB0,pB1;
  int sl_prev=0,sl_cur=0,sl_next=SLOTB;
  #define ROT() do{sl_prev=sl_cur;sl_cur=sl_next;sl_next=(sl_next==(NSLOT-1)*SLOTB)?0:sl_next+SLOTB;}while(0)
  DMA_K(2,2*SLOTB);
  WAIT_BAR(3);
  qkt(pA0,pA1,Kbase,qr,negm,r32,hi);asm volatile("s_nop 15\n\ts_nop 7":"+v"(pA0),"+v"(pA1));CMASK(pA0,pA1,0);
  START(pA0,pA1);
  _Pragma("unroll") for(int r=0;r<16;++r)pA1[r]=__builtin_amdgcn_exp2f(pA1[r]);
  WAIT_BAR(0);
  DMA_K(3,0);DMA_V(1,SLOTB);
  ROT();
  kload8(kf,kp0+sl_cur);
  WAIT_BAR(2);
  s16x4 vlo[8],vhi[8]; u32x4 pw0,pw1,pw2,pw3;
  #define PKW(P,B) cvtpk_s(P[B],P[B+1])
  #define PAF(k) __builtin_bit_cast(bf16x8,pw##k)
  #define VFR(i) (bf16x8){vlo[i][0],vlo[i][1],vlo[i][2],vlo[i][3],vhi[i][0],vhi[i][1],vhi[i][2],vhi[i][3]}
  #define PIN(x) asm volatile("":"+v"(x))
  #define MX3(a,b,c) __builtin_fmaxf(__builtin_fmaxf((a),(b)),(c))
  #define GAPA(MF,A0,A1,A2,A3,W0,W1,PW) do{ MF; sacc+=A0; sacc+=A1; sacc+=A2; sacc+=A3; PIN(sacc); W0; W1; PIN(PW); SBAR(); }while(0)
  #define EX(v) __builtin_amdgcn_exp2f(v)
  #define GAPB(MF,X,B) do{ MF; X[B]=EX(X[B]); X[B+1]=EX(X[B+1]); X[B+2]=EX(X[B+2]); X[B+3]=EX(X[B+3]); PIN(X); SBAR(); }while(0)
  #define VRD(i) do{ vlo[i]=vtr(vp_+(((i)>>2)*4096+((i)&3)*1024)); vhi[i]=vtr(vp_+(((i)>>2)*4096+((i)&3)*1024+512)); }while(0)
  #define KRD(G,j) do{ if(G){ kload2(kf,kp0+sl_next,j); SBAR(); } }while(0)
  #define STEP(C0,C1,P0,P1,t,GK,GV,GL) do{ SBAR(); \
    const lds_cptr vp_=vp0+sl_prev; \
    VRD(0); SBAR(); float sacc=(P0[0]+P0[1]); \
    GAPA(C0=__builtin_amdgcn_mfma_f32_32x32x16_bf16(kf[0],qr[0],negm,0,0,0), P0[2],P0[3],P0[4],P0[5],     pw0[0]=PKW(P0,0), pw0[1]=PKW(P0,2), pw0); \
    VRD(4); SBAR(); GAPA(C1=__builtin_amdgcn_mfma_f32_32x32x16_bf16(kf[1],qr[0],negm,0,0,0), P0[6],P0[7],P0[8],P0[9],     pw0[2]=PKW(P0,4), pw0[3]=PKW(P0,6), pw0); \
    VRD(1); SBAR(); GAPA(C0=__builtin_amdgcn_mfma_f32_32x32x16_bf16(kf[2],qr[1],C0,0,0,0),   P0[10],P0[11],P0[12],P0[13], pw1[0]=PKW(P0,8), pw1[1]=PKW(P0,10), pw1); \
    VRD(5); SBAR(); GAPA(C1=__builtin_amdgcn_mfma_f32_32x32x16_bf16(kf[3],qr[1],C1,0,0,0),   P0[14],P0[15],P1[0],P1[1],   pw1[2]=PKW(P0,12),pw1[3]=PKW(P0,14), pw1); \
    VRD(2); SBAR(); GAPA(C0=__builtin_amdgcn_mfma_f32_32x32x16_bf16(kf[4],qr[2],C0,0,0,0),   P1[2],P1[3],P1[4],P1[5],     pw2[0]=PKW(P1,0), pw2[1]=PKW(P1,2), pw2); \
    VRD(6); SBAR(); GAPA(C1=__builtin_amdgcn_mfma_f32_32x32x16_bf16(kf[5],qr[2],C1,0,0,0),   P1[6],P1[7],P1[8],P1[9],     pw2[2]=PKW(P1,4), pw2[3]=PKW(P1,6), pw2); \
    VRD(3); SBAR(); GAPA(C0=__builtin_amdgcn_mfma_f32_32x32x16_bf16(kf[6],qr[3],C0,0,0,0),   P1[10],P1[11],P1[12],P1[13], pw3[0]=PKW(P1,8), pw3[1]=PKW(P1,10), pw3); \
    VRD(7); SBAR(); GAPA(C1=__builtin_amdgcn_mfma_f32_32x32x16_bf16(kf[7],qr[3],C1,0,0,0),   P1[14],P1[15],0.f,0.f,       pw3[2]=PKW(P1,12),pw3[3]=PKW(P1,14), pw3); \
    l_reg+=sacc; \
    if(GK){DMA_K((t)+3,sl_cur);} if(GV){DMA_V((t)+1,sl_next);} \
    CMASK(C0,C1,t); \
    { float a=MX3(C0[0],C0[1],C1[0]),b=MX3(C0[2],C0[3],C1[1]); a=MX3(a,C1[2],C1[3]); \
      _Pragma("unroll") for(int r=4;r<16;r+=4){a=MX3(a,C0[r],C0[r+1]);b=MX3(b,C0[r+2],C0[r+3]);a=MX3(a,C1[r],C1[r+1]);b=MX3(b,C1[r+2],C1[r+3]);} \
      float rm=__builtin_fmaxf(a,b); { auto rr=__builtin_amdgcn_permlane32_swap(__float_as_uint(rm),__float_as_uint(rm),false,false); rm=__builtin_fmaxf(__uint_as_float(rr[0]),__uint_as_float(rr[1])); } \
      resc=false; \
      if(__builtin_expect(__any(rm>(float)THRL),0)){ const float dl=__builtin_fmaxf(rm,0.f); mhat+=dl; \
        _Pragma("unroll") for(int r=0;r<16;++r){C0[r]-=dl;C1[r]-=dl;} \
        _Pragma("unroll") for(int r=0;r<16;++r)negm[r]=-mhat; asm volatile("":"+v"(negm)); \
        const float f=__builtin_amdgcn_exp2f(-dl); l_reg*=f; if(hi==0)wsf[r32]=f; resc=true; } } \
    SBAR(); \
    GAPB(o[0]=__builtin_amdgcn_mfma_f32_32x32x16_bf16(PAF(0),VFR(0),o[0],0,0,0), C0,0); \
    GAPB(o[1]=__builtin_amdgcn_mfma_f32_32x32x16_bf16(PAF(0),VFR(4),o[1],0,0,0), C0,4); \
    KRD(GL,0); GAPB(o[0]=__builtin_amdgcn_mfma_f32_32x32x16_bf16(PAF(1),VFR(1),o[0],0,0,0), C0,8); \
    KRD(GL,1); GAPB(o[1]=__builtin_amdgcn_mfma_f32_32x32x16_bf16(PAF(1),VFR(5),o[1],0,0,0), C0,12); \
    KRD(GL,2); GAPB(o[0]=__builtin_amdgcn_mfma_f32_32x32x16_bf16(PAF(2),VFR(2),o[0],0,0,0), C1,0); \
    KRD(GL,3); GAPB(o[1]=__builtin_amdgcn_mfma_f32_32x32x16_bf16(PAF(2),VFR(6),o[1],0,0,0), C1,4); \
    GAPB(o[0]=__builtin_amdgcn_mfma_f32_32x32x16_bf16(PAF(3),VFR(3),o[0],0,0,0), C1,8); \
    GAPB(o[1]=__builtin_amdgcn_mfma_f32_32x32x16_bf16(PAF(3),VFR(7),o[1],0,0,0), C1,12); \
    }while(0)
  int t=1;
  #undef CMASK
  #define CMASK(P0,P1,t) do{}while(0)
  for(;t+5<NT;t+=2){
    STEP(pB0,pB1,pA0,pA1,t,true,true,true);     WAIT_BAR(2); RESC(); ROT();
    STEP(pA0,pA1,pB0,pB1,t+1,true,true,true);   WAIT_BAR(2); RESC(); ROT();
  }
  #undef CMASK
  #define CMASK(P0,P1,t) do{ if((t)>=NT-2)kmask(P0,P1,L-64*(t),hi);}while(0)
  #define ENDW(tt) do{ if((tt)+3<NT){WAIT_BAR(2);} else if((tt)+2<NT){WAIT_BAR(1);} else {WAIT_BAR(0);} }while(0)
  for(;t+1<NT;t+=2){
    STEP(pB0,pB1,pA0,pA1,t,(t+3<NT),(t+1<NT),(t+1<NT));       ENDW(t);   RESC(); ROT();
    STEP(pA0,pA1,pB0,pB1,t+1,(t+4<NT),(t+2<NT),(t+2<NT));     ENDW(t+1); RESC(); ROT();
  }
  STEP(pB0,pB1,pA0,pA1,NT-1,false,false,false); RESC();
  { float sacc=pB0[0]+pB0[1]; _Pragma("unroll") for(int r=2;r<16;++r)sacc+=pB0[r]; _Pragma("unroll") for(int r=0;r<16;++r)sacc+=pB1[r]; l_reg+=sacc;
    pw0=(u32x4){PKW(pB0,0),PKW(pB0,2),PKW(pB0,4),PKW(pB0,6)};pw1=(u32x4){PKW(pB0,8),PKW(pB0,10),PKW(pB0,12),PKW(pB0,14)};pw2=(u32x4){PKW(pB1,0),PKW(pB1,2),PKW(pB1,4),PKW(pB1,6)};pw3=(u32x4){PKW(pB1,8),PKW(pB1,10),PKW(pB1,12),PKW(pB1,14)};
    SBAR(); pv(o,vb0+sl_cur,PAF(0),PAF(1),PAF(2),PAF(3)); }
  #undef PKW
  #undef PAF
  #undef VFR
  #undef PIN
  #undef MX3
  #undef GAPA
  #undef GAPB
  #undef EX
  #undef VRD
  #undef KRD
  #undef STEP
  #undef ENDW
  {auto rr=__builtin_amdgcn_permlane32_swap(__float_as_uint(l_reg),__float_as_uint(l_reg),false,false);l_reg=__uint_as_float(rr[0])+__uint_as_float(rr[1]);}
  if(hi==0)wsf[32+r32]=l_reg;asm volatile("s_waitcnt lgkmcnt(0)":::"memory");
  float rli[16];
  #pragma unroll
  for(int r=0;r<16;++r)rli[r]=__builtin_amdgcn_rcpf(wsf[32+crow(r,hi)]);
  bf16*Ow=O+(rowbase+q0+rh*QBLK)*QP+(4*kvh+qh)*D;
  { bf16*stg=(bf16*)(shm+LDS_OST)+wid*2048;
    #pragma unroll
    for(int r=0;r<16;++r){const int orow=crow(r,hi);
      #pragma unroll
      for(int d0=0;d0<2;++d0)stg[orow*64+d0*32+r32]=__float2bfloat16(o[d0][r]*rli[r]);}
    asm volatile("s_waitcnt lgkmcnt(0)":::"memory");
    #pragma unroll
    for(int i=0;i<4;++i){const int row=i*8+(lane>>3),ch=lane&7; const u32x4 v=*(const u32x4*)(stg+row*64+ch*8); if(q0+rh*QBLK+row<L)ATTN_STORE16(Ow+(long)row*QP+ch*8,v);} }
  asm volatile("s_waitcnt lgkmcnt(0)\n\ts_barrier":::"memory");
  #undef DMA_K
  #undef DMA_V
  #undef CMASK
  #undef START
  #undef RESC
  #undef ROT
}
constexpr int ATTN_LDS_BYTES=LDS_BYTES;
#undef SBAR
#undef WAIT_BAR
}
constexpr int DM = 1024, FF = 2816, NLAYER = 4;
constexpr int LP = 4112, LS = 2064, NSEQ_P = 4, NSEQ_S = 16, ROWS_P = NSEQ_P * LP  , T_ROWS = ROWS_P + NSEQ_S * LS  ;
constexpr int TPAD = 49664, NMT = TPAD / 256;
constexpr int NWIN = 4608;
constexpr float NORM_EPS = 1e-6f;
constexpr float QSCALE = 0.125f * 1.4426950408889634f;
constexpr int ATT_UNITS_P = NSEQ_P * 4 * 65, ATT_UNITS_S = NSEQ_S * 4 * 33, ATT_UNITS = ATT_UNITS_P + ATT_UNITS_S;

constexpr size_t MiB = 1u << 20;
constexpr size_t WS_CTL = 0;
constexpr size_t WS_ROPE = MiB / 4;
constexpr size_t WS_HMETA = 3 * MiB / 2;
constexpr size_t WS_SSQ = 3 * MiB;
constexpr size_t WS_W = 8 * MiB;
constexpr size_t W_GU1 = 0, W_D1 = W_GU1 + (size_t)5632 * 1024 * 2, W_IN = W_D1 + (size_t)1024 * 2816 * 2, W_GC = W_IN + (size_t)NWIN * 1024 * 2, W_OC = W_GC + 2 * MiB,
                 W_GA = W_OC + 2 * MiB, W_OA = W_GA + 2 * MiB, W_M = W_OA + 2 * MiB, W_GU2 = W_M + 2 * MiB, W_D2 = W_GU2 + (size_t)5632 * 1024 * 2, W_END = W_D2 + (size_t)1024 * 2816 * 2;
constexpr size_t WS_HB = 64 * MiB;
constexpr size_t ROWB = (size_t)TPAD * 1024 * 2;
constexpr size_t WS_BIG = WS_HB + 98 * MiB;
constexpr size_t WS_Q = WS_BIG, WS_K = WS_Q + ROWB, WS_V = WS_K + ROWB / 4, WS_CB = WS_V + ROWB / 4, WS_Z = WS_CB + ROWB, WS_END = WS_Z + ROWB;
constexpr size_t WS_HID = WS_BIG;
constexpr size_t WS_SCR = WS_K;
static_assert(WS_ROPE + (size_t)LP * 64 * 4 <= WS_HMETA && WS_HMETA + (size_t)20 * 16 * 1024 * 4 <= WS_SSQ && WS_SSQ + (size_t)TPAD * 16 * 4 <= WS_W, "d_ws map (small regions)");
static_assert(W_END <= 56 * MiB && ROWB <= 98 * MiB && (size_t)TPAD * FF * 2 <= WS_END - WS_BIG && 256 * 131072 <= ROWB / 2, "d_ws map");

constexpr int RING_BYTES = 131072, MISC_OFF = RING_BYTES + 320, PTAB_OFF = RING_BYTES + 1024, LDS_BYTES = 147456;
constexpr int NWAVES = 8;

#define GAS __attribute__((address_space(1)))
#define LAS __attribute__((address_space(3)))
typedef unsigned short bf16;
typedef unsigned v4u __attribute__((ext_vector_type(4)));
typedef float f32x4 __attribute__((ext_vector_type(4)));
__device__ __forceinline__ unsigned f2bf(float f) { unsigned u = __builtin_bit_cast(unsigned, f); return (u + 0x7fffu + ((u >> 16) & 1u)) >> 16; }
__device__ __forceinline__ unsigned pk2(float lo, float hi) { return pg8::cvt_pk_bf16(lo, hi); }
__device__ __forceinline__ float bflo(unsigned u) { return __builtin_bit_cast(float, u << 16); }
__device__ __forceinline__ float bfhi(unsigned u) { return __builtin_bit_cast(float, u & 0xffff0000u); }
__device__ __forceinline__ float wave_sum(float v) {
#pragma unroll
    for (int o = 1; o < 64; o <<= 1) v += __shfl_xor(v, o);
    return v;
}
__device__ __forceinline__ void rowinfo(int r, int& pos, int& L) {
    if (r < ROWS_P) { L = LP; pos = r % LP; } else if (r < T_ROWS) { L = LS; pos = (r - ROWS_P) % LS; } else { L = 1 << 30; pos = 0; }
}
__device__ __forceinline__ float* hrow(int r, float* out, float* hmeta) {
    if (r < ROWS_P) { const int s = r / LP, pos = r - s * LP; return pos < 16 ? hmeta + (size_t)(s * 16 + pos) * DM : out + (size_t)(s * 4096 + pos - 16) * DM; }
    const int r2 = r - ROWS_P, s = r2 / LS, pos = r2 - s * LS;
    return pos < 16 ? hmeta + (size_t)((NSEQ_P + s) * 16 + pos) * DM : out + (size_t)NSEQ_P * 4096 * DM + (size_t)(s * 2048 + pos - 16) * DM;
}
__device__ __forceinline__ float sigmoidf_(float x) { return __builtin_amdgcn_rcpf(1.0f + __builtin_amdgcn_exp2f(-1.4426950408889634f * x)); }

struct PlainOrder : pg8::StaticOrder {
    const char* A; const char* Bt; size_t tstep;
    __device__ __forceinline__ const char* aptr(const pg8::Unit& u) const { return A + (size_t)u.pm * tstep; }
    __device__ __forceinline__ const char* bptr(const pg8::Unit& u) const { return Bt + (size_t)u.pn * tstep; }
};
struct ChainOrder {
    pg8::StaticOrder base; const char* A[4]; const char* B[4]; size_t tstep;
    __device__ __forceinline__ bool next(int i, pg8::Unit& u) const { if (!base.next(i >> 2, u)) return false; u.sub = i & 3; return true; }
    __device__ __forceinline__ const char* aptr(const pg8::Unit& u) const { const char* p = u.sub == 0 ? A[0] : u.sub == 1 ? A[1] : u.sub == 2 ? A[2] : A[3]; return p + (size_t)u.pm * tstep; }
    __device__ __forceinline__ const char* bptr(const pg8::Unit& u) const { const char* p = u.sub == 0 ? B[0] : u.sub == 1 ? B[1] : u.sub == 2 ? B[2] : B[3]; return p + (size_t)u.pn * tstep; }
    __device__ __forceinline__ void a_ready(const pg8::Unit&) const {}
    __device__ __forceinline__ void done(const pg8::Unit&) const {}
};

using pg8::f32x4; using pg8::u32x4; using pg8::Unit; using pg8::bf16_t;
typedef f32x4 Acc[2][2][4][2];
__device__ __forceinline__ u32x4 pack8(const f32x4 a, const f32x4 b) { u32x4 w; w.x = pk2(a[0], a[1]); w.y = pk2(a[2], a[3]); w.z = pk2(b[0], b[1]); w.w = pk2(b[2], b[3]); return w; }
__device__ __forceinline__ void unpack8(const u32x4 w, f32x4& a, f32x4& b) { a = (f32x4){bflo(w.x), bfhi(w.x), bflo(w.y), bfhi(w.y)}; b = (f32x4){bflo(w.z), bfhi(w.z), bflo(w.w), bfhi(w.w)}; }
__device__ __forceinline__ float rstd_of(const float* ssq, int row) { const f32x4* p = (const f32x4*)(ssq + (size_t)row * 16); const f32x4 a = p[0], b = p[1], c = p[2], d = p[3];
    const float s = (((a[0] + a[1]) + (a[2] + a[3])) + ((b[0] + b[1]) + (b[2] + b[3]))) + (((c[0] + c[1]) + (c[2] + c[3])) + ((d[0] + d[1]) + (d[2] + d[3])));
    return __builtin_amdgcn_rsqf(s * (1.0f / DM) + NORM_EPS); }

struct EpiSwiGLU {
    static constexpr bool PERM = true, AFTER_DRAIN = false;
    bf16_t* hid; const float* ssq;
    __device__ __forceinline__ void operator()(const Acc& acc, const Unit& u, int wr, int wc, int fr, int fq) const {
#pragma unroll
        for (int ai = 0; ai < 2; ++ai)
#pragma unroll
            for (int m = 0; m < 4; ++m) {
                const int row = u.pm * 256 + ai * 128 + wr * 64 + m * 16 + fr; const float rs = rstd_of(ssq, row);
                f32x4 o[2];
#pragma unroll
                for (int n = 0; n < 2; ++n)
#pragma unroll
                    for (int e = 0; e < 4; ++e) { const float g = acc[ai][0][m][n][e] * rs, up = acc[ai][1][m][n][e] * rs; o[n][e] = g * sigmoidf_(g) * up; }
                *(u32x4*)(hid + (size_t)row * FF + u.pn * 128 + wc * 32 + 8 * fq) = pack8(o[0], o[1]);
            }
    }
};
struct EpiResid {
    static constexpr bool PERM = true, AFTER_DRAIN = false;
    float* out; float* hmeta; bf16_t* hb; float* ssq_out; float scale;
    __device__ __forceinline__ void operator()(const Acc& acc, const Unit& u, int wr, int wc, int fr, int fq) const {
#pragma unroll
        for (int ai = 0; ai < 2; ++ai)
#pragma unroll
            for (int m = 0; m < 4; ++m) {
                const int row = u.pm * 256 + ai * 128 + wr * 64 + m * 16 + fr; const bool ok = row < T_ROWS;
                float ss = 0.f;
                if (ok) {
                    float* hp = hrow(row, out, hmeta) + u.pn * 256 + wc * 32 + 8 * fq; bf16_t* bp = hb + (size_t)row * DM + u.pn * 256 + wc * 32 + 8 * fq;
#pragma unroll
                    for (int bj = 0; bj < 2; ++bj) {
                        f32x4 a = *(const f32x4*)(hp + bj * 128), b = *(const f32x4*)(hp + bj * 128 + 4);
                        a = a + acc[ai][bj][m][0] * scale; b = b + acc[ai][bj][m][1] * scale;
                        *(f32x4*)(hp + bj * 128) = a; *(f32x4*)(hp + bj * 128 + 4) = b;
                        *(u32x4*)(bp + bj * 128) = pack8(a, b);
                        ss += (a[0] * a[0] + a[1] * a[1]) + (a[2] * a[2] + a[3] * a[3]) + (b[0] * b[0] + b[1] * b[1]) + (b[2] * b[2] + b[3] * b[3]);
                    }
                }
                ss += __shfl_xor(ss, 16); ss += __shfl_xor(ss, 32);
                if (ok && fq == 0) ssq_out[(size_t)row * 16 + u.pn * 4 + wc] = ss;
                if (m & 1) asm volatile("" ::: "memory");
            }
    }
};
struct EpiWin {
    static constexpr bool PERM = true, AFTER_DRAIN = false;
    bf16_t *q, *k, *v, *cb, *z; const float* ssq; const float* rope; const float* qg; const float* kg;
    __device__ __forceinline__ void operator()(const Acc& acc, const Unit& u, int wr, int wc, int fr, int fq) const {
        const int pn = u.pn;
        if (pn <= 4) {
            const float* g = pn < 4 ? qg : kg; const float osc = pn < 4 ? QSCALE : 1.0f;
            f32x4 G[2][2];
#pragma unroll
            for (int bj = 0; bj < 2; ++bj)
#pragma unroll
                for (int n = 0; n < 2; ++n) G[bj][n] = *(const f32x4*)(g + 32 * bj + 16 * n + 4 * fq) * osc;
#pragma unroll
            for (int ai = 0; ai < 2; ++ai)
#pragma unroll
                for (int m = 0; m < 4; ++m) {
                    const int row = u.pm * 256 + ai * 128 + wr * 64 + m * 16 + fr; const float rs = rstd_of(ssq, row);
                    int pos, L; rowinfo(row, pos, L);
                    f32x4 x[2][2]; float ss = 0.f;
#pragma unroll
                    for (int bj = 0; bj < 2; ++bj)
#pragma unroll
                        for (int n = 0; n < 2; ++n) { x[bj][n] = acc[ai][bj][m][n] * rs; const f32x4 t = x[bj][n] * x[bj][n]; ss += (t[0] + t[1]) + (t[2] + t[3]); }
                    ss += __shfl_xor(ss, 16); ss += __shfl_xor(ss, 32);
                    const float rn = __builtin_amdgcn_rsqf(ss * (1.0f / 64.0f) + NORM_EPS);
                    bf16_t* dst = pn < 4 ? q + (size_t)row * 1024 + (4 * pn + wc) * 64 + 8 * fq : k + (size_t)row * 256 + wc * 64 + 8 * fq;
#pragma unroll
                    for (int bj = 0; bj < 2; ++bj) {
                        const f32x4 c4 = *(const f32x4*)(rope + ((pos * 2 + bj) * 2 + 0) * 16 + 4 * fq), s4 = *(const f32x4*)(rope + ((pos * 2 + bj) * 2 + 1) * 16 + 4 * fq);
                        const f32x4 y1 = x[bj][0] * rn * G[bj][0], y2 = x[bj][1] * rn * G[bj][1];
                        const f32x4 o1 = y1 * c4 - y2 * s4, o2 = y2 * c4 + y1 * s4;
                        *(u32x4*)(dst + 32 * bj) = pack8(o1, o2);
                    }
                    if (m & 1) asm volatile("" ::: "memory");
                }
        } else if (pn < 10) {
            bf16_t* base; int pitch, c0;
            if (pn == 5) { base = v; pitch = 256; c0 = 0; } else { base = cb; pitch = 1024; c0 = 256 * (pn - 6); }
#pragma unroll
            for (int ai = 0; ai < 2; ++ai)
#pragma unroll
                for (int m = 0; m < 4; ++m) {
                    const int row = u.pm * 256 + ai * 128 + wr * 64 + m * 16 + fr; const float rs = rstd_of(ssq, row);
#pragma unroll
                    for (int bj = 0; bj < 2; ++bj) *(u32x4*)(base + (size_t)row * pitch + c0 + 128 * bj + wc * 32 + 8 * fq) = pack8(acc[ai][bj][m][0] * rs, acc[ai][bj][m][1] * rs);
                }
        } else {
#pragma unroll
            for (int ai = 0; ai < 2; ++ai)
#pragma unroll
                for (int m = 0; m < 4; ++m) {
                    const int row = u.pm * 256 + ai * 128 + wr * 64 + m * 16 + fr; const float rs = rstd_of(ssq, row), rs2 = rs * rs;
                    *(u32x4*)(z + (size_t)row * 1024 + 128 * (pn - 10) + wc * 32 + 8 * fq) = pack8(acc[ai][0][m][0] * acc[ai][1][m][0] * rs2, acc[ai][0][m][1] * acc[ai][1][m][1] * rs2);
                }
        }
    }
};
struct EpiMerge {
    static constexpr bool PERM = true, AFTER_DRAIN = false;
    bf16_t* merged; u32x4* scr; const float* ssq; int tid;
    __device__ __forceinline__ void operator()(const Acc& acc, const Unit& u, int wr, int wc, int fr, int fq) const {
        const int sub = u.sub;
#pragma unroll
        for (int ai = 0; ai < 2; ++ai)
#pragma unroll
            for (int m = 0; m < 4; ++m) {
                const int row = u.pm * 256 + ai * 128 + wr * 64 + m * 16 + fr;
                float rs = 1.f; if ((sub & 1) == 0) rs = rstd_of(ssq, row);
#pragma unroll
                for (int bj = 0; bj < 2; ++bj) {
                    u32x4* mp = (u32x4*)(merged + (size_t)row * DM + u.pn * 256 + bj * 128 + wc * 32 + 8 * fq);
                    u32x4* sp = scr + ((ai * 4 + m) * 2 + bj) * 512 + tid;
                    const f32x4 v0 = acc[ai][bj][m][0], v1 = acc[ai][bj][m][1];
                    if ((sub & 1) == 0) {
                        f32x4 s0, s1;
#pragma unroll
                        for (int e = 0; e < 4; ++e) { s0[e] = sigmoidf_(v0[e] * rs); s1[e] = sigmoidf_(v1[e] * rs); }
                        if (sub == 0) *mp = pack8(s0, s1); else *sp = pack8(s0, s1);
                    } else if (sub == 1) {
                        f32x4 g0, g1; unpack8(*mp, g0, g1); *mp = pack8(g0 * v0, g1 * v1);
                    } else {
                        f32x4 c0, c1, s0, s1; unpack8(*mp, c0, c1); unpack8(*sp, s0, s1); *mp = pack8(c0 + s0 * v0, c1 + s1 * v1);
                    }
                }
                if (m & 1) asm volatile("" ::: "memory");
            }
    }
};

__device__ __forceinline__ void cvt_item(const float* W, int Nsrc, int n0src, const float* gain, bool permqk, bf16* WT, int K, int nrow0, int k0, LAS float* scr, int lane) {
#pragma unroll 8
    for (int i = 0; i < 32; ++i) { const int kk = 2 * i + (lane >> 5); float w = W[(size_t)(k0 + kk) * Nsrc + n0src + (lane & 31)]; if (gain) w *= gain[k0 + kk]; scr[kk * 33 + (lane & 31)] = w; }
    asm volatile("s_waitcnt lgkmcnt(0)" ::: "memory");
    const int c = lane & 7;
#pragma unroll
    for (int j = 0; j < 4; ++j) { const int n = (lane >> 3) + 8 * j; const int ns = permqk ? (16 * ((n >> 2) & 1) + 4 * (n >> 3) + (n & 3)) : n; const LAS float* s = scr + (8 * c) * 33 + ns;
        v4u o; o.x = pk2(s[0 * 33], s[1 * 33]); o.y = pk2(s[2 * 33], s[3 * 33]); o.z = pk2(s[4 * 33], s[5 * 33]); o.w = pk2(s[6 * 33], s[7 * 33]);
        *(GAS v4u*)(WT + (size_t)(nrow0 + n) * K + k0 + 8 * c) = o; }
    asm volatile("s_waitcnt lgkmcnt(0)" ::: "memory");
}
struct Args { const float* in[21]; float* out; unsigned char* ws; int ph_lo, ph_hi; };
struct PT {
    volatile LAS unsigned long long* t;
    __device__ __forceinline__ unsigned long long get(int i) const { const unsigned long long v = t[i]; const unsigned lo = __builtin_amdgcn_readfirstlane((unsigned)v), hi = __builtin_amdgcn_readfirstlane((unsigned)(v >> 32)); return ((unsigned long long)hi << 32) | lo; }
    __device__ __forceinline__ const float* in(int i) const { return (const float*)get(i); }
    __device__ __forceinline__ float* out() const { return (float*)get(21); }
    __device__ __forceinline__ unsigned char* ws() const { return (unsigned char*)get(22); }
};

__device__ __forceinline__ void convert_layer(const PT a, unsigned char* ws, int l, LAS unsigned char* lds, int gw, int NGW, int wave, int lane) {
    LAS float* scr = (LAS float*)(lds + wave * 16384);
    bf16* W = (bf16*)(ws + WS_W);
    const size_t ffo = (size_t)l * DM * FF, sqo = (size_t)l * DM * DM;
    const float* win = a.in(8) + (size_t)l * DM * 6656; const float* mixg = a.in(7) + l * DM;
    for (int it = gw; it < 13312; it += NGW) {
        int r = it;
        if (r < 2816) { const int kb = r / 176, nb = r % 176, pn = nb >> 3, t = nb & 7; const float* src = (t >> 2) ? a.in(5) + ffo : a.in(4) + ffo;
            cvt_item(src, FF, 128 * pn + 32 * (t & 3), a.in(3) + l * DM, false, (bf16*)((char*)W + W_GU1), 1024, nb * 32, kb * 64, scr, lane); continue; } r -= 2816;
        if (r < 1408) { const int kb = r / 32, nb = r % 32; cvt_item(a.in(6) + ffo, DM, nb * 32, nullptr, false, (bf16*)((char*)W + W_D1), FF, nb * 32, kb * 64, scr, lane); continue; } r -= 1408;
        if (r < 2304) { const int kb = r / 144, nb = r % 144, pn = nb >> 3, t = nb & 7; int n0; bool pq = false;
            if (pn < 4) { n0 = 64 * (4 * pn + (t & 3)) + 32 * (t >> 2); pq = true; }
            else if (pn == 4) { n0 = 1024 + 64 * (t & 3) + 32 * (t >> 2); pq = true; }
            else if (pn == 5) n0 = 1280 + 32 * t;
            else if (pn < 10) n0 = 1536 + 256 * (pn - 6) + 32 * t;
            else n0 = ((t >> 2) ? 3584 : 2560) + 128 * (pn - 10) + 32 * (t & 3);
            cvt_item(win, 6656, n0, mixg, pq, (bf16*)((char*)W + W_IN), 1024, nb * 32, kb * 64, scr, lane); continue; } r -= 2304;
        if (r < 2560) { const int seg = r / 512, q = r % 512, kb = q / 32, nb = q % 32;
            const float* src; int ns, n0; const float* gn = nullptr; size_t dst;
            if (seg == 0) { src = win; ns = 6656; n0 = 5632 + nb * 32; gn = mixg; dst = W_GC; }
            else if (seg == 1) { src = a.in(14) + sqo; ns = DM; n0 = nb * 32; dst = W_OC; }
            else if (seg == 2) { src = win; ns = 6656; n0 = 4608 + nb * 32; gn = mixg; dst = W_GA; }
            else if (seg == 3) { src = a.in(13) + sqo; ns = DM; n0 = nb * 32; dst = W_OA; }
            else { src = a.in(15) + sqo; ns = DM; n0 = nb * 32; dst = W_M; }
            cvt_item(src, ns, n0, gn, false, (bf16*)((char*)W + dst), 1024, nb * 32, kb * 64, scr, lane); continue; } r -= 2560;
        if (r < 2816) { const int kb = r / 176, nb = r % 176, pn = nb >> 3, t = nb & 7; const float* src = (t >> 2) ? a.in(18) + ffo : a.in(17) + ffo;
            cvt_item(src, FF, 128 * pn + 32 * (t & 3), a.in(16) + l * DM, false, (bf16*)((char*)W + W_GU2), 1024, nb * 32, kb * 64, scr, lane); continue; } r -= 2816;
        { const int kb = r / 32, nb = r % 32; cvt_item(a.in(19) + ffo, DM, nb * 32, nullptr, false, (bf16*)((char*)W + W_D2), FF, nb * 32, kb * 64, scr, lane); }
    }
}

__device__ __forceinline__ void prologue(const PT a, unsigned char* ws, int tid, int wave, int lane, int bid, int G) {
    const int gtid = bid * 512 + tid, GT = G * 512, gw = bid * NWAVES + wave, NGW = G * NWAVES;
    float* ssq = (float*)(ws + WS_SSQ); bf16* hb = (bf16*)(ws + WS_HB); float* hmeta = (float*)(ws + WS_HMETA); float* rope = (float*)(ws + WS_ROPE);
    for (int i = gtid; i < (TPAD - T_ROWS) * 16; i += GT) ssq[(size_t)T_ROWS * 16 + i] = 0.f;
    for (int i = gtid; i < (TPAD - T_ROWS) * DM / 8; i += GT) ((v4u*)(hb + (size_t)T_ROWS * DM))[i] = (v4u){0u, 0u, 0u, 0u};
    if (gtid < 64) ((unsigned*)(ws + WS_CTL))[gtid] = 0u;
    for (int i = gtid; i < LP * 32; i += GT) {
        const int pos = i >> 5, axis = (i >> 4) & 1, f = i & 15;
        float coord; if (pos < 16) coord = axis ? (float)pos : -1.0f; else { const int t = pos - 16; coord = axis ? (float)(t & 63) : (float)(t >> 6); }
        const float inv = powf(10000.0f, -(float)f * (1.0f / 16.0f)); const float ang = coord * inv;
        float s, c; sincosf(ang, &s, &c);
        rope[((pos * 2 + axis) * 2 + 0) * 16 + f] = c; rope[((pos * 2 + axis) * 2 + 1) * 16 + f] = s;
    }
    for (int r = gw; r < T_ROWS; r += NGW) {
        int pos, L; rowinfo(r, pos, L);
        const float* src;
        if (pos < 16) src = a.in(2) + (size_t)pos * DM;
        else if (r < ROWS_P) src = a.in(0) + ((size_t)(r / LP) * 4096 + pos - 16) * DM;
        else src = a.in(1) + ((size_t)((r - ROWS_P) / LS) * 2048 + pos - 16) * DM;
        float* dst = hrow(r, a.out(), hmeta);
        f32x4 v[4]; float s = 0.f;
#pragma unroll
        for (int j = 0; j < 4; ++j) { v[j] = ((const f32x4*)src)[lane + 64 * j]; s += (v[j][0] * v[j][0] + v[j][1] * v[j][1]) + (v[j][2] * v[j][2] + v[j][3] * v[j][3]); }
        s = wave_sum(s);
        unsigned long long* o8 = (unsigned long long*)(hb + (size_t)r * DM) + lane;
#pragma unroll
        for (int j = 0; j < 4; ++j) { ((f32x4*)dst)[lane + 64 * j] = v[j]; o8[64 * j] = (unsigned long long)pk2(v[j][0], v[j][1]) | ((unsigned long long)pk2(v[j][2], v[j][3]) << 32); }
        if (lane < 16) ssq[(size_t)r * 16 + lane] = lane == 0 ? s : 0.f;
    }
}

__device__ __forceinline__ void conv_phase(const PT a, unsigned char* ws, int l, int tid, int bid, int G) {
    bf16* cb = (bf16*)(ws + WS_CB); const bf16* z = (const bf16*)(ws + WS_Z);
    const float* cw = a.in(9) + (size_t)l * 3 * DM; const float* cbias = a.in(10) + (size_t)l * DM;
    const int chunk = tid & 127, sub = tid >> 7, c0 = chunk * 8;
    f32x4 w0[2], w1[2], w2[2], bb[2];
#pragma unroll
    for (int h = 0; h < 2; ++h) { w0[h] = *(const f32x4*)(cw + c0 + 4 * h); w1[h] = *(const f32x4*)(cw + DM + c0 + 4 * h); w2[h] = *(const f32x4*)(cw + 2 * DM + c0 + 4 * h); bb[h] = *(const f32x4*)(cbias + c0 + 4 * h); }
    const int nstrip = (T_ROWS + 63) / 64;
    for (int strip = bid; strip < nstrip; strip += G) {
        const int r0 = strip * 64 + sub * 16;
#pragma unroll 4
        for (int i = 0; i < 16; ++i) {
            const int r = r0 + i; if (r >= T_ROWS) break;
            int pos, L; rowinfo(r, pos, L);
            const u32x4 zero = (u32x4){0u, 0u, 0u, 0u};
            const u32x4 zc = *(const u32x4*)(z + (size_t)r * DM + c0);
            const u32x4 zp = pos > 0 ? *(const u32x4*)(z + (size_t)(r - 1) * DM + c0) : zero;
            const u32x4 zn = pos < L - 1 ? *(const u32x4*)(z + (size_t)(r + 1) * DM + c0) : zero;
            u32x4* cp = (u32x4*)(cb + (size_t)r * DM + c0); const u32x4 cv = *cp;
            f32x4 p0, p1, c0v, c1v, n0, n1, b0, b1; unpack8(zp, p0, p1); unpack8(zc, c0v, c1v); unpack8(zn, n0, n1); unpack8(cv, b0, b1);
            const f32x4 o0 = b0 * (w0[0] * p0 + w1[0] * c0v + w2[0] * n0 + bb[0]), o1 = b1 * (w0[1] * p1 + w1[1] * c1v + w2[1] * n1 + bb[1]);
            *cp = pack8(o0, o1);
        }
    }
}

__device__ __forceinline__ void attention_phase(const PT a, unsigned char* ws, int l, unsigned char* lds_generic, int tid) {
    using abf = attn_body::bf16;
    const abf* Q = (const abf*)(ws + WS_Q); const abf* K = (const abf*)(ws + WS_K); const abf* V = (const abf*)(ws + WS_V); abf* O = (abf*)(ws + WS_Q);
    unsigned* ctr = (unsigned*)(ws + WS_CTL) + l;
    volatile unsigned* slot = (volatile unsigned*)(lds_generic + MISC_OFF);
    for (;;) {
        if (tid == 0) *slot = atomicAdd(ctr, 1u);
        __syncthreads();
        const int u = (int)__builtin_amdgcn_readfirstlane(*slot);
        if (u >= ATT_UNITS) break;
        int tidu = tid; asm volatile("" : "+v"(tidu));
        if (u < ATT_UNITS_P) { const int s = u / 260, rem = u - s * 260, kvh = rem / 65, qblk = rem - kvh * 65;
            attn_body::attn_unit<8, LP, 66>((long)s * LP, kvh, qblk, Q, K, V, O, (char*)lds_generic, tidu); }
        else { const int u2 = u - ATT_UNITS_P, s = u2 / 132, rem = u2 - s * 132, kvh = rem / 33, qblk = rem - kvh * 33;
            attn_body::attn_unit<8, LS, 34>((long)ROWS_P + (long)s * LS, kvh, qblk, Q, K, V, O, (char*)lds_generic, tidu); }
    }
}

__device__ __forceinline__ void final_phase(const PT a, unsigned char* ws, int wave, int lane, int bid, int G) {
    const int gw = bid * NWAVES + wave, NGW = G * NWAVES;
    const float* ssq = (const float*)(ws + WS_SSQ); float* hmeta = (float*)(ws + WS_HMETA);
    f32x4 g[4];
#pragma unroll
    for (int j = 0; j < 4; ++j) g[j] = ((const f32x4*)a.in(20))[lane + 64 * j];
    for (int r = gw; r < T_ROWS; r += NGW) {
        int pos, L; rowinfo(r, pos, L); if (pos < 16) continue;
        float* p = hrow(r, a.out(), hmeta); const float rs = rstd_of(ssq, r);
#pragma unroll
        for (int j = 0; j < 4; ++j) { f32x4 v = ((f32x4*)p)[lane + 64 * j]; ((f32x4*)p)[lane + 64 * j] = v * rs * g[j]; }
    }
}

constexpr int NSTEPS = 2 + 9 * NLAYER;

template <int STEP>
__device__ __forceinline__ void run_step(const PT pt, unsigned char* lds, cg::grid_group& grid, const int ph_lo, const int ph_hi) {
#ifdef MAX_STEP
    if (STEP >= MAX_STEP && STEP != NSTEPS - 1) return;
#endif
    if (STEP < ph_lo || STEP >= ph_hi) return;
    if (STEP > ph_lo) { __threadfence(); grid.sync(); }
    LAS unsigned char* l3 = (LAS unsigned char*)lds;
    int tid = threadIdx.x; asm volatile("" : "+v"(tid));
    int bid = blockIdx.x; asm volatile("" : "+s"(bid));
    int G = gridDim.x; asm volatile("" : "+s"(G));
    unsigned char* ws = pt.ws();
    const int lane = tid & 63, wave = __builtin_amdgcn_readfirstlane(tid >> 6);
    const int gw = bid * NWAVES + wave, NGW = G * NWAVES;
    float* ssq = (float*)(ws + WS_SSQ); float* hmeta = (float*)(ws + WS_HMETA);
    bf16_t* hb = (bf16_t*)(ws + WS_HB);
    if constexpr (STEP == 0) { prologue(pt, ws, tid, wave, lane, bid, G); }
    else if constexpr (STEP == NSTEPS - 1) { final_phase(pt, ws, wave, lane, bid, G); }
    else {
        constexpr int l = (STEP - 1) / 9, ph = (STEP - 1) % 9;
        if constexpr (ph == 0) {
#ifndef NO_CVT
            convert_layer(pt, ws, l, l3, gw, NGW, wave, lane);
#endif
            __syncthreads();
        } else if constexpr (ph == 1 || ph == 7) {
            constexpr int f = ph == 7;
            PlainOrder S; S.init(TPAD, 2 * FF, G, bid); S.A = (const char*)hb; S.Bt = (const char*)(ws + WS_W + (f ? W_GU2 : W_GU1)); S.tstep = (size_t)256 * 1024 * 2;
            pg8::Gemm g{nullptr, nullptr, TPAD, 2 * FF, 1024};
            EpiSwiGLU E{(bf16_t*)(ws + WS_HID), ssq};
#ifndef NO_GU
            pg8::gemm_phase<EpiSwiGLU, PlainOrder, true, true>(l3, g, S, E, tid);
#endif
        } else if constexpr (ph == 2 || ph == 6 || ph == 8) {
            constexpr int f = ph == 8; constexpr int K = ph == 6 ? 1024 : FF;
            PlainOrder S; S.init(TPAD, DM, G, bid);
            S.A = ph == 6 ? (const char*)(ws + WS_Z) : (const char*)(ws + WS_HID);
            S.Bt = (const char*)(ws + WS_W + (ph == 6 ? W_M : (f ? W_D2 : W_D1))); S.tstep = (size_t)256 * K * 2;
            pg8::Gemm g{nullptr, nullptr, TPAD, DM, K};
            EpiResid E{pt.out(), hmeta, hb, ssq, ph == 6 ? 1.0f : 0.5f};
#ifndef NO_RES
            pg8::gemm_phase<EpiResid, PlainOrder, true, true>(l3, g, S, E, tid);
#endif
        } else if constexpr (ph == 3) {
            PlainOrder S; S.init(TPAD, NWIN, G, bid); S.A = (const char*)hb; S.Bt = (const char*)(ws + WS_W + W_IN); S.tstep = (size_t)256 * 1024 * 2;
            pg8::Gemm g{nullptr, nullptr, TPAD, NWIN, 1024};
            EpiWin E{(bf16_t*)(ws + WS_Q), (bf16_t*)(ws + WS_K), (bf16_t*)(ws + WS_V), (bf16_t*)(ws + WS_CB), (bf16_t*)(ws + WS_Z), ssq,
                     (const float*)(ws + WS_ROPE), pt.in(11) + l * 64, pt.in(12) + l * 64};
#ifndef NO_WIN
            pg8::gemm_phase<EpiWin, PlainOrder, true, true>(l3, g, S, E, tid);
#endif
        } else if constexpr (ph == 4) {
#ifndef NO_CONV
            conv_phase(pt, ws, l, tid, bid, G);
#endif
#ifndef NO_ATT
            attention_phase(pt, ws, l, lds, tid);
#endif
        } else {
            ChainOrder S; S.base.init(TPAD, DM, G, bid); S.tstep = (size_t)256 * 1024 * 2;
            S.A[0] = (const char*)hb; S.A[1] = (const char*)(ws + WS_CB); S.A[2] = (const char*)hb; S.A[3] = (const char*)(ws + WS_Q);
            S.B[0] = (const char*)(ws + WS_W + W_GC); S.B[1] = (const char*)(ws + WS_W + W_OC); S.B[2] = (const char*)(ws + WS_W + W_GA); S.B[3] = (const char*)(ws + WS_W + W_OA);
            pg8::Gemm g{nullptr, nullptr, TPAD, DM, 1024};
            EpiMerge E{(bf16_t*)(ws + WS_Z), (u32x4*)(ws + WS_SCR + (size_t)bid * 131072), ssq, tid};
#ifndef NO_MERGE
            pg8::gemm_phase<EpiMerge, ChainOrder, true, true>(l3, g, S, E, tid);
#endif
        }
    }
}
template <int STEP>
__device__ __forceinline__ void run_from(const PT pt, unsigned char* lds, cg::grid_group& grid, const int ph_lo, const int ph_hi) {
    run_step<STEP>(pt, lds, grid, ph_lo, ph_hi);
    if constexpr (STEP + 1 < NSTEPS) run_from<STEP + 1>(pt, lds, grid, ph_lo, ph_hi);
}

__global__ void __launch_bounds__(NWAVES * 64, 2) mega_fwd(Args args) {
    extern __shared__ __attribute__((aligned(16))) unsigned char lds[];
    cg::grid_group grid = cg::this_grid();
    PT pt; pt.t = (volatile LAS unsigned long long*)((LAS unsigned char*)lds + PTAB_OFF);
    if (threadIdx.x == 0) {
#pragma unroll
        for (int i = 0; i < 21; ++i) pt.t[i] = (unsigned long long)args.in[i];
        pt.t[21] = (unsigned long long)args.out; pt.t[22] = (unsigned long long)args.ws;
    }
    const int ph_lo = args.ph_lo, ph_hi = args.ph_hi;
    __syncthreads();
    run_from<0>(pt, lds, grid, ph_lo, ph_hi);
}

#ifndef LAUNCH_PER_STEP
#define LAUNCH_PER_STEP 0
#endif
extern "C" void kernel_launch(void* const* d_in, const int* in_sizes, int n_in, void* d_out, int out_size, void* d_ws, size_t ws_size, hipStream_t stream) {
    static int grid = 0;
    if (grid == 0) {
        if (n_in != 21 || ws_size < WS_END) { fprintf(stderr, "kernel_launch: need 21 inputs and >= %zu bytes of workspace; got %d, %zu\n", (size_t)WS_END, n_in, ws_size); grid = -1; return; }
        int dev = 0, cus = 0, per_cu = 0;
        hipGetDevice(&dev); hipDeviceGetAttribute(&cus, hipDeviceAttributeMultiprocessorCount, dev);
        if (hipFuncSetAttribute((const void*)mega_fwd, hipFuncAttributeMaxDynamicSharedMemorySize, LDS_BYTES) != hipSuccess) { fprintf(stderr, "kernel_launch: hipFuncSetAttribute failed\n"); grid = -1; return; }
        if (hipOccupancyMaxActiveBlocksPerMultiprocessor(&per_cu, (const void*)mega_fwd, NWAVES * 64, LDS_BYTES) != hipSuccess || per_cu < 1) per_cu = 1;
        (void)hipGetLastError();
        grid = cus * per_cu;
    }
    if (grid < 0) return;
    Args a{};
    for (int i = 0; i < 21; ++i) a.in[i] = (const float*)d_in[i];
    a.out = (float*)d_out; a.ws = (unsigned char*)d_ws;
#if LAUNCH_PER_STEP
    for (int s = 0; s < NSTEPS; ++s) { a.ph_lo = s; a.ph_hi = s + 1; void* kargs[] = {&a}; hipLaunchCooperativeKernel((void*)mega_fwd, dim3(grid), dim3(NWAVES * 64), kargs, LDS_BYTES, stream); }
#else
    a.ph_lo = 0; a.ph_hi = NSTEPS; void* kargs[] = {&a};
    hipError_t e = hipLaunchCooperativeKernel((void*)mega_fwd, dim3(grid), dim3(NWAVES * 64), kargs, LDS_BYTES, stream);
    if (e != hipSuccess) fprintf(stderr, "cooperative launch failed: %s (grid %d)\n", hipGetErrorString(e), grid);
#endif
}
```

```cpp
#include <hip/hip_runtime.h>
#include <hip/hip_cooperative_groups.h>
#include <hip/hip_bf16.h>
#include <cstdio>
#include <cstdint>
#include <cmath>
namespace cg = cooperative_groups;
namespace pg8 {
#define PG8_LAS __attribute__((address_space(3)))
typedef unsigned short bf16_t;
typedef short bf16x8 __attribute__((ext_vector_type(8)));
typedef float f32x4 __attribute__((ext_vector_type(4)));
typedef unsigned u32x4 __attribute__((ext_vector_type(4)));
constexpr int BM = 256, BK = 64, HALF = 128, HTB = HALF * BK * 2  , STAGE_BYTES = 8 * HTB, NXCD = 8, WGM = 8;

__host__ __device__ __forceinline__ int lds_byte(int r, int c) { const int st = (r >> 4) * 2 + (c >> 5), rr = r & 15, cc = c & 31, ob = rr * 64 + cc * 2; return st * 1024 + (ob ^ (((ob >> 9) & 1) << 5)); }
__host__ __device__ __forceinline__ void stage_rc(int b, int& R, int& C) { const int st = b / 1024, sb = b % 1024, swz = sb ^ (((sb >> 9) & 1) << 5); R = (st >> 1) * 16 + swz / 64; C = (st & 1) * 32 + (swz % 64) / 2; }
__host__ __device__ __forceinline__ int perm32(int rho) { const int n = rho >> 4, i = rho & 15; return 8 * (i >> 2) + 4 * n + (i & 3); }

struct Unit { int pm, pn, sub; };
struct Gemm { const bf16_t* A; const bf16_t* Bt; int M, N, K; };

struct StaticOrder {
    int nM, nN, nwg, G, c;
    __host__ __device__ void init(int M, int N, int G_, int c_) { nM = M / BM; nN = N / BM; nwg = nM * nN; G = G_; c = c_; }
    __host__ __device__ bool next(int i, Unit& u) const {
        const long L = (long)i * G + c; if (L >= nwg) return false;
        int wgid = (int)L; { const int q = nwg / NXCD, r = nwg % NXCD, xcd = wgid % NXCD, off = wgid / NXCD; wgid = (xcd < r ? xcd * (q + 1) : r * (q + 1) + (xcd - r) * q) + off; }
        const int nig = WGM * nN, gid = wgid / nig, fm = gid * WGM, gsz = (nM - fm) < WGM ? (nM - fm) : WGM;
        u.pm = fm + ((wgid % nig) % gsz); u.pn = (wgid % nig) / gsz; u.sub = 0; return true;
    }
    __device__ __forceinline__ void a_ready(const Unit&) const {}
    __device__ __forceinline__ void done(const Unit&) const {}
};

__device__ __forceinline__ unsigned cvt_pk_bf16(float lo, float hi) { unsigned r; asm volatile("v_cvt_pk_bf16_f32 %0, %1, %2" : "=v"(r) : "v"(lo), "v"(hi)); return r; }
typedef float f32x2 __attribute__((ext_vector_type(2)));
template <class Epi, class Sched, bool ALIGN_EPI = false, bool SP2 = false>
__device__ __forceinline__ void gemm_phase(PG8_LAS unsigned char* lds, const Gemm g, const Sched& S, const Epi& E, const int tid) {
    const int wid = __builtin_amdgcn_readfirstlane(tid >> 6), lane = tid & 63, wr = wid >> 2, wc = wid & 3, fr = lane & 15, fq = lane >> 4;
    const int K = g.K, nt = K / BK;
    unsigned voffA[2], voffB[2];
#pragma unroll
    for (int i = 0; i < 2; ++i) { int R, C; stage_rc(tid * 16 + i * 8192, R, C); const int Rb = Epi::PERM ? ((R & ~31) + perm32(R & 31)) : R;
        voffA[i] = (unsigned)(R * K + C) * 2u; voffB[i] = (unsigned)(Rb * K + C) * 2u; }
    const size_t kstep = (size_t)(BK * 2);
    const size_t hstep = (size_t)HALF * K * 2;
        const unsigned ldsw = (unsigned)wid * 1024u;
    const int aoff = lds_byte(wr * 64 + fr, fq * 8), boff = lds_byte(wc * 32 + fr, fq * 8);
#define PG8_SA(b, h) (((b) * 2 + (h)) * HTB)
#define PG8_SB(b, h) ((4 + (b) * 2 + (h)) * HTB)
#define PG8_STAGE(bufoff, gbase, voff) do { _Pragma("unroll") for (int _i = 0; _i < 2; ++_i) \
        __builtin_amdgcn_global_load_lds((const unsigned*)((const char*)(gbase) + (voff)[_i]), (PG8_LAS unsigned*)(lds + (bufoff) + ldsw + _i * 8192), 16, 0, 0); } while (0)
#define PG8_LDA(dst, b, h) do { _Pragma("unroll") for (int m = 0; m < 4; ++m) _Pragma("unroll") for (int k = 0; k < 2; ++k) dst[m][k] = *(const PG8_LAS bf16x8*)(lds + PG8_SA(b, h) + aoff + m * 2048 + k * 1024); } while (0)
#define PG8_LDB(dst, b, h) do { _Pragma("unroll") for (int n = 0; n < 2; ++n) _Pragma("unroll") for (int k = 0; k < 2; ++k) dst[n][k] = *(const PG8_LAS bf16x8*)(lds + PG8_SB(b, h) + boff + n * 2048 + k * 1024); } while (0)
#define PG8_MMA(ai, bj, At, Bt) do { __builtin_amdgcn_s_setprio(1); _Pragma("unroll") for (int m = 0; m < 4; ++m) _Pragma("unroll") for (int n = 0; n < 2; ++n) _Pragma("unroll") for (int k = 0; k < 2; ++k) \
        acc[ai][bj][m][n] = __builtin_amdgcn_mfma_f32_16x16x32_bf16(Bt[n][k], At[m][k], acc[ai][bj][m][n], 0, 0, 0); __builtin_amdgcn_s_setprio(0); } while (0)
#define PG8_WAIT_V(n) asm volatile("s_waitcnt vmcnt(" #n ")" ::: "memory")
#define PG8_WAIT_L(n) asm volatile("s_waitcnt lgkmcnt(" #n ")" ::: "memory")
#define PG8_BAR __builtin_amdgcn_s_barrier()
#define PG8_SCHED __builtin_amdgcn_sched_barrier(0)
    Unit cur, nxt; int ui = 0;
    if (!S.next(0, cur)) return;
    f32x4 acc[2][2][4][2];
#pragma unroll
    for (int a = 0; a < 2; ++a)
#pragma unroll
        for (int b = 0; b < 2; ++b)
#pragma unroll
            for (int m = 0; m < 4; ++m)
#pragma unroll
                for (int n = 0; n < 2; ++n) acc[a][b][m][n] = (f32x4){0.f, 0.f, 0.f, 0.f};
    bf16x8 At[4][2], B0[2][2], B1[2][2];
    const char* cA = S.aptr(cur); const char* cB = S.bptr(cur);
    S.a_ready(cur);
    if constexpr (SP2) {
        PG8_STAGE(PG8_SB(0, 0), cB, voffB); PG8_STAGE(PG8_SB(0, 1), cB + hstep, voffB); PG8_STAGE(PG8_SA(0, 0), cA, voffA); PG8_STAGE(PG8_SA(0, 1), cA + hstep, voffA);
        if (wr == 1) PG8_BAR;
        PG8_WAIT_V(2); PG8_BAR;
        PG8_STAGE(PG8_SB(1, 0), cB + kstep, voffB); PG8_STAGE(PG8_SA(1, 0), cA + kstep, voffA); PG8_STAGE(PG8_SB(1, 1), cB + hstep + kstep, voffB);
        PG8_WAIT_V(6); PG8_BAR;
    } else {
        PG8_STAGE(PG8_SB(0, 0), cB, voffB); PG8_STAGE(PG8_SA(0, 0), cA, voffA); PG8_STAGE(PG8_SB(0, 1), cB + hstep, voffB); PG8_STAGE(PG8_SA(0, 1), cA + hstep, voffA);
        if (wr == 1) PG8_BAR;
        PG8_WAIT_V(4); PG8_BAR;
        PG8_STAGE(PG8_SB(1, 0), cB + kstep, voffB); PG8_STAGE(PG8_SA(1, 0), cA + kstep, voffA); PG8_STAGE(PG8_SB(1, 1), cB + hstep + kstep, voffB);
        PG8_WAIT_V(6); PG8_BAR;
    }
    for (;;) {
        const bool has_next = S.next(ui + 1, nxt);
        const char* nA = has_next ? S.aptr(nxt) : cA; const char* nB = has_next ? S.bptr(nxt) : cB;
        for (int t = 0; t < nt; t += 2) {
            const bool last = (t == nt - 2);
            const char* a1 = cA + (size_t)(t + 1) * kstep;
            const char* a2 = last ? nA : cA + (size_t)(t + 2) * kstep; const char* b2 = last ? nB : cB + (size_t)(t + 2) * kstep;
            const char* a3 = a2 + kstep; const char* b3 = b2 + kstep;
            if (last && has_next) S.a_ready(nxt);
            if constexpr (SP2) {
            PG8_LDB(B0, 0, 0); PG8_LDB(B1, 0, 1); PG8_SCHED; PG8_LDA(At, 0, 0); PG8_STAGE(PG8_SA(1, 1), a1 + hstep, voffA);
            PG8_WAIT_V(8); PG8_WAIT_L(0); PG8_BAR; PG8_MMA(0, 0, At, B0); PG8_MMA(0, 1, At, B1); PG8_BAR; PG8_SCHED;
            PG8_LDA(At, 0, 1); PG8_STAGE(PG8_SB(0, 0), b2, voffB); PG8_STAGE(PG8_SB(0, 1), b2 + hstep, voffB); PG8_STAGE(PG8_SA(0, 0), a2, voffA);
            PG8_WAIT_V(8); PG8_WAIT_L(0); PG8_BAR; PG8_MMA(1, 0, At, B0); PG8_MMA(1, 1, At, B1); PG8_BAR; PG8_SCHED;
            PG8_LDB(B0, 1, 0); PG8_LDB(B1, 1, 1); PG8_SCHED; PG8_LDA(At, 1, 0); PG8_STAGE(PG8_SA(0, 1), a2 + hstep, voffA);
            PG8_WAIT_V(8); PG8_WAIT_L(0); PG8_BAR; PG8_MMA(0, 0, At, B0); PG8_MMA(0, 1, At, B1); PG8_BAR; PG8_SCHED;
            PG8_LDA(At, 1, 1); PG8_STAGE(PG8_SB(1, 0), b3, voffB); PG8_STAGE(PG8_SB(1, 1), b3 + hstep, voffB); PG8_STAGE(PG8_SA(1, 0), a3, voffA);
            PG8_WAIT_V(8); PG8_WAIT_L(0); PG8_BAR; PG8_MMA(1, 0, At, B0); PG8_MMA(1, 1, At, B1); PG8_BAR; PG8_SCHED;
            } else {
            PG8_LDB(B0, 0, 0); PG8_SCHED; PG8_LDA(At, 0, 0); PG8_STAGE(PG8_SA(1, 1), a1 + hstep, voffA);
            PG8_WAIT_L(8); PG8_BAR; PG8_WAIT_L(0); PG8_MMA(0, 0, At, B0); PG8_BAR; PG8_SCHED;
            PG8_LDB(B1, 0, 1); PG8_STAGE(PG8_SB(0, 0), b2, voffB);
            PG8_BAR; PG8_WAIT_L(0); PG8_MMA(0, 1, At, B1); PG8_BAR;
            PG8_LDA(At, 0, 1); PG8_STAGE(PG8_SA(0, 0), a2, voffA);
            PG8_BAR; PG8_WAIT_L(0); PG8_MMA(1, 0, At, B0); PG8_BAR; PG8_SCHED;
            PG8_STAGE(PG8_SB(0, 1), b2 + hstep, voffB);
            PG8_WAIT_V(6); PG8_BAR; PG8_MMA(1, 1, At, B1); PG8_BAR;
            PG8_LDB(B0, 1, 0); PG8_SCHED; PG8_LDA(At, 1, 0); PG8_STAGE(PG8_SA(0, 1), a2 + hstep, voffA);
            PG8_WAIT_L(8); PG8_BAR; PG8_WAIT_L(0); PG8_MMA(0, 0, At, B0); PG8_BAR; PG8_SCHED;
            PG8_LDB(B1, 1, 1); PG8_STAGE(PG8_SB(1, 0), b3, voffB);
            PG8_BAR; PG8_WAIT_L(0); PG8_MMA(0, 1, At, B1); PG8_BAR;
            PG8_LDA(At, 1, 1); PG8_STAGE(PG8_SA(1, 0), a3, voffA);
            PG8_BAR; PG8_WAIT_L(0); PG8_MMA(1, 0, At, B0); PG8_BAR; PG8_SCHED;
            PG8_STAGE(PG8_SB(1, 1), b3 + hstep, voffB);
            PG8_WAIT_V(6); PG8_BAR; PG8_MMA(1, 1, At, B1); PG8_BAR;
            }
        }
        if constexpr (ALIGN_EPI) { if (wr == 0) PG8_BAR; }
        if constexpr (!Epi::AFTER_DRAIN) { E(acc, cur, wr, wc, fr, fq); S.done(cur); }
        if (!has_next) break;
#pragma unroll
        for (int a = 0; a < 2; ++a)
#pragma unroll
            for (int b = 0; b < 2; ++b)
#pragma unroll
                for (int m = 0; m < 4; ++m)
#pragma unroll
                    for (int n = 0; n < 2; ++n) acc[a][b][m][n] = (f32x4){0.f, 0.f, 0.f, 0.f};
        cur = nxt; cA = nA; cB = nB; ++ui;
        if constexpr (ALIGN_EPI) { if (wr == 1) PG8_BAR; }
    }
    PG8_WAIT_V(0);
    if constexpr (!ALIGN_EPI) { if (wr == 0) PG8_BAR; }
    PG8_BAR;
    if constexpr (Epi::AFTER_DRAIN) { E.fused(acc, cur, wr, wc, fr, fq, lds, wid, lane); S.done(cur); }
#undef PG8_SA
#undef PG8_SB
#undef PG8_STAGE
#undef PG8_LDA
#undef PG8_LDB
#undef PG8_MMA
#undef PG8_WAIT_V
#undef PG8_WAIT_L
#undef PG8_BAR
#undef PG8_SCHED
}
}
namespace attn_body {
using bf16=__hip_bfloat16;
using bf16x8=__attribute__((ext_vector_type(8)))short;
using s16x4=__attribute__((ext_vector_type(4)))short;
using f32x16=__attribute__((ext_vector_type(16)))float;
using u32x4=__attribute__((ext_vector_type(4)))unsigned;
constexpr int D=64,QP=1024,KP=256;
constexpr int NW=8,QBLK=32,KVBLK=64;
__device__ __forceinline__ int crow(int r,int hi){return (r&3)+8*(r>>2)+4*hi;}
#define SBAR() __builtin_amdgcn_sched_barrier(0)
__device__ __forceinline__ void kmask(f32x16&p0,f32x16&p1,int rem,int hi){
  const float NEG=-INFINITY;
  #pragma unroll
  for(int r=0;r<16;++r){int kv=4*hi+(r&3)+8*(r>>2); if(kv>=rem)p0[r]=NEG; if(kv+32>=rem)p1[r]=NEG;}
}

constexpr int NSLOT=3, SLOTB=8192;
constexpr int LDS_K=0, LDS_V=NSLOT*SLOTB, LDS_WS=2*NSLOT*SLOTB, LDS_OST=LDS_WS+NW*64*4, LDS_BYTES=LDS_OST+NW*4096;
constexpr float C2=0.125f*1.4426950408889634f;
__device__ __forceinline__ void glds16(const void*gsrc,unsigned lds_dst){unsigned keep;
  asm volatile("s_mov_b32 %0, m0\n\ts_mov_b32 m0, %2\n\ts_nop 0\n\tglobal_load_lds_dwordx4 %1, off\n\ts_mov_b32 m0, %0":"=&s"(keep):"v"(gsrc),"s"(lds_dst):"memory");}
__device__ __forceinline__ float max3f(float a,float b,float c){float r;asm("v_max3_f32 %0, %1, %2, %3":"=v"(r):"v"(a),"v"(b),"v"(c));return r;}
__device__ __forceinline__ float max2f(float a,float b){float r;asm("v_max_f32_e32 %0, %1, %2":"=v"(r):"v"(a),"v"(b));return r;}
__device__ __forceinline__ float fadd_s(float a,float b){float r;asm("v_add_f32_e32 %0, %1, %2":"=v"(r):"v"(a),"v"(b));return r;}
__device__ __forceinline__ float fsub_s(float a,float b){float r;asm("v_sub_f32_e32 %0, %1, %2":"=v"(r):"v"(a),"v"(b));return r;}
typedef float f32x2_t __attribute__((ext_vector_type(2))); typedef __bf16 bf16x2_t __attribute__((ext_vector_type(2)));
__device__ __forceinline__ unsigned cvtpk_s(float lo,float hi){f32x2_t v={lo,hi};bf16x2_t b=__builtin_convertvector(v,bf16x2_t);return __builtin_bit_cast(unsigned,b);}
#define WAIT_BAR(N) asm volatile("s_waitcnt vmcnt(" #N ") lgkmcnt(0)\n\ts_barrier":::"memory")

__device__ __forceinline__ void qkt(f32x16&p0,f32x16&p1,const char*Kslot,const bf16x8*qr,const f32x16&negm,int r32,int hi){
  const char*kb=Kslot+hi*1024+r32*16;
  #pragma unroll
  for(int d0=0;d0<4;++d0){
    const bf16x8 b0=*reinterpret_cast<const bf16x8*>(kb+d0*2048);
    const bf16x8 b1=*reinterpret_cast<const bf16x8*>(kb+d0*2048+512);
    if(d0==0){p0=__builtin_amdgcn_mfma_f32_32x32x16_bf16(b0,qr[0],negm,0,0,0);p1=__builtin_amdgcn_mfma_f32_32x32x16_bf16(b1,qr[0],negm,0,0,0);}
    else{p0=__builtin_amdgcn_mfma_f32_32x32x16_bf16(b0,qr[d0],p0,0,0,0);p1=__builtin_amdgcn_mfma_f32_32x32x16_bf16(b1,qr[d0],p1,0,0,0);}}
}
typedef __attribute__((address_space(3))) const char* lds_cptr;
typedef short v4i16_t __attribute__((ext_vector_type(4)));
__device__ __forceinline__ void kload8(bf16x8*kf,lds_cptr kp){
  kf[0]=*(const __attribute__((address_space(3))) bf16x8*)(kp);      kf[1]=*(const __attribute__((address_space(3))) bf16x8*)(kp+512);
  kf[2]=*(const __attribute__((address_space(3))) bf16x8*)(kp+2048); kf[3]=*(const __attribute__((address_space(3))) bf16x8*)(kp+2560);
  kf[4]=*(const __attribute__((address_space(3))) bf16x8*)(kp+4096); kf[5]=*(const __attribute__((address_space(3))) bf16x8*)(kp+4608);
  kf[6]=*(const __attribute__((address_space(3))) bf16x8*)(kp+6144); kf[7]=*(const __attribute__((address_space(3))) bf16x8*)(kp+6656);
}
__device__ __forceinline__ void kload2(bf16x8*kf,lds_cptr kp,int j){ kf[2*j]=*(const __attribute__((address_space(3))) bf16x8*)(kp+j*2048); kf[2*j+1]=*(const __attribute__((address_space(3))) bf16x8*)(kp+j*2048+512); }
__device__ __forceinline__ s16x4 vtr(lds_cptr p){ return __builtin_bit_cast(s16x4,__builtin_amdgcn_ds_read_tr16_b64_v4i16((__attribute__((address_space(3))) v4i16_t*)p)); }
__device__ __forceinline__ float rowmax(const f32x16&p0,const f32x16&p1){
  float a=max3f(p0[0],p0[1],p1[0]),b=max3f(p0[2],p0[3],p1[1]);a=max3f(a,p1[2],p1[3]);
  #pragma unroll
  for(int r=4;r<16;r+=4){a=max3f(a,p0[r],p0[r+1]);b=max3f(b,p0[r+2],p0[r+3]);a=max3f(a,p1[r],p1[r+1]);b=max3f(b,p1[r+2],p1[r+3]);}
  const float m=max2f(a,b);
  auto rr=__builtin_amdgcn_permlane32_swap(__float_as_uint(m),__float_as_uint(m),false,false);
  return max2f(__uint_as_float(rr[0]),__uint_as_float(rr[1]));
}
__device__ __forceinline__ void pv(f32x16*o,int vb,bf16x8 pa0,bf16x8 pa1,bf16x8 pa2,bf16x8 pa3){
  #pragma unroll
  for(int d0=0;d0<2;++d0){s16x4 lo[4],hi[4];
    #pragma unroll
    for(int ks=0;ks<4;++ks){
      asm volatile("ds_read_b64_tr_b16 %0,%1 offset:%c2":"=&v"(lo[ks]):"v"(vb),"i"(d0*4096+ks*1024):"memory");
      asm volatile("ds_read_b64_tr_b16 %0,%1 offset:%c2":"=&v"(hi[ks]):"v"(vb),"i"(d0*4096+ks*1024+512):"memory");}
    asm volatile("s_waitcnt lgkmcnt(0)":::"memory");SBAR();
    #define PK(k) (bf16x8){lo[k][0],lo[k][1],lo[k][2],lo[k][3],hi[k][0],hi[k][1],hi[k][2],hi[k][3]}
    o[d0]=__builtin_amdgcn_mfma_f32_32x32x16_bf16(pa0,PK(0),o[d0],0,0,0);
    o[d0]=__builtin_amdgcn_mfma_f32_32x32x16_bf16(pa1,PK(1),o[d0],0,0,0);
    o[d0]=__builtin_amdgcn_mfma_f32_32x32x16_bf16(pa2,PK(2),o[d0],0,0,0);
    o[d0]=__builtin_amdgcn_mfma_f32_32x32x16_bf16(pa3,PK(3),o[d0],0,0,0);
    #undef PK
  }
}

#ifndef ATTN_STORE16
#define ATTN_STORE16(p,v) (*(u32x4*)(p)=(v))
#endif
template<int THRL,int L,int NT> __device__ __forceinline__ void attn_unit(long rowbase,int kvh,int qblk,const bf16*Q,const bf16*__restrict__ K,const bf16*__restrict__ V,bf16*O,char*shm,const int tid){
  const int lane=tid&63,r32=lane&31,hi=lane>>5; const int wid=__builtin_amdgcn_readfirstlane(tid>>6);
  const int q0=qblk*64, qh=wid>>1, rh=wid&1;
  const bf16*Qw=Q+(rowbase+q0+rh*QBLK)*QP+(4*kvh+qh)*D;
  const bf16*Kh=K+rowbase*KP+kvh*D,*Vh=V+rowbase*KP+kvh*D;
  const unsigned lds0=(unsigned)(uintptr_t)shm;
  float*wsf=(float*)(shm+LDS_WS)+wid*64;
  const bf16*ksrc=Kh+(long)lane*KP+wid*8;
  const bf16*vsrc=Vh+(long)(16*(wid&3)+(lane>>2))*KP+(wid>>2)*32+(lane&3)*8;
  const unsigned kdst=lds0+LDS_K+wid*1024, vdst=lds0+LDS_V+wid*1024;
  #define DMA_K(t,slot) glds16(ksrc+(long)(t)*KVBLK*KP,(unsigned)__builtin_amdgcn_readfirstlane(kdst+(slot)))
  #define DMA_V(t,slot) glds16(vsrc+(long)(t)*KVBLK*KP,(unsigned)__builtin_amdgcn_readfirstlane(vdst+(slot)))
  const int vb0=(int)(lds0+LDS_V)+((lane>>4)&1)*32+(lane&3)*8+(4*hi+((lane&15)>>2))*64;
  const char*Kbase=shm+LDS_K; bf16x8 kf[8];
  const lds_cptr shm3=(lds_cptr)shm; const lds_cptr kp0=shm3+LDS_K+hi*1024+r32*16; const lds_cptr vp0=shm3+LDS_V+((lane>>4)&1)*32+(lane&3)*8+(4*hi+((lane&15)>>2))*64;
  DMA_K(0,0);DMA_V(0,0);DMA_K(1,SLOTB);
  bf16x8 qr[4];
  #pragma unroll
  for(int d0=0;d0<4;++d0)qr[d0]=*reinterpret_cast<const bf16x8*>(&Qw[(long)r32*QP+d0*16+hi*8]);
  if(q0+rh*QBLK+r32>=L){
    #pragma unroll
    for(int d0=0;d0<4;++d0)qr[d0]=bf16x8{0,0,0,0,0,0,0,0}; }
  float mhat=0.f,l_reg=0.f;f32x16 o[2];o[0]=f32x16{};o[1]=f32x16{};f32x16 negm=f32x16{};asm volatile("":"+v"(negm));
  #define CMASK(P0,P1,t) do{ if((t)>=NT-2)kmask(P0,P1,L-64*(t),hi);}while(0)
  bool resc=false;
  #define START(P0,P1) do{ const float rm=rowmax(P0,P1); resc=false; \
    { const float dl=rm; mhat=fadd_s(mhat,dl); \
      _Pragma("unroll") for(int r=0;r<16;++r){P0[r]=fsub_s(P0[r],dl);P1[r]=fsub_s(P1[r],dl);} \
      _Pragma("unroll") for(int r=0;r<16;++r)negm[r]=-mhat; asm volatile("":"+v"(negm)); } \
    _Pragma("unroll") for(int r=0;r<16;++r)P0[r]=__builtin_amdgcn_exp2f(P0[r]); }while(0)
  #define RESC() do{ if(resc){ asm volatile("s_waitcnt lgkmcnt(0)":::"memory"); \
      _Pragma("unroll") for(int d_=0;d_<2;++d_) _Pragma("unroll") for(int r=0;r<16;++r)o[d_][r]*=wsf[crow(r,hi)]; } }while(0)
  f32x16 pA0,pA1,pB0,pB1;
  int sl_prev=0,sl_cur=0,sl_next=SLOTB;
  #define ROT() do{sl_prev=sl_cur;sl_cur=sl_next;sl_next=(sl_next==(NSLOT-1)*SLOTB)?0:sl_next+SLOTB;}while(0)
  DMA_K(2,2*SLOTB);
  WAIT_BAR(3);
  qkt(pA0,pA1,Kbase,qr,negm,r32,hi);asm volatile("s_nop 15\n\ts_nop 7":"+v"(pA0),"+v"(pA1));CMASK(pA0,pA1,0);
  START(pA0,pA1);
  _Pragma("unroll") for(int r=0;r<16;++r)pA1[r]=__builtin_amdgcn_exp2f(pA1[r]);
  WAIT_BAR(0);
  DMA_K(3,0);DMA_V(1,SLOTB);
  ROT();
  kload8(kf,kp0+sl_cur);
  WAIT_BAR(2);
  s16x4 vlo[8],vhi[8]; u32x4 pw0,pw1,pw2,pw3;
  #define PKW(P,B) cvtpk_s(P[B],P[B+1])
  #define PAF(k) __builtin_bit_cast(bf16x8,pw##k)
  #define VFR(i) (bf16x8){vlo[i][0],vlo[i][1],vlo[i][2],vlo[i][3],vhi[i][0],vhi[i][1],vhi[i][2],vhi[i][3]}
  #define PIN(x) asm volatile("":"+v"(x))
  #define MX3(a,b,c) __builtin_fmaxf(__builtin_fmaxf((a),(b)),(c))
  #define GAPA(MF,A0,A1,A2,A3,W0,W1,PW) do{ MF; sacc+=A0; sacc+=A1; sacc+=A2; sacc+=A3; PIN(sacc); W0; W1; PIN(PW); SBAR(); }while(0)
  #define EX(v) __builtin_amdgcn_exp2f(v)
  #define GAPB(MF,X,B) do{ MF; X[B]=EX(X[B]); X[B+1]=EX(X[B+1]); X[B+2]=EX(X[B+2]); X[B+3]=EX(X[B+3]); PIN(X); SBAR(); }while(0)
  #define VRD(i) do{ vlo[i]=vtr(vp_+(((i)>>2)*4096+((i)&3)*1024)); vhi[i]=vtr(vp_+(((i)>>2)*4096+((i)&3)*1024+512)); }while(0)
  #define KRD(G,j) do{ if(G){ kload2(kf,kp0+sl_next,j); SBAR(); } }while(0)
  #define STEP(C0,C1,P0,P1,t,GK,GV,GL) do{ SBAR(); \
    const lds_cptr vp_=vp0+sl_prev; \
    VRD(0); SBAR(); float sacc=(P0[0]+P0[1]); \
    GAPA(C0=__builtin_amdgcn_mfma_f32_32x32x16_bf16(kf[0],qr[0],negm,0,0,0), P0[2],P0[3],P0[4],P0[5],     pw0[0]=PKW(P0,0), pw0[1]=PKW(P0,2), pw0); \
    VRD(4); SBAR(); GAPA(C1=__builtin_amdgcn_mfma_f32_32x32x16_bf16(kf[1],qr[0],negm,0,0,0), P0[6],P0[7],P0[8],P0[9],     pw0[2]=PKW(P0,4), pw0[3]=PKW(P0,6), pw0); \
    VRD(1); SBAR(); GAPA(C0=__builtin_amdgcn_mfma_f32_32x32x16_bf16(kf[2],qr[1],C0,0,0,0),   P0[10],P0[11],P0[12],P0[13], pw1[0]=PKW(P0,8), pw1[1]=PKW(P0,10), pw1); \
    VRD(5); SBAR(); GAPA(C1=__builtin_amdgcn_mfma_f32_32x32x16_bf16(kf[3],qr[1],C1,0,0,0),   P0[14],P0[15],P1[0],P1[1],   pw1[2]=PKW(P0,12),pw1[3]=PKW(P0,14), pw1); \
    VRD(2); SBAR(); GAPA(C0=__builtin_amdgcn_mfma_f32_32x32x16_bf16(kf[4],qr[2],C0,0,0,0),   P1[2],P1[3],P1[4],P1[5],     pw2[0]=PKW(P1,0), pw2[1]=PKW(P1,2), pw2); \
    VRD(6); SBAR(); GAPA(C1=__builtin_amdgcn_mfma_f32_32x32x16_bf16(kf[5],qr[2],C1,0,0,0),   P1[6],P1[7],P1[8],P1[9],     pw2[2]=PKW(P1,4), pw2[3]=PKW(P1,6), pw2); \
    VRD(3); SBAR(); GAPA(C0=__builtin_amdgcn_mfma_f32_32x32x16_bf16(kf[6],qr[3],C0,0,0,0),   P1[10],P1[11],P1[12],P1[13], pw3[0]=PKW(P1,8), pw3[1]=PKW(P1,10), pw3); \
    VRD(7); SBAR(); GAPA(C1=__builtin_amdgcn_mfma_f32_32x32x16_bf16(kf[7],qr[3],C1,0,0,0),   P1[14],P1[15],0.f,0.f,       pw3[2]=PKW(P1,12),pw3[3]=PKW(P1,14), pw3); \
    l_reg+=sacc; \
    if(GK){DMA_K((t)+3,sl_cur);} if(GV){DMA_V((t)+1,sl_next);} \
    CMASK(C0,C1,t); \
    { float a=MX3(C0[0],C0[1],C1[0]),b=MX3(C0[2],C0[3],C1[1]); a=MX3(a,C1[2],C1[3]); \
      _Pragma("unroll") for(int r=4;r<16;r+=4){a=MX3(a,C0[r],C0[r+1]);b=MX3(b,C0[r+2],C0[r+3]);a=MX3(a,C1[r],C1[r+1]);b=MX3(b,C1[r+2],C1[r+3]);} \
      float rm=__builtin_fmaxf(a,b); { auto rr=__builtin_amdgcn_permlane32_swap(__float_as_uint(rm),__float_as_uint(rm),false,false); rm=__builtin_fmaxf(__uint_as_float(rr[0]),__uint_as_float(rr[1])); } \
      resc=false; \
      if(__builtin_expect(__any(rm>(float)THRL),0)){ const float dl=__builtin_fmaxf(rm,0.f); mhat+=dl; \
        _Pragma("unroll") for(int r=0;r<16;++r){C0[r]-=dl;C1[r]-=dl;} \
        _Pragma("unroll") for(int r=0;r<16;++r)negm[r]=-mhat; asm volatile("":"+v"(negm)); \
        const float f=__builtin_amdgcn_exp2f(-dl); l_reg*=f; if(hi==0)wsf[r32]=f; resc=true; } } \
    SBAR(); \
    GAPB(o[0]=__builtin_amdgcn_mfma_f32_32x32x16_bf16(PAF(0),VFR(0),o[0],0,0,0), C0,0); \
    GAPB(o[1]=__builtin_amdgcn_mfma_f32_32x32x16_bf16(PAF(0),VFR(4),o[1],0,0,0), C0,4); \
    KRD(GL,0); GAPB(o[0]=__builtin_amdgcn_mfma_f32_32x32x16_bf16(PAF(1),VFR(1),o[0],0,0,0), C0,8); \
    KRD(GL,1); GAPB(o[1]=__builtin_amdgcn_mfma_f32_32x32x16_bf16(PAF(1),VFR(5),o[1],0,0,0), C0,12); \
    KRD(GL,2); GAPB(o[0]=__builtin_amdgcn_mfma_f32_32x32x16_bf16(PAF(2),VFR(2),o[0],0,0,0), C1,0); \
    KRD(GL,3); GAPB(o[1]=__builtin_amdgcn_mfma_f32_32x32x16_bf16(PAF(2),VFR(6),o[1],0,0,0), C1,4); \
    GAPB(o[0]=__builtin_amdgcn_mfma_f32_32x32x16_bf16(PAF(3),VFR(3),o[0],0,0,0), C1,8); \
    GAPB(o[1]=__builtin_amdgcn_mfma_f32_32x32x16_bf16(PAF(3),VFR(7),o[1],0,0,0), C1,12); \
    }while(0)
  int t=1;
  #undef CMASK
  #define CMASK(P0,P1,t) do{}while(0)
  for(;t+5<NT;t+=2){
    STEP(pB0,pB1,pA0,pA1,t,true,true,true);     WAIT_BAR(2); RESC(); ROT();
    STEP(pA0,pA1,pB0,pB1,t+1,true,true,true);   WAIT_BAR(2); RESC(); ROT();
  }
  #undef CMASK
  #define CMASK(P0,P1,t) do{ if((t)>=NT-2)kmask(P0,P1,L-64*(t),hi);}while(0)
  #define ENDW(tt) do{ if((tt)+3<NT){WAIT_BAR(2);} else if((tt)+2<NT){WAIT_BAR(1);} else {WAIT_BAR(0);} }while(0)
  for(;t+1<NT;t+=2){
    STEP(pB0,pB1,pA0,pA1,t,(t+3<NT),(t+1<NT),(t+1<NT));       ENDW(t);   RESC(); ROT();
    STEP(pA0,pA1,pB0,pB1,t+1,(t+4<NT),(t+2<NT),(t+2<NT));     ENDW(t+1); RESC(); ROT();
  }
  STEP(pB0,pB1,pA0,pA1,NT-1,false,false,false); RESC();
  { float sacc=pB0[0]+pB0[1]; _Pragma("unroll") for(int r=2;r<16;++r)sacc+=pB0[r]; _Pragma("unroll") for(int r=0;r<16;++r)sacc+=pB1[r]; l_reg+=sacc;
    pw0=(u32x4){PKW(pB0,0),PKW(pB0,2),PKW(pB0,4),PKW(pB0,6)};pw1=(u32x4){PKW(pB0,8),PKW(pB0,10),PKW(pB0,12),PKW(pB0,14)};pw2=(u32x4){PKW(pB1,0),PKW(pB1,2),PKW(pB1,4),PKW(pB1,6)};pw3=(u32x4){PKW(pB1,8),PKW(pB1,10),PKW(pB1,12),PKW(pB1,14)};
    SBAR(); pv(o,vb0+sl_cur,PAF(0),PAF(1),PAF(2),PAF(3)); }
  #undef PKW
  #undef PAF
  #undef VFR
  #undef PIN
  #undef MX3
  #undef GAPA
  #undef GAPB
  #undef EX
  #undef VRD
  #undef KRD
  #undef STEP
  #undef ENDW
  {auto rr=__builtin_amdgcn_permlane32_swap(__float_as_uint(l_reg),__float_as_uint(l_reg),false,false);l_reg=__uint_as_float(rr[0])+__uint_as_float(rr[1]);}
  if(hi==0)wsf[32+r32]=l_reg;asm volatile("s_waitcnt lgkmcnt(0)":::"memory");
  float rli[16];
  #pragma unroll
  for(int r=0;r<16;++r)rli[r]=__builtin_amdgcn_rcpf(wsf[32+crow(r,hi)]);
  bf16*Ow=O+(rowbase+q0+rh*QBLK)*QP+(4*kvh+qh)*D;
  { bf16*stg=(bf16*)(shm+LDS_OST)+wid*2048;
    #pragma unroll
    for(int r=0;r<16;++r){const int orow=crow(r,hi);
      #pragma unroll
      for(int d0=0;d0<2;++d0)stg[orow*64+d0*32+r32]=__float2bfloat16(o[d0][r]*rli[r]);}
    asm volatile("s_waitcnt lgkmcnt(0)":::"memory");
    #pragma unroll
    for(int i=0;i<4;++i){const int row=i*8+(lane>>3),ch=lane&7; const u32x4 v=*(const u32x4*)(stg+row*64+ch*8); if(q0+rh*QBLK+row<L)ATTN_STORE16(Ow+(long)row*QP+ch*8,v);} }
  asm volatile("s_waitcnt lgkmcnt(0)\n\ts_barrier":::"memory");
  #undef DMA_K
  #undef DMA_V
  #undef CMASK
  #undef START
  #undef RESC
  #undef ROT
}
constexpr int ATTN_LDS_BYTES=LDS_BYTES;
#undef SBAR
#undef WAIT_BAR
}
constexpr int DM = 1024, FF = 2816, NLAYER = 4;
constexpr int LP = 4112, LS = 2064, NSEQ_P = 4, NSEQ_S = 16, ROWS_P = NSEQ_P * LP  , T_ROWS = ROWS_P + NSEQ_S * LS  ;
constexpr int TPAD = 49664, NMT = TPAD / 256;
constexpr int NWIN = 4608;
constexpr float NORM_EPS = 1e-6f;
constexpr float QSCALE = 0.125f * 1.4426950408889634f;
constexpr int ATT_UNITS_P = NSEQ_P * 4 * 65, ATT_UNITS_S = NSEQ_S * 4 * 33, ATT_UNITS = ATT_UNITS_P + ATT_UNITS_S;

constexpr size_t MiB = 1u << 20;
constexpr size_t WS_CTL = 0;
constexpr size_t WS_ROPE = MiB / 4;
constexpr size_t WS_HMETA = 3 * MiB / 2;
constexpr size_t WS_SSQ = 3 * MiB;
constexpr size_t WS_W = 8 * MiB;
constexpr size_t W_GU1 = 0, W_D1 = W_GU1 + (size_t)5632 * 1024 * 2, W_IN = W_D1 + (size_t)1024 * 2816 * 2, W_GC = W_IN + (size_t)NWIN * 1024 * 2, W_OC = W_GC + 2 * MiB,
                 W_GA = W_OC + 2 * MiB, W_OA = W_GA + 2 * MiB, W_M = W_OA + 2 * MiB, W_GU2 = W_M + 2 * MiB, W_D2 = W_GU2 + (size_t)5632 * 1024 * 2, W_END = W_D2 + (size_t)1024 * 2816 * 2;
constexpr size_t WS_HB = 64 * MiB;
constexpr size_t ROWB = (size_t)TPAD * 1024 * 2;
constexpr size_t WS_BIG = WS_HB + 98 * MiB;
constexpr size_t WS_Q = WS_BIG, WS_K = WS_Q + ROWB, WS_V = WS_K + ROWB / 4, WS_CB = WS_V + ROWB / 4, WS_Z = WS_CB + ROWB, WS_END = WS_Z + ROWB;
constexpr size_t WS_HID = WS_BIG;
constexpr size_t WS_SCR = WS_K;
static_assert(WS_ROPE + (size_t)LP * 64 * 4 <= WS_HMETA && WS_HMETA + (size_t)20 * 16 * 1024 * 4 <= WS_SSQ && WS_SSQ + (size_t)TPAD * 16 * 4 <= WS_W, "d_ws map (small regions)");
static_assert(W_END <= 56 * MiB && ROWB <= 98 * MiB && (size_t)TPAD * FF * 2 <= WS_END - WS_BIG && 256 * 131072 <= ROWB / 2, "d_ws map");

constexpr int RING_BYTES = 131072, MISC_OFF = RING_BYTES + 320, PTAB_OFF = RING_BYTES + 1024, LDS_BYTES = 147456;
constexpr int NWAVES = 8;

#define GAS __attribute__((address_space(1)))
#define LAS __attribute__((address_space(3)))
typedef unsigned short bf16;
typedef unsigned v4u __attribute__((ext_vector_type(4)));
typedef float f32x4 __attribute__((ext_vector_type(4)));
__device__ __forceinline__ unsigned f2bf(float f) { unsigned u = __builtin_bit_cast(unsigned, f); return (u + 0x7fffu + ((u >> 16) & 1u)) >> 16; }
__device__ __forceinline__ unsigned pk2(float lo, float hi) { return pg8::cvt_pk_bf16(lo, hi); }
__device__ __forceinline__ float bflo(unsigned u) { return __builtin_bit_cast(float, u << 16); }
__device__ __forceinline__ float bfhi(unsigned u) { return __builtin_bit_cast(float, u & 0xffff0000u); }
__device__ __forceinline__ float wave_sum(float v) {
#pragma unroll
    for (int o = 1; o < 64; o <<= 1) v += __shfl_xor(v, o);
    return v;
}
__device__ __forceinline__ void rowinfo(int r, int& pos, int& L) {
    if (r < ROWS_P) { L = LP; pos = r % LP; } else if (r < T_ROWS) { L = LS; pos = (r - ROWS_P) % LS; } else { L = 1 << 30; pos = 0; }
}
__device__ __forceinline__ float* hrow(int r, float* out, float* hmeta) {
    if (r < ROWS_P) { const int s = r / LP, pos = r - s * LP; return pos < 16 ? hmeta + (size_t)(s * 16 + pos) * DM : out + (size_t)(s * 4096 + pos - 16) * DM; }
    const int r2 = r - ROWS_P, s = r2 / LS, pos = r2 - s * LS;
    return pos < 16 ? hmeta + (size_t)((NSEQ_P + s) * 16 + pos) * DM : out + (size_t)NSEQ_P * 4096 * DM + (size_t)(s * 2048 + pos - 16) * DM;
}
__device__ __forceinline__ float sigmoidf_(float x) { return __builtin_amdgcn_rcpf(1.0f + __builtin_amdgcn_exp2f(-1.4426950408889634f * x)); }

struct PlainOrder : pg8::StaticOrder {
    const char* A; const char* Bt; size_t tstep;
    __device__ __forceinline__ const char* aptr(const pg8::Unit& u) const { return A + (size_t)u.pm * tstep; }
    __device__ __forceinline__ const char* bptr(const pg8::Unit& u) const { return Bt + (size_t)u.pn * tstep; }
};
struct ChainOrder {
    pg8::StaticOrder base; const char* A[4]; const char* B[4]; size_t tstep;
    __device__ __forceinline__ bool next(int i, pg8::Unit& u) const { if (!base.next(i >> 2, u)) return false; u.sub = i & 3; return true; }
    __device__ __forceinline__ const char* aptr(const pg8::Unit& u) const { const char* p = u.sub == 0 ? A[0] : u.sub == 1 ? A[1] : u.sub == 2 ? A[2] : A[3]; return p + (size_t)u.pm * tstep; }
    __device__ __forceinline__ const char* bptr(const pg8::Unit& u) const { const char* p = u.sub == 0 ? B[0] : u.sub == 1 ? B[1] : u.sub == 2 ? B[2] : B[3]; return p + (size_t)u.pn * tstep; }
    __device__ __forceinline__ void a_ready(const pg8::Unit&) const {}
    __device__ __forceinline__ void done(const pg8::Unit&) const {}
};

using pg8::f32x4; using pg8::u32x4; using pg8::Unit; using pg8::bf16_t;
typedef f32x4 Acc[2][2][4][2];
__device__ __forceinline__ u32x4 pack8(const f32x4 a, const f32x4 b) { u32x4 w; w.x = pk2(a[0], a[1]); w.y = pk2(a[2], a[3]); w.z = pk2(b[0], b[1]); w.w = pk2(b[2], b[3]); return w; }
__device__ __forceinline__ void unpack8(const u32x4 w, f32x4& a, f32x4& b) { a = (f32x4){bflo(w.x), bfhi(w.x), bflo(w.y), bfhi(w.y)}; b = (f32x4){bflo(w.z), bfhi(w.z), bflo(w.w), bfhi(w.w)}; }
__device__ __forceinline__ float rstd_of(const float* ssq, int row) { const f32x4* p = (const f32x4*)(ssq + (size_t)row * 16); const f32x4 a = p[0], b = p[1], c = p[2], d = p[3];
    const float s = (((a[0] + a[1]) + (a[2] + a[3])) + ((b[0] + b[1]) + (b[2] + b[3]))) + (((c[0] + c[1]) + (c[2] + c[3])) + ((d[0] + d[1]) + (d[2] + d[3])));
    return __builtin_amdgcn_rsqf(s * (1.0f / DM) + NORM_EPS); }

struct EpiSwiGLU {
    static constexpr bool PERM = true, AFTER_DRAIN = false;
    bf16_t* hid; const float* ssq;
    __device__ __forceinline__ void operator()(const Acc& acc, const Unit& u, int wr, int wc, int fr, int fq) const {
#pragma unroll
        for (int ai = 0; ai < 2; ++ai)
#pragma unroll
            for (int m = 0; m < 4; ++m) {
                const int row = u.pm * 256 + ai * 128 + wr * 64 + m * 16 + fr; const float rs = rstd_of(ssq, row);
                f32x4 o[2];
#pragma unroll
                for (int n = 0; n < 2; ++n)
#pragma unroll
                    for (int e = 0; e < 4; ++e) { const float g = acc[ai][0][m][n][e] * rs, up = acc[ai][1][m][n][e] * rs; o[n][e] = g * sigmoidf_(g) * up; }
                *(u32x4*)(hid + (size_t)row * FF + u.pn * 128 + wc * 32 + 8 * fq) = pack8(o[0], o[1]);
            }
    }
};
struct EpiResid {
    static constexpr bool PERM = true, AFTER_DRAIN = false;
    float* out; float* hmeta; bf16_t* hb; float* ssq_out; float scale;
    __device__ __forceinline__ void operator()(const Acc& acc, const Unit& u, int wr, int wc, int fr, int fq) const {
#pragma unroll
        for (int ai = 0; ai < 2; ++ai)
#pragma unroll
            for (int m = 0; m < 4; ++m) {
                const int row = u.pm * 256 + ai * 128 + wr * 64 + m * 16 + fr; const bool ok = row < T_ROWS;
                float ss = 0.f;
                if (ok) {
                    float* hp = hrow(row, out, hmeta) + u.pn * 256 + wc * 32 + 8 * fq; bf16_t* bp = hb + (size_t)row * DM + u.pn * 256 + wc * 32 + 8 * fq;
#pragma unroll
                    for (int bj = 0; bj < 2; ++bj) {
                        f32x4 a = *(const f32x4*)(hp + bj * 128), b = *(const f32x4*)(hp + bj * 128 + 4);
                        a = a + acc[ai][bj][m][0] * scale; b = b + acc[ai][bj][m][1] * scale;
                        *(f32x4*)(hp + bj * 128) = a; *(f32x4*)(hp + bj * 128 + 4) = b;
                        *(u32x4*)(bp + bj * 128) = pack8(a, b);
                        ss += (a[0] * a[0] + a[1] * a[1]) + (a[2] * a[2] + a[3] * a[3]) + (b[0] * b[0] + b[1] * b[1]) + (b[2] * b[2] + b[3] * b[3]);
                    }
                }
                ss += __shfl_xor(ss, 16); ss += __shfl_xor(ss, 32);
                if (ok && fq == 0) ssq_out[(size_t)row * 16 + u.pn * 4 + wc] = ss;
                if (m & 1) asm volatile("" ::: "memory");
            }
    }
};
struct EpiWin {
    static constexpr bool PERM = true, AFTER_DRAIN = false;
    bf16_t *q, *k, *v, *cb, *z; const float* ssq; const float* rope; const float* qg; const float* kg;
    __device__ __forceinline__ void operator()(const Acc& acc, const Unit& u, int wr, int wc, int fr, int fq) const {
        const int pn = u.pn;
        if (pn <= 4) {
            const float* g = pn < 4 ? qg : kg; const float osc = pn < 4 ? QSCALE : 1.0f;
            f32x4 G[2][2];
#pragma unroll
            for (int bj = 0; bj < 2; ++bj)
#pragma unroll
                for (int n = 0; n < 2; ++n) G[bj][n] = *(const f32x4*)(g + 32 * bj + 16 * n + 4 * fq) * osc;
#pragma unroll
            for (int ai = 0; ai < 2; ++ai)
#pragma unroll
                for (int m = 0; m < 4; ++m) {
                    const int row = u.pm * 256 + ai * 128 + wr * 64 + m * 16 + fr; const float rs = rstd_of(ssq, row);
                    int pos, L; rowinfo(row, pos, L);
                    f32x4 x[2][2]; float ss = 0.f;
#pragma unroll
                    for (int bj = 0; bj < 2; ++bj)
#pragma unroll
                        for (int n = 0; n < 2; ++n) { x[bj][n] = acc[ai][bj][m][n] * rs; const f32x4 t = x[bj][n] * x[bj][n]; ss += (t[0] + t[1]) + (t[2] + t[3]); }
                    ss += __shfl_xor(ss, 16); ss += __shfl_xor(ss, 32);
                    const float rn = __builtin_amdgcn_rsqf(ss * (1.0f / 64.0f) + NORM_EPS);
                    bf16_t* dst = pn < 4 ? q + (size_t)row * 1024 + (4 * pn + wc) * 64 + 8 * fq : k + (size_t)row * 256 + wc * 64 + 8 * fq;
#pragma unroll
                    for (int bj = 0; bj < 2; ++bj) {
                        const f32x4 c4 = *(const f32x4*)(rope + ((pos * 2 + bj) * 2 + 0) * 16 + 4 * fq), s4 = *(const f32x4*)(rope + ((pos * 2 + bj) * 2 + 1) * 16 + 4 * fq);
                        const f32x4 y1 = x[bj][0] * rn * G[bj][0], y2 = x[bj][1] * rn * G[bj][1];
                        const f32x4 o1 = y1 * c4 - y2 * s4, o2 = y2 * c4 + y1 * s4;
                        *(u32x4*)(dst + 32 * bj) = pack8(o1, o2);
                    }
                    if (m & 1) asm volatile("" ::: "memory");
                }
        } else if (pn < 10) {
            bf16_t* base; int pitch, c0;
            if (pn == 5) { base = v; pitch = 256; c0 = 0; } else { base = cb; pitch = 1024; c0 = 256 * (pn - 6); }
#pragma unroll
            for (int ai = 0; ai < 2; ++ai)
#pragma unroll
                for (int m = 0; m < 4; ++m) {
                    const int row = u.pm * 256 + ai * 128 + wr * 64 + m * 16 + fr; const float rs = rstd_of(ssq, row);
#pragma unroll
                    for (int bj = 0; bj < 2; ++bj) *(u32x4*)(base + (size_t)row * pitch + c0 + 128 * bj + wc * 32 + 8 * fq) = pack8(acc[ai][bj][m][0] * rs, acc[ai][bj][m][1] * rs);
                }
        } else {
#pragma unroll
            for (int ai = 0; ai < 2; ++ai)
#pragma unroll
                for (int m = 0; m < 4; ++m) {
                    const int row = u.pm * 256 + ai * 128 + wr * 64 + m * 16 + fr; const float rs = rstd_of(ssq, row), rs2 = rs * rs;
                    *(u32x4*)(z + (size_t)row * 1024 + 128 * (pn - 10) + wc * 32 + 8 * fq) = pack8(acc[ai][0][m][0] * acc[ai][1][m][0] * rs2, acc[ai][0][m][1] * acc[ai][1][m][1] * rs2);
                }
        }
    }
};
struct EpiMerge {
    static constexpr bool PERM = true, AFTER_DRAIN = false;
    bf16_t* merged; u32x4* scr; const float* ssq; int tid;
    __device__ __forceinline__ void operator()(const Acc& acc, const Unit& u, int wr, int wc, int fr, int fq) const {
        const int sub = u.sub;
#pragma unroll
        for (int ai = 0; ai < 2; ++ai)
#pragma unroll
            for (int m = 0; m < 4; ++m) {
                const int row = u.pm * 256 + ai * 128 + wr * 64 + m * 16 + fr;
                float rs = 1.f; if ((sub & 1) == 0) rs = rstd_of(ssq, row);
#pragma unroll
                for (int bj = 0; bj < 2; ++bj) {
                    u32x4* mp = (u32x4*)(merged + (size_t)row * DM + u.pn * 256 + bj * 128 + wc * 32 + 8 * fq);
                    u32x4* sp = scr + ((ai * 4 + m) * 2 + bj) * 512 + tid;
                    const f32x4 v0 = acc[ai][bj][m][0], v1 = acc[ai][bj][m][1];
                    if ((sub & 1) == 0) {
                        f32x4 s0, s1;
#pragma unroll
                        for (int e = 0; e < 4; ++e) { s0[e] = sigmoidf_(v0[e] * rs); s1[e] = sigmoidf_(v1[e] * rs); }
                        if (sub == 0) *mp = pack8(s0, s1); else *sp = pack8(s0, s1);
                    } else if (sub == 1) {
                        f32x4 g0, g1; unpack8(*mp, g0, g1); *mp = pack8(g0 * v0, g1 * v1);
                    } else {
                        f32x4 c0, c1, s0, s1; unpack8(*mp, c0, c1); unpack8(*sp, s0, s1); *mp = pack8(c0 + s0 * v0, c1 + s1 * v1);
                    }
                }
                if (m & 1) asm volatile("" ::: "memory");
            }
    }
};

__device__ __forceinline__ void cvt_item(const float* W, int Nsrc, int n0src, const float* gain, bool permqk, bf16* WT, int K, int nrow0, int k0, LAS float* scr, int lane) {
#pragma unroll 8
    for (int i = 0; i < 32; ++i) { const int kk = 2 * i + (lane >> 5); float w = W[(size_t)(k0 + kk) * Nsrc + n0src + (lane & 31)]; if (gain) w *= gain[k0 + kk]; scr[kk * 33 + (lane & 31)] = w; }
    asm volatile("s_waitcnt lgkmcnt(0)" ::: "memory");
    const int c = lane & 7;
#pragma unroll
    for (int j = 0; j < 4; ++j) { const int n = (lane >> 3) + 8 * j; const int ns = permqk ? (16 * ((n >> 2) & 1) + 4 * (n >> 3) + (n & 3)) : n; const LAS float* s = scr + (8 * c) * 33 + ns;
        v4u o; o.x = pk2(s[0 * 33], s[1 * 33]); o.y = pk2(s[2 * 33], s[3 * 33]); o.z = pk2(s[4 * 33], s[5 * 33]); o.w = pk2(s[6 * 33], s[7 * 33]);
        *(GAS v4u*)(WT + (size_t)(nrow0 + n) * K + k0 + 8 * c) = o; }
    asm volatile("s_waitcnt lgkmcnt(0)" ::: "memory");
}
struct Args { const float* in[21]; float* out; unsigned char* ws; int ph_lo, ph_hi; };
struct PT {
    volatile LAS unsigned long long* t;
    __device__ __forceinline__ unsigned long long get(int i) const { const unsigned long long v = t[i]; const unsigned lo = __builtin_amdgcn_readfirstlane((unsigned)v), hi = __builtin_amdgcn_readfirstlane((unsigned)(v >> 32)); return ((unsigned long long)hi << 32) | lo; }
    __device__ __forceinline__ const float* in(int i) const { return (const float*)(const GAS float*)get(i); }
    __device__ __forceinline__ float* out() const { return (float*)(GAS float*)get(21); }
    __device__ __forceinline__ unsigned char* ws() const { return (unsigned char*)(GAS unsigned char*)get(22); }
};

__device__ __forceinline__ void convert_layer(const PT a, unsigned char* ws, int l, LAS unsigned char* lds, int gw, int NGW, int wave, int lane) {
    LAS float* scr = (LAS float*)(lds + wave * 16384);
    bf16* W = (bf16*)(ws + WS_W);
    const size_t ffo = (size_t)l * DM * FF, sqo = (size_t)l * DM * DM;
    const float* win = a.in(8) + (size_t)l * DM * 6656; const float* mixg = a.in(7) + l * DM;
    for (int it = gw; it < 13312; it += NGW) {
        int r = it;
        if (r < 2816) { const int kb = r / 176, nb = r % 176, pn = nb >> 3, t = nb & 7; const float* src = (t >> 2) ? a.in(5) + ffo : a.in(4) + ffo;
            cvt_item(src, FF, 128 * pn + 32 * (t & 3), a.in(3) + l * DM, false, (bf16*)((char*)W + W_GU1), 1024, nb * 32, kb * 64, scr, lane); continue; } r -= 2816;
        if (r < 1408) { const int kb = r / 32, nb = r % 32; cvt_item(a.in(6) + ffo, DM, nb * 32, nullptr, false, (bf16*)((char*)W + W_D1), FF, nb * 32, kb * 64, scr, lane); continue; } r -= 1408;
        if (r < 2304) { const int kb = r / 144, nb = r % 144, pn = nb >> 3, t = nb & 7; int n0; bool pq = false;
            if (pn < 4) { n0 = 64 * (4 * pn + (t & 3)) + 32 * (t >> 2); pq = true; }
            else if (pn == 4) { n0 = 1024 + 64 * (t & 3) + 32 * (t >> 2); pq = true; }
            else if (pn == 5) n0 = 1280 + 32 * t;
            else if (pn < 10) n0 = 1536 + 256 * (pn - 6) + 32 * t;
            else n0 = ((t >> 2) ? 3584 : 2560) + 128 * (pn - 10) + 32 * (t & 3);
            cvt_item(win, 6656, n0, mixg, pq, (bf16*)((char*)W + W_IN), 1024, nb * 32, kb * 64, scr, lane); continue; } r -= 2304;
        if (r < 2560) { const int seg = r / 512, q = r % 512, kb = q / 32, nb = q % 32;
            const float* src; int ns, n0; const float* gn = nullptr; size_t dst;
            if (seg == 0) { src = win; ns = 6656; n0 = 5632 + nb * 32; gn = mixg; dst = W_GC; }
            else if (seg == 1) { src = a.in(14) + sqo; ns = DM; n0 = nb * 32; dst = W_OC; }
            else if (seg == 2) { src = win; ns = 6656; n0 = 4608 + nb * 32; gn = mixg; dst = W_GA; }
            else if (seg == 3) { src = a.in(13) + sqo; ns = DM; n0 = nb * 32; dst = W_OA; }
            else { src = a.in(15) + sqo; ns = DM; n0 = nb * 32; dst = W_M; }
            cvt_item(src, ns, n0, gn, false, (bf16*)((char*)W + dst), 1024, nb * 32, kb * 64, scr, lane); continue; } r -= 2560;
        if (r < 2816) { const int kb = r / 176, nb = r % 176, pn = nb >> 3, t = nb & 7; const float* src = (t >> 2) ? a.in(18) + ffo : a.in(17) + ffo;
            cvt_item(src, FF, 128 * pn + 32 * (t & 3), a.in(16) + l * DM, false, (bf16*)((char*)W + W_GU2), 1024, nb * 32, kb * 64, scr, lane); continue; } r -= 2816;
        { const int kb = r / 32, nb = r % 32; cvt_item(a.in(19) + ffo, DM, nb * 32, nullptr, false, (bf16*)((char*)W + W_D2), FF, nb * 32, kb * 64, scr, lane); }
    }
}

__device__ __forceinline__ void prologue(const PT a, unsigned char* ws, int tid, int wave, int lane, int bid, int G) {
    const int gtid = bid * 512 + tid, GT = G * 512, gw = bid * NWAVES + wave, NGW = G * NWAVES;
    float* ssq = (float*)(ws + WS_SSQ); bf16* hb = (bf16*)(ws + WS_HB); float* hmeta = (float*)(ws + WS_HMETA); float* rope = (float*)(ws + WS_ROPE);
    for (int i = gtid; i < (TPAD - T_ROWS) * 16; i += GT) ssq[(size_t)T_ROWS * 16 + i] = 0.f;
    for (int i = gtid; i < (TPAD - T_ROWS) * DM / 8; i += GT) ((v4u*)(hb + (size_t)T_ROWS * DM))[i] = (v4u){0u, 0u, 0u, 0u};
    if (gtid < 64) ((unsigned*)(ws + WS_CTL))[gtid] = 0u;
    for (int i = gtid; i < LP * 32; i += GT) {
        const int pos = i >> 5, axis = (i >> 4) & 1, f = i & 15;
        float coord; if (pos < 16) coord = axis ? (float)pos : -1.0f; else { const int t = pos - 16; coord = axis ? (float)(t & 63) : (float)(t >> 6); }
        const float inv = powf(10000.0f, -(float)f * (1.0f / 16.0f)); const float ang = coord * inv;
        float s, c; sincosf(ang, &s, &c);
        rope[((pos * 2 + axis) * 2 + 0) * 16 + f] = c; rope[((pos * 2 + axis) * 2 + 1) * 16 + f] = s;
    }
    for (int r = gw; r < T_ROWS; r += NGW) {
        int pos, L; rowinfo(r, pos, L);
        const float* src;
        if (pos < 16) src = a.in(2) + (size_t)pos * DM;
        else if (r < ROWS_P) src = a.in(0) + ((size_t)(r / LP) * 4096 + pos - 16) * DM;
        else src = a.in(1) + ((size_t)((r - ROWS_P) / LS) * 2048 + pos - 16) * DM;
        float* dst = hrow(r, a.out(), hmeta);
        f32x4 v[4]; float s = 0.f;
#pragma unroll
        for (int j = 0; j < 4; ++j) { v[j] = ((const f32x4*)src)[lane + 64 * j]; s += (v[j][0] * v[j][0] + v[j][1] * v[j][1]) + (v[j][2] * v[j][2] + v[j][3] * v[j][3]); }
        s = wave_sum(s);
        unsigned long long* o8 = (unsigned long long*)(hb + (size_t)r * DM) + lane;
#pragma unroll
        for (int j = 0; j < 4; ++j) { ((f32x4*)dst)[lane + 64 * j] = v[j]; o8[64 * j] = (unsigned long long)pk2(v[j][0], v[j][1]) | ((unsigned long long)pk2(v[j][2], v[j][3]) << 32); }
        if (lane < 16) ssq[(size_t)r * 16 + lane] = lane == 0 ? s : 0.f;
    }
}

__device__ __forceinline__ void conv_phase(const PT a, unsigned char* ws, int l, int tid, int bid, int G) {
    bf16* cb = (bf16*)(ws + WS_CB); const bf16* z = (const bf16*)(ws + WS_Z);
    const float* cw = a.in(9) + (size_t)l * 3 * DM; const float* cbias = a.in(10) + (size_t)l * DM;
    const int chunk = tid & 127, sub = tid >> 7, c0 = chunk * 8;
    f32x4 w0[2], w1[2], w2[2], bb[2];
#pragma unroll
    for (int h = 0; h < 2; ++h) { w0[h] = *(const f32x4*)(cw + c0 + 4 * h); w1[h] = *(const f32x4*)(cw + DM + c0 + 4 * h); w2[h] = *(const f32x4*)(cw + 2 * DM + c0 + 4 * h); bb[h] = *(const f32x4*)(cbias + c0 + 4 * h); }
    const int nstrip = (T_ROWS + 63) / 64;
    for (int strip = bid; strip < nstrip; strip += G) {
        const int r0 = strip * 64 + sub * 16;
#pragma unroll 4
        for (int i = 0; i < 16; ++i) {
            const int r = r0 + i; if (r >= T_ROWS) break;
            int pos, L; rowinfo(r, pos, L);
            const u32x4 zero = (u32x4){0u, 0u, 0u, 0u};
            const u32x4 zc = *(const u32x4*)(z + (size_t)r * DM + c0);
            const u32x4 zp = pos > 0 ? *(const u32x4*)(z + (size_t)(r - 1) * DM + c0) : zero;
            const u32x4 zn = pos < L - 1 ? *(const u32x4*)(z + (size_t)(r + 1) * DM + c0) : zero;
            u32x4* cp = (u32x4*)(cb + (size_t)r * DM + c0); const u32x4 cv = *cp;
            f32x4 p0, p1, c0v, c1v, n0, n1, b0, b1; unpack8(zp, p0, p1); unpack8(zc, c0v, c1v); unpack8(zn, n0, n1); unpack8(cv, b0, b1);
            const f32x4 o0 = b0 * (w0[0] * p0 + w1[0] * c0v + w2[0] * n0 + bb[0]), o1 = b1 * (w0[1] * p1 + w1[1] * c1v + w2[1] * n1 + bb[1]);
            *cp = pack8(o0, o1);
        }
    }
}

__device__ __forceinline__ void attention_phase(const PT a, unsigned char* ws, int l, unsigned char* lds_generic, int tid) {
    using abf = attn_body::bf16;
    const abf* Q = (const abf*)(ws + WS_Q); const abf* K = (const abf*)(ws + WS_K); const abf* V = (const abf*)(ws + WS_V); abf* O = (abf*)(ws + WS_Q);
    unsigned* ctr = (unsigned*)(ws + WS_CTL) + l;
    volatile unsigned* slot = (volatile unsigned*)(lds_generic + MISC_OFF);
    for (;;) {
        if (tid == 0) *slot = atomicAdd(ctr, 1u);
        __syncthreads();
        const int u = (int)__builtin_amdgcn_readfirstlane(*slot);
        if (u >= ATT_UNITS) break;
        int tidu = tid; asm volatile("" : "+v"(tidu));
        if (u < ATT_UNITS_P) { const int s = u / 260, rem = u - s * 260, kvh = rem / 65, qblk = rem - kvh * 65;
            attn_body::attn_unit<8, LP, 66>((long)s * LP, kvh, qblk, Q, K, V, O, (char*)lds_generic, tidu); }
        else { const int u2 = u - ATT_UNITS_P, s = u2 / 132, rem = u2 - s * 132, kvh = rem / 33, qblk = rem - kvh * 33;
            attn_body::attn_unit<8, LS, 34>((long)ROWS_P + (long)s * LS, kvh, qblk, Q, K, V, O, (char*)lds_generic, tidu); }
    }
}

__device__ __forceinline__ void final_phase(const PT a, unsigned char* ws, int wave, int lane, int bid, int G) {
    const int gw = bid * NWAVES + wave, NGW = G * NWAVES;
    const float* ssq = (const float*)(ws + WS_SSQ); float* hmeta = (float*)(ws + WS_HMETA);
    f32x4 g[4];
#pragma unroll
    for (int j = 0; j < 4; ++j) g[j] = ((const f32x4*)a.in(20))[lane + 64 * j];
    for (int r = gw; r < T_ROWS; r += NGW) {
        int pos, L; rowinfo(r, pos, L); if (pos < 16) continue;
        float* p = hrow(r, a.out(), hmeta); const float rs = rstd_of(ssq, r);
#pragma unroll
        for (int j = 0; j < 4; ++j) { f32x4 v = ((f32x4*)p)[lane + 64 * j]; ((f32x4*)p)[lane + 64 * j] = v * rs * g[j]; }
    }
}

constexpr int NSTEPS = 2 + 9 * NLAYER;

template <int STEP>
__device__ __forceinline__ void run_step(const PT pt, unsigned char* lds, cg::grid_group& grid, const int ph_lo, const int ph_hi) {
#ifdef MAX_STEP
    if (STEP >= MAX_STEP && STEP != NSTEPS - 1) return;
#endif
    if (STEP < ph_lo || STEP >= ph_hi) return;
    if (STEP > ph_lo) { asm volatile("s_waitcnt vmcnt(0)" ::: "memory"); grid.sync(); }
    LAS unsigned char* l3 = (LAS unsigned char*)lds;
    int tid = threadIdx.x; asm volatile("" : "+v"(tid));
    int bid = blockIdx.x; asm volatile("" : "+s"(bid));
    int G = gridDim.x; asm volatile("" : "+s"(G));
    unsigned char* ws = pt.ws();
    const int lane = tid & 63, wave = __builtin_amdgcn_readfirstlane(tid >> 6);
    const int gw = bid * NWAVES + wave, NGW = G * NWAVES;
    float* ssq = (float*)(ws + WS_SSQ); float* hmeta = (float*)(ws + WS_HMETA);
    bf16_t* hb = (bf16_t*)(ws + WS_HB);
    if constexpr (STEP == 0) { prologue(pt, ws, tid, wave, lane, bid, G); }
    else if constexpr (STEP == NSTEPS - 1) { final_phase(pt, ws, wave, lane, bid, G); }
    else {
        constexpr int l = (STEP - 1) / 9, ph = (STEP - 1) % 9;
        if constexpr (ph == 0) {
#ifndef NO_CVT
            convert_layer(pt, ws, l, l3, gw, NGW, wave, lane);
#endif
            __syncthreads();
        } else if constexpr (ph == 1 || ph == 7) {
            constexpr int f = ph == 7;
            PlainOrder S; S.init(TPAD, 2 * FF, G, bid); S.A = (const char*)hb; S.Bt = (const char*)(ws + WS_W + (f ? W_GU2 : W_GU1)); S.tstep = (size_t)256 * 1024 * 2;
            pg8::Gemm g{nullptr, nullptr, TPAD, 2 * FF, 1024};
            EpiSwiGLU E{(bf16_t*)(ws + WS_HID), ssq};
#ifndef NO_GU
            pg8::gemm_phase<EpiSwiGLU, PlainOrder, true, true>(l3, g, S, E, tid);
#endif
        } else if constexpr (ph == 2 || ph == 6 || ph == 8) {
            constexpr int f = ph == 8; constexpr int K = ph == 6 ? 1024 : FF;
            PlainOrder S; S.init(TPAD, DM, G, bid);
            S.A = ph == 6 ? (const char*)(ws + WS_Z) : (const char*)(ws + WS_HID);
            S.Bt = (const char*)(ws + WS_W + (ph == 6 ? W_M : (f ? W_D2 : W_D1))); S.tstep = (size_t)256 * K * 2;
            pg8::Gemm g{nullptr, nullptr, TPAD, DM, K};
            EpiResid E{pt.out(), hmeta, hb, ssq, ph == 6 ? 1.0f : 0.5f};
#ifndef NO_RES
            pg8::gemm_phase<EpiResid, PlainOrder, true, true>(l3, g, S, E, tid);
#endif
        } else if constexpr (ph == 3) {
            PlainOrder S; S.init(TPAD, NWIN, G, bid); S.A = (const char*)hb; S.Bt = (const char*)(ws + WS_W + W_IN); S.tstep = (size_t)256 * 1024 * 2;
            pg8::Gemm g{nullptr, nullptr, TPAD, NWIN, 1024};
            EpiWin E{(bf16_t*)(ws + WS_Q), (bf16_t*)(ws + WS_K), (bf16_t*)(ws + WS_V), (bf16_t*)(ws + WS_CB), (bf16_t*)(ws + WS_Z), ssq,
                     (const float*)(ws + WS_ROPE), pt.in(11) + l * 64, pt.in(12) + l * 64};
#ifndef NO_WIN
            pg8::gemm_phase<EpiWin, PlainOrder, true, true>(l3, g, S, E, tid);
#endif
        } else if constexpr (ph == 4) {
#ifndef NO_CONV
            conv_phase(pt, ws, l, tid, bid, G);
#endif
#ifndef NO_ATT
            attention_phase(pt, ws, l, lds, tid);
#endif
        } else {
            ChainOrder S; S.base.init(TPAD, DM, G, bid); S.tstep = (size_t)256 * 1024 * 2;
            S.A[0] = (const char*)hb; S.A[1] = (const char*)(ws + WS_CB); S.A[2] = (const char*)hb; S.A[3] = (const char*)(ws + WS_Q);
            S.B[0] = (const char*)(ws + WS_W + W_GC); S.B[1] = (const char*)(ws + WS_W + W_OC); S.B[2] = (const char*)(ws + WS_W + W_GA); S.B[3] = (const char*)(ws + WS_W + W_OA);
            pg8::Gemm g{nullptr, nullptr, TPAD, DM, 1024};
            EpiMerge E{(bf16_t*)(ws + WS_Z), (u32x4*)(ws + WS_SCR + (size_t)bid * 131072), ssq, tid};
#ifndef NO_MERGE
            pg8::gemm_phase<EpiMerge, ChainOrder, true, true>(l3, g, S, E, tid);
#endif
        }
    }
}
template <int STEP>
__device__ __forceinline__ void run_from(const PT pt, unsigned char* lds, cg::grid_group& grid, const int ph_lo, const int ph_hi) {
    run_step<STEP>(pt, lds, grid, ph_lo, ph_hi);
    if constexpr (STEP + 1 < NSTEPS) run_from<STEP + 1>(pt, lds, grid, ph_lo, ph_hi);
}

__global__ void __launch_bounds__(NWAVES * 64, 2) mega_fwd(Args args) {
    extern __shared__ __attribute__((aligned(16))) unsigned char lds[];
    cg::grid_group grid = cg::this_grid();
    PT pt; pt.t = (volatile LAS unsigned long long*)((LAS unsigned char*)lds + PTAB_OFF);
    if (threadIdx.x == 0) {
#pragma unroll
        for (int i = 0; i < 21; ++i) pt.t[i] = (unsigned long long)args.in[i];
        pt.t[21] = (unsigned long long)args.out; pt.t[22] = (unsigned long long)args.ws;
    }
    const int ph_lo = args.ph_lo, ph_hi = args.ph_hi;
    __syncthreads();
    run_from<0>(pt, lds, grid, ph_lo, ph_hi);
}

#ifndef LAUNCH_PER_STEP
#define LAUNCH_PER_STEP 0
#endif
extern "C" void kernel_launch(void* const* d_in, const int* in_sizes, int n_in, void* d_out, int out_size, void* d_ws, size_t ws_size, hipStream_t stream) {
    static int grid = 0;
    if (grid == 0) {
        if (n_in != 21 || ws_size < WS_END) { fprintf(stderr, "kernel_launch: need 21 inputs and >= %zu bytes of workspace; got %d, %zu\n", (size_t)WS_END, n_in, ws_size); grid = -1; return; }
        int dev = 0, cus = 0, per_cu = 0;
        hipGetDevice(&dev); hipDeviceGetAttribute(&cus, hipDeviceAttributeMultiprocessorCount, dev);
        if (hipFuncSetAttribute((const void*)mega_fwd, hipFuncAttributeMaxDynamicSharedMemorySize, LDS_BYTES) != hipSuccess) { fprintf(stderr, "kernel_launch: hipFuncSetAttribute failed\n"); grid = -1; return; }
        if (hipOccupancyMaxActiveBlocksPerMultiprocessor(&per_cu, (const void*)mega_fwd, NWAVES * 64, LDS_BYTES) != hipSuccess || per_cu < 1) per_cu = 1;
        (void)hipGetLastError();
        grid = cus * per_cu;
    }
    if (grid < 0) return;
    Args a{};
    for (int i = 0; i < 21; ++i) a.in[i] = (const float*)d_in[i];
    a.out = (float*)d_out; a.ws = (unsigned char*)d_ws;
#if LAUNCH_PER_STEP
    for (int s = 0; s < NSTEPS; ++s) { a.ph_lo = s; a.ph_hi = s + 1; void* kargs[] = {&a}; hipLaunchCooperativeKernel((void*)mega_fwd, dim3(grid), dim3(NWAVES * 64), kargs, LDS_BYTES, stream); }
#else
    a.ph_lo = 0; a.ph_hi = NSTEPS; void* kargs[] = {&a};
    hipError_t e = hipLaunchCooperativeKernel((void*)mega_fwd, dim3(grid), dim3(NWAVES * 64), kargs, LDS_BYTES, stream);
    if (e != hipSuccess) fprintf(stderr, "cooperative launch failed: %s (grid %d)\n", hipGetErrorString(e), grid);
#endif
}
```

```cpp
#include <hip/hip_runtime.h>
#include <hip/hip_cooperative_groups.h>
#include <hip/hip_bf16.h>
#include <cstdio>
#include <cstdint>
#include <cmath>
namespace cg = cooperative_groups;
namespace pg8 {
#define PG8_LAS __attribute__((address_space(3)))
typedef unsigned short bf16_t;
typedef short bf16x8 __attribute__((ext_vector_type(8)));
typedef float f32x4 __attribute__((ext_vector_type(4)));
typedef unsigned u32x4 __attribute__((ext_vector_type(4)));
constexpr int BM = 256, BK = 64, HALF = 128, HTB = HALF * BK * 2  , STAGE_BYTES = 8 * HTB, NXCD = 8, WGM = 8;

__host__ __device__ __forceinline__ int lds_byte(int r, int c) { const int st = (r >> 4) * 2 + (c >> 5), rr = r & 15, cc = c & 31, ob = rr * 64 + cc * 2; return st * 1024 + (ob ^ (((ob >> 9) & 1) << 5)); }
__host__ __device__ __forceinline__ void stage_rc(int b, int& R, int& C) { const int st = b / 1024, sb = b % 1024, swz = sb ^ (((sb >> 9) & 1) << 5); R = (st >> 1) * 16 + swz / 64; C = (st & 1) * 32 + (swz % 64) / 2; }
__host__ __device__ __forceinline__ int perm32(int rho) { const int n = rho >> 4, i = rho & 15; return 8 * (i >> 2) + 4 * n + (i & 3); }

struct Unit { int pm, pn, sub; };
struct Gemm { const bf16_t* A; const bf16_t* Bt; int M, N, K; };

struct StaticOrder {
    int nM, nN, nwg, G, c;
    __host__ __device__ void init(int M, int N, int G_, int c_) { nM = M / BM; nN = N / BM; nwg = nM * nN; G = G_; c = c_; }
    __host__ __device__ bool next(int i, Unit& u) const {
        const long L = (long)i * G + c; if (L >= nwg) return false;
        int wgid = (int)L; { const int q = nwg / NXCD, r = nwg % NXCD, xcd = wgid % NXCD, off = wgid / NXCD; wgid = (xcd < r ? xcd * (q + 1) : r * (q + 1) + (xcd - r) * q) + off; }
        const int nig = WGM * nN, gid = wgid / nig, fm = gid * WGM, gsz = (nM - fm) < WGM ? (nM - fm) : WGM;
        u.pm = fm + ((wgid % nig) % gsz); u.pn = (wgid % nig) / gsz; u.sub = 0; return true;
    }
    __device__ __forceinline__ void a_ready(const Unit&) const {}
    __device__ __forceinline__ void done(const Unit&) const {}
};

__device__ __forceinline__ unsigned cvt_pk_bf16(float lo, float hi) { unsigned r; asm volatile("v_cvt_pk_bf16_f32 %0, %1, %2" : "=v"(r) : "v"(lo), "v"(hi)); return r; }
typedef float f32x2 __attribute__((ext_vector_type(2)));
template <class Epi, class Sched, bool ALIGN_EPI = false, bool SP2 = false>
__device__ __forceinline__ void gemm_phase(PG8_LAS unsigned char* lds, const Gemm g, const Sched& S, const Epi& E, const int tid) {
    const int wid = __builtin_amdgcn_readfirstlane(tid >> 6), lane = tid & 63, wr = wid >> 2, wc = wid & 3, fr = lane & 15, fq = lane >> 4;
    const int K = g.K, nt = K / BK;
    unsigned voffA[2], voffB[2];
#pragma unroll
    for (int i = 0; i < 2; ++i) { int R, C; stage_rc(tid * 16 + i * 8192, R, C); const int Rb = Epi::PERM ? ((R & ~31) + perm32(R & 31)) : R;
        voffA[i] = (unsigned)(R * K + C) * 2u; voffB[i] = (unsigned)(Rb * K + C) * 2u; }
    const size_t kstep = (size_t)(BK * 2);
    const size_t hstep = (size_t)HALF * K * 2;
        const unsigned ldsw = (unsigned)wid * 1024u;
    const int aoff = lds_byte(wr * 64 + fr, fq * 8), boff = lds_byte(wc * 32 + fr, fq * 8);
#define PG8_SA(b, h) (((b) * 2 + (h)) * HTB)
#define PG8_SB(b, h) ((4 + (b) * 2 + (h)) * HTB)
#define PG8_STAGE(bufoff, gbase, voff) do { _Pragma("unroll") for (int _i = 0; _i < 2; ++_i) \
        __builtin_amdgcn_global_load_lds((const unsigned*)((const char*)(gbase) + (voff)[_i]), (PG8_LAS unsigned*)(lds + (bufoff) + ldsw + _i * 8192), 16, 0, 0); } while (0)
#define PG8_LDA(dst, b, h) do { _Pragma("unroll") for (int m = 0; m < 4; ++m) _Pragma("unroll") for (int k = 0; k < 2; ++k) dst[m][k] = *(const PG8_LAS bf16x8*)(lds + PG8_SA(b, h) + aoff + m * 2048 + k * 1024); } while (0)
#define PG8_LDB(dst, b, h) do { _Pragma("unroll") for (int n = 0; n < 2; ++n) _Pragma("unroll") for (int k = 0; k < 2; ++k) dst[n][k] = *(const PG8_LAS bf16x8*)(lds + PG8_SB(b, h) + boff + n * 2048 + k * 1024); } while (0)
#define PG8_MMA(ai, bj, At, Bt) do { __builtin_amdgcn_s_setprio(1); _Pragma("unroll") for (int m = 0; m < 4; ++m) _Pragma("unroll") for (int n = 0; n < 2; ++n) _Pragma("unroll") for (int k = 0; k < 2; ++k) \
        acc[ai][bj][m][n] = __builtin_amdgcn_mfma_f32_16x16x32_bf16(Bt[n][k], At[m][k], acc[ai][bj][m][n], 0, 0, 0); __builtin_amdgcn_s_setprio(0); } while (0)
#define PG8_WAIT_V(n) asm volatile("s_waitcnt vmcnt(" #n ")" ::: "memory")
#define PG8_WAIT_L(n) asm volatile("s_waitcnt lgkmcnt(" #n ")" ::: "memory")
#define PG8_BAR __builtin_amdgcn_s_barrier()
#define PG8_SCHED __builtin_amdgcn_sched_barrier(0)
    Unit cur, nxt; int ui = 0;
    if (!S.next(0, cur)) return;
    f32x4 acc[2][2][4][2];
#pragma unroll
    for (int a = 0; a < 2; ++a)
#pragma unroll
        for (int b = 0; b < 2; ++b)
#pragma unroll
            for (int m = 0; m < 4; ++m)
#pragma unroll
                for (int n = 0; n < 2; ++n) acc[a][b][m][n] = (f32x4){0.f, 0.f, 0.f, 0.f};
    bf16x8 At[4][2], B0[2][2], B1[2][2];
    const char* cA = S.aptr(cur); const char* cB = S.bptr(cur);
    S.a_ready(cur);
    if constexpr (SP2) {
        PG8_STAGE(PG8_SB(0, 0), cB, voffB); PG8_STAGE(PG8_SB(0, 1), cB + hstep, voffB); PG8_STAGE(PG8_SA(0, 0), cA, voffA); PG8_STAGE(PG8_SA(0, 1), cA + hstep, voffA);
        if (wr == 1) PG8_BAR;
        PG8_WAIT_V(2); PG8_BAR;
        PG8_STAGE(PG8_SB(1, 0), cB + kstep, voffB); PG8_STAGE(PG8_SA(1, 0), cA + kstep, voffA); PG8_STAGE(PG8_SB(1, 1), cB + hstep + kstep, voffB);
        PG8_WAIT_V(6); PG8_BAR;
    } else {
        PG8_STAGE(PG8_SB(0, 0), cB, voffB); PG8_STAGE(PG8_SA(0, 0), cA, voffA); PG8_STAGE(PG8_SB(0, 1), cB + hstep, voffB); PG8_STAGE(PG8_SA(0, 1), cA + hstep, voffA);
        if (wr == 1) PG8_BAR;
        PG8_WAIT_V(4); PG8_BAR;
        PG8_STAGE(PG8_SB(1, 0), cB + kstep, voffB); PG8_STAGE(PG8_SA(1, 0), cA + kstep, voffA); PG8_STAGE(PG8_SB(1, 1), cB + hstep + kstep, voffB);
        PG8_WAIT_V(6); PG8_BAR;
    }
    for (;;) {
        const bool has_next = S.next(ui + 1, nxt);
        const char* nA = has_next ? S.aptr(nxt) : cA; const char* nB = has_next ? S.bptr(nxt) : cB;
        for (int t = 0; t < nt; t += 2) {
            const bool last = (t == nt - 2);
            const char* a1 = cA + (size_t)(t + 1) * kstep;
            const char* a2 = last ? nA : cA + (size_t)(t + 2) * kstep; const char* b2 = last ? nB : cB + (size_t)(t + 2) * kstep;
            const char* a3 = a2 + kstep; const char* b3 = b2 + kstep;
            if (last && has_next) S.a_ready(nxt);
            if constexpr (SP2) {
            PG8_LDB(B0, 0, 0); PG8_LDB(B1, 0, 1); PG8_SCHED; PG8_LDA(At, 0, 0); PG8_STAGE(PG8_SA(1, 1), a1 + hstep, voffA);
            PG8_WAIT_V(8); PG8_WAIT_L(0); PG8_BAR; PG8_MMA(0, 0, At, B0); PG8_MMA(0, 1, At, B1); PG8_BAR; PG8_SCHED;
            PG8_LDA(At, 0, 1); PG8_STAGE(PG8_SB(0, 0), b2, voffB); PG8_STAGE(PG8_SB(0, 1), b2 + hstep, voffB); PG8_STAGE(PG8_SA(0, 0), a2, voffA);
            PG8_WAIT_V(8); PG8_WAIT_L(0); PG8_BAR; PG8_MMA(1, 0, At, B0); PG8_MMA(1, 1, At, B1); PG8_BAR; PG8_SCHED;
            PG8_LDB(B0, 1, 0); PG8_LDB(B1, 1, 1); PG8_SCHED; PG8_LDA(At, 1, 0); PG8_STAGE(PG8_SA(0, 1), a2 + hstep, voffA);
            PG8_WAIT_V(8); PG8_WAIT_L(0); PG8_BAR; PG8_MMA(0, 0, At, B0); PG8_MMA(0, 1, At, B1); PG8_BAR; PG8_SCHED;
            PG8_LDA(At, 1, 1); PG8_STAGE(PG8_SB(1, 0), b3, voffB); PG8_STAGE(PG8_SB(1, 1), b3 + hstep, voffB); PG8_STAGE(PG8_SA(1, 0), a3, voffA);
            PG8_WAIT_V(8); PG8_WAIT_L(0); PG8_BAR; PG8_MMA(1, 0, At, B0); PG8_MMA(1, 1, At, B1); PG8_BAR; PG8_SCHED;
            } else {
            PG8_LDB(B0, 0, 0); PG8_SCHED; PG8_LDA(At, 0, 0); PG8_STAGE(PG8_SA(1, 1), a1 + hstep, voffA);
            PG8_WAIT_L(8); PG8_BAR; PG8_WAIT_L(0); PG8_MMA(0, 0, At, B0); PG8_BAR; PG8_SCHED;
            PG8_LDB(B1, 0, 1); PG8_STAGE(PG8_SB(0, 0), b2, voffB);
            PG8_BAR; PG8_WAIT_L(0); PG8_MMA(0, 1, At, B1); PG8_BAR;
            PG8_LDA(At, 0, 1); PG8_STAGE(PG8_SA(0, 0), a2, voffA);
            PG8_BAR; PG8_WAIT_L(0); PG8_MMA(1, 0, At, B0); PG8_BAR; PG8_SCHED;
            PG8_STAGE(PG8_SB(0, 1), b2 + hstep, voffB);
            PG8_WAIT_V(6); PG8_BAR; PG8_MMA(1, 1, At, B1); PG8_BAR;
            PG8_LDB(B0, 1, 0); PG8_SCHED; PG8_LDA(At, 1, 0); PG8_STAGE(PG8_SA(0, 1), a2 + hstep, voffA);
            PG8_WAIT_L(8); PG8_BAR; PG8_WAIT_L(0); PG8_MMA(0, 0, At, B0); PG8_BAR; PG8_SCHED;
            PG8_LDB(B1, 1, 1); PG8_STAGE(PG8_SB(1, 0), b3, voffB);
            PG8_BAR; PG8_WAIT_L(0); PG8_MMA(0, 1, At, B1); PG8_BAR;
            PG8_LDA(At, 1, 1); PG8_STAGE(PG8_SA(1, 0), a3, voffA);
            PG8_BAR; PG8_WAIT_L(0); PG8_MMA(1, 0, At, B0); PG8_BAR; PG8_SCHED;
            PG8_STAGE(PG8_SB(1, 1), b3 + hstep, voffB);
            PG8_WAIT_V(6); PG8_BAR; PG8_MMA(1, 1, At, B1); PG8_BAR;
            }
        }
        if constexpr (ALIGN_EPI) { if (wr == 0) PG8_BAR; }
        if constexpr (!Epi::AFTER_DRAIN) { E(acc, cur, wr, wc, fr, fq); S.done(cur); }
        if (!has_next) break;
#pragma unroll
        for (int a = 0; a < 2; ++a)
#pragma unroll
            for (int b = 0; b < 2; ++b)
#pragma unroll
                for (int m = 0; m < 4; ++m)
#pragma unroll
                    for (int n = 0; n < 2; ++n) acc[a][b][m][n] = (f32x4){0.f, 0.f, 0.f, 0.f};
        cur = nxt; cA = nA; cB = nB; ++ui;
        if constexpr (ALIGN_EPI) { if (wr == 1) PG8_BAR; }
    }
    PG8_WAIT_V(0);
    if constexpr (!ALIGN_EPI) { if (wr == 0) PG8_BAR; }
    PG8_BAR;
    if constexpr (Epi::AFTER_DRAIN) { E.fused(acc, cur, wr, wc, fr, fq, lds, wid, lane); S.done(cur); }
#undef PG8_SA
#undef PG8_SB
#undef PG8_STAGE
#undef PG8_LDA
#undef PG8_LDB
#undef PG8_MMA
#undef PG8_WAIT_V
#undef PG8_WAIT_L
#undef PG8_BAR
#undef PG8_SCHED
}
}
namespace attn_body {
using bf16=__hip_bfloat16;
using bf16x8=__attribute__((ext_vector_type(8)))short;
using s16x4=__attribute__((ext_vector_type(4)))short;
using f32x16=__attribute__((ext_vector_type(16)))float;
using u32x4=__attribute__((ext_vector_type(4)))unsigned;
constexpr int D=64,QP=1024,KP=256;
constexpr int NW=8,QBLK=32,KVBLK=64;
__device__ __forceinline__ int crow(int r,int hi){return (r&3)+8*(r>>2)+4*hi;}
#define SBAR() __builtin_amdgcn_sched_barrier(0)
__device__ __forceinline__ void kmask(f32x16&p0,f32x16&p1,int rem,int hi){
  const float NEG=-INFINITY;
  #pragma unroll
  for(int r=0;r<16;++r){int kv=4*hi+(r&3)+8*(r>>2); if(kv>=rem)p0[r]=NEG; if(kv+32>=rem)p1[r]=NEG;}
}

constexpr int NSLOT=3, SLOTB=8192;
constexpr int LDS_K=0, LDS_V=NSLOT*SLOTB, LDS_WS=2*NSLOT*SLOTB, LDS_OST=LDS_WS+NW*64*4, LDS_BYTES=LDS_OST+NW*4096;
constexpr float C2=0.125f*1.4426950408889634f;
__device__ __forceinline__ void glds16(const void*gsrc,unsigned lds_dst){unsigned keep;
  asm volatile("s_mov_b32 %0, m0\n\ts_mov_b32 m0, %2\n\ts_nop 0\n\tglobal_load_lds_dwordx4 %1, off\n\ts_mov_b32 m0, %0":"=&s"(keep):"v"(gsrc),"s"(lds_dst):"memory");}
__device__ __forceinline__ float max3f(float a,float b,float c){float r;asm("v_max3_f32 %0, %1, %2, %3":"=v"(r):"v"(a),"v"(b),"v"(c));return r;}
__device__ __forceinline__ float max2f(float a,float b){float r;asm("v_max_f32_e32 %0, %1, %2":"=v"(r):"v"(a),"v"(b));return r;}
__device__ __forceinline__ float fadd_s(float a,float b){float r;asm("v_add_f32_e32 %0, %1, %2":"=v"(r):"v"(a),"v"(b));return r;}
__device__ __forceinline__ float fsub_s(float a,float b){float r;asm("v_sub_f32_e32 %0, %1, %2":"=v"(r):"v"(a),"v"(b));return r;}
typedef float f32x2_t __attribute__((ext_vector_type(2))); typedef __bf16 bf16x2_t __attribute__((ext_vector_type(2)));
__device__ __forceinline__ unsigned cvtpk_s(float lo,float hi){f32x2_t v={lo,hi};bf16x2_t b=__builtin_convertvector(v,bf16x2_t);return __builtin_bit_cast(unsigned,b);}
#define WAIT_BAR(N) asm volatile("s_waitcnt vmcnt(" #N ") lgkmcnt(0)\n\ts_barrier":::"memory")

__device__ __forceinline__ void qkt(f32x16&p0,f32x16&p1,const char*Kslot,const bf16x8*qr,const f32x16&negm,int r32,int hi){
  const char*kb=Kslot+hi*1024+r32*16;
  #pragma unroll
  for(int d0=0;d0<4;++d0){
    const bf16x8 b0=*reinterpret_cast<const bf16x8*>(kb+d0*2048);
    const bf16x8 b1=*reinterpret_cast<const bf16x8*>(kb+d0*2048+512);
    if(d0==0){p0=__builtin_amdgcn_mfma_f32_32x32x16_bf16(b0,qr[0],negm,0,0,0);p1=__builtin_amdgcn_mfma_f32_32x32x16_bf16(b1,qr[0],negm,0,0,0);}
    else{p0=__builtin_amdgcn_mfma_f32_32x32x16_bf16(b0,qr[d0],p0,0,0,0);p1=__builtin_amdgcn_mfma_f32_32x32x16_bf16(b1,qr[d0],p1,0,0,0);}}
}
typedef __attribute__((address_space(3))) const char* lds_cptr;
typedef short v4i16_t __attribute__((ext_vector_type(4)));
__device__ __forceinline__ void kload8(bf16x8*kf,lds_cptr kp){
  kf[0]=*(const __attribute__((address_space(3))) bf16x8*)(kp);      kf[1]=*(const __attribute__((address_space(3))) bf16x8*)(kp+512);
  kf[2]=*(const __attribute__((address_space(3))) bf16x8*)(kp+2048); kf[3]=*(const __attribute__((address_space(3))) bf16x8*)(kp+2560);
  kf[4]=*(const __attribute__((address_space(3))) bf16x8*)(kp+4096); kf[5]=*(const __attribute__((address_space(3))) bf16x8*)(kp+4608);
  kf[6]=*(const __attribute__((address_space(3))) bf16x8*)(kp+6144); kf[7]=*(const __attribute__((address_space(3))) bf16x8*)(kp+6656);
}
__device__ __forceinline__ void kload2(bf16x8*kf,lds_cptr kp,int j){ kf[2*j]=*(const __attribute__((address_space(3))) bf16x8*)(kp+j*2048); kf[2*j+1]=*(const __attribute__((address_space(3))) bf16x8*)(kp+j*2048+512); }
__device__ __forceinline__ s16x4 vtr(lds_cptr p){ return __builtin_bit_cast(s16x4,__builtin_amdgcn_ds_read_tr16_b64_v4i16((__attribute__((address_space(3))) v4i16_t*)p)); }
__device__ __forceinline__ float rowmax(const f32x16&p0,const f32x16&p1){
  float a=max3f(p0[0],p0[1],p1[0]),b=max3f(p0[2],p0[3],p1[1]);a=max3f(a,p1[2],p1[3]);
  #pragma unroll
  for(int r=4;r<16;r+=4){a=max3f(a,p0[r],p0[r+1]);b=max3f(b,p0[r+2],p0[r+3]);a=max3f(a,p1[r],p1[r+1]);b=max3f(b,p1[r+2],p1[r+3]);}
  const float m=max2f(a,b);
  auto rr=__builtin_amdgcn_permlane32_swap(__float_as_uint(m),__float_as_uint(m),false,false);
  return max2f(__uint_as_float(rr[0]),__uint_as_float(rr[1]));
}
__device__ __forceinline__ void pv(f32x16*o,int vb,bf16x8 pa0,bf16x8 pa1,bf16x8 pa2,bf16x8 pa3){
  #pragma unroll
  for(int d0=0;d0<2;++d0){s16x4 lo[4],hi[4];
    #pragma unroll
    for(int ks=0;ks<4;++ks){
      asm volatile("ds_read_b64_tr_b16 %0,%1 offset:%c2":"=&v"(lo[ks]):"v"(vb),"i"(d0*4096+ks*1024):"memory");
      asm volatile("ds_read_b64_tr_b16 %0,%1 offset:%c2":"=&v"(hi[ks]):"v"(vb),"i"(d0*4096+ks*1024+512):"memory");}
    asm volatile("s_waitcnt lgkmcnt(0)":::"memory");SBAR();
    #define PK(k) (bf16x8){lo[k][0],lo[k][1],lo[k][2],lo[k][3],hi[k][0],hi[k][1],hi[k][2],hi[k][3]}
    o[d0]=__builtin_amdgcn_mfma_f32_32x32x16_bf16(pa0,PK(0),o[d0],0,0,0);
    o[d0]=__builtin_amdgcn_mfma_f32_32x32x16_bf16(pa1,PK(1),o[d0],0,0,0);
    o[d0]=__builtin_amdgcn_mfma_f32_32x32x16_bf16(pa2,PK(2),o[d0],0,0,0);
    o[d0]=__builtin_amdgcn_mfma_f32_32x32x16_bf16(pa3,PK(3),o[d0],0,0,0);
    #undef PK
  }
}

#ifndef ATTN_STORE16
#define ATTN_STORE16(p,v) (*(u32x4*)(p)=(v))
#endif
template<int THRL,int L,int NT> __device__ __forceinline__ void attn_unit(long rowbase,int kvh,int qblk,const bf16*Q,const bf16*__restrict__ K,const bf16*__restrict__ V,bf16*O,char*shm,const int tid){
  const int lane=tid&63,r32=lane&31,hi=lane>>5; const int wid=__builtin_amdgcn_readfirstlane(tid>>6);
  const int q0=qblk*64, qh=wid>>1, rh=wid&1;
  const bf16*Qw=Q+(rowbase+q0+rh*QBLK)*QP+(4*kvh+qh)*D;
  const bf16*Kh=K+rowbase*KP+kvh*D,*Vh=V+rowbase*KP+kvh*D;
  const unsigned lds0=(unsigned)(uintptr_t)shm;
  float*wsf=(float*)(shm+LDS_WS)+wid*64;
  const bf16*ksrc=Kh+(long)lane*KP+wid*8;
  const bf16*vsrc=Vh+(long)(16*(wid&3)+(lane>>2))*KP+(wid>>2)*32+(lane&3)*8;
  const unsigned kdst=lds0+LDS_K+wid*1024, vdst=lds0+LDS_V+wid*1024;
  #define DMA_K(t,slot) glds16(ksrc+(long)(t)*KVBLK*KP,(unsigned)__builtin_amdgcn_readfirstlane(kdst+(slot)))
  #define DMA_V(t,slot) glds16(vsrc+(long)(t)*KVBLK*KP,(unsigned)__builtin_amdgcn_readfirstlane(vdst+(slot)))
  const int vb0=(int)(lds0+LDS_V)+((lane>>4)&1)*32+(lane&3)*8+(4*hi+((lane&15)>>2))*64;
  const char*Kbase=shm+LDS_K; bf16x8 kf[8];
  const lds_cptr shm3=(lds_cptr)shm; const lds_cptr kp0=shm3+LDS_K+hi*1024+r32*16; const lds_cptr vp0=shm3+LDS_V+((lane>>4)&1)*32+(lane&3)*8+(4*hi+((lane&15)>>2))*64;
  DMA_K(0,0);DMA_V(0,0);DMA_K(1,SLOTB);
  bf16x8 qr[4];
  #pragma unroll
  for(int d0=0;d0<4;++d0)qr[d0]=*reinterpret_cast<const bf16x8*>(&Qw[(long)r32*QP+d0*16+hi*8]);
  if(q0+rh*QBLK+r32>=L){
    #pragma unroll
    for(int d0=0;d0<4;++d0)qr[d0]=bf16x8{0,0,0,0,0,0,0,0}; }
  float mhat=0.f,l_reg=0.f;f32x16 o[2];o[0]=f32x16{};o[1]=f32x16{};f32x16 negm=f32x16{};asm volatile("":"+v"(negm));
  #define CMASK(P0,P1,t) do{ if((t)>=NT-2)kmask(P0,P1,L-64*(t),hi);}while(0)
  bool resc=false;
  #define START(P0,P1) do{ const float rm=rowmax(P0,P1); resc=false; \
    { const float dl=rm; mhat=fadd_s(mhat,dl); \
      _Pragma("unroll") for(int r=0;r<16;++r){P0[r]=fsub_s(P0[r],dl);P1[r]=fsub_s(P1[r],dl);} \
      _Pragma("unroll") for(int r=0;r<16;++r)negm[r]=-mhat; asm volatile("":"+v"(negm)); } \
    _Pragma("unroll") for(int r=0;r<16;++r)P0[r]=__builtin_amdgcn_exp2f(P0[r]); }while(0)
  #define RESC() do{ if(resc){ asm volatile("s_waitcnt lgkmcnt(0)":::"memory"); \
      _Pragma("unroll") for(int d_=0;d_<2;++d_) _Pragma("unroll") for(int r=0;r<16;++r)o[d_][r]*=wsf[crow(r,hi)]; } }while(0)
  f32x16 pA0,pA1,pB0,pB1;
  int sl_prev=0,sl_cur=0,sl_next=SLOTB;
  #define ROT() do{sl_prev=sl_cur;sl_cur=sl_next;sl_next=(sl_next==(NSLOT-1)*SLOTB)?0:sl_next+SLOTB;}while(0)
  DMA_K(2,2*SLOTB);
  WAIT_BAR(3);
  qkt(pA0,pA1,Kbase,qr,negm,r32,hi);asm volatile("s_nop 15\n\ts_nop 7":"+v"(pA0),"+v"(pA1));CMASK(pA0,pA1,0);
  START(pA0,pA1);
  _Pragma("unroll") for(int r=0;r<16;++r)pA1[r]=__builtin_amdgcn_exp2f(pA1[r]);
  WAIT_BAR(0);
  DMA_K(3,0);DMA_V(1,SLOTB);
  ROT();
  kload8(kf,kp0+sl_cur);
  WAIT_BAR(2);
  s16x4 vlo[8],vhi[8]; u32x4 pw0,pw1,pw2,pw3;
  #define PKW(P,B) cvtpk_s(P[B],P[B+1])
  #define PAF(k) __builtin_bit_cast(bf16x8,pw##k)
  #define VFR(i) (bf16x8){vlo[i][0],vlo[i][1],vlo[i][2],vlo[i][3],vhi[i][0],vhi[i][1],vhi[i][2],vhi[i][3]}
  #define PIN(x) asm volatile("":"+v"(x))
  #define MX3(a,b,c) __builtin_fmaxf(__builtin_fmaxf((a),(b)),(c))
  #define GAPA(MF,A0,A1,A2,A3,W0,W1,PW) do{ MF; sacc+=A0; sacc+=A1; sacc+=A2; sacc+=A3; PIN(sacc); W0; W1; PIN(PW); SBAR(); }while(0)
  #define EX(v) __builtin_amdgcn_exp2f(v)
  #define GAPB(MF,X,B) do{ MF; X[B]=EX(X[B]); X[B+1]=EX(X[B+1]); X[B+2]=EX(X[B+2]); X[B+3]=EX(X[B+3]); PIN(X); SBAR(); }while(0)
  #define VRD(i) do{ vlo[i]=vtr(vp_+(((i)>>2)*4096+((i)&3)*1024)); vhi[i]=vtr(vp_+(((i)>>2)*4096+((i)&3)*1024+512)); }while(0)
  #define KRD(G,j) do{ if(G){ kload2(kf,kp0+sl_next,j); SBAR(); } }while(0)
  #define STEP(C0,C1,P0,P1,t,GK,GV,GL) do{ SBAR(); \
    const lds_cptr vp_=vp0+sl_prev; \
    VRD(0); SBAR(); float sacc=(P0[0]+P0[1]); \
    GAPA(C0=__builtin_amdgcn_mfma_f32_32x32x16_bf16(kf[0],qr[0],negm,0,0,0), P0[2],P0[3],P0[4],P0[5],     pw0[0]=PKW(P0,0), pw0[1]=PKW(P0,2), pw0); \
    VRD(4); SBAR(); GAPA(C1=__builtin_amdgcn_mfma_f32_32x32x16_bf16(kf[1],qr[0],negm,0,0,0), P0[6],P0[7],P0[8],P0[9],     pw0[2]=PKW(P0,4), pw0[3]=PKW(P0,6), pw0); \
    VRD(1); SBAR(); GAPA(C0=__builtin_amdgcn_mfma_f32_32x32x16_bf16(kf[2],qr[1],C0,0,0,0),   P0[10],P0[11],P0[12],P0[13], pw1[0]=PKW(P0,8), pw1[1]=PKW(P0,10), pw1); \
    VRD(5); SBAR(); GAPA(C1=__builtin_amdgcn_mfma_f32_32x32x16_bf16(kf[3],qr[1],C1,0,0,0),   P0[14],P0[15],P1[0],P1[1],   pw1[2]=PKW(P0,12),pw1[3]=PKW(P0,14), pw1); \
    VRD(2); SBAR(); GAPA(C0=__builtin_amdgcn_mfma_f32_32x32x16_bf16(kf[4],qr[2],C0,0,0,0),   P1[2],P1[3],P1[4],P1[5],     pw2[0]=PKW(P1,0), pw2[1]=PKW(P1,2), pw2); \
    VRD(6); SBAR(); GAPA(C1=__builtin_amdgcn_mfma_f32_32x32x16_bf16(kf[5],qr[2],C1,0,0,0),   P1[6],P1[7],P1[8],P1[9],     pw2[2]=PKW(P1,4), pw2[3]=PKW(P1,6), pw2); \
    VRD(3); SBAR(); GAPA(C0=__builtin_amdgcn_mfma_f32_32x32x16_bf16(kf[6],qr[3],C0,0,0,0),   P1[10],P1[11],P1[12],P1[13], pw3[0]=PKW(P1,8), pw3[1]=PKW(P1,10), pw3); \
    VRD(7); SBAR(); GAPA(C1=__builtin_amdgcn_mfma_f32_32x32x16_bf16(kf[7],qr[3],C1,0,0,0),   P1[14],P1[15],0.f,0.f,       pw3[2]=PKW(P1,12),pw3[3]=PKW(P1,14), pw3); \
    l_reg+=sacc; \
    if(GK){DMA_K((t)+3,sl_cur);} if(GV){DMA_V((t)+1,sl_next);} \
    CMASK(C0,C1,t); \
    { float a=MX3(C0[0],C0[1],C1[0]),b=MX3(C0[2],C0[3],C1[1]); a=MX3(a,C1[2],C1[3]); \
      _Pragma("unroll") for(int r=4;r<16;r+=4){a=MX3(a,C0[r],C0[r+1]);b=MX3(b,C0[r+2],C0[r+3]);a=MX3(a,C1[r],C1[r+1]);b=MX3(b,C1[r+2],C1[r+3]);} \
      float rm=__builtin_fmaxf(a,b); { auto rr=__builtin_amdgcn_permlane32_swap(__float_as_uint(rm),__float_as_uint(rm),false,false); rm=__builtin_fmaxf(__uint_as_float(rr[0]),__uint_as_float(rr[1])); } \
      resc=false; \
      if(__builtin_expect(__any(rm>(float)THRL),0)){ const float dl=__builtin_fmaxf(rm,0.f); mhat+=dl; \
        _Pragma("unroll") for(int r=0;r<16;++r){C0[r]-=dl;C1[r]-=dl;} \
        _Pragma("unroll") for(int r=0;r<16;++r)negm[r]=-mhat; asm volatile("":"+v"(negm)); \
        const float f=__builtin_amdgcn_exp2f(-dl); l_reg*=f; if(hi==0)wsf[r32]=f; resc=true; } } \
    SBAR(); \
    GAPB(o[0]=__builtin_amdgcn_mfma_f32_32x32x16_bf16(PAF(0),VFR(0),o[0],0,0,0), C0,0); \
    GAPB(o[1]=__builtin_amdgcn_mfma_f32_32x32x16_bf16(PAF(0),VFR(4),o[1],0,0,0), C0,4); \
    KRD(GL,0); GAPB(o[0]=__builtin_amdgcn_mfma_f32_32x32x16_bf16(PAF(1),VFR(1),o[0],0,0,0), C0,8); \
    KRD(GL,1); GAPB(o[1]=__builtin_amdgcn_mfma_f32_32x32x16_bf16(PAF(1),VFR(5),o[1],0,0,0), C0,12); \
    KRD(GL,2); GAPB(o[0]=__builtin_amdgcn_mfma_f32_32x32x16_bf16(PAF(2),VFR(2),o[0],0,0,0), C1,0); \
    KRD(GL,3); GAPB(o[1]=__builtin_amdgcn_mfma_f32_32x32x16_bf16(PAF(2),VFR(6),o[1],0,0,0), C1,4); \
    GAPB(o[0]=__builtin_amdgcn_mfma_f32_32x32x16_bf16(PAF(3),VFR(3),o[0],0,0,0), C1,8); \
    GAPB(o[1]=__builtin_amdgcn_mfma_f32_32x32x16_bf16(PAF(3),VFR(7),o[1],0,0,0), C1,12); \
    }while(0)
  int t=1;
  #undef CMASK
  #define CMASK(P0,P1,t) do{}while(0)
  for(;t+5<NT;t+=2){
    STEP(pB0,pB1,pA0,pA1,t,true,true,true);     WAIT_BAR(2); RESC(); ROT();
    STEP(pA0,pA1,pB0,pB1,t+1,true,true,true);   WAIT_BAR(2); RESC(); ROT();
  }
  #undef CMASK
  #define CMASK(P0,P1,t) do{ if((t)>=NT-2)kmask(P0,P1,L-64*(t),hi);}while(0)
  #define ENDW(tt) do{ if((tt)+3<NT){WAIT_BAR(2);} else if((tt)+2<NT){WAIT_BAR(1);} else {WAIT_BAR(0);} }while(0)
  for(;t+1<NT;t+=2){
    STEP(pB0,pB1,pA0,pA1,t,(t+3<NT),(t+1<NT),(t+1<NT));       ENDW(t);   RESC(); ROT();
    STEP(pA0,pA1,pB0,pB1,t+1,(t+4<NT),(t+2<NT),(t+2<NT));     ENDW(t+1); RESC(); ROT();
  }
  STEP(pB0,pB1,pA0,pA1,NT-1,false,false,false); RESC();
  { float sacc=pB0[0]+pB0[1]; _Pragma("unroll") for(int r=2;r<16;++r)sacc+=pB0[r]; _Pragma("unroll") for(int r=0;r<16;++r)sacc+=pB1[r]; l_reg+=sacc;
    pw0=(u32x4){PKW(pB0,0),PKW(pB0,2),PKW(pB0,4),PKW(pB0,6)};pw1=(u32x4){PKW(pB0,8),PKW(pB0,10),PKW(pB0,12),PKW(pB0,14)};pw2=(u32x4){PKW(pB1,0),PKW(pB1,2),PKW(pB1,4),PKW(pB1,6)};pw3=(u32x4){PKW(pB1,8),PKW(pB1,10),PKW(pB1,12),PKW(pB1,14)};
    SBAR(); pv(o,vb0+sl_cur,PAF(0),PAF(1),PAF(2),PAF(3)); }
  #undef PKW
  #undef PAF
  #undef VFR
  #undef PIN
  #undef MX3
  #undef GAPA
  #undef GAPB
  #undef EX
  #undef VRD
  #undef KRD
  #undef STEP
  #undef ENDW
  {auto rr=__builtin_amdgcn_permlane32_swap(__float_as_uint(l_reg),__float_as_uint(l_reg),false,false);l_reg=__uint_as_float(rr[0])+__uint_as_float(rr[1]);}
  if(hi==0)wsf[32+r32]=l_reg;asm volatile("s_waitcnt lgkmcnt(0)":::"memory");
  float rli[16];
  #pragma unroll
  for(int r=0;r<16;++r)rli[r]=__builtin_amdgcn_rcpf(wsf[32+crow(r,hi)]);
  bf16*Ow=O+(rowbase+q0+rh*QBLK)*QP+(4*kvh+qh)*D;
  { bf16*stg=(bf16*)(shm+LDS_OST)+wid*2048;
    #pragma unroll
    for(int r=0;r<16;++r){const int orow=crow(r,hi);
      #pragma unroll
      for(int d0=0;d0<2;++d0)stg[orow*64+d0*32+r32]=__float2bfloat16(o[d0][r]*rli[r]);}
    asm volatile("s_waitcnt lgkmcnt(0)":::"memory");
    #pragma unroll
    for(int i=0;i<4;++i){const int row=i*8+(lane>>3),ch=lane&7; const u32x4 v=*(const u32x4*)(stg+row*64+ch*8); if(q0+rh*QBLK+row<L)ATTN_STORE16(Ow+(long)row*QP+ch*8,v);} }
  asm volatile("s_waitcnt lgkmcnt(0)\n\ts_barrier":::"memory");
  #undef DMA_K
  #undef DMA_V
  #undef CMASK
  #undef START
  #undef RESC
  #undef ROT
}
constexpr int ATTN_LDS_BYTES=LDS_BYTES;
#undef SBAR
#undef WAIT_BAR
}
constexpr int DM = 1024, FF = 2816, NLAYER = 4;
constexpr int LP = 4112, LS = 2064, NSEQ_P = 4, NSEQ_S = 16, ROWS_P = NSEQ_P * LP  , T_ROWS = ROWS_P + NSEQ_S * LS  ;
constexpr int TPAD = 49664, NMT = TPAD / 256;
constexpr int NWIN = 4608;
constexpr float NORM_EPS = 1e-6f;
constexpr float QSCALE = 0.125f * 1.4426950408889634f;
constexpr int ATT_UNITS_P = NSEQ_P * 4 * 65, ATT_UNITS_S = NSEQ_S * 4 * 33, ATT_UNITS = ATT_UNITS_P + ATT_UNITS_S;

constexpr size_t MiB = 1u << 20;
constexpr size_t WS_CTL = 0;
constexpr size_t WS_ROPE = MiB / 4;
constexpr size_t WS_HMETA = 3 * MiB / 2;
constexpr size_t WS_SSQ = 3 * MiB;
constexpr size_t WS_W = 8 * MiB;
constexpr size_t W_GU1 = 0, W_D1 = W_GU1 + (size_t)5632 * 1024 * 2, W_IN = W_D1 + (size_t)1024 * 2816 * 2, W_GC = W_IN + (size_t)NWIN * 1024 * 2, W_OC = W_GC + 2 * MiB,
                 W_GA = W_OC + 2 * MiB, W_OA = W_GA + 2 * MiB, W_M = W_OA + 2 * MiB, W_GU2 = W_M + 2 * MiB, W_D2 = W_GU2 + (size_t)5632 * 1024 * 2, W_END = W_D2 + (size_t)1024 * 2816 * 2;
constexpr size_t WS_HB = 64 * MiB;
constexpr size_t ROWB = (size_t)TPAD * 1024 * 2;
constexpr size_t WS_BIG = WS_HB + 98 * MiB;
constexpr size_t WS_Q = WS_BIG, WS_K = WS_Q + ROWB, WS_V = WS_K + ROWB / 4, WS_CB = WS_V + ROWB / 4, WS_Z = WS_CB + ROWB, WS_END = WS_Z + ROWB;
constexpr size_t WS_HID = WS_BIG;
constexpr size_t WS_SCR = WS_K;
static_assert(WS_ROPE + (size_t)LP * 64 * 4 <= WS_HMETA && WS_HMETA + (size_t)20 * 16 * 1024 * 4 <= WS_SSQ && WS_SSQ + (size_t)TPAD * 16 * 4 <= WS_W, "d_ws map (small regions)");
static_assert(W_END <= 56 * MiB && ROWB <= 98 * MiB && (size_t)TPAD * FF * 2 <= WS_END - WS_BIG && 256 * 131072 <= ROWB / 2, "d_ws map");

constexpr int RING_BYTES = 131072, MISC_OFF = RING_BYTES + 320, PTAB_OFF = RING_BYTES + 1024, LDS_BYTES = 147456;
constexpr int NWAVES = 8;

#define GAS __attribute__((address_space(1)))
#define LAS __attribute__((address_space(3)))
typedef unsigned short bf16;
typedef unsigned v4u __attribute__((ext_vector_type(4)));
typedef float f32x4 __attribute__((ext_vector_type(4)));
__device__ __forceinline__ unsigned f2bf(float f) { unsigned u = __builtin_bit_cast(unsigned, f); return (u + 0x7fffu + ((u >> 16) & 1u)) >> 16; }
__device__ __forceinline__ unsigned pk2(float lo, float hi) { return pg8::cvt_pk_bf16(lo, hi); }
__device__ __forceinline__ float bflo(unsigned u) { return __builtin_bit_cast(float, u << 16); }
__device__ __forceinline__ float bfhi(unsigned u) { return __builtin_bit_cast(float, u & 0xffff0000u); }
__device__ __forceinline__ float wave_sum(float v) {
#pragma unroll
    for (int o = 1; o < 64; o <<= 1) v += __shfl_xor(v, o);
    return v;
}
__device__ __forceinline__ void rowinfo(int r, int& pos, int& L) {
    if (r < ROWS_P) { L = LP; pos = r % LP; } else if (r < T_ROWS) { L = LS; pos = (r - ROWS_P) % LS; } else { L = 1 << 30; pos = 0; }
}
__device__ __forceinline__ float sigmoidf_(float x) { return __builtin_amdgcn_rcpf(1.0f + __builtin_amdgcn_exp2f(-1.4426950408889634f * x)); }

struct PlainOrder : pg8::StaticOrder {
    const char* A; const char* Bt; size_t tstep;
    __device__ __forceinline__ const char* aptr(const pg8::Unit& u) const { return A + (size_t)u.pm * tstep; }
    __device__ __forceinline__ const char* bptr(const pg8::Unit& u) const { return Bt + (size_t)u.pn * tstep; }
};
struct ChainOrder {
    pg8::StaticOrder base; const char* A[4]; const char* B[4]; size_t tstep;
    __device__ __forceinline__ bool next(int i, pg8::Unit& u) const { if (!base.next(i >> 2, u)) return false; u.sub = i & 3; return true; }
    __device__ __forceinline__ const char* aptr(const pg8::Unit& u) const { const char* p = u.sub == 0 ? A[0] : u.sub == 1 ? A[1] : u.sub == 2 ? A[2] : A[3]; return p + (size_t)u.pm * tstep; }
    __device__ __forceinline__ const char* bptr(const pg8::Unit& u) const { const char* p = u.sub == 0 ? B[0] : u.sub == 1 ? B[1] : u.sub == 2 ? B[2] : B[3]; return p + (size_t)u.pn * tstep; }
    __device__ __forceinline__ void a_ready(const pg8::Unit&) const {}
    __device__ __forceinline__ void done(const pg8::Unit&) const {}
};

using pg8::f32x4; using pg8::u32x4; using pg8::Unit; using pg8::bf16_t;
typedef f32x4 Acc[2][2][4][2];
__device__ __forceinline__ u32x4 pack8(const f32x4 a, const f32x4 b) { u32x4 w; w.x = pk2(a[0], a[1]); w.y = pk2(a[2], a[3]); w.z = pk2(b[0], b[1]); w.w = pk2(b[2], b[3]); return w; }
__device__ __forceinline__ void unpack8(const u32x4 w, f32x4& a, f32x4& b) { a = (f32x4){bflo(w.x), bfhi(w.x), bflo(w.y), bfhi(w.y)}; b = (f32x4){bflo(w.z), bfhi(w.z), bflo(w.w), bfhi(w.w)}; }
__device__ __forceinline__ float rstd_of(const float* ssq, int row) { const f32x4* p = (const f32x4*)(ssq + (size_t)row * 16); const f32x4 a = p[0], b = p[1], c = p[2], d = p[3];
    const float s = (((a[0] + a[1]) + (a[2] + a[3])) + ((b[0] + b[1]) + (b[2] + b[3]))) + (((c[0] + c[1]) + (c[2] + c[3])) + ((d[0] + d[1]) + (d[2] + d[3])));
    return __builtin_amdgcn_rsqf(s * (1.0f / DM) + NORM_EPS); }

struct EpiSwiGLU {
    static constexpr bool PERM = true, AFTER_DRAIN = false;
    bf16_t* hid; const float* ssq;
    __device__ __forceinline__ void operator()(const Acc& acc, const Unit& u, int wr, int wc, int fr, int fq) const {
#pragma unroll
        for (int ai = 0; ai < 2; ++ai)
#pragma unroll
            for (int m = 0; m < 4; ++m) {
                const int row = u.pm * 256 + ai * 128 + wr * 64 + m * 16 + fr; const float rs = rstd_of(ssq, row);
                f32x4 o[2];
#pragma unroll
                for (int n = 0; n < 2; ++n)
#pragma unroll
                    for (int e = 0; e < 4; ++e) { const float g = acc[ai][0][m][n][e] * rs, up = acc[ai][1][m][n][e] * rs; o[n][e] = g * sigmoidf_(g) * up; }
                *(u32x4*)(hid + (size_t)row * FF + u.pn * 128 + wc * 32 + 8 * fq) = pack8(o[0], o[1]);
            }
    }
};
struct EpiResid {
    static constexpr bool PERM = true, AFTER_DRAIN = false;
    bf16_t* hb; float* ssq_out; float scale;
    __device__ __forceinline__ void operator()(const Acc& acc, const Unit& u, int wr, int wc, int fr, int fq) const {
#pragma unroll
        for (int ai = 0; ai < 2; ++ai)
#pragma unroll
            for (int m = 0; m < 4; ++m) {
                const int row = u.pm * 256 + ai * 128 + wr * 64 + m * 16 + fr; const bool ok = row < T_ROWS;
                float ss = 0.f;
                if (ok) {
                    bf16_t* bp = hb + (size_t)row * DM + u.pn * 256 + wc * 32 + 8 * fq;
#pragma unroll
                    for (int bj = 0; bj < 2; ++bj) {
                        f32x4 a, b; unpack8(*(const u32x4*)(bp + bj * 128), a, b);
                        a = a + acc[ai][bj][m][0] * scale; b = b + acc[ai][bj][m][1] * scale;
                        const u32x4 w = pack8(a, b); *(u32x4*)(bp + bj * 128) = w;
                        unpack8(w, a, b);
                        ss += (a[0] * a[0] + a[1] * a[1]) + (a[2] * a[2] + a[3] * a[3]) + (b[0] * b[0] + b[1] * b[1]) + (b[2] * b[2] + b[3] * b[3]);
                    }
                }
                ss += __shfl_xor(ss, 16); ss += __shfl_xor(ss, 32);
                if (ok && fq == 0) ssq_out[(size_t)row * 16 + u.pn * 4 + wc] = ss;
                if (m & 1) asm volatile("" ::: "memory");
            }
    }
};
struct EpiWin {
    static constexpr bool PERM = true, AFTER_DRAIN = false;
    bf16_t *q, *k, *v, *cb, *z; const float* ssq; const float* rope; const float* qg; const float* kg;
    __device__ __forceinline__ void operator()(const Acc& acc, const Unit& u, int wr, int wc, int fr, int fq) const {
        const int pn = u.pn;
        if (pn <= 4) {
            const float* g = pn < 4 ? qg : kg; const float osc = pn < 4 ? QSCALE : 1.0f;
            f32x4 G[2][2];
#pragma unroll
            for (int bj = 0; bj < 2; ++bj)
#pragma unroll
                for (int n = 0; n < 2; ++n) G[bj][n] = *(const f32x4*)(g + 32 * bj + 16 * n + 4 * fq) * osc;
#pragma unroll
            for (int ai = 0; ai < 2; ++ai)
#pragma unroll
                for (int m = 0; m < 4; ++m) {
                    const int row = u.pm * 256 + ai * 128 + wr * 64 + m * 16 + fr; const float rs = rstd_of(ssq, row);
                    int pos, L; rowinfo(row, pos, L);
                    f32x4 x[2][2]; float ss = 0.f;
#pragma unroll
                    for (int bj = 0; bj < 2; ++bj)
#pragma unroll
                        for (int n = 0; n < 2; ++n) { x[bj][n] = acc[ai][bj][m][n] * rs; const f32x4 t = x[bj][n] * x[bj][n]; ss += (t[0] + t[1]) + (t[2] + t[3]); }
                    ss += __shfl_xor(ss, 16); ss += __shfl_xor(ss, 32);
                    const float rn = __builtin_amdgcn_rsqf(ss * (1.0f / 64.0f) + NORM_EPS);
                    bf16_t* dst = pn < 4 ? q + (size_t)row * 1024 + (4 * pn + wc) * 64 + 8 * fq : k + (size_t)row * 256 + wc * 64 + 8 * fq;
#pragma unroll
                    for (int bj = 0; bj < 2; ++bj) {
                        const f32x4 c4 = *(const f32x4*)(rope + ((pos * 2 + bj) * 2 + 0) * 16 + 4 * fq), s4 = *(const f32x4*)(rope + ((pos * 2 + bj) * 2 + 1) * 16 + 4 * fq);
                        const f32x4 y1 = x[bj][0] * rn * G[bj][0], y2 = x[bj][1] * rn * G[bj][1];
                        const f32x4 o1 = y1 * c4 - y2 * s4, o2 = y2 * c4 + y1 * s4;
                        *(u32x4*)(dst + 32 * bj) = pack8(o1, o2);
                    }
                    if (m & 1) asm volatile("" ::: "memory");
                }
        } else if (pn < 10) {
            bf16_t* base; int pitch, c0;
            if (pn == 5) { base = v; pitch = 256; c0 = 0; } else { base = cb; pitch = 1024; c0 = 256 * (pn - 6); }
#pragma unroll
            for (int ai = 0; ai < 2; ++ai)
#pragma unroll
                for (int m = 0; m < 4; ++m) {
                    const int row = u.pm * 256 + ai * 128 + wr * 64 + m * 16 + fr; const float rs = rstd_of(ssq, row);
#pragma unroll
                    for (int bj = 0; bj < 2; ++bj) *(u32x4*)(base + (size_t)row * pitch + c0 + 128 * bj + wc * 32 + 8 * fq) = pack8(acc[ai][bj][m][0] * rs, acc[ai][bj][m][1] * rs);
                }
        } else {
#pragma unroll
            for (int ai = 0; ai < 2; ++ai)
#pragma unroll
                for (int m = 0; m < 4; ++m) {
                    const int row = u.pm * 256 + ai * 128 + wr * 64 + m * 16 + fr; const float rs = rstd_of(ssq, row), rs2 = rs * rs;
                    *(u32x4*)(z + (size_t)row * 1024 + 128 * (pn - 10) + wc * 32 + 8 * fq) = pack8(acc[ai][0][m][0] * acc[ai][1][m][0] * rs2, acc[ai][0][m][1] * acc[ai][1][m][1] * rs2);
                }
        }
    }
};
struct EpiMerge {
    static constexpr bool PERM = true, AFTER_DRAIN = false;
    bf16_t* merged; u32x4* scr; const float* ssq; int tid;
    __device__ __forceinline__ void operator()(const Acc& acc, const Unit& u, int wr, int wc, int fr, int fq) const {
        const int sub = u.sub;
#pragma unroll
        for (int ai = 0; ai < 2; ++ai)
#pragma unroll
            for (int m = 0; m < 4; ++m) {
                const int row = u.pm * 256 + ai * 128 + wr * 64 + m * 16 + fr;
                float rs = 1.f; if ((sub & 1) == 0) rs = rstd_of(ssq, row);
#pragma unroll
                for (int bj = 0; bj < 2; ++bj) {
                    u32x4* mp = (u32x4*)(merged + (size_t)row * DM + u.pn * 256 + bj * 128 + wc * 32 + 8 * fq);
                    u32x4* sp = scr + ((ai * 4 + m) * 2 + bj) * 512 + tid;
                    const f32x4 v0 = acc[ai][bj][m][0], v1 = acc[ai][bj][m][1];
                    if ((sub & 1) == 0) {
                        f32x4 s0, s1;
#pragma unroll
                        for (int e = 0; e < 4; ++e) { s0[e] = sigmoidf_(v0[e] * rs); s1[e] = sigmoidf_(v1[e] * rs); }
                        if (sub == 0) *mp = pack8(s0, s1); else *sp = pack8(s0, s1);
                    } else if (sub == 1) {
                        f32x4 g0, g1; unpack8(*mp, g0, g1); *mp = pack8(g0 * v0, g1 * v1);
                    } else {
                        f32x4 c0, c1, s0, s1; unpack8(*mp, c0, c1); unpack8(*sp, s0, s1); *mp = pack8(c0 + s0 * v0, c1 + s1 * v1);
                    }
                }
                if (m & 1) asm volatile("" ::: "memory");
            }
    }
};

__device__ __forceinline__ void cvt_item(const float* W, int Nsrc, int n0src, const float* gain, bool permqk, bf16* WT, int K, int nrow0, int k0, LAS float* scr, int lane) {
#pragma unroll 8
    for (int i = 0; i < 32; ++i) { const int kk = 2 * i + (lane >> 5); float w = W[(size_t)(k0 + kk) * Nsrc + n0src + (lane & 31)]; if (gain) w *= gain[k0 + kk]; scr[kk * 33 + (lane & 31)] = w; }
    asm volatile("s_waitcnt lgkmcnt(0)" ::: "memory");
    const int c = lane & 7;
#pragma unroll
    for (int j = 0; j < 4; ++j) { const int n = (lane >> 3) + 8 * j; const int ns = permqk ? (16 * ((n >> 2) & 1) + 4 * (n >> 3) + (n & 3)) : n; const LAS float* s = scr + (8 * c) * 33 + ns;
        v4u o; o.x = pk2(s[0 * 33], s[1 * 33]); o.y = pk2(s[2 * 33], s[3 * 33]); o.z = pk2(s[4 * 33], s[5 * 33]); o.w = pk2(s[6 * 33], s[7 * 33]);
        *(GAS v4u*)(WT + (size_t)(nrow0 + n) * K + k0 + 8 * c) = o; }
    asm volatile("s_waitcnt lgkmcnt(0)" ::: "memory");
}
struct Args { const float* in[21]; float* out; unsigned char* ws; int ph_lo, ph_hi; };
struct PT {
    volatile LAS unsigned long long* t;
    __device__ __forceinline__ unsigned long long get(int i) const { const unsigned long long v = t[i]; const unsigned lo = __builtin_amdgcn_readfirstlane((unsigned)v), hi = __builtin_amdgcn_readfirstlane((unsigned)(v >> 32)); return ((unsigned long long)hi << 32) | lo; }
    __device__ __forceinline__ const float* in(int i) const { return (const float*)(const GAS float*)get(i); }
    __device__ __forceinline__ float* out() const { return (float*)(GAS float*)get(21); }
    __device__ __forceinline__ unsigned char* ws() const { return (unsigned char*)(GAS unsigned char*)get(22); }
};

__device__ __forceinline__ void convert_layer(const PT a, unsigned char* ws, int l, LAS unsigned char* lds, int gw, int NGW, int wave, int lane) {
    LAS float* scr = (LAS float*)(lds + wave * 16384);
    bf16* W = (bf16*)(ws + WS_W);
    const size_t ffo = (size_t)l * DM * FF, sqo = (size_t)l * DM * DM;
    const float* win = a.in(8) + (size_t)l * DM * 6656; const float* mixg = a.in(7) + l * DM;
    for (int it = gw; it < 13312; it += NGW) {
        int r = it;
        if (r < 2816) { const int kb = r / 176, nb = r % 176, pn = nb >> 3, t = nb & 7; const float* src = (t >> 2) ? a.in(5) + ffo : a.in(4) + ffo;
            cvt_item(src, FF, 128 * pn + 32 * (t & 3), a.in(3) + l * DM, false, (bf16*)((char*)W + W_GU1), 1024, nb * 32, kb * 64, scr, lane); continue; } r -= 2816;
        if (r < 1408) { const int kb = r / 32, nb = r % 32; cvt_item(a.in(6) + ffo, DM, nb * 32, nullptr, false, (bf16*)((char*)W + W_D1), FF, nb * 32, kb * 64, scr, lane); continue; } r -= 1408;
        if (r < 2304) { const int kb = r / 144, nb = r % 144, pn = nb >> 3, t = nb & 7; int n0; bool pq = false;
            if (pn < 4) { n0 = 64 * (4 * pn + (t & 3)) + 32 * (t >> 2); pq = true; }
            else if (pn == 4) { n0 = 1024 + 64 * (t & 3) + 32 * (t >> 2); pq = true; }
            else if (pn == 5) n0 = 1280 + 32 * t;
            else if (pn < 10) n0 = 1536 + 256 * (pn - 6) + 32 * t;
            else n0 = ((t >> 2) ? 3584 : 2560) + 128 * (pn - 10) + 32 * (t & 3);
            cvt_item(win, 6656, n0, mixg, pq, (bf16*)((char*)W + W_IN), 1024, nb * 32, kb * 64, scr, lane); continue; } r -= 2304;
        if (r < 2560) { const int seg = r / 512, q = r % 512, kb = q / 32, nb = q % 32;
            const float* src; int ns, n0; const float* gn = nullptr; size_t dst;
            if (seg == 0) { src = win; ns = 6656; n0 = 5632 + nb * 32; gn = mixg; dst = W_GC; }
            else if (seg == 1) { src = a.in(14) + sqo; ns = DM; n0 = nb * 32; dst = W_OC; }
            else if (seg == 2) { src = win; ns = 6656; n0 = 4608 + nb * 32; gn = mixg; dst = W_GA; }
            else if (seg == 3) { src = a.in(13) + sqo; ns = DM; n0 = nb * 32; dst = W_OA; }
            else { src = a.in(15) + sqo; ns = DM; n0 = nb * 32; dst = W_M; }
            cvt_item(src, ns, n0, gn, false, (bf16*)((char*)W + dst), 1024, nb * 32, kb * 64, scr, lane); continue; } r -= 2560;
        if (r < 2816) { const int kb = r / 176, nb = r % 176, pn = nb >> 3, t = nb & 7; const float* src = (t >> 2) ? a.in(18) + ffo : a.in(17) + ffo;
            cvt_item(src, FF, 128 * pn + 32 * (t & 3), a.in(16) + l * DM, false, (bf16*)((char*)W + W_GU2), 1024, nb * 32, kb * 64, scr, lane); continue; } r -= 2816;
        { const int kb = r / 32, nb = r % 32; cvt_item(a.in(19) + ffo, DM, nb * 32, nullptr, false, (bf16*)((char*)W + W_D2), FF, nb * 32, kb * 64, scr, lane); }
    }
}

__device__ __forceinline__ void prologue(const PT a, unsigned char* ws, int tid, int wave, int lane, int bid, int G) {
    const int gtid = bid * 512 + tid, GT = G * 512, gw = bid * NWAVES + wave, NGW = G * NWAVES;
    float* ssq = (float*)(ws + WS_SSQ); bf16* hb = (bf16*)(ws + WS_HB); float* rope = (float*)(ws + WS_ROPE);
    for (int i = gtid; i < (TPAD - T_ROWS) * 16; i += GT) ssq[(size_t)T_ROWS * 16 + i] = 0.f;
    for (int i = gtid; i < (TPAD - T_ROWS) * DM / 8; i += GT) ((v4u*)(hb + (size_t)T_ROWS * DM))[i] = (v4u){0u, 0u, 0u, 0u};
    if (gtid < 64) ((unsigned*)(ws + WS_CTL))[gtid] = 0u;
    for (int i = gtid; i < LP * 32; i += GT) {
        const int pos = i >> 5, axis = (i >> 4) & 1, f = i & 15;
        float coord; if (pos < 16) coord = axis ? (float)pos : -1.0f; else { const int t = pos - 16; coord = axis ? (float)(t & 63) : (float)(t >> 6); }
        const float inv = powf(10000.0f, -(float)f * (1.0f / 16.0f)); const float ang = coord * inv;
        float s, c; sincosf(ang, &s, &c);
        rope[((pos * 2 + axis) * 2 + 0) * 16 + f] = c; rope[((pos * 2 + axis) * 2 + 1) * 16 + f] = s;
    }
    for (int r = gw; r < T_ROWS; r += NGW) {
        int pos, L; rowinfo(r, pos, L);
        const float* src;
        if (pos < 16) src = a.in(2) + (size_t)pos * DM;
        else if (r < ROWS_P) src = a.in(0) + ((size_t)(r / LP) * 4096 + pos - 16) * DM;
        else src = a.in(1) + ((size_t)((r - ROWS_P) / LS) * 2048 + pos - 16) * DM;
        f32x4 v[4]; float s = 0.f;
        unsigned long long* o8 = (unsigned long long*)(hb + (size_t)r * DM) + lane;
#pragma unroll
        for (int j = 0; j < 4; ++j) { v[j] = ((const f32x4*)src)[lane + 64 * j];
            const unsigned lo = pk2(v[j][0], v[j][1]), hi = pk2(v[j][2], v[j][3]); o8[64 * j] = (unsigned long long)lo | ((unsigned long long)hi << 32);
            const float a0 = bflo(lo), a1 = bfhi(lo), a2 = bflo(hi), a3 = bfhi(hi); s += (a0 * a0 + a1 * a1) + (a2 * a2 + a3 * a3); }
        s = wave_sum(s);
        if (lane < 16) ssq[(size_t)r * 16 + lane] = lane == 0 ? s : 0.f;
    }
}

__device__ __forceinline__ void conv_phase(const PT a, unsigned char* ws, int l, int tid, int bid, int G) {
    bf16* cb = (bf16*)(ws + WS_CB); const bf16* z = (const bf16*)(ws + WS_Z);
    const float* cw = a.in(9) + (size_t)l * 3 * DM; const float* cbias = a.in(10) + (size_t)l * DM;
    const int chunk = tid & 127, sub = tid >> 7, c0 = chunk * 8;
    f32x4 w0[2], w1[2], w2[2], bb[2];
#pragma unroll
    for (int h = 0; h < 2; ++h) { w0[h] = *(const f32x4*)(cw + c0 + 4 * h); w1[h] = *(const f32x4*)(cw + DM + c0 + 4 * h); w2[h] = *(const f32x4*)(cw + 2 * DM + c0 + 4 * h); bb[h] = *(const f32x4*)(cbias + c0 + 4 * h); }
    const int nstrip = (T_ROWS + 63) / 64;
    for (int strip = bid; strip < nstrip; strip += G) {
        const int r0 = strip * 64 + sub * 16;
#pragma unroll 4
        for (int i = 0; i < 16; ++i) {
            const int r = r0 + i; if (r >= T_ROWS) break;
            int pos, L; rowinfo(r, pos, L);
            const u32x4 zero = (u32x4){0u, 0u, 0u, 0u};
            const u32x4 zc = *(const u32x4*)(z + (size_t)r * DM + c0);
            const u32x4 zp = pos > 0 ? *(const u32x4*)(z + (size_t)(r - 1) * DM + c0) : zero;
            const u32x4 zn = pos < L - 1 ? *(const u32x4*)(z + (size_t)(r + 1) * DM + c0) : zero;
            u32x4* cp = (u32x4*)(cb + (size_t)r * DM + c0); const u32x4 cv = *cp;
            f32x4 p0, p1, c0v, c1v, n0, n1, b0, b1; unpack8(zp, p0, p1); unpack8(zc, c0v, c1v); unpack8(zn, n0, n1); unpack8(cv, b0, b1);
            const f32x4 o0 = b0 * (w0[0] * p0 + w1[0] * c0v + w2[0] * n0 + bb[0]), o1 = b1 * (w0[1] * p1 + w1[1] * c1v + w2[1] * n1 + bb[1]);
            *cp = pack8(o0, o1);
        }
    }
}

__device__ __forceinline__ void attention_phase(const PT a, unsigned char* ws, int l, unsigned char* lds_generic, int tid) {
    using abf = attn_body::bf16;
    const abf* Q = (const abf*)(ws + WS_Q); const abf* K = (const abf*)(ws + WS_K); const abf* V = (const abf*)(ws + WS_V); abf* O = (abf*)(ws + WS_Q);
    unsigned* ctr = (unsigned*)(ws + WS_CTL) + l;
    volatile unsigned* slot = (volatile unsigned*)(lds_generic + MISC_OFF);
    for (;;) {
        if (tid == 0) *slot = atomicAdd(ctr, 1u);
        __syncthreads();
        const int u = (int)__builtin_amdgcn_readfirstlane(*slot);
        if (u >= ATT_UNITS) break;
        int tidu = tid; asm volatile("" : "+v"(tidu));
        if (u < ATT_UNITS_P) { const int s = u / 260, rem = u - s * 260, kvh = rem / 65, qblk = rem - kvh * 65;
            attn_body::attn_unit<8, LP, 66>((long)s * LP, kvh, qblk, Q, K, V, O, (char*)lds_generic, tidu); }
        else { const int u2 = u - ATT_UNITS_P, s = u2 / 132, rem = u2 - s * 132, kvh = rem / 33, qblk = rem - kvh * 33;
            attn_body::attn_unit<8, LS, 34>((long)ROWS_P + (long)s * LS, kvh, qblk, Q, K, V, O, (char*)lds_generic, tidu); }
    }
}

__device__ __forceinline__ void final_phase(const PT a, unsigned char* ws, int wave, int lane, int bid, int G) {
    const int gw = bid * NWAVES + wave, NGW = G * NWAVES;
    const float* ssq = (const float*)(ws + WS_SSQ); const bf16* hb = (const bf16*)(ws + WS_HB); float* out = a.out();
    f32x4 g[4];
#pragma unroll
    for (int j = 0; j < 4; ++j) g[j] = ((const f32x4*)a.in(20))[lane + 64 * j];
    for (int r = gw; r < T_ROWS; r += NGW) {
        int pos, L; rowinfo(r, pos, L); if (pos < 16) continue;
        float* p = r < ROWS_P ? out + ((size_t)(r / LP) * 4096 + pos - 16) * DM : out + (size_t)NSEQ_P * 4096 * DM + ((size_t)((r - ROWS_P) / LS) * 2048 + pos - 16) * DM;
        const float rs = rstd_of(ssq, r);
        const unsigned long long* i8 = (const unsigned long long*)(hb + (size_t)r * DM) + lane;
#pragma unroll
        for (int j = 0; j < 4; ++j) { const unsigned long long w = i8[64 * j]; const unsigned lo = (unsigned)w, hi = (unsigned)(w >> 32);
            const f32x4 v = (f32x4){bflo(lo), bfhi(lo), bflo(hi), bfhi(hi)}; ((f32x4*)p)[lane + 64 * j] = v * rs * g[j]; }
    }
}

constexpr int NSTEPS = 2 + 9 * NLAYER;

template <int STEP>
__device__ __forceinline__ void run_step(const PT pt, unsigned char* lds, cg::grid_group& grid, const int ph_lo, const int ph_hi) {
#ifdef MAX_STEP
    if (STEP >= MAX_STEP && STEP != NSTEPS - 1) return;
#endif
    if (STEP < ph_lo || STEP >= ph_hi) return;
    if (STEP > ph_lo) { asm volatile("s_waitcnt vmcnt(0)" ::: "memory"); grid.sync(); }
    LAS unsigned char* l3 = (LAS unsigned char*)lds;
    int tid = threadIdx.x; asm volatile("" : "+v"(tid));
    int bid = blockIdx.x; asm volatile("" : "+s"(bid));
    int G = gridDim.x; asm volatile("" : "+s"(G));
    unsigned char* ws = pt.ws();
    const int lane = tid & 63, wave = __builtin_amdgcn_readfirstlane(tid >> 6);
    const int gw = bid * NWAVES + wave, NGW = G * NWAVES;
    float* ssq = (float*)(ws + WS_SSQ);
    bf16_t* hb = (bf16_t*)(ws + WS_HB);
    if constexpr (STEP == 0) { prologue(pt, ws, tid, wave, lane, bid, G); }
    else if constexpr (STEP == NSTEPS - 1) { final_phase(pt, ws, wave, lane, bid, G); }
    else {
        constexpr int l = (STEP - 1) / 9, ph = (STEP - 1) % 9;
        if constexpr (ph == 0) {
#ifndef NO_CVT
            convert_layer(pt, ws, l, l3, gw, NGW, wave, lane);
#endif
            __syncthreads();
        } else if constexpr (ph == 1 || ph == 7) {
            constexpr int f = ph == 7;
            PlainOrder S; S.init(TPAD, 2 * FF, G, bid); S.A = (const char*)hb; S.Bt = (const char*)(ws + WS_W + (f ? W_GU2 : W_GU1)); S.tstep = (size_t)256 * 1024 * 2;
            pg8::Gemm g{nullptr, nullptr, TPAD, 2 * FF, 1024};
            EpiSwiGLU E{(bf16_t*)(ws + WS_HID), ssq};
#ifndef NO_GU
            pg8::gemm_phase<EpiSwiGLU, PlainOrder, true, true>(l3, g, S, E, tid);
#endif
        } else if constexpr (ph == 2 || ph == 6 || ph == 8) {
            constexpr int f = ph == 8; constexpr int K = ph == 6 ? 1024 : FF;
            PlainOrder S; S.init(TPAD, DM, G, bid);
            S.A = ph == 6 ? (const char*)(ws + WS_Z) : (const char*)(ws + WS_HID);
            S.Bt = (const char*)(ws + WS_W + (ph == 6 ? W_M : (f ? W_D2 : W_D1))); S.tstep = (size_t)256 * K * 2;
            pg8::Gemm g{nullptr, nullptr, TPAD, DM, K};
            EpiResid E{hb, ssq, ph == 6 ? 1.0f : 0.5f};
#ifndef NO_RES
            pg8::gemm_phase<EpiResid, PlainOrder, true, true>(l3, g, S, E, tid);
#endif
        } else if constexpr (ph == 3) {
            PlainOrder S; S.init(TPAD, NWIN, G, bid); S.A = (const char*)hb; S.Bt = (const char*)(ws + WS_W + W_IN); S.tstep = (size_t)256 * 1024 * 2;
            pg8::Gemm g{nullptr, nullptr, TPAD, NWIN, 1024};
            EpiWin E{(bf16_t*)(ws + WS_Q), (bf16_t*)(ws + WS_K), (bf16_t*)(ws + WS_V), (bf16_t*)(ws + WS_CB), (bf16_t*)(ws + WS_Z), ssq,
                     (const float*)(ws + WS_ROPE), pt.in(11) + l * 64, pt.in(12) + l * 64};
#ifndef NO_WIN
            pg8::gemm_phase<EpiWin, PlainOrder, true, true>(l3, g, S, E, tid);
#endif
        } else if constexpr (ph == 4) {
#ifndef NO_CONV
            conv_phase(pt, ws, l, tid, bid, G);
#endif
#ifndef NO_ATT
            attention_phase(pt, ws, l, lds, tid);
#endif
        } else {
            ChainOrder S; S.base.init(TPAD, DM, G, bid); S.tstep = (size_t)256 * 1024 * 2;
            S.A[0] = (const char*)hb; S.A[1] = (const char*)(ws + WS_CB); S.A[2] = (const char*)hb; S.A[3] = (const char*)(ws + WS_Q);
            S.B[0] = (const char*)(ws + WS_W + W_GC); S.B[1] = (const char*)(ws + WS_W + W_OC); S.B[2] = (const char*)(ws + WS_W + W_GA); S.B[3] = (const char*)(ws + WS_W + W_OA);
            pg8::Gemm g{nullptr, nullptr, TPAD, DM, 1024};
            EpiMerge E{(bf16_t*)(ws + WS_Z), (u32x4*)(ws + WS_SCR + (size_t)bid * 131072), ssq, tid};
#ifndef NO_MERGE
            pg8::gemm_phase<EpiMerge, ChainOrder, true, true>(l3, g, S, E, tid);
#endif
        }
    }
}
template <int STEP>
__device__ __forceinline__ void run_from(const PT pt, unsigned char* lds, cg::grid_group& grid, const int ph_lo, const int ph_hi) {
    run_step<STEP>(pt, lds, grid, ph_lo, ph_hi);
    if constexpr (STEP + 1 < NSTEPS) run_from<STEP + 1>(pt, lds, grid, ph_lo, ph_hi);
}

__global__ void __launch_bounds__(NWAVES * 64, 2) mega_fwd(Args args) {
    extern __shared__ __attribute__((aligned(16))) unsigned char lds[];
    cg::grid_group grid = cg::this_grid();
    PT pt; pt.t = (volatile LAS unsigned long long*)((LAS unsigned char*)lds + PTAB_OFF);
    if (threadIdx.x == 0) {
#pragma unroll
        for (int i = 0; i < 21; ++i) pt.t[i] = (unsigned long long)args.in[i];
        pt.t[21] = (unsigned long long)args.out; pt.t[22] = (unsigned long long)args.ws;
    }
    const int ph_lo = args.ph_lo, ph_hi = args.ph_hi;
    __syncthreads();
    run_from<0>(pt, lds, grid, ph_lo, ph_hi);
}

#ifndef LAUNCH_PER_STEP
#define LAUNCH_PER_STEP 0
#endif
extern "C" void kernel_launch(void* const* d_in, const int* in_sizes, int n_in, void* d_out, int out_size, void* d_ws, size_t ws_size, hipStream_t stream) {
    static int grid = 0;
    if (grid == 0) {
        if (n_in != 21 || ws_size < WS_END) { fprintf(stderr, "kernel_launch: need 21 inputs and >= %zu bytes of workspace; got %d, %zu\n", (size_t)WS_END, n_in, ws_size); grid = -1; return; }
        int dev = 0, cus = 0, per_cu = 0;
        hipGetDevice(&dev); hipDeviceGetAttribute(&cus, hipDeviceAttributeMultiprocessorCount, dev);
        if (hipFuncSetAttribute((const void*)mega_fwd, hipFuncAttributeMaxDynamicSharedMemorySize, LDS_BYTES) != hipSuccess) { fprintf(stderr, "kernel_launch: hipFuncSetAttribute failed\n"); grid = -1; return; }
        if (hipOccupancyMaxActiveBlocksPerMultiprocessor(&per_cu, (const void*)mega_fwd, NWAVES * 64, LDS_BYTES) != hipSuccess || per_cu < 1) per_cu = 1;
        (void)hipGetLastError();
        grid = cus * per_cu;
    }
    if (grid < 0) return;
    Args a{};
    for (int i = 0; i < 21; ++i) a.in[i] = (const float*)d_in[i];
    a.out = (float*)d_out; a.ws = (unsigned char*)d_ws;
#if LAUNCH_PER_STEP
    for (int s = 0; s < NSTEPS; ++s) { a.ph_lo = s; a.ph_hi = s + 1; void* kargs[] = {&a}; hipLaunchCooperativeKernel((void*)mega_fwd, dim3(grid), dim3(NWAVES * 64), kargs, LDS_BYTES, stream); }
#else
    a.ph_lo = 0; a.ph_hi = NSTEPS; void* kargs[] = {&a};
    hipError_t e = hipLaunchCooperativeKernel((void*)mega_fwd, dim3(grid), dim3(NWAVES * 64), kargs, LDS_BYTES, stream);
    if (e != hipSuccess) fprintf(stderr, "cooperative launch failed: %s (grid %d)\n", hipGetErrorString(e), grid);
#endif
}
```

```cpp
#include <hip/hip_runtime.h>
#include <hip/hip_cooperative_groups.h>
#include <hip/hip_bf16.h>
#include <cstdio>
#include <cstdint>
#include <cmath>
namespace cg = cooperative_groups;
namespace pg8 {
#define PG8_LAS __attribute__((address_space(3)))
typedef unsigned short bf16_t;
typedef short bf16x8 __attribute__((ext_vector_type(8)));
typedef float f32x4 __attribute__((ext_vector_type(4)));
typedef unsigned u32x4 __attribute__((ext_vector_type(4)));
constexpr int BM = 256, BK = 64, HALF = 128, HTB = HALF * BK * 2  , STAGE_BYTES = 8 * HTB, NXCD = 8, WGM = 8;

__host__ __device__ __forceinline__ int lds_byte(int r, int c) { const int st = (r >> 4) * 2 + (c >> 5), rr = r & 15, cc = c & 31, ob = rr * 64 + cc * 2; return st * 1024 + (ob ^ (((ob >> 9) & 1) << 5)); }
__host__ __device__ __forceinline__ void stage_rc(int b, int& R, int& C) { const int st = b / 1024, sb = b % 1024, swz = sb ^ (((sb >> 9) & 1) << 5); R = (st >> 1) * 16 + swz / 64; C = (st & 1) * 32 + (swz % 64) / 2; }
__host__ __device__ __forceinline__ int perm32(int rho) { const int n = rho >> 4, i = rho & 15; return 8 * (i >> 2) + 4 * n + (i & 3); }

struct Unit { int pm, pn, sub; };
struct Gemm { const bf16_t* A; const bf16_t* Bt; int M, N, K; };

struct StaticOrder {
    int nM, nN, nwg, G, c;
    __host__ __device__ void init(int M, int N, int G_, int c_) { nM = M / BM; nN = N / BM; nwg = nM * nN; G = G_; c = c_; }
    __host__ __device__ bool next(int i, Unit& u) const {
        const long L = (long)i * G + c; if (L >= nwg) return false;
        int wgid = (int)L; { const int q = nwg / NXCD, r = nwg % NXCD, xcd = wgid % NXCD, off = wgid / NXCD; wgid = (xcd < r ? xcd * (q + 1) : r * (q + 1) + (xcd - r) * q) + off; }
        const int nig = WGM * nN, gid = wgid / nig, fm = gid * WGM, gsz = (nM - fm) < WGM ? (nM - fm) : WGM;
        u.pm = fm + ((wgid % nig) % gsz); u.pn = (wgid % nig) / gsz; u.sub = 0; return true;
    }
    __device__ __forceinline__ void a_ready(const Unit&) const {}
    __device__ __forceinline__ void done(const Unit&) const {}
};

__device__ __forceinline__ unsigned cvt_pk_bf16(float lo, float hi) { unsigned r; asm volatile("v_cvt_pk_bf16_f32 %0, %1, %2" : "=v"(r) : "v"(lo), "v"(hi)); return r; }
typedef float f32x2 __attribute__((ext_vector_type(2)));
template <class Epi, class Sched, bool ALIGN_EPI = false, bool SP2 = false>
__device__ __forceinline__ void gemm_phase(PG8_LAS unsigned char* lds, const Gemm g, const Sched& S, const Epi& E, const int tid) {
    const int wid = __builtin_amdgcn_readfirstlane(tid >> 6), lane = tid & 63, wr = wid >> 2, wc = wid & 3, fr = lane & 15, fq = lane >> 4;
    const int K = g.K, nt = K / BK;
    unsigned voffA[2], voffB[2];
#pragma unroll
    for (int i = 0; i < 2; ++i) { int R, C; stage_rc(tid * 16 + i * 8192, R, C); const int Rb = Epi::PERM ? ((R & ~31) + perm32(R & 31)) : R;
        voffA[i] = (unsigned)(R * K + C) * 2u; voffB[i] = (unsigned)(Rb * K + C) * 2u; }
    const size_t kstep = (size_t)(BK * 2);
    const size_t hstep = (size_t)HALF * K * 2;
        const unsigned ldsw = (unsigned)wid * 1024u;
    const int aoff = lds_byte(wr * 64 + fr, fq * 8), boff = lds_byte(wc * 32 + fr, fq * 8);
#define PG8_SA(b, h) (((b) * 2 + (h)) * HTB)
#define PG8_SB(b, h) ((4 + (b) * 2 + (h)) * HTB)
#define PG8_STAGE(bufoff, gbase, voff) do { _Pragma("unroll") for (int _i = 0; _i < 2; ++_i) \
        __builtin_amdgcn_global_load_lds((const unsigned*)((const char*)(gbase) + (voff)[_i]), (PG8_LAS unsigned*)(lds + (bufoff) + ldsw + _i * 8192), 16, 0, 0); } while (0)
#define PG8_LDA(dst, b, h) do { _Pragma("unroll") for (int m = 0; m < 4; ++m) _Pragma("unroll") for (int k = 0; k < 2; ++k) dst[m][k] = *(const PG8_LAS bf16x8*)(lds + PG8_SA(b, h) + aoff + m * 2048 + k * 1024); } while (0)
#define PG8_LDB(dst, b, h) do { _Pragma("unroll") for (int n = 0; n < 2; ++n) _Pragma("unroll") for (int k = 0; k < 2; ++k) dst[n][k] = *(const PG8_LAS bf16x8*)(lds + PG8_SB(b, h) + boff + n * 2048 + k * 1024); } while (0)
#define PG8_MMA(ai, bj, At, Bt) do { __builtin_amdgcn_s_setprio(1); _Pragma("unroll") for (int m = 0; m < 4; ++m) _Pragma("unroll") for (int n = 0; n < 2; ++n) _Pragma("unroll") for (int k = 0; k < 2; ++k) \
        acc[ai][bj][m][n] = __builtin_amdgcn_mfma_f32_16x16x32_bf16(Bt[n][k], At[m][k], acc[ai][bj][m][n], 0, 0, 0); __builtin_amdgcn_s_setprio(0); } while (0)
#define PG8_WAIT_V(n) asm volatile("s_waitcnt vmcnt(" #n ")" ::: "memory")
#define PG8_WAIT_L(n) asm volatile("s_waitcnt lgkmcnt(" #n ")" ::: "memory")
#define PG8_BAR __builtin_amdgcn_s_barrier()
#define PG8_SCHED __builtin_amdgcn_sched_barrier(0)
    Unit cur, nxt; int ui = 0;
    if (!S.next(0, cur)) return;
    f32x4 acc[2][2][4][2];
#pragma unroll
    for (int a = 0; a < 2; ++a)
#pragma unroll
        for (int b = 0; b < 2; ++b)
#pragma unroll
            for (int m = 0; m < 4; ++m)
#pragma unroll
                for (int n = 0; n < 2; ++n) acc[a][b][m][n] = (f32x4){0.f, 0.f, 0.f, 0.f};
    bf16x8 At[4][2], B0[2][2], B1[2][2];
    const char* cA = S.aptr(cur); const char* cB = S.bptr(cur);
    S.a_ready(cur);
    if constexpr (SP2) {
        PG8_STAGE(PG8_SB(0, 0), cB, voffB); PG8_STAGE(PG8_SB(0, 1), cB + hstep, voffB); PG8_STAGE(PG8_SA(0, 0), cA, voffA); PG8_STAGE(PG8_SA(0, 1), cA + hstep, voffA);
        if (wr == 1) PG8_BAR;
        PG8_WAIT_V(2); PG8_BAR;
        PG8_STAGE(PG8_SB(1, 0), cB + kstep, voffB); PG8_STAGE(PG8_SA(1, 0), cA + kstep, voffA); PG8_STAGE(PG8_SB(1, 1), cB + hstep + kstep, voffB);
        PG8_WAIT_V(6); PG8_BAR;
    } else {
        PG8_STAGE(PG8_SB(0, 0), cB, voffB); PG8_STAGE(PG8_SA(0, 0), cA, voffA); PG8_STAGE(PG8_SB(0, 1), cB + hstep, voffB); PG8_STAGE(PG8_SA(0, 1), cA + hstep, voffA);
        if (wr == 1) PG8_BAR;
        PG8_WAIT_V(4); PG8_BAR;
        PG8_STAGE(PG8_SB(1, 0), cB + kstep, voffB); PG8_STAGE(PG8_SA(1, 0), cA + kstep, voffA); PG8_STAGE(PG8_SB(1, 1), cB + hstep + kstep, voffB);
        PG8_WAIT_V(6); PG8_BAR;
    }
    for (;;) {
        const bool has_next = S.next(ui + 1, nxt);
        const char* nA = has_next ? S.aptr(nxt) : cA; const char* nB = has_next ? S.bptr(nxt) : cB;
        for (int t = 0; t < nt; t += 2) {
            const bool last = (t == nt - 2);
            const char* a1 = cA + (size_t)(t + 1) * kstep;
            const char* a2 = last ? nA : cA + (size_t)(t + 2) * kstep; const char* b2 = last ? nB : cB + (size_t)(t + 2) * kstep;
            const char* a3 = a2 + kstep; const char* b3 = b2 + kstep;
            if (last && has_next) S.a_ready(nxt);
            if constexpr (SP2) {
            PG8_LDB(B0, 0, 0); PG8_LDB(B1, 0, 1); PG8_SCHED; PG8_LDA(At, 0, 0); PG8_STAGE(PG8_SA(1, 1), a1 + hstep, voffA);
            PG8_WAIT_V(8); PG8_WAIT_L(0); PG8_BAR; PG8_MMA(0, 0, At, B0); PG8_MMA(0, 1, At, B1); PG8_BAR; PG8_SCHED;
            PG8_LDA(At, 0, 1); PG8_STAGE(PG8_SB(0, 0), b2, voffB); PG8_STAGE(PG8_SB(0, 1), b2 + hstep, voffB); PG8_STAGE(PG8_SA(0, 0), a2, voffA);
            PG8_WAIT_V(8); PG8_WAIT_L(0); PG8_BAR; PG8_MMA(1, 0, At, B0); PG8_MMA(1, 1, At, B1); PG8_BAR; PG8_SCHED;
            PG8_LDB(B0, 1, 0); PG8_LDB(B1, 1, 1); PG8_SCHED; PG8_LDA(At, 1, 0); PG8_STAGE(PG8_SA(0, 1), a2 + hstep, voffA);
            PG8_WAIT_V(8); PG8_WAIT_L(0); PG8_BAR; PG8_MMA(0, 0, At, B0); PG8_MMA(0, 1, At, B1); PG8_BAR; PG8_SCHED;
            PG8_LDA(At, 1, 1); PG8_STAGE(PG8_SB(1, 0), b3, voffB); PG8_STAGE(PG8_SB(1, 1), b3 + hstep, voffB); PG8_STAGE(PG8_SA(1, 0), a3, voffA);
            PG8_WAIT_V(8); PG8_WAIT_L(0); PG8_BAR; PG8_MMA(1, 0, At, B0); PG8_MMA(1, 1, At, B1); PG8_BAR; PG8_SCHED;
            } else {
            PG8_LDB(B0, 0, 0); PG8_SCHED; PG8_LDA(At, 0, 0); PG8_STAGE(PG8_SA(1, 1), a1 + hstep, voffA);
            PG8_WAIT_L(8); PG8_BAR; PG8_WAIT_L(0); PG8_MMA(0, 0, At, B0); PG8_BAR; PG8_SCHED;
            PG8_LDB(B1, 0, 1); PG8_STAGE(PG8_SB(0, 0), b2, voffB);
            PG8_BAR; PG8_WAIT_L(0); PG8_MMA(0, 1, At, B1); PG8_BAR;
            PG8_LDA(At, 0, 1); PG8_STAGE(PG8_SA(0, 0), a2, voffA);
            PG8_BAR; PG8_WAIT_L(0); PG8_MMA(1, 0, At, B0); PG8_BAR; PG8_SCHED;
            PG8_STAGE(PG8_SB(0, 1), b2 + hstep, voffB);
            PG8_WAIT_V(6); PG8_BAR; PG8_MMA(1, 1, At, B1); PG8_BAR;
            PG8_LDB(B0, 1, 0); PG8_SCHED; PG8_LDA(At, 1, 0); PG8_STAGE(PG8_SA(0, 1), a2 + hstep, voffA);
            PG8_WAIT_L(8); PG8_BAR; PG8_WAIT_L(0); PG8_MMA(0, 0, At, B0); PG8_BAR; PG8_SCHED;
            PG8_LDB(B1, 1, 1); PG8_STAGE(PG8_SB(1, 0), b3, voffB);
            PG8_BAR; PG8_WAIT_L(0); PG8_MMA(0, 1, At, B1); PG8_BAR;
            PG8_LDA(At, 1, 1); PG8_STAGE(PG8_SA(1, 0), a3, voffA);
            PG8_BAR; PG8_WAIT_L(0); PG8_MMA(1, 0, At, B0); PG8_BAR; PG8_SCHED;
            PG8_STAGE(PG8_SB(1, 1), b3 + hstep, voffB);
            PG8_WAIT_V(6); PG8_BAR; PG8_MMA(1, 1, At, B1); PG8_BAR;
            }
        }
        if constexpr (ALIGN_EPI) { if (wr == 0) PG8_BAR; }
        if constexpr (!Epi::AFTER_DRAIN) { E(acc, cur, wr, wc, fr, fq); S.done(cur); }
        if (!has_next) break;
#pragma unroll
        for (int a = 0; a < 2; ++a)
#pragma unroll
            for (int b = 0; b < 2; ++b)
#pragma unroll
                for (int m = 0; m < 4; ++m)
#pragma unroll
                    for (int n = 0; n < 2; ++n) acc[a][b][m][n] = (f32x4){0.f, 0.f, 0.f, 0.f};
        cur = nxt; cA = nA; cB = nB; ++ui;
        if constexpr (ALIGN_EPI) { if (wr == 1) PG8_BAR; }
    }
    PG8_WAIT_V(0);
    if constexpr (!ALIGN_EPI) { if (wr == 0) PG8_BAR; }
    PG8_BAR;
    if constexpr (Epi::AFTER_DRAIN) { E.fused(acc, cur, wr, wc, fr, fq, lds, wid, lane); S.done(cur); }
#undef PG8_SA
#undef PG8_SB
#undef PG8_STAGE
#undef PG8_LDA
#undef PG8_LDB
#undef PG8_MMA
#undef PG8_WAIT_V
#undef PG8_WAIT_L
#undef PG8_BAR
#undef PG8_SCHED
}
}
namespace attn_body {
using bf16=__hip_bfloat16;
using bf16x8=__attribute__((ext_vector_type(8)))short;
using s16x4=__attribute__((ext_vector_type(4)))short;
using f32x16=__attribute__((ext_vector_type(16)))float;
using u32x4=__attribute__((ext_vector_type(4)))unsigned;
constexpr int D=64,QP=1024,KP=256;
constexpr int NW=8,QBLK=32,KVBLK=64;
__device__ __forceinline__ int crow(int r,int hi){return (r&3)+8*(r>>2)+4*hi;}
#define SBAR() __builtin_amdgcn_sched_barrier(0)
__device__ __forceinline__ void kmask(f32x16&p0,f32x16&p1,int rem,int hi){
  const float NEG=-INFINITY;
  #pragma unroll
  for(int r=0;r<16;++r){int kv=4*hi+(r&3)+8*(r>>2); if(kv>=rem)p0[r]=NEG; if(kv+32>=rem)p1[r]=NEG;}
}

constexpr int NSLOT=3, SLOTB=8192;
constexpr int LDS_K=0, LDS_V=NSLOT*SLOTB, LDS_WS=2*NSLOT*SLOTB, LDS_OST=LDS_WS+NW*64*4, LDS_BYTES=LDS_OST+NW*4096;
constexpr float C2=0.125f*1.4426950408889634f;
__device__ __forceinline__ void glds16(const void*gsrc,unsigned lds_dst){unsigned keep;
  asm volatile("s_mov_b32 %0, m0\n\ts_mov_b32 m0, %2\n\ts_nop 0\n\tglobal_load_lds_dwordx4 %1, off\n\ts_mov_b32 m0, %0":"=&s"(keep):"v"(gsrc),"s"(lds_dst):"memory");}
__device__ __forceinline__ float max3f(float a,float b,float c){float r;asm("v_max3_f32 %0, %1, %2, %3":"=v"(r):"v"(a),"v"(b),"v"(c));return r;}
__device__ __forceinline__ float max2f(float a,float b){float r;asm("v_max_f32_e32 %0, %1, %2":"=v"(r):"v"(a),"v"(b));return r;}
__device__ __forceinline__ float fadd_s(float a,float b){float r;asm("v_add_f32_e32 %0, %1, %2":"=v"(r):"v"(a),"v"(b));return r;}
__device__ __forceinline__ float fsub_s(float a,float b){float r;asm("v_sub_f32_e32 %0, %1, %2":"=v"(r):"v"(a),"v"(b));return r;}
typedef float f32x2_t __attribute__((ext_vector_type(2))); typedef __bf16 bf16x2_t __attribute__((ext_vector_type(2)));
__device__ __forceinline__ unsigned cvtpk_s(float lo,float hi){f32x2_t v={lo,hi};bf16x2_t b=__builtin_convertvector(v,bf16x2_t);return __builtin_bit_cast(unsigned,b);}
#define WAIT_BAR(N) asm volatile("s_waitcnt vmcnt(" #N ") lgkmcnt(0)\n\ts_barrier":::"memory")

__device__ __forceinline__ void qkt(f32x16&p0,f32x16&p1,const char*Kslot,const bf16x8*qr,const f32x16&negm,int r32,int hi){
  const char*kb=Kslot+hi*1024+r32*16;
  #pragma unroll
  for(int d0=0;d0<4;++d0){
    const bf16x8 b0=*reinterpret_cast<const bf16x8*>(kb+d0*2048);
    const bf16x8 b1=*reinterpret_cast<const bf16x8*>(kb+d0*2048+512);
    if(d0==0){p0=__builtin_amdgcn_mfma_f32_32x32x16_bf16(b0,qr[0],negm,0,0,0);p1=__builtin_amdgcn_mfma_f32_32x32x16_bf16(b1,qr[0],negm,0,0,0);}
    else{p0=__builtin_amdgcn_mfma_f32_32x32x16_bf16(b0,qr[d0],p0,0,0,0);p1=__builtin_amdgcn_mfma_f32_32x32x16_bf16(b1,qr[d0],p1,0,0,0);}}
}
typedef __attribute__((address_space(3))) const char* lds_cptr;
typedef short v4i16_t __attribute__((ext_vector_type(4)));
__device__ __forceinline__ void kload8(bf16x8*kf,lds_cptr kp){
  kf[0]=*(const __attribute__((address_space(3))) bf16x8*)(kp);      kf[1]=*(const __attribute__((address_space(3))) bf16x8*)(kp+512);
  kf[2]=*(const __attribute__((address_space(3))) bf16x8*)(kp+2048); kf[3]=*(const __attribute__((address_space(3))) bf16x8*)(kp+2560);
  kf[4]=*(const __attribute__((address_space(3))) bf16x8*)(kp+4096); kf[5]=*(const __attribute__((address_space(3))) bf16x8*)(kp+4608);
  kf[6]=*(const __attribute__((address_space(3))) bf16x8*)(kp+6144); kf[7]=*(const __attribute__((address_space(3))) bf16x8*)(kp+6656);
}
__device__ __forceinline__ void kload2(bf16x8*kf,lds_cptr kp,int j){ kf[2*j]=*(const __attribute__((address_space(3))) bf16x8*)(kp+j*2048); kf[2*j+1]=*(const __attribute__((address_space(3))) bf16x8*)(kp+j*2048+512); }
__device__ __forceinline__ s16x4 vtr(lds_cptr p){ return __builtin_bit_cast(s16x4,__builtin_amdgcn_ds_read_tr16_b64_v4i16((__attribute__((address_space(3))) v4i16_t*)p)); }
__device__ __forceinline__ float rowmax(const f32x16&p0,const f32x16&p1){
  float a=max3f(p0[0],p0[1],p1[0]),b=max3f(p0[2],p0[3],p1[1]);a=max3f(a,p1[2],p1[3]);
  #pragma unroll
  for(int r=4;r<16;r+=4){a=max3f(a,p0[r],p0[r+1]);b=max3f(b,p0[r+2],p0[r+3]);a=max3f(a,p1[r],p1[r+1]);b=max3f(b,p1[r+2],p1[r+3]);}
  const float m=max2f(a,b);
  auto rr=__builtin_amdgcn_permlane32_swap(__float_as_uint(m),__float_as_uint(m),false,false);
  return max2f(__uint_as_float(rr[0]),__uint_as_float(rr[1]));
}
__device__ __forceinline__ void pv(f32x16*o,int vb,bf16x8 pa0,bf16x8 pa1,bf16x8 pa2,bf16x8 pa3){
  #pragma unroll
  for(int d0=0;d0<2;++d0){s16x4 lo[4],hi[4];
    #pragma unroll
    for(int ks=0;ks<4;++ks){
      asm volatile("ds_read_b64_tr_b16 %0,%1 offset:%c2":"=&v"(lo[ks]):"v"(vb),"i"(d0*4096+ks*1024):"memory");
      asm volatile("ds_read_b64_tr_b16 %0,%1 offset:%c2":"=&v"(hi[ks]):"v"(vb),"i"(d0*4096+ks*1024+512):"memory");}
    asm volatile("s_waitcnt lgkmcnt(0)":::"memory");SBAR();
    #define PK(k) (bf16x8){lo[k][0],lo[k][1],lo[k][2],lo[k][3],hi[k][0],hi[k][1],hi[k][2],hi[k][3]}
    o[d0]=__builtin_amdgcn_mfma_f32_32x32x16_bf16(pa0,PK(0),o[d0],0,0,0);
    o[d0]=__builtin_amdgcn_mfma_f32_32x32x16_bf16(pa1,PK(1),o[d0],0,0,0);
    o[d0]=__builtin_amdgcn_mfma_f32_32x32x16_bf16(pa2,PK(2),o[d0],0,0,0);
    o[d0]=__builtin_amdgcn_mfma_f32_32x32x16_bf16(pa3,PK(3),o[d0],0,0,0);
    #undef PK
  }
}

#ifndef ATTN_STORE16
#define ATTN_STORE16(p,v) (*(u32x4*)(p)=(v))
#endif
template<int THRL,int L,int NT> __device__ __forceinline__ void attn_unit(long rowbase,int kvh,int qblk,const bf16*Q,const bf16*__restrict__ K,const bf16*__restrict__ V,bf16*O,char*shm,const int tid){
  const int lane=tid&63,r32=lane&31,hi=lane>>5; const int wid=__builtin_amdgcn_readfirstlane(tid>>6);
  const int q0=qblk*64, qh=wid>>1, rh=wid&1;
  const bf16*Qw=Q+(rowbase+q0+rh*QBLK)*QP+(4*kvh+qh)*D;
  const bf16*Kh=K+rowbase*KP+kvh*D,*Vh=V+rowbase*KP+kvh*D;
  const unsigned lds0=(unsigned)(uintptr_t)shm;
  float*wsf=(float*)(shm+LDS_WS)+wid*64;
  const bf16*ksrc=Kh+(long)lane*KP+wid*8;
  const bf16*vsrc=Vh+(long)(16*(wid&3)+(lane>>2))*KP+(wid>>2)*32+(lane&3)*8;
  const unsigned kdst=lds0+LDS_K+wid*1024, vdst=lds0+LDS_V+wid*1024;
  #define DMA_K(t,slot) glds16(ksrc+(long)(t)*KVBLK*KP,(unsigned)__builtin_amdgcn_readfirstlane(kdst+(slot)))
  #define DMA_V(t,slot) glds16(vsrc+(long)(t)*KVBLK*KP,(unsigned)__builtin_amdgcn_readfirstlane(vdst+(slot)))
  const int vb0=(int)(lds0+LDS_V)+((lane>>4)&1)*32+(lane&3)*8+(4*hi+((lane&15)>>2))*64;
  const char*Kbase=shm+LDS_K; bf16x8 kf[8];
  const lds_cptr shm3=(lds_cptr)shm; const lds_cptr kp0=shm3+LDS_K+hi*1024+r32*16; const lds_cptr vp0=shm3+LDS_V+((lane>>4)&1)*32+(lane&3)*8+(4*hi+((lane&15)>>2))*64;
  DMA_K(0,0);DMA_V(0,0);DMA_K(1,SLOTB);
  bf16x8 qr[4];
  #pragma unroll
  for(int d0=0;d0<4;++d0)qr[d0]=*reinterpret_cast<const bf16x8*>(&Qw[(long)r32*QP+d0*16+hi*8]);
  if(q0+rh*QBLK+r32>=L){
    #pragma unroll
    for(int d0=0;d0<4;++d0)qr[d0]=bf16x8{0,0,0,0,0,0,0,0}; }
  float mhat=0.f,l_reg=0.f;f32x16 o[2];o[0]=f32x16{};o[1]=f32x16{};f32x16 negm=f32x16{};asm volatile("":"+v"(negm));
  #define CMASK(P0,P1,t) do{ if((t)>=NT-2)kmask(P0,P1,L-64*(t),hi);}while(0)
  bool resc=false;
  #define START(P0,P1) do{ const float rm=rowmax(P0,P1); resc=false; \
    { const float dl=rm; mhat=fadd_s(mhat,dl); \
      _Pragma("unroll") for(int r=0;r<16;++r){P0[r]=fsub_s(P0[r],dl);P1[r]=fsub_s(P1[r],dl);} \
      _Pragma("unroll") for(int r=0;r<16;++r)negm[r]=-mhat; asm volatile("":"+v"(negm)); } \
    _Pragma("unroll") for(int r=0;r<16;++r)P0[r]=__builtin_amdgcn_exp2f(P0[r]); }while(0)
  #define RESC() do{ if(resc){ asm volatile("s_waitcnt lgkmcnt(0)":::"memory"); \
      _Pragma("unroll") for(int d_=0;d_<2;++d_) _Pragma("unroll") for(int r=0;r<16;++r)o[d_][r]*=wsf[crow(r,hi)]; } }while(0)
  f32x16 pA0,pA1,pB0,pB1;
  int sl_prev=0,sl_cur=0,sl_next=SLOTB;
  #define ROT() do{sl_prev=sl_cur;sl_cur=sl_next;sl_next=(sl_next==(NSLOT-1)*SLOTB)?0:sl_next+SLOTB;}while(0)
  DMA_K(2,2*SLOTB);
  WAIT_BAR(3);
  qkt(pA0,pA1,Kbase,qr,negm,r32,hi);asm volatile("s_nop 15\n\ts_nop 7":"+v"(pA0),"+v"(pA1));CMASK(pA0,pA1,0);
  START(pA0,pA1);
  _Pragma("unroll") for(int r=0;r<16;++r)pA1[r]=__builtin_amdgcn_exp2f(pA1[r]);
  WAIT_BAR(0);
  DMA_K(3,0);DMA_V(1,SLOTB);
  ROT();
  kload8(kf,kp0+sl_cur);
  WAIT_BAR(2);
  s16x4 vlo[8],vhi[8]; u32x4 pw0,pw1,pw2,pw3;
  #define PKW(P,B) cvtpk_s(P[B],P[B+1])
  #define PAF(k) __builtin_bit_cast(bf16x8,pw##k)
  #define VFR(i) (bf16x8){vlo[i][0],vlo[i][1],vlo[i][2],vlo[i][3],vhi[i][0],vhi[i][1],vhi[i][2],vhi[i][3]}
  #define PIN(x) asm volatile("":"+v"(x))
  #define MX3(a,b,c) __builtin_fmaxf(__builtin_fmaxf((a),(b)),(c))
  #define GAPA(MF,A0,A1,A2,A3,W0,W1,PW) do{ MF; sacc+=A0; sacc+=A1; sacc+=A2; sacc+=A3; PIN(sacc); W0; W1; PIN(PW); SBAR(); }while(0)
  #define EX(v) __builtin_amdgcn_exp2f(v)
  #define GAPB(MF,X,B) do{ MF; X[B]=EX(X[B]); X[B+1]=EX(X[B+1]); X[B+2]=EX(X[B+2]); X[B+3]=EX(X[B+3]); PIN(X); SBAR(); }while(0)
  #define VRD(i) do{ vlo[i]=vtr(vp_+(((i)>>2)*4096+((i)&3)*1024)); vhi[i]=vtr(vp_+(((i)>>2)*4096+((i)&3)*1024+512)); }while(0)
  #define KRD(G,j) do{ if(G){ kload2(kf,kp0+sl_next,j); SBAR(); } }while(0)
  #define STEP(C0,C1,P0,P1,t,GK,GV,GL) do{ SBAR(); \
    const lds_cptr vp_=vp0+sl_prev; \
    VRD(0); SBAR(); float sacc=(P0[0]+P0[1]); \
    GAPA(C0=__builtin_amdgcn_mfma_f32_32x32x16_bf16(kf[0],qr[0],negm,0,0,0), P0[2],P0[3],P0[4],P0[5],     pw0[0]=PKW(P0,0), pw0[1]=PKW(P0,2), pw0); \
    VRD(4); SBAR(); GAPA(C1=__builtin_amdgcn_mfma_f32_32x32x16_bf16(kf[1],qr[0],negm,0,0,0), P0[6],P0[7],P0[8],P0[9],     pw0[2]=PKW(P0,4), pw0[3]=PKW(P0,6), pw0); \
    VRD(1); SBAR(); GAPA(C0=__builtin_amdgcn_mfma_f32_32x32x16_bf16(kf[2],qr[1],C0,0,0,0),   P0[10],P0[11],P0[12],P0[13], pw1[0]=PKW(P0,8), pw1[1]=PKW(P0,10), pw1); \
    VRD(5); SBAR(); GAPA(C1=__builtin_amdgcn_mfma_f32_32x32x16_bf16(kf[3],qr[1],C1,0,0,0),   P0[14],P0[15],P1[0],P1[1],   pw1[2]=PKW(P0,12),pw1[3]=PKW(P0,14), pw1); \
    VRD(2); SBAR(); GAPA(C0=__builtin_amdgcn_mfma_f32_32x32x16_bf16(kf[4],qr[2],C0,0,0,0),   P1[2],P1[3],P1[4],P1[5],     pw2[0]=PKW(P1,0), pw2[1]=PKW(P1,2), pw2); \
    VRD(6); SBAR(); GAPA(C1=__builtin_amdgcn_mfma_f32_32x32x16_bf16(kf[5],qr[2],C1,0,0,0),   P1[6],P1[7],P1[8],P1[9],     pw2[2]=PKW(P1,4), pw2[3]=PKW(P1,6), pw2); \
    VRD(3); SBAR(); GAPA(C0=__builtin_amdgcn_mfma_f32_32x32x16_bf16(kf[6],qr[3],C0,0,0,0),   P1[10],P1[11],P1[12],P1[13], pw3[0]=PKW(P1,8), pw3[1]=PKW(P1,10), pw3); \
    VRD(7); SBAR(); GAPA(C1=__builtin_amdgcn_mfma_f32_32x32x16_bf16(kf[7],qr[3],C1,0,0,0),   P1[14],P1[15],0.f,0.f,       pw3[2]=PKW(P1,12),pw3[3]=PKW(P1,14), pw3); \
    l_reg+=sacc; \
    if(GK){DMA_K((t)+3,sl_cur);} if(GV){DMA_V((t)+1,sl_next);} \
    CMASK(C0,C1,t); \
    { float a=MX3(C0[0],C0[1],C1[0]),b=MX3(C0[2],C0[3],C1[1]); a=MX3(a,C1[2],C1[3]); \
      _Pragma("unroll") for(int r=4;r<16;r+=4){a=MX3(a,C0[r],C0[r+1]);b=MX3(b,C0[r+2],C0[r+3]);a=MX3(a,C1[r],C1[r+1]);b=MX3(b,C1[r+2],C1[r+3]);} \
      float rm=__builtin_fmaxf(a,b); { auto rr=__builtin_amdgcn_permlane32_swap(__float_as_uint(rm),__float_as_uint(rm),false,false); rm=__builtin_fmaxf(__uint_as_float(rr[0]),__uint_as_float(rr[1])); } \
      resc=false; \
      if(__builtin_expect(__any(rm>(float)THRL),0)){ const float dl=__builtin_fmaxf(rm,0.f); mhat+=dl; \
        _Pragma("unroll") for(int r=0;r<16;++r){C0[r]-=dl;C1[r]-=dl;} \
        _Pragma("unroll") for(int r=0;r<16;++r)negm[r]=-mhat; asm volatile("":"+v"(negm)); \
        const float f=__builtin_amdgcn_exp2f(-dl); l_reg*=f; if(hi==0)wsf[r32]=f; resc=true; } } \
    SBAR(); \
    GAPB(o[0]=__builtin_amdgcn_mfma_f32_32x32x16_bf16(PAF(0),VFR(0),o[0],0,0,0), C0,0); \
    GAPB(o[1]=__builtin_amdgcn_mfma_f32_32x32x16_bf16(PAF(0),VFR(4),o[1],0,0,0), C0,4); \
    KRD(GL,0); GAPB(o[0]=__builtin_amdgcn_mfma_f32_32x32x16_bf16(PAF(1),VFR(1),o[0],0,0,0), C0,8); \
    KRD(GL,1); GAPB(o[1]=__builtin_amdgcn_mfma_f32_32x32x16_bf16(PAF(1),VFR(5),o[1],0,0,0), C0,12); \
    KRD(GL,2); GAPB(o[0]=__builtin_amdgcn_mfma_f32_32x32x16_bf16(PAF(2),VFR(2),o[0],0,0,0), C1,0); \
    KRD(GL,3); GAPB(o[1]=__builtin_amdgcn_mfma_f32_32x32x16_bf16(PAF(2),VFR(6),o[1],0,0,0), C1,4); \
    GAPB(o[0]=__builtin_amdgcn_mfma_f32_32x32x16_bf16(PAF(3),VFR(3),o[0],0,0,0), C1,8); \
    GAPB(o[1]=__builtin_amdgcn_mfma_f32_32x32x16_bf16(PAF(3),VFR(7),o[1],0,0,0), C1,12); \
    }while(0)
  int t=1;
  #undef CMASK
  #define CMASK(P0,P1,t) do{}while(0)
  for(;t+5<NT;t+=2){
    STEP(pB0,pB1,pA0,pA1,t,true,true,true);     WAIT_BAR(2); RESC(); ROT();
    STEP(pA0,pA1,pB0,pB1,t+1,true,true,true);   WAIT_BAR(2); RESC(); ROT();
  }
  #undef CMASK
  #define CMASK(P0,P1,t) do{ if((t)>=NT-2)kmask(P0,P1,L-64*(t),hi);}while(0)
  #define ENDW(tt) do{ if((tt)+3<NT){WAIT_BAR(2);} else if((tt)+2<NT){WAIT_BAR(1);} else {WAIT_BAR(0);} }while(0)
  for(;t+1<NT;t+=2){
    STEP(pB0,pB1,pA0,pA1,t,(t+3<NT),(t+1<NT),(t+1<NT));       ENDW(t);   RESC(); ROT();
    STEP(pA0,pA1,pB0,pB1,t+1,(t+4<NT),(t+2<NT),(t+2<NT));     ENDW(t+1); RESC(); ROT();
  }
  STEP(pB0,pB1,pA0,pA1,NT-1,false,false,false); RESC();
  { float sacc=pB0[0]+pB0[1]; _Pragma("unroll") for(int r=2;r<16;++r)sacc+=pB0[r]; _Pragma("unroll") for(int r=0;r<16;++r)sacc+=pB1[r]; l_reg+=sacc;
    pw0=(u32x4){PKW(pB0,0),PKW(pB0,2),PKW(pB0,4),PKW(pB0,6)};pw1=(u32x4){PKW(pB0,8),PKW(pB0,10),PKW(pB0,12),PKW(pB0,14)};pw2=(u32x4){PKW(pB1,0),PKW(pB1,2),PKW(pB1,4),PKW(pB1,6)};pw3=(u32x4){PKW(pB1,8),PKW(pB1,10),PKW(pB1,12),PKW(pB1,14)};
    SBAR(); pv(o,vb0+sl_cur,PAF(0),PAF(1),PAF(2),PAF(3)); }
  #undef PKW
  #undef PAF
  #undef VFR
  #undef PIN
  #undef MX3
  #undef GAPA
  #undef GAPB
  #undef EX
  #undef VRD
  #undef KRD
  #undef STEP
  #undef ENDW
  {auto rr=__builtin_amdgcn_permlane32_swap(__float_as_uint(l_reg),__float_as_uint(l_reg),false,false);l_reg=__uint_as_float(rr[0])+__uint_as_float(rr[1]);}
  if(hi==0)wsf[32+r32]=l_reg;asm volatile("s_waitcnt lgkmcnt(0)":::"memory");
  float rli[16];
  #pragma unroll
  for(int r=0;r<16;++r)rli[r]=__builtin_amdgcn_rcpf(wsf[32+crow(r,hi)]);
  bf16*Ow=O+(rowbase+q0+rh*QBLK)*QP+(4*kvh+qh)*D;
  { bf16*stg=(bf16*)(shm+LDS_OST)+wid*2048;
    #pragma unroll
    for(int r=0;r<16;++r){const int orow=crow(r,hi);
      #pragma unroll
      for(int d0=0;d0<2;++d0)stg[orow*64+d0*32+r32]=__float2bfloat16(o[d0][r]*rli[r]);}
    asm volatile("s_waitcnt lgkmcnt(0)":::"memory");
    #pragma unroll
    for(int i=0;i<4;++i){const int row=i*8+(lane>>3),ch=lane&7; const u32x4 v=*(const u32x4*)(stg+row*64+ch*8); if(q0+rh*QBLK+row<L)ATTN_STORE16(Ow+(long)row*QP+ch*8,v);} }
  asm volatile("s_waitcnt lgkmcnt(0)\n\ts_barrier":::"memory");
  #undef DMA_K
  #undef DMA_V
  #undef CMASK
  #undef START
  #undef RESC
  #undef ROT
}
constexpr int ATTN_LDS_BYTES=LDS_BYTES;
#undef SBAR
#undef WAIT_BAR
}
constexpr int DM = 1024, FF = 2816, NLAYER = 4;
constexpr int LP = 4112, LS = 2064, NSEQ_P = 4, NSEQ_S = 16, ROWS_P = NSEQ_P * LP  , T_ROWS = ROWS_P + NSEQ_S * LS  ;
constexpr int TPAD = 49664, NMT = TPAD / 256;
constexpr int NWIN = 4608;
constexpr float NORM_EPS = 1e-6f;
constexpr float QSCALE = 0.125f * 1.4426950408889634f;
constexpr int ATT_UNITS_P = NSEQ_P * 4 * 65, ATT_UNITS_S = NSEQ_S * 4 * 33, ATT_UNITS = ATT_UNITS_P + ATT_UNITS_S;

constexpr size_t MiB = 1u << 20;
constexpr int CW_BAR = 4096;
constexpr size_t WS_CTL = 0;
constexpr size_t WS_ROPE = MiB / 4;
constexpr size_t WS_HMETA = 3 * MiB / 2;
constexpr size_t WS_SSQ = 3 * MiB;
constexpr size_t WS_W = 8 * MiB;
constexpr size_t W_GU1 = 0, W_D1 = W_GU1 + (size_t)5632 * 1024 * 2, W_IN = W_D1 + (size_t)1024 * 2816 * 2, W_GC = W_IN + (size_t)NWIN * 1024 * 2, W_OC = W_GC + 2 * MiB,
                 W_GA = W_OC + 2 * MiB, W_OA = W_GA + 2 * MiB, W_M = W_OA + 2 * MiB, W_GU2 = W_M + 2 * MiB, W_D2 = W_GU2 + (size_t)5632 * 1024 * 2, W_END = W_D2 + (size_t)1024 * 2816 * 2;
constexpr size_t WS_HB = 64 * MiB;
constexpr size_t ROWB = (size_t)TPAD * 1024 * 2;
constexpr size_t WS_BIG = WS_HB + 98 * MiB;
constexpr size_t WS_Q = WS_BIG, WS_K = WS_Q + ROWB, WS_V = WS_K + ROWB / 4, WS_CB = WS_V + ROWB / 4, WS_Z = WS_CB + ROWB, WS_END = WS_Z + ROWB;
constexpr size_t WS_HID = WS_BIG;
constexpr size_t WS_SCR = WS_K;
static_assert((CW_BAR + 3456) * 4 <= (int)WS_ROPE && WS_ROPE + (size_t)LP * 64 * 4 <= WS_HMETA && WS_HMETA + (size_t)20 * 16 * 1024 * 4 <= WS_SSQ && WS_SSQ + (size_t)TPAD * 16 * 4 <= WS_W, "d_ws map (small regions)");
static_assert(W_END <= 56 * MiB && ROWB <= 98 * MiB && (size_t)TPAD * FF * 2 <= WS_END - WS_BIG && 256 * 131072 <= ROWB / 2, "d_ws map");

constexpr int RING_BYTES = 131072, MISC_OFF = RING_BYTES + 320, PTAB_OFF = RING_BYTES + 1024, LDS_BYTES = 147456;
constexpr int NWAVES = 8;

#define GAS __attribute__((address_space(1)))
#define LAS __attribute__((address_space(3)))
typedef unsigned short bf16;
typedef unsigned v4u __attribute__((ext_vector_type(4)));
typedef float f32x4 __attribute__((ext_vector_type(4)));
__device__ __forceinline__ unsigned f2bf(float f) { unsigned u = __builtin_bit_cast(unsigned, f); return (u + 0x7fffu + ((u >> 16) & 1u)) >> 16; }
__device__ __forceinline__ unsigned pk2(float lo, float hi) { return pg8::cvt_pk_bf16(lo, hi); }
__device__ __forceinline__ float bflo(unsigned u) { return __builtin_bit_cast(float, u << 16); }
__device__ __forceinline__ float bfhi(unsigned u) { return __builtin_bit_cast(float, u & 0xffff0000u); }
__device__ __forceinline__ float wave_sum(float v) {
#pragma unroll
    for (int o = 1; o < 64; o <<= 1) v += __shfl_xor(v, o);
    return v;
}
__device__ __forceinline__ void rowinfo(int r, int& pos, int& L) {
    if (r < ROWS_P) { L = LP; pos = r % LP; } else if (r < T_ROWS) { L = LS; pos = (r - ROWS_P) % LS; } else { L = 1 << 30; pos = 0; }
}
__device__ __forceinline__ float sigmoidf_(float x) { return __builtin_amdgcn_rcpf(1.0f + __builtin_amdgcn_exp2f(-1.4426950408889634f * x)); }

struct PlainOrder : pg8::StaticOrder {
    const char* A; const char* Bt; size_t tstep;
    __device__ __forceinline__ const char* aptr(const pg8::Unit& u) const { return A + (size_t)u.pm * tstep; }
    __device__ __forceinline__ const char* bptr(const pg8::Unit& u) const { return Bt + (size_t)u.pn * tstep; }
};
struct ChainOrder {
    pg8::StaticOrder base; const char* A[4]; const char* B[4]; size_t tstep;
    __device__ __forceinline__ bool next(int i, pg8::Unit& u) const { if (!base.next(i >> 2, u)) return false; u.sub = i & 3; return true; }
    __device__ __forceinline__ const char* aptr(const pg8::Unit& u) const { const char* p = u.sub == 0 ? A[0] : u.sub == 1 ? A[1] : u.sub == 2 ? A[2] : A[3]; return p + (size_t)u.pm * tstep; }
    __device__ __forceinline__ const char* bptr(const pg8::Unit& u) const { const char* p = u.sub == 0 ? B[0] : u.sub == 1 ? B[1] : u.sub == 2 ? B[2] : B[3]; return p + (size_t)u.pn * tstep; }
    __device__ __forceinline__ void a_ready(const pg8::Unit&) const {}
    __device__ __forceinline__ void done(const pg8::Unit&) const {}
};

using pg8::f32x4; using pg8::u32x4; using pg8::Unit; using pg8::bf16_t;
typedef f32x4 Acc[2][2][4][2];
__device__ __forceinline__ u32x4 pack8(const f32x4 a, const f32x4 b) { u32x4 w; w.x = pk2(a[0], a[1]); w.y = pk2(a[2], a[3]); w.z = pk2(b[0], b[1]); w.w = pk2(b[2], b[3]); return w; }
__device__ __forceinline__ void unpack8(const u32x4 w, f32x4& a, f32x4& b) { a = (f32x4){bflo(w.x), bfhi(w.x), bflo(w.y), bfhi(w.y)}; b = (f32x4){bflo(w.z), bfhi(w.z), bflo(w.w), bfhi(w.w)}; }
__device__ __forceinline__ float rstd_of(const float* ssq, int row) { const f32x4* p = (const f32x4*)(ssq + (size_t)row * 16); const f32x4 a = p[0], b = p[1], c = p[2], d = p[3];
    const float s = (((a[0] + a[1]) + (a[2] + a[3])) + ((b[0] + b[1]) + (b[2] + b[3]))) + (((c[0] + c[1]) + (c[2] + c[3])) + ((d[0] + d[1]) + (d[2] + d[3])));
    return __builtin_amdgcn_rsqf(s * (1.0f / DM) + NORM_EPS); }

struct EpiSwiGLU {
    static constexpr bool PERM = true, AFTER_DRAIN = false;
    bf16_t* hid; const float* ssq;
    __device__ __forceinline__ void operator()(const Acc& acc, const Unit& u, int wr, int wc, int fr, int fq) const {
#pragma unroll
        for (int ai = 0; ai < 2; ++ai)
#pragma unroll
            for (int m = 0; m < 4; ++m) {
                const int row = u.pm * 256 + ai * 128 + wr * 64 + m * 16 + fr; const float rs = rstd_of(ssq, row);
                f32x4 o[2];
#pragma unroll
                for (int n = 0; n < 2; ++n)
#pragma unroll
                    for (int e = 0; e < 4; ++e) { const float g = acc[ai][0][m][n][e] * rs, up = acc[ai][1][m][n][e] * rs; o[n][e] = g * sigmoidf_(g) * up; }
                *(u32x4*)(hid + (size_t)row * FF + u.pn * 128 + wc * 32 + 8 * fq) = pack8(o[0], o[1]);
            }
    }
};
struct EpiResid {
    static constexpr bool PERM = true, AFTER_DRAIN = false;
    bf16_t* hb; float* ssq_out; float scale;
    __device__ __forceinline__ void operator()(const Acc& acc, const Unit& u, int wr, int wc, int fr, int fq) const {
#pragma unroll
        for (int ai = 0; ai < 2; ++ai)
#pragma unroll
            for (int m = 0; m < 4; ++m) {
                const int row = u.pm * 256 + ai * 128 + wr * 64 + m * 16 + fr; const bool ok = row < T_ROWS;
                float ss = 0.f;
                if (ok) {
                    bf16_t* bp = hb + (size_t)row * DM + u.pn * 256 + wc * 32 + 8 * fq;
#pragma unroll
                    for (int bj = 0; bj < 2; ++bj) {
                        f32x4 a, b; unpack8(*(const u32x4*)(bp + bj * 128), a, b);
                        a = a + acc[ai][bj][m][0] * scale; b = b + acc[ai][bj][m][1] * scale;
                        const u32x4 w = pack8(a, b); *(u32x4*)(bp + bj * 128) = w;
                        unpack8(w, a, b);
                        ss += (a[0] * a[0] + a[1] * a[1]) + (a[2] * a[2] + a[3] * a[3]) + (b[0] * b[0] + b[1] * b[1]) + (b[2] * b[2] + b[3] * b[3]);
                    }
                }
                ss += __shfl_xor(ss, 16); ss += __shfl_xor(ss, 32);
                if (ok && fq == 0) ssq_out[(size_t)row * 16 + u.pn * 4 + wc] = ss;
                if (m & 1) asm volatile("" ::: "memory");
            }
    }
};
struct EpiWin {
    static constexpr bool PERM = true, AFTER_DRAIN = false;
    bf16_t *q, *k, *v, *cb, *z; const float* ssq; const float* rope; const float* qg; const float* kg;
    __device__ __forceinline__ void operator()(const Acc& acc, const Unit& u, int wr, int wc, int fr, int fq) const {
        const int pn = u.pn;
        if (pn <= 4) {
            const float* g = pn < 4 ? qg : kg; const float osc = pn < 4 ? QSCALE : 1.0f;
            f32x4 G[2][2];
#pragma unroll
            for (int bj = 0; bj < 2; ++bj)
#pragma unroll
                for (int n = 0; n < 2; ++n) G[bj][n] = *(const f32x4*)(g + 32 * bj + 16 * n + 4 * fq) * osc;
#pragma unroll
            for (int ai = 0; ai < 2; ++ai)
#pragma unroll
                for (int m = 0; m < 4; ++m) {
                    const int row = u.pm * 256 + ai * 128 + wr * 64 + m * 16 + fr; const float rs = rstd_of(ssq, row);
                    int pos, L; rowinfo(row, pos, L);
                    f32x4 x[2][2]; float ss = 0.f;
#pragma unroll
                    for (int bj = 0; bj < 2; ++bj)
#pragma unroll
                        for (int n = 0; n < 2; ++n) { x[bj][n] = acc[ai][bj][m][n] * rs; const f32x4 t = x[bj][n] * x[bj][n]; ss += (t[0] + t[1]) + (t[2] + t[3]); }
                    ss += __shfl_xor(ss, 16); ss += __shfl_xor(ss, 32);
                    const float rn = __builtin_amdgcn_rsqf(ss * (1.0f / 64.0f) + NORM_EPS);
                    bf16_t* dst = pn < 4 ? q + (size_t)row * 1024 + (4 * pn + wc) * 64 + 8 * fq : k + (size_t)row * 256 + wc * 64 + 8 * fq;
#pragma unroll
                    for (int bj = 0; bj < 2; ++bj) {
                        const f32x4 c4 = *(const f32x4*)(rope + ((pos * 2 + bj) * 2 + 0) * 16 + 4 * fq), s4 = *(const f32x4*)(rope + ((pos * 2 + bj) * 2 + 1) * 16 + 4 * fq);
                        const f32x4 y1 = x[bj][0] * rn * G[bj][0], y2 = x[bj][1] * rn * G[bj][1];
                        const f32x4 o1 = y1 * c4 - y2 * s4, o2 = y2 * c4 + y1 * s4;
                        *(u32x4*)(dst + 32 * bj) = pack8(o1, o2);
                    }
                    if (m & 1) asm volatile("" ::: "memory");
                }
        } else if (pn < 10) {
            bf16_t* base; int pitch, c0;
            if (pn == 5) { base = v; pitch = 256; c0 = 0; } else { base = cb; pitch = 1024; c0 = 256 * (pn - 6); }
#pragma unroll
            for (int ai = 0; ai < 2; ++ai)
#pragma unroll
                for (int m = 0; m < 4; ++m) {
                    const int row = u.pm * 256 + ai * 128 + wr * 64 + m * 16 + fr; const float rs = rstd_of(ssq, row);
#pragma unroll
                    for (int bj = 0; bj < 2; ++bj) *(u32x4*)(base + (size_t)row * pitch + c0 + 128 * bj + wc * 32 + 8 * fq) = pack8(acc[ai][bj][m][0] * rs, acc[ai][bj][m][1] * rs);
                }
        } else {
#pragma unroll
            for (int ai = 0; ai < 2; ++ai)
#pragma unroll
                for (int m = 0; m < 4; ++m) {
                    const int row = u.pm * 256 + ai * 128 + wr * 64 + m * 16 + fr; const float rs = rstd_of(ssq, row), rs2 = rs * rs;
                    *(u32x4*)(z + (size_t)row * 1024 + 128 * (pn - 10) + wc * 32 + 8 * fq) = pack8(acc[ai][0][m][0] * acc[ai][1][m][0] * rs2, acc[ai][0][m][1] * acc[ai][1][m][1] * rs2);
                }
        }
    }
};
struct EpiMerge {
    static constexpr bool PERM = true, AFTER_DRAIN = false;
    bf16_t* merged; u32x4* scr; const float* ssq; int tid;
    __device__ __forceinline__ void operator()(const Acc& acc, const Unit& u, int wr, int wc, int fr, int fq) const {
        const int sub = u.sub;
#pragma unroll
        for (int ai = 0; ai < 2; ++ai)
#pragma unroll
            for (int m = 0; m < 4; ++m) {
                const int row = u.pm * 256 + ai * 128 + wr * 64 + m * 16 + fr;
                float rs = 1.f; if ((sub & 1) == 0) rs = rstd_of(ssq, row);
#pragma unroll
                for (int bj = 0; bj < 2; ++bj) {
                    u32x4* mp = (u32x4*)(merged + (size_t)row * DM + u.pn * 256 + bj * 128 + wc * 32 + 8 * fq);
                    u32x4* sp = scr + ((ai * 4 + m) * 2 + bj) * 512 + tid;
                    const f32x4 v0 = acc[ai][bj][m][0], v1 = acc[ai][bj][m][1];
                    if ((sub & 1) == 0) {
                        f32x4 s0, s1;
#pragma unroll
                        for (int e = 0; e < 4; ++e) { s0[e] = sigmoidf_(v0[e] * rs); s1[e] = sigmoidf_(v1[e] * rs); }
                        if (sub == 0) *mp = pack8(s0, s1); else *sp = pack8(s0, s1);
                    } else if (sub == 1) {
                        f32x4 g0, g1; unpack8(*mp, g0, g1); *mp = pack8(g0 * v0, g1 * v1);
                    } else {
                        f32x4 c0, c1, s0, s1; unpack8(*mp, c0, c1); unpack8(*sp, s0, s1); *mp = pack8(c0 + s0 * v0, c1 + s1 * v1);
                    }
                }
                if (m & 1) asm volatile("" ::: "memory");
            }
    }
};

__device__ __forceinline__ void cvt_item(const float* W, int Nsrc, int n0src, const float* gain, bool permqk, bf16* WT, int K, int nrow0, int k0, LAS float* scr, int lane) {
#pragma unroll 8
    for (int i = 0; i < 32; ++i) { const int kk = 2 * i + (lane >> 5); float w = W[(size_t)(k0 + kk) * Nsrc + n0src + (lane & 31)]; if (gain) w *= gain[k0 + kk]; scr[kk * 33 + (lane & 31)] = w; }
    asm volatile("s_waitcnt lgkmcnt(0)" ::: "memory");
    const int c = lane & 7;
#pragma unroll
    for (int j = 0; j < 4; ++j) { const int n = (lane >> 3) + 8 * j; const int ns = permqk ? (16 * ((n >> 2) & 1) + 4 * (n >> 3) + (n & 3)) : n; const LAS float* s = scr + (8 * c) * 33 + ns;
        v4u o; o.x = pk2(s[0 * 33], s[1 * 33]); o.y = pk2(s[2 * 33], s[3 * 33]); o.z = pk2(s[4 * 33], s[5 * 33]); o.w = pk2(s[6 * 33], s[7 * 33]);
        *(GAS v4u*)(WT + (size_t)(nrow0 + n) * K + k0 + 8 * c) = o; }
    asm volatile("s_waitcnt lgkmcnt(0)" ::: "memory");
}
#define RLX_AGENT __ATOMIC_RELAXED, __HIP_MEMORY_SCOPE_AGENT
#define XB_TMO      128
#define XB_XCNT(j)  (256  + 64 * (j))
#define XB_XSUB(j)  (1280 + 64 * (j))
#define XB_XGEN(j)  (2304 + 64 * (j))
#define XB_TOP      3328
#define XB_TOPGEN   3392
#define XCD_BAR_WORDS 3456
#define XB_SPIN_CAP (1u << 18)

__device__ __forceinline__ unsigned xb_ld(unsigned* p)              { return __hip_atomic_load(p, __ATOMIC_RELAXED, __HIP_MEMORY_SCOPE_AGENT); }
__device__ __forceinline__ unsigned xb_add(unsigned* p, unsigned v) { return __hip_atomic_fetch_add(p, v, __ATOMIC_RELAXED, __HIP_MEMORY_SCOPE_AGENT); }
__device__ __forceinline__ unsigned xb_xcc_id() { return (unsigned)__builtin_amdgcn_s_getreg((3 << 11) | 20) & 0xFu; }
#define XB_SPIN(cond, bar) do { unsigned _sp = 0; while (cond) { __builtin_amdgcn_s_sleep(1); \
    if ((++_sp & 255u) == 0u) { if (xb_ld(&(bar)[XB_TMO])) break; if (_sp > XB_SPIN_CAP) { atomicAdd(&(bar)[XB_TMO], 1u); break; } } } } while (0)

struct XcdBarrier {
    unsigned* bar; unsigned x;
    volatile LAS unsigned* st;
};

__device__ __forceinline__ XcdBarrier xcd_barrier_post(unsigned* bar, volatile LAS unsigned* st) {
    XcdBarrier b; b.bar = bar; b.x = xb_xcc_id(); b.st = st;
    if (threadIdx.x == 0) (void)xb_add(&bar[XB_XCNT(b.x)], 1u);
    return b;
}
__device__ __forceinline__ void xcd_barrier_complete(unsigned* bar, unsigned x, unsigned& nloc, unsigned& nx) {
    const unsigned G = gridDim.x * gridDim.y * gridDim.z;
    unsigned sum, cnt, mine, sp = 0u;
    for (;;) {
        sum = 0u; cnt = 0u; mine = 0u;
#pragma unroll
        for (unsigned j = 0; j < 16; ++j) { const unsigned c = xb_ld(&bar[XB_XCNT(j)]); sum += c; cnt += (c > 0u) ? 1u : 0u; mine = (j == x) ? c : mine; }
        if (sum == G) break;
        __builtin_amdgcn_s_sleep(1);
        if ((++sp & 255u) == 0u) { if (xb_ld(&bar[XB_TMO])) break; if (sp > XB_SPIN_CAP) { atomicAdd(&bar[XB_TMO], 1u); break; } }
    }
    nloc = mine > 0u ? mine : 1u; nx = cnt > 0u ? cnt : 1u;
}

__device__ __forceinline__ void xcd_barrier(const XcdBarrier& b) {
    asm volatile("s_waitcnt vmcnt(0)" ::: "memory");
    __syncthreads();
    if (threadIdx.x == 0) {
        unsigned* bar = b.bar;
        __builtin_amdgcn_s_waitcnt(0);
        unsigned nloc = b.st[0], nx = b.st[1];
        if (nloc == 0u) { xcd_barrier_complete(bar, b.x, nloc, nx); b.st[0] = nloc; b.st[1] = nx; }
        const unsigned old = xb_add(&bar[XB_XSUB(b.x)], 1u);
        const unsigned gen = old / nloc;
        if (old + 1u == (gen + 1u) * nloc) {
            __builtin_amdgcn_fence(__ATOMIC_RELEASE, "agent");
            asm volatile("s_waitcnt vmcnt(0)" ::: "memory");
            const unsigned og = xb_add(&bar[XB_TOP], 1u);
            const unsigned tg = og / nx;
            if (og + 1u == (tg + 1u) * nx) xb_add(&bar[XB_TOPGEN], 1u);
            else XB_SPIN(xb_ld(&bar[XB_TOPGEN]) == tg, bar);
            __builtin_amdgcn_fence(__ATOMIC_ACQUIRE, "agent");
            xb_add(&bar[XB_XGEN(b.x)], 1u);
            asm volatile("s_waitcnt vmcnt(0)" ::: "memory");
        } else {
            XB_SPIN(xb_ld(&bar[XB_XGEN(b.x)]) == gen, bar);
            __builtin_amdgcn_fence(__ATOMIC_ACQUIRE, "agent");
            asm volatile("s_waitcnt vmcnt(0)" ::: "memory");
        }
    }
    __syncthreads();
}
struct Args { const float* in[21]; float* out; unsigned char* ws; int ph_lo, ph_hi; };
struct PT {
    volatile LAS unsigned long long* t;
    __device__ __forceinline__ unsigned long long get(int i) const { const unsigned long long v = t[i]; const unsigned lo = __builtin_amdgcn_readfirstlane((unsigned)v), hi = __builtin_amdgcn_readfirstlane((unsigned)(v >> 32)); return ((unsigned long long)hi << 32) | lo; }
    __device__ __forceinline__ const float* in(int i) const { return (const float*)(const GAS float*)get(i); }
    __device__ __forceinline__ float* out() const { return (float*)(GAS float*)get(21); }
    __device__ __forceinline__ unsigned char* ws() const { return (unsigned char*)(GAS unsigned char*)get(22); }
};

__device__ __forceinline__ void convert_layer(const PT a, unsigned char* ws, int l, LAS unsigned char* lds, int gw, int NGW, int wave, int lane) {
    LAS float* scr = (LAS float*)(lds + wave * 16384);
    bf16* W = (bf16*)(ws + WS_W);
    const size_t ffo = (size_t)l * DM * FF, sqo = (size_t)l * DM * DM;
    const float* win = a.in(8) + (size_t)l * DM * 6656; const float* mixg = a.in(7) + l * DM;
    for (int it = gw; it < 13312; it += NGW) {
        int r = it;
        if (r < 2816) { const int kb = r / 176, nb = r % 176, pn = nb >> 3, t = nb & 7; const float* src = (t >> 2) ? a.in(5) + ffo : a.in(4) + ffo;
            cvt_item(src, FF, 128 * pn + 32 * (t & 3), a.in(3) + l * DM, false, (bf16*)((char*)W + W_GU1), 1024, nb * 32, kb * 64, scr, lane); continue; } r -= 2816;
        if (r < 1408) { const int kb = r / 32, nb = r % 32; cvt_item(a.in(6) + ffo, DM, nb * 32, nullptr, false, (bf16*)((char*)W + W_D1), FF, nb * 32, kb * 64, scr, lane); continue; } r -= 1408;
        if (r < 2304) { const int kb = r / 144, nb = r % 144, pn = nb >> 3, t = nb & 7; int n0; bool pq = false;
            if (pn < 4) { n0 = 64 * (4 * pn + (t & 3)) + 32 * (t >> 2); pq = true; }
            else if (pn == 4) { n0 = 1024 + 64 * (t & 3) + 32 * (t >> 2); pq = true; }
            else if (pn == 5) n0 = 1280 + 32 * t;
            else if (pn < 10) n0 = 1536 + 256 * (pn - 6) + 32 * t;
            else n0 = ((t >> 2) ? 3584 : 2560) + 128 * (pn - 10) + 32 * (t & 3);
            cvt_item(win, 6656, n0, mixg, pq, (bf16*)((char*)W + W_IN), 1024, nb * 32, kb * 64, scr, lane); continue; } r -= 2304;
        if (r < 2560) { const int seg = r / 512, q = r % 512, kb = q / 32, nb = q % 32;
            const float* src; int ns, n0; const float* gn = nullptr; size_t dst;
            if (seg == 0) { src = win; ns = 6656; n0 = 5632 + nb * 32; gn = mixg; dst = W_GC; }
            else if (seg == 1) { src = a.in(14) + sqo; ns = DM; n0 = nb * 32; dst = W_OC; }
            else if (seg == 2) { src = win; ns = 6656; n0 = 4608 + nb * 32; gn = mixg; dst = W_GA; }
            else if (seg == 3) { src = a.in(13) + sqo; ns = DM; n0 = nb * 32; dst = W_OA; }
            else { src = a.in(15) + sqo; ns = DM; n0 = nb * 32; dst = W_M; }
            cvt_item(src, ns, n0, gn, false, (bf16*)((char*)W + dst), 1024, nb * 32, kb * 64, scr, lane); continue; } r -= 2560;
        if (r < 2816) { const int kb = r / 176, nb = r % 176, pn = nb >> 3, t = nb & 7; const float* src = (t >> 2) ? a.in(18) + ffo : a.in(17) + ffo;
            cvt_item(src, FF, 128 * pn + 32 * (t & 3), a.in(16) + l * DM, false, (bf16*)((char*)W + W_GU2), 1024, nb * 32, kb * 64, scr, lane); continue; } r -= 2816;
        { const int kb = r / 32, nb = r % 32; cvt_item(a.in(19) + ffo, DM, nb * 32, nullptr, false, (bf16*)((char*)W + W_D2), FF, nb * 32, kb * 64, scr, lane); }
    }
}

__device__ __forceinline__ void prologue(const PT a, unsigned char* ws, int tid, int wave, int lane, int bid, int G) {
    const int gtid = bid * 512 + tid, GT = G * 512, gw = bid * NWAVES + wave, NGW = G * NWAVES;
    float* ssq = (float*)(ws + WS_SSQ); bf16* hb = (bf16*)(ws + WS_HB); float* rope = (float*)(ws + WS_ROPE);
    for (int i = gtid; i < (TPAD - T_ROWS) * 16; i += GT) ssq[(size_t)T_ROWS * 16 + i] = 0.f;
    for (int i = gtid; i < (TPAD - T_ROWS) * DM / 8; i += GT) ((v4u*)(hb + (size_t)T_ROWS * DM))[i] = (v4u){0u, 0u, 0u, 0u};
    if (gtid < 64) ((unsigned*)(ws + WS_CTL))[gtid] = 0u;
    for (int i = gtid; i < LP * 32; i += GT) {
        const int pos = i >> 5, axis = (i >> 4) & 1, f = i & 15;
        float coord; if (pos < 16) coord = axis ? (float)pos : -1.0f; else { const int t = pos - 16; coord = axis ? (float)(t & 63) : (float)(t >> 6); }
        const float inv = powf(10000.0f, -(float)f * (1.0f / 16.0f)); const float ang = coord * inv;
        float s, c; sincosf(ang, &s, &c);
        rope[((pos * 2 + axis) * 2 + 0) * 16 + f] = c; rope[((pos * 2 + axis) * 2 + 1) * 16 + f] = s;
    }
    for (int r = gw; r < T_ROWS; r += NGW) {
        int pos, L; rowinfo(r, pos, L);
        const float* src;
        if (pos < 16) src = a.in(2) + (size_t)pos * DM;
        else if (r < ROWS_P) src = a.in(0) + ((size_t)(r / LP) * 4096 + pos - 16) * DM;
        else src = a.in(1) + ((size_t)((r - ROWS_P) / LS) * 2048 + pos - 16) * DM;
        f32x4 v[4]; float s = 0.f;
        unsigned long long* o8 = (unsigned long long*)(hb + (size_t)r * DM) + lane;
#pragma unroll
        for (int j = 0; j < 4; ++j) { v[j] = ((const f32x4*)src)[lane + 64 * j];
            const unsigned lo = pk2(v[j][0], v[j][1]), hi = pk2(v[j][2], v[j][3]); o8[64 * j] = (unsigned long long)lo | ((unsigned long long)hi << 32);
            const float a0 = bflo(lo), a1 = bfhi(lo), a2 = bflo(hi), a3 = bfhi(hi); s += (a0 * a0 + a1 * a1) + (a2 * a2 + a3 * a3); }
        s = wave_sum(s);
        if (lane < 16) ssq[(size_t)r * 16 + lane] = lane == 0 ? s : 0.f;
    }
}

__device__ __forceinline__ void conv_phase(const PT a, unsigned char* ws, int l, int tid, int bid, int G) {
    bf16* cb = (bf16*)(ws + WS_CB); const bf16* z = (const bf16*)(ws + WS_Z);
    const float* cw = a.in(9) + (size_t)l * 3 * DM; const float* cbias = a.in(10) + (size_t)l * DM;
    const int chunk = tid & 127, sub = tid >> 7, c0 = chunk * 8;
    f32x4 w0[2], w1[2], w2[2], bb[2];
#pragma unroll
    for (int h = 0; h < 2; ++h) { w0[h] = *(const f32x4*)(cw + c0 + 4 * h); w1[h] = *(const f32x4*)(cw + DM + c0 + 4 * h); w2[h] = *(const f32x4*)(cw + 2 * DM + c0 + 4 * h); bb[h] = *(const f32x4*)(cbias + c0 + 4 * h); }
    const int nstrip = (T_ROWS + 63) / 64;
    for (int strip = bid; strip < nstrip; strip += G) {
        const int r0 = strip * 64 + sub * 16;
#pragma unroll 4
        for (int i = 0; i < 16; ++i) {
            const int r = r0 + i; if (r >= T_ROWS) break;
            int pos, L; rowinfo(r, pos, L);
            const u32x4 zero = (u32x4){0u, 0u, 0u, 0u};
            const u32x4 zc = *(const u32x4*)(z + (size_t)r * DM + c0);
            const u32x4 zp = pos > 0 ? *(const u32x4*)(z + (size_t)(r - 1) * DM + c0) : zero;
            const u32x4 zn = pos < L - 1 ? *(const u32x4*)(z + (size_t)(r + 1) * DM + c0) : zero;
            u32x4* cp = (u32x4*)(cb + (size_t)r * DM + c0); const u32x4 cv = *cp;
            f32x4 p0, p1, c0v, c1v, n0, n1, b0, b1; unpack8(zp, p0, p1); unpack8(zc, c0v, c1v); unpack8(zn, n0, n1); unpack8(cv, b0, b1);
            const f32x4 o0 = b0 * (w0[0] * p0 + w1[0] * c0v + w2[0] * n0 + bb[0]), o1 = b1 * (w0[1] * p1 + w1[1] * c1v + w2[1] * n1 + bb[1]);
            *cp = pack8(o0, o1);
        }
    }
}

__device__ __forceinline__ void attention_phase(const PT a, unsigned char* ws, int l, unsigned char* lds_generic, int tid) {
    using abf = attn_body::bf16;
    const abf* Q = (const abf*)(ws + WS_Q); const abf* K = (const abf*)(ws + WS_K); const abf* V = (const abf*)(ws + WS_V); abf* O = (abf*)(ws + WS_Q);
    unsigned* ctr = (unsigned*)(ws + WS_CTL) + l;
    volatile unsigned* slot = (volatile unsigned*)(lds_generic + MISC_OFF);
    for (;;) {
        if (tid == 0) *slot = atomicAdd(ctr, 1u);
        __syncthreads();
        const int u = (int)__builtin_amdgcn_readfirstlane(*slot);
        if (u >= ATT_UNITS) break;
        int tidu = tid; asm volatile("" : "+v"(tidu));
        if (u < ATT_UNITS_P) { const int s = u / 260, rem = u - s * 260, kvh = rem / 65, qblk = rem - kvh * 65;
            attn_body::attn_unit<8, LP, 66>((long)s * LP, kvh, qblk, Q, K, V, O, (char*)lds_generic, tidu); }
        else { const int u2 = u - ATT_UNITS_P, s = u2 / 132, rem = u2 - s * 132, kvh = rem / 33, qblk = rem - kvh * 33;
            attn_body::attn_unit<8, LS, 34>((long)ROWS_P + (long)s * LS, kvh, qblk, Q, K, V, O, (char*)lds_generic, tidu); }
    }
}

__device__ __forceinline__ void final_phase(const PT a, unsigned char* ws, int wave, int lane, int bid, int G) {
    const int gw = bid * NWAVES + wave, NGW = G * NWAVES;
    const float* ssq = (const float*)(ws + WS_SSQ); const bf16* hb = (const bf16*)(ws + WS_HB); float* out = a.out();
    f32x4 g[4];
#pragma unroll
    for (int j = 0; j < 4; ++j) g[j] = ((const f32x4*)a.in(20))[lane + 64 * j];
    for (int r = gw; r < T_ROWS; r += NGW) {
        int pos, L; rowinfo(r, pos, L); if (pos < 16) continue;
        float* p = r < ROWS_P ? out + ((size_t)(r / LP) * 4096 + pos - 16) * DM : out + (size_t)NSEQ_P * 4096 * DM + ((size_t)((r - ROWS_P) / LS) * 2048 + pos - 16) * DM;
        const float rs = rstd_of(ssq, r);
        const unsigned long long* i8 = (const unsigned long long*)(hb + (size_t)r * DM) + lane;
#pragma unroll
        for (int j = 0; j < 4; ++j) { const unsigned long long w = i8[64 * j]; const unsigned lo = (unsigned)w, hi = (unsigned)(w >> 32);
            const f32x4 v = (f32x4){bflo(lo), bfhi(lo), bflo(hi), bfhi(hi)}; ((f32x4*)p)[lane + 64 * j] = v * rs * g[j]; }
    }
}

constexpr int NSTEPS = 2 + 9 * NLAYER;

template <int STEP>
__device__ __forceinline__ void run_step(const PT pt, unsigned char* lds, cg::grid_group& grid, XcdBarrier& bar, const int ph_lo, const int ph_hi) {
#ifdef MAX_STEP
    if (STEP >= MAX_STEP && STEP != NSTEPS - 1) return;
#endif
    if (STEP < ph_lo || STEP >= ph_hi) return;
    if (STEP > ph_lo) {
        if (STEP == ph_lo + 1) {
            asm volatile("s_waitcnt vmcnt(0)" ::: "memory"); grid.sync();
            bar = xcd_barrier_post((unsigned*)(pt.ws() + WS_CTL) + CW_BAR, (volatile LAS unsigned*)((LAS unsigned char*)lds + MISC_OFF + 32));
        } else xcd_barrier(bar);
#ifdef DUP_SYNC
        xcd_barrier(bar); xcd_barrier(bar);
#endif
    }
    LAS unsigned char* l3 = (LAS unsigned char*)lds;
    int tid = threadIdx.x; asm volatile("" : "+v"(tid));
    int bid = blockIdx.x; asm volatile("" : "+s"(bid));
    int G = gridDim.x; asm volatile("" : "+s"(G));
    unsigned char* ws = pt.ws();
    const int lane = tid & 63, wave = __builtin_amdgcn_readfirstlane(tid >> 6);
    const int gw = bid * NWAVES + wave, NGW = G * NWAVES;
    float* ssq = (float*)(ws + WS_SSQ);
    bf16_t* hb = (bf16_t*)(ws + WS_HB);
    if constexpr (STEP == 0) { prologue(pt, ws, tid, wave, lane, bid, G); }
    else if constexpr (STEP == NSTEPS - 1) { final_phase(pt, ws, wave, lane, bid, G); }
    else {
        constexpr int l = (STEP - 1) / 9, ph = (STEP - 1) % 9;
        if constexpr (ph == 0) {
#ifndef NO_CVT
            convert_layer(pt, ws, l, l3, gw, NGW, wave, lane);
#ifdef DUP_CVT
            __syncthreads();
            convert_layer(pt, ws, l, l3, gw, NGW, wave, lane);
#endif
#endif
            __syncthreads();
        } else if constexpr (ph == 1 || ph == 7) {
            constexpr int f = ph == 7;
            PlainOrder S; S.init(TPAD, 2 * FF, G, bid); S.A = (const char*)hb; S.Bt = (const char*)(ws + WS_W + (f ? W_GU2 : W_GU1)); S.tstep = (size_t)256 * 1024 * 2;
            pg8::Gemm g{nullptr, nullptr, TPAD, 2 * FF, 1024};
            EpiSwiGLU E{(bf16_t*)(ws + WS_HID), ssq};
#ifndef NO_GU
            pg8::gemm_phase<EpiSwiGLU, PlainOrder, true, true>(l3, g, S, E, tid);
#ifdef DUP_GU
            __syncthreads();
            pg8::gemm_phase<EpiSwiGLU, PlainOrder, true, true>(l3, g, S, E, tid);
#endif
#endif
        } else if constexpr (ph == 2 || ph == 6 || ph == 8) {
            constexpr int f = ph == 8; constexpr int K = ph == 6 ? 1024 : FF;
            PlainOrder S; S.init(TPAD, DM, G, bid);
            S.A = ph == 6 ? (const char*)(ws + WS_Z) : (const char*)(ws + WS_HID);
            S.Bt = (const char*)(ws + WS_W + (ph == 6 ? W_M : (f ? W_D2 : W_D1))); S.tstep = (size_t)256 * K * 2;
            pg8::Gemm g{nullptr, nullptr, TPAD, DM, K};
            EpiResid E{hb, ssq, ph == 6 ? 1.0f : 0.5f};
#ifndef NO_RES
            pg8::gemm_phase<EpiResid, PlainOrder, true, true>(l3, g, S, E, tid);
#endif
        } else if constexpr (ph == 3) {
            PlainOrder S; S.init(TPAD, NWIN, G, bid); S.A = (const char*)hb; S.Bt = (const char*)(ws + WS_W + W_IN); S.tstep = (size_t)256 * 1024 * 2;
            pg8::Gemm g{nullptr, nullptr, TPAD, NWIN, 1024};
            EpiWin E{(bf16_t*)(ws + WS_Q), (bf16_t*)(ws + WS_K), (bf16_t*)(ws + WS_V), (bf16_t*)(ws + WS_CB), (bf16_t*)(ws + WS_Z), ssq,
                     (const float*)(ws + WS_ROPE), pt.in(11) + l * 64, pt.in(12) + l * 64};
#ifndef NO_WIN
            pg8::gemm_phase<EpiWin, PlainOrder, true, true>(l3, g, S, E, tid);
#ifdef DUP_WIN
            __syncthreads();
            pg8::gemm_phase<EpiWin, PlainOrder, true, true>(l3, g, S, E, tid);
#endif
#endif
        } else if constexpr (ph == 4) {
#ifndef NO_CONV
            conv_phase(pt, ws, l, tid, bid, G);
#endif
#ifndef NO_ATT
            attention_phase(pt, ws, l, lds, tid);
#endif
        } else {
            ChainOrder S; S.base.init(TPAD, DM, G, bid); S.tstep = (size_t)256 * 1024 * 2;
            S.A[0] = (const char*)hb; S.A[1] = (const char*)(ws + WS_CB); S.A[2] = (const char*)hb; S.A[3] = (const char*)(ws + WS_Q);
            S.B[0] = (const char*)(ws + WS_W + W_GC); S.B[1] = (const char*)(ws + WS_W + W_OC); S.B[2] = (const char*)(ws + WS_W + W_GA); S.B[3] = (const char*)(ws + WS_W + W_OA);
            pg8::Gemm g{nullptr, nullptr, TPAD, DM, 1024};
            EpiMerge E{(bf16_t*)(ws + WS_Z), (u32x4*)(ws + WS_SCR + (size_t)bid * 131072), ssq, tid};
#ifndef NO_MERGE
            pg8::gemm_phase<EpiMerge, ChainOrder, true, true>(l3, g, S, E, tid);
#ifdef DUP_MERGE
            __syncthreads();
            pg8::gemm_phase<EpiMerge, ChainOrder, true, true>(l3, g, S, E, tid);
#endif
#endif
        }
    }
}
template <int STEP>
__device__ __forceinline__ void run_from(const PT pt, unsigned char* lds, cg::grid_group& grid, XcdBarrier& bar, const int ph_lo, const int ph_hi) {
    run_step<STEP>(pt, lds, grid, bar, ph_lo, ph_hi);
    if constexpr (STEP + 1 < NSTEPS) run_from<STEP + 1>(pt, lds, grid, bar, ph_lo, ph_hi);
}

__global__ void __launch_bounds__(NWAVES * 64, 2) mega_fwd(Args args) {
    extern __shared__ __attribute__((aligned(16))) unsigned char lds[];
    cg::grid_group grid = cg::this_grid();
    PT pt; pt.t = (volatile LAS unsigned long long*)((LAS unsigned char*)lds + PTAB_OFF);
    if (threadIdx.x == 0) {
#pragma unroll
        for (int i = 0; i < 21; ++i) pt.t[i] = (unsigned long long)args.in[i];
        pt.t[21] = (unsigned long long)args.out; pt.t[22] = (unsigned long long)args.ws;
    }
    if (threadIdx.x < 8) ((volatile LAS unsigned*)((LAS unsigned char*)lds + MISC_OFF + 32))[threadIdx.x] = 0u;
    const int ph_lo = args.ph_lo, ph_hi = args.ph_hi;
    if (blockIdx.x == 0) { unsigned* bw = (unsigned*)(args.ws + WS_CTL) + CW_BAR; for (int i = threadIdx.x; i < XCD_BAR_WORDS; i += NWAVES * 64) bw[i] = 0u; }
    __syncthreads();
    XcdBarrier bar; bar.bar = nullptr; bar.x = 0; bar.st = nullptr;
    run_from<0>(pt, lds, grid, bar, ph_lo, ph_hi);
}

#ifndef LAUNCH_PER_STEP
#define LAUNCH_PER_STEP 0
#endif
extern "C" void kernel_launch(void* const* d_in, const int* in_sizes, int n_in, void* d_out, int out_size, void* d_ws, size_t ws_size, hipStream_t stream) {
    static int grid = 0;
    if (grid == 0) {
        if (n_in != 21 || ws_size < WS_END) { fprintf(stderr, "kernel_launch: need 21 inputs and >= %zu bytes of workspace; got %d, %zu\n", (size_t)WS_END, n_in, ws_size); grid = -1; return; }
        int dev = 0, cus = 0, per_cu = 0;
        hipGetDevice(&dev); hipDeviceGetAttribute(&cus, hipDeviceAttributeMultiprocessorCount, dev);
        if (hipFuncSetAttribute((const void*)mega_fwd, hipFuncAttributeMaxDynamicSharedMemorySize, LDS_BYTES) != hipSuccess) { fprintf(stderr, "kernel_launch: hipFuncSetAttribute failed\n"); grid = -1; return; }
        if (hipOccupancyMaxActiveBlocksPerMultiprocessor(&per_cu, (const void*)mega_fwd, NWAVES * 64, LDS_BYTES) != hipSuccess || per_cu < 1) per_cu = 1;
        (void)hipGetLastError();
        grid = cus * per_cu;
    }
    if (grid < 0) return;
    Args a{};
    for (int i = 0; i < 21; ++i) a.in[i] = (const float*)d_in[i];
    a.out = (float*)d_out; a.ws = (unsigned char*)d_ws;
#if LAUNCH_PER_STEP
    for (int s = 0; s < NSTEPS; ++s) { a.ph_lo = s; a.ph_hi = s + 1; void* kargs[] = {&a}; hipLaunchCooperativeKernel((void*)mega_fwd, dim3(grid), dim3(NWAVES * 64), kargs, LDS_BYTES, stream); }
#else
    a.ph_lo = 0; a.ph_hi = NSTEPS; void* kargs[] = {&a};
    hipError_t e = hipLaunchCooperativeKernel((void*)mega_fwd, dim3(grid), dim3(NWAVES * 64), kargs, LDS_BYTES, stream);
    if (e != hipSuccess) fprintf(stderr, "cooperative launch failed: %s (grid %d)\n", hipGetErrorString(e), grid);
#endif
}
```

```cpp
#include <hip/hip_runtime.h>
#include <hip/hip_cooperative_groups.h>
#include <hip/hip_bf16.h>
#include <cstdio>
#include <cstdint>
#include <cmath>
namespace cg = cooperative_groups;
namespace pg8 {
#define PG8_LAS __attribute__((address_space(3)))
typedef unsigned short bf16_t;
typedef short bf16x8 __attribute__((ext_vector_type(8)));
typedef float f32x4 __attribute__((ext_vector_type(4)));
typedef unsigned u32x4 __attribute__((ext_vector_type(4)));
constexpr int BM = 256, BK = 64, HALF = 128, HTB = HALF * BK * 2  , STAGE_BYTES = 8 * HTB, NXCD = 8, WGM = 8;

__host__ __device__ __forceinline__ int lds_byte(int r, int c) { const int st = (r >> 4) * 2 + (c >> 5), rr = r & 15, cc = c & 31, ob = rr * 64 + cc * 2; return st * 1024 + (ob ^ (((ob >> 9) & 1) << 5)); }
__host__ __device__ __forceinline__ void stage_rc(int b, int& R, int& C) { const int st = b / 1024, sb = b % 1024, swz = sb ^ (((sb >> 9) & 1) << 5); R = (st >> 1) * 16 + swz / 64; C = (st & 1) * 32 + (swz % 64) / 2; }
__host__ __device__ __forceinline__ int perm32(int rho) { const int n = rho >> 4, i = rho & 15; return 8 * (i >> 2) + 4 * n + (i & 3); }

struct Unit { int pm, pn, sub; };
struct Gemm { const bf16_t* A; const bf16_t* Bt; int M, N, K; };

struct StaticOrder {
    int nM, nN, nwg, G, c;
    __host__ __device__ void init(int M, int N, int G_, int c_) { nM = M / BM; nN = N / BM; nwg = nM * nN; G = G_; c = c_; }
    __host__ __device__ bool next(int i, Unit& u) const {
        const long L = (long)i * G + c; if (L >= nwg) return false;
        int wgid = (int)L; { const int q = nwg / NXCD, r = nwg % NXCD, xcd = wgid % NXCD, off = wgid / NXCD; wgid = (xcd < r ? xcd * (q + 1) : r * (q + 1) + (xcd - r) * q) + off; }
        const int nig = WGM * nN, gid = wgid / nig, fm = gid * WGM, gsz = (nM - fm) < WGM ? (nM - fm) : WGM;
        u.pm = fm + ((wgid % nig) % gsz); u.pn = (wgid % nig) / gsz; u.sub = 0; return true;
    }
    __device__ __forceinline__ void a_ready(const Unit&) const {}
    __device__ __forceinline__ void done(const Unit&) const {}
};

__device__ __forceinline__ unsigned cvt_pk_bf16(float lo, float hi) { unsigned r; asm volatile("v_cvt_pk_bf16_f32 %0, %1, %2" : "=v"(r) : "v"(lo), "v"(hi)); return r; }
typedef float f32x2 __attribute__((ext_vector_type(2)));
template <class Epi, class Sched, bool ALIGN_EPI = false, bool SP2 = false>
__device__ __forceinline__ void gemm_phase(PG8_LAS unsigned char* lds, const Gemm g, const Sched& S, const Epi& E, const int tid) {
    const int wid = __builtin_amdgcn_readfirstlane(tid >> 6), lane = tid & 63, wr = wid >> 2, wc = wid & 3, fr = lane & 15, fq = lane >> 4;
    const int K = g.K, nt = K / BK;
    unsigned voffA[2], voffB[2];
#pragma unroll
    for (int i = 0; i < 2; ++i) { int R, C; stage_rc(tid * 16 + i * 8192, R, C); const int Rb = Epi::PERM ? ((R & ~31) + perm32(R & 31)) : R;
        voffA[i] = (unsigned)(R * K + C) * 2u; voffB[i] = (unsigned)(Rb * K + C) * 2u; }
    const size_t kstep = (size_t)(BK * 2);
    const size_t hstep = (size_t)HALF * K * 2;
        const unsigned ldsw = (unsigned)wid * 1024u;
    const int aoff = lds_byte(wr * 64 + fr, fq * 8), boff = lds_byte(wc * 32 + fr, fq * 8);
#define PG8_SA(b, h) (((b) * 2 + (h)) * HTB)
#define PG8_SB(b, h) ((4 + (b) * 2 + (h)) * HTB)
#define PG8_STAGE(bufoff, gbase, voff) do { _Pragma("unroll") for (int _i = 0; _i < 2; ++_i) \
        __builtin_amdgcn_global_load_lds((const unsigned*)((const char*)(gbase) + (voff)[_i]), (PG8_LAS unsigned*)(lds + (bufoff) + ldsw + _i * 8192), 16, 0, 0); } while (0)
#define PG8_LDA(dst, b, h) do { _Pragma("unroll") for (int m = 0; m < 4; ++m) _Pragma("unroll") for (int k = 0; k < 2; ++k) dst[m][k] = *(const PG8_LAS bf16x8*)(lds + PG8_SA(b, h) + aoff + m * 2048 + k * 1024); } while (0)
#define PG8_LDB(dst, b, h) do { _Pragma("unroll") for (int n = 0; n < 2; ++n) _Pragma("unroll") for (int k = 0; k < 2; ++k) dst[n][k] = *(const PG8_LAS bf16x8*)(lds + PG8_SB(b, h) + boff + n * 2048 + k * 1024); } while (0)
#define PG8_MMA(ai, bj, At, Bt) do { __builtin_amdgcn_s_setprio(1); _Pragma("unroll") for (int m = 0; m < 4; ++m) _Pragma("unroll") for (int n = 0; n < 2; ++n) _Pragma("unroll") for (int k = 0; k < 2; ++k) \
        acc[ai][bj][m][n] = __builtin_amdgcn_mfma_f32_16x16x32_bf16(Bt[n][k], At[m][k], acc[ai][bj][m][n], 0, 0, 0); __builtin_amdgcn_s_setprio(0); } while (0)
#define PG8_WAIT_V(n) asm volatile("s_waitcnt vmcnt(" #n ")" ::: "memory")
#define PG8_WAIT_L(n) asm volatile("s_waitcnt lgkmcnt(" #n ")" ::: "memory")
#define PG8_BAR __builtin_amdgcn_s_barrier()
#define PG8_SCHED __builtin_amdgcn_sched_barrier(0)
    Unit cur, nxt; int ui = 0;
    if (!S.next(0, cur)) return;
    f32x4 acc[2][2][4][2];
#pragma unroll
    for (int a = 0; a < 2; ++a)
#pragma unroll
        for (int b = 0; b < 2; ++b)
#pragma unroll
            for (int m = 0; m < 4; ++m)
#pragma unroll
                for (int n = 0; n < 2; ++n) acc[a][b][m][n] = (f32x4){0.f, 0.f, 0.f, 0.f};
    bf16x8 At[4][2], B0[2][2], B1[2][2];
    const char* cA = S.aptr(cur); const char* cB = S.bptr(cur);
    S.a_ready(cur);
    if constexpr (SP2) {
        PG8_STAGE(PG8_SB(0, 0), cB, voffB); PG8_STAGE(PG8_SB(0, 1), cB + hstep, voffB); PG8_STAGE(PG8_SA(0, 0), cA, voffA); PG8_STAGE(PG8_SA(0, 1), cA + hstep, voffA);
        if (wr == 1) PG8_BAR;
        PG8_WAIT_V(2); PG8_BAR;
        PG8_STAGE(PG8_SB(1, 0), cB + kstep, voffB); PG8_STAGE(PG8_SA(1, 0), cA + kstep, voffA); PG8_STAGE(PG8_SB(1, 1), cB + hstep + kstep, voffB);
        PG8_WAIT_V(6); PG8_BAR;
    } else {
        PG8_STAGE(PG8_SB(0, 0), cB, voffB); PG8_STAGE(PG8_SA(0, 0), cA, voffA); PG8_STAGE(PG8_SB(0, 1), cB + hstep, voffB); PG8_STAGE(PG8_SA(0, 1), cA + hstep, voffA);
        if (wr == 1) PG8_BAR;
        PG8_WAIT_V(4); PG8_BAR;
        PG8_STAGE(PG8_SB(1, 0), cB + kstep, voffB); PG8_STAGE(PG8_SA(1, 0), cA + kstep, voffA); PG8_STAGE(PG8_SB(1, 1), cB + hstep + kstep, voffB);
        PG8_WAIT_V(6); PG8_BAR;
    }
    for (;;) {
        const bool has_next = S.next(ui + 1, nxt);
        const char* nA = has_next ? S.aptr(nxt) : cA; const char* nB = has_next ? S.bptr(nxt) : cB;
        for (int t = 0; t < nt; t += 2) {
            const bool last = (t == nt - 2);
            const char* a1 = cA + (size_t)(t + 1) * kstep;
            const char* a2 = last ? nA : cA + (size_t)(t + 2) * kstep; const char* b2 = last ? nB : cB + (size_t)(t + 2) * kstep;
            const char* a3 = a2 + kstep; const char* b3 = b2 + kstep;
            if (last && has_next) S.a_ready(nxt);
            if constexpr (SP2) {
            PG8_LDB(B0, 0, 0); PG8_LDB(B1, 0, 1); PG8_SCHED; PG8_LDA(At, 0, 0); PG8_STAGE(PG8_SA(1, 1), a1 + hstep, voffA);
            PG8_WAIT_V(8); PG8_WAIT_L(0); PG8_BAR; PG8_MMA(0, 0, At, B0); PG8_MMA(0, 1, At, B1); PG8_BAR; PG8_SCHED;
            PG8_LDA(At, 0, 1); PG8_STAGE(PG8_SB(0, 0), b2, voffB); PG8_STAGE(PG8_SB(0, 1), b2 + hstep, voffB); PG8_STAGE(PG8_SA(0, 0), a2, voffA);
            PG8_WAIT_V(8); PG8_WAIT_L(0); PG8_BAR; PG8_MMA(1, 0, At, B0); PG8_MMA(1, 1, At, B1); PG8_BAR; PG8_SCHED;
            PG8_LDB(B0, 1, 0); PG8_LDB(B1, 1, 1); PG8_SCHED; PG8_LDA(At, 1, 0); PG8_STAGE(PG8_SA(0, 1), a2 + hstep, voffA);
            PG8_WAIT_V(8); PG8_WAIT_L(0); PG8_BAR; PG8_MMA(0, 0, At, B0); PG8_MMA(0, 1, At, B1); PG8_BAR; PG8_SCHED;
            PG8_LDA(At, 1, 1); PG8_STAGE(PG8_SB(1, 0), b3, voffB); PG8_STAGE(PG8_SB(1, 1), b3 + hstep, voffB); PG8_STAGE(PG8_SA(1, 0), a3, voffA);
            PG8_WAIT_V(8); PG8_WAIT_L(0); PG8_BAR; PG8_MMA(1, 0, At, B0); PG8_MMA(1, 1, At, B1); PG8_BAR; PG8_SCHED;
            } else {
            PG8_LDB(B0, 0, 0); PG8_SCHED; PG8_LDA(At, 0, 0); PG8_STAGE(PG8_SA(1, 1), a1 + hstep, voffA);
            PG8_WAIT_L(8); PG8_BAR; PG8_WAIT_L(0); PG8_MMA(0, 0, At, B0); PG8_BAR; PG8_SCHED;
            PG8_LDB(B1, 0, 1); PG8_STAGE(PG8_SB(0, 0), b2, voffB);
            PG8_BAR; PG8_WAIT_L(0); PG8_MMA(0, 1, At, B1); PG8_BAR;
            PG8_LDA(At, 0, 1); PG8_STAGE(PG8_SA(0, 0), a2, voffA);
            PG8_BAR; PG8_WAIT_L(0); PG8_MMA(1, 0, At, B0); PG8_BAR; PG8_SCHED;
            PG8_STAGE(PG8_SB(0, 1), b2 + hstep, voffB);
            PG8_WAIT_V(6); PG8_BAR; PG8_MMA(1, 1, At, B1); PG8_BAR;
            PG8_LDB(B0, 1, 0); PG8_SCHED; PG8_LDA(At, 1, 0); PG8_STAGE(PG8_SA(0, 1), a2 + hstep, voffA);
            PG8_WAIT_L(8); PG8_BAR; PG8_WAIT_L(0); PG8_MMA(0, 0, At, B0); PG8_BAR; PG8_SCHED;
            PG8_LDB(B1, 1, 1); PG8_STAGE(PG8_SB(1, 0), b3, voffB);
            PG8_BAR; PG8_WAIT_L(0); PG8_MMA(0, 1, At, B1); PG8_BAR;
            PG8_LDA(At, 1, 1); PG8_STAGE(PG8_SA(1, 0), a3, voffA);
            PG8_BAR; PG8_WAIT_L(0); PG8_MMA(1, 0, At, B0); PG8_BAR; PG8_SCHED;
            PG8_STAGE(PG8_SB(1, 1), b3 + hstep, voffB);
            PG8_WAIT_V(6); PG8_BAR; PG8_MMA(1, 1, At, B1); PG8_BAR;
            }
        }
        if constexpr (ALIGN_EPI) { if (wr == 0) PG8_BAR; }
        if constexpr (!Epi::AFTER_DRAIN) { E(acc, cur, wr, wc, fr, fq); S.done(cur); }
        if (!has_next) break;
#pragma unroll
        for (int a = 0; a < 2; ++a)
#pragma unroll
            for (int b = 0; b < 2; ++b)
#pragma unroll
                for (int m = 0; m < 4; ++m)
#pragma unroll
                    for (int n = 0; n < 2; ++n) acc[a][b][m][n] = (f32x4){0.f, 0.f, 0.f, 0.f};
        cur = nxt; cA = nA; cB = nB; ++ui;
        if constexpr (ALIGN_EPI) { if (wr == 1) PG8_BAR; }
    }
    PG8_WAIT_V(0);
    if constexpr (!ALIGN_EPI) { if (wr == 0) PG8_BAR; }
    PG8_BAR;
    if constexpr (Epi::AFTER_DRAIN) { E.fused(acc, cur, wr, wc, fr, fq, lds, wid, lane); S.done(cur); }
#undef PG8_SA
#undef PG8_SB
#undef PG8_STAGE
#undef PG8_LDA
#undef PG8_LDB
#undef PG8_MMA
#undef PG8_WAIT_V
#undef PG8_WAIT_L
#undef PG8_BAR
#undef PG8_SCHED
}
}
namespace attn_body {
using bf16=__hip_bfloat16;
using bf16x8=__attribute__((ext_vector_type(8)))short;
using s16x4=__attribute__((ext_vector_type(4)))short;
using f32x16=__attribute__((ext_vector_type(16)))float;
using u32x4=__attribute__((ext_vector_type(4)))unsigned;
constexpr int D=64,QP=1024,KP=256;
constexpr int NW=8,QBLK=32,KVBLK=64;
__device__ __forceinline__ int crow(int r,int hi){return (r&3)+8*(r>>2)+4*hi;}
#define SBAR() __builtin_amdgcn_sched_barrier(0)
__device__ __forceinline__ void kmask(f32x16&p0,f32x16&p1,int rem,int hi){
  const float NEG=-INFINITY;
  #pragma unroll
  for(int r=0;r<16;++r){int kv=4*hi+(r&3)+8*(r>>2); if(kv>=rem)p0[r]=NEG; if(kv+32>=rem)p1[r]=NEG;}
}

constexpr int NSLOT=3, SLOTB=8192;
constexpr int LDS_K=0, LDS_V=NSLOT*SLOTB, LDS_WS=2*NSLOT*SLOTB, LDS_OST=LDS_WS+NW*64*4, LDS_BYTES=LDS_OST+NW*4096;
constexpr float C2=0.125f*1.4426950408889634f;
__device__ __forceinline__ void glds16(const void*gsrc,unsigned lds_dst){unsigned keep;
  asm volatile("s_mov_b32 %0, m0\n\ts_mov_b32 m0, %2\n\ts_nop 0\n\tglobal_load_lds_dwordx4 %1, off\n\ts_mov_b32 m0, %0":"=&s"(keep):"v"(gsrc),"s"(lds_dst):"memory");}
__device__ __forceinline__ float max3f(float a,float b,float c){float r;asm("v_max3_f32 %0, %1, %2, %3":"=v"(r):"v"(a),"v"(b),"v"(c));return r;}
__device__ __forceinline__ float max2f(float a,float b){float r;asm("v_max_f32_e32 %0, %1, %2":"=v"(r):"v"(a),"v"(b));return r;}
__device__ __forceinline__ float fadd_s(float a,float b){float r;asm("v_add_f32_e32 %0, %1, %2":"=v"(r):"v"(a),"v"(b));return r;}
__device__ __forceinline__ float fsub_s(float a,float b){float r;asm("v_sub_f32_e32 %0, %1, %2":"=v"(r):"v"(a),"v"(b));return r;}
typedef float f32x2_t __attribute__((ext_vector_type(2))); typedef __bf16 bf16x2_t __attribute__((ext_vector_type(2)));
__device__ __forceinline__ unsigned cvtpk_s(float lo,float hi){f32x2_t v={lo,hi};bf16x2_t b=__builtin_convertvector(v,bf16x2_t);return __builtin_bit_cast(unsigned,b);}
#define WAIT_BAR(N) asm volatile("s_waitcnt vmcnt(" #N ") lgkmcnt(0)\n\ts_barrier":::"memory")

__device__ __forceinline__ void qkt(f32x16&p0,f32x16&p1,const char*Kslot,const bf16x8*qr,const f32x16&negm,int r32,int hi){
  const char*kb=Kslot+hi*1024+r32*16;
  #pragma unroll
  for(int d0=0;d0<4;++d0){
    const bf16x8 b0=*reinterpret_cast<const bf16x8*>(kb+d0*2048);
    const bf16x8 b1=*reinterpret_cast<const bf16x8*>(kb+d0*2048+512);
    if(d0==0){p0=__builtin_amdgcn_mfma_f32_32x32x16_bf16(b0,qr[0],negm,0,0,0);p1=__builtin_amdgcn_mfma_f32_32x32x16_bf16(b1,qr[0],negm,0,0,0);}
    else{p0=__builtin_amdgcn_mfma_f32_32x32x16_bf16(b0,qr[d0],p0,0,0,0);p1=__builtin_amdgcn_mfma_f32_32x32x16_bf16(b1,qr[d0],p1,0,0,0);}}
}
typedef __attribute__((address_space(3))) const char* lds_cptr;
typedef short v4i16_t __attribute__((ext_vector_type(4)));
__device__ __forceinline__ void kload8(bf16x8*kf,lds_cptr kp){
  kf[0]=*(const __attribute__((address_space(3))) bf16x8*)(kp);      kf[1]=*(const __attribute__((address_space(3))) bf16x8*)(kp+512);
  kf[2]=*(const __attribute__((address_space(3))) bf16x8*)(kp+2048); kf[3]=*(const __attribute__((address_space(3))) bf16x8*)(kp+2560);
  kf[4]=*(const __attribute__((address_space(3))) bf16x8*)(kp+4096); kf[5]=*(const __attribute__((address_space(3))) bf16x8*)(kp+4608);
  kf[6]=*(const __attribute__((address_space(3))) bf16x8*)(kp+6144); kf[7]=*(const __attribute__((address_space(3))) bf16x8*)(kp+6656);
}
__device__ __forceinline__ void kload2(bf16x8*kf,lds_cptr kp,int j){ kf[2*j]=*(const __attribute__((address_space(3))) bf16x8*)(kp+j*2048); kf[2*j+1]=*(const __attribute__((address_space(3))) bf16x8*)(kp+j*2048+512); }
__device__ __forceinline__ s16x4 vtr(lds_cptr p){ return __builtin_bit_cast(s16x4,__builtin_amdgcn_ds_read_tr16_b64_v4i16((__attribute__((address_space(3))) v4i16_t*)p)); }
__device__ __forceinline__ float rowmax(const f32x16&p0,const f32x16&p1){
  float a=max3f(p0[0],p0[1],p1[0]),b=max3f(p0[2],p0[3],p1[1]);a=max3f(a,p1[2],p1[3]);
  #pragma unroll
  for(int r=4;r<16;r+=4){a=max3f(a,p0[r],p0[r+1]);b=max3f(b,p0[r+2],p0[r+3]);a=max3f(a,p1[r],p1[r+1]);b=max3f(b,p1[r+2],p1[r+3]);}
  const float m=max2f(a,b);
  auto rr=__builtin_amdgcn_permlane32_swap(__float_as_uint(m),__float_as_uint(m),false,false);
  return max2f(__uint_as_float(rr[0]),__uint_as_float(rr[1]));
}
__device__ __forceinline__ void pv(f32x16*o,int vb,bf16x8 pa0,bf16x8 pa1,bf16x8 pa2,bf16x8 pa3){
  #pragma unroll
  for(int d0=0;d0<2;++d0){s16x4 lo[4],hi[4];
    #pragma unroll
    for(int ks=0;ks<4;++ks){
      asm volatile("ds_read_b64_tr_b16 %0,%1 offset:%c2":"=&v"(lo[ks]):"v"(vb),"i"(d0*4096+ks*1024):"memory");
      asm volatile("ds_read_b64_tr_b16 %0,%1 offset:%c2":"=&v"(hi[ks]):"v"(vb),"i"(d0*4096+ks*1024+512):"memory");}
    asm volatile("s_waitcnt lgkmcnt(0)":::"memory");SBAR();
    #define PK(k) (bf16x8){lo[k][0],lo[k][1],lo[k][2],lo[k][3],hi[k][0],hi[k][1],hi[k][2],hi[k][3]}
    o[d0]=__builtin_amdgcn_mfma_f32_32x32x16_bf16(pa0,PK(0),o[d0],0,0,0);
    o[d0]=__builtin_amdgcn_mfma_f32_32x32x16_bf16(pa1,PK(1),o[d0],0,0,0);
    o[d0]=__builtin_amdgcn_mfma_f32_32x32x16_bf16(pa2,PK(2),o[d0],0,0,0);
    o[d0]=__builtin_amdgcn_mfma_f32_32x32x16_bf16(pa3,PK(3),o[d0],0,0,0);
    #undef PK
  }
}

#ifndef ATTN_STORE16
#define ATTN_STORE16(p,v) (*(u32x4*)(p)=(v))
#endif
template<int THRL,int L,int NT> __device__ __forceinline__ void attn_unit(long rowbase,int kvh,int qblk,const bf16*Q,const bf16*__restrict__ K,const bf16*__restrict__ V,bf16*O,char*shm,const int tid){
  const int lane=tid&63,r32=lane&31,hi=lane>>5; const int wid=__builtin_amdgcn_readfirstlane(tid>>6);
  const int q0=qblk*64, qh=wid>>1, rh=wid&1;
  const bf16*Qw=Q+(rowbase+q0+rh*QBLK)*QP+(4*kvh+qh)*D;
  const bf16*Kh=K+rowbase*KP+kvh*D,*Vh=V+rowbase*KP+kvh*D;
  const unsigned lds0=(unsigned)(uintptr_t)shm;
  float*wsf=(float*)(shm+LDS_WS)+wid*64;
  const bf16*ksrc=Kh+(long)lane*KP+wid*8;
  const bf16*vsrc=Vh+(long)(16*(wid&3)+(lane>>2))*KP+(wid>>2)*32+(lane&3)*8;
  const unsigned kdst=lds0+LDS_K+wid*1024, vdst=lds0+LDS_V+wid*1024;
  #define DMA_K(t,slot) glds16(ksrc+(long)(t)*KVBLK*KP,(unsigned)__builtin_amdgcn_readfirstlane(kdst+(slot)))
  #define DMA_V(t,slot) glds16(vsrc+(long)(t)*KVBLK*KP,(unsigned)__builtin_amdgcn_readfirstlane(vdst+(slot)))
  const int vb0=(int)(lds0+LDS_V)+((lane>>4)&1)*32+(lane&3)*8+(4*hi+((lane&15)>>2))*64;
  const char*Kbase=shm+LDS_K; bf16x8 kf[8];
  const lds_cptr shm3=(lds_cptr)shm; const lds_cptr kp0=shm3+LDS_K+hi*1024+r32*16; const lds_cptr vp0=shm3+LDS_V+((lane>>4)&1)*32+(lane&3)*8+(4*hi+((lane&15)>>2))*64;
  DMA_K(0,0);DMA_V(0,0);DMA_K(1,SLOTB);
  bf16x8 qr[4];
  #pragma unroll
  for(int d0=0;d0<4;++d0)qr[d0]=*reinterpret_cast<const bf16x8*>(&Qw[(long)r32*QP+d0*16+hi*8]);
  if(q0+rh*QBLK+r32>=L){
    #pragma unroll
    for(int d0=0;d0<4;++d0)qr[d0]=bf16x8{0,0,0,0,0,0,0,0}; }
  float mhat=0.f,l_reg=0.f;f32x16 o[2];o[0]=f32x16{};o[1]=f32x16{};f32x16 negm=f32x16{};asm volatile("":"+v"(negm));
  #define CMASK(P0,P1,t) do{ if((t)>=NT-2)kmask(P0,P1,L-64*(t),hi);}while(0)
  bool resc=false;
  #define START(P0,P1) do{ const float rm=rowmax(P0,P1); resc=false; \
    { const float dl=rm; mhat=fadd_s(mhat,dl); \
      _Pragma("unroll") for(int r=0;r<16;++r){P0[r]=fsub_s(P0[r],dl);P1[r]=fsub_s(P1[r],dl);} \
      _Pragma("unroll") for(int r=0;r<16;++r)negm[r]=-mhat; asm volatile("":"+v"(negm)); } \
    _Pragma("unroll") for(int r=0;r<16;++r)P0[r]=__builtin_amdgcn_exp2f(P0[r]); }while(0)
  #define RESC() do{ if(resc){ asm volatile("s_waitcnt lgkmcnt(0)":::"memory"); \
      _Pragma("unroll") for(int d_=0;d_<2;++d_) _Pragma("unroll") for(int r=0;r<16;++r)o[d_][r]*=wsf[crow(r,hi)]; } }while(0)
  f32x16 pA0,pA1,pB0,pB1;
  int sl_prev=0,sl_cur=0,sl_next=SLOTB;
  #define ROT() do{sl_prev=sl_cur;sl_cur=sl_next;sl_next=(sl_next==(NSLOT-1)*SLOTB)?0:sl_next+SLOTB;}while(0)
  DMA_K(2,2*SLOTB);
  WAIT_BAR(3);
  qkt(pA0,pA1,Kbase,qr,negm,r32,hi);asm volatile("s_nop 15\n\ts_nop 7":"+v"(pA0),"+v"(pA1));CMASK(pA0,pA1,0);
  START(pA0,pA1);
  _Pragma("unroll") for(int r=0;r<16;++r)pA1[r]=__builtin_amdgcn_exp2f(pA1[r]);
  WAIT_BAR(0);
  DMA_K(3,0);DMA_V(1,SLOTB);
  ROT();
  kload8(kf,kp0+sl_cur);
  WAIT_BAR(2);
  s16x4 vlo[8],vhi[8]; u32x4 pw0,pw1,pw2,pw3;
  #define PKW(P,B) cvtpk_s(P[B],P[B+1])
  #define PAF(k) __builtin_bit_cast(bf16x8,pw##k)
  #define VFR(i) (bf16x8){vlo[i][0],vlo[i][1],vlo[i][2],vlo[i][3],vhi[i][0],vhi[i][1],vhi[i][2],vhi[i][3]}
  #define PIN(x) asm volatile("":"+v"(x))
  #define MX3(a,b,c) __builtin_fmaxf(__builtin_fmaxf((a),(b)),(c))
  #define GAPA(MF,A0,A1,A2,A3,W0,W1,PW) do{ MF; sacc+=A0; sacc+=A1; sacc+=A2; sacc+=A3; PIN(sacc); W0; W1; PIN(PW); SBAR(); }while(0)
  #define EX(v) __builtin_amdgcn_exp2f(v)
  #define GAPB(MF,X,B) do{ MF; X[B]=EX(X[B]); X[B+1]=EX(X[B+1]); X[B+2]=EX(X[B+2]); X[B+3]=EX(X[B+3]); PIN(X); SBAR(); }while(0)
  #define VRD(i) do{ vlo[i]=vtr(vp_+(((i)>>2)*4096+((i)&3)*1024)); vhi[i]=vtr(vp_+(((i)>>2)*4096+((i)&3)*1024+512)); }while(0)
  #define KRD(G,j) do{ if(G){ kload2(kf,kp0+sl_next,j); SBAR(); } }while(0)
  #define STEP(C0,C1,P0,P1,t,GK,GV,GL) do{ SBAR(); \
    const lds_cptr vp_=vp0+sl_prev; \
    VRD(0); SBAR(); float sacc=(P0[0]+P0[1]); \
    GAPA(C0=__builtin_amdgcn_mfma_f32_32x32x16_bf16(kf[0],qr[0],negm,0,0,0), P0[2],P0[3],P0[4],P0[5],     pw0[0]=PKW(P0,0), pw0[1]=PKW(P0,2), pw0); \
    VRD(4); SBAR(); GAPA(C1=__builtin_amdgcn_mfma_f32_32x32x16_bf16(kf[1],qr[0],negm,0,0,0), P0[6],P0[7],P0[8],P0[9],     pw0[2]=PKW(P0,4), pw0[3]=PKW(P0,6), pw0); \
    VRD(1); SBAR(); GAPA(C0=__builtin_amdgcn_mfma_f32_32x32x16_bf16(kf[2],qr[1],C0,0,0,0),   P0[10],P0[11],P0[12],P0[13], pw1[0]=PKW(P0,8), pw1[1]=PKW(P0,10), pw1); \
    VRD(5); SBAR(); GAPA(C1=__builtin_amdgcn_mfma_f32_32x32x16_bf16(kf[3],qr[1],C1,0,0,0),   P0[14],P0[15],P1[0],P1[1],   pw1[2]=PKW(P0,12),pw1[3]=PKW(P0,14), pw1); \
    VRD(2); SBAR(); GAPA(C0=__builtin_amdgcn_mfma_f32_32x32x16_bf16(kf[4],qr[2],C0,0,0,0),   P1[2],P1[3],P1[4],P1[5],     pw2[0]=PKW(P1,0), pw2[1]=PKW(P1,2), pw2); \
    VRD(6); SBAR(); GAPA(C1=__builtin_amdgcn_mfma_f32_32x32x16_bf16(kf[5],qr[2],C1,0,0,0),   P1[6],P1[7],P1[8],P1[9],     pw2[2]=PKW(P1,4), pw2[3]=PKW(P1,6), pw2); \
    VRD(3); SBAR(); GAPA(C0=__builtin_amdgcn_mfma_f32_32x32x16_bf16(kf[6],qr[3],C0,0,0,0),   P1[10],P1[11],P1[12],P1[13], pw3[0]=PKW(P1,8), pw3[1]=PKW(P1,10), pw3); \
    VRD(7); SBAR(); GAPA(C1=__builtin_amdgcn_mfma_f32_32x32x16_bf16(kf[7],qr[3],C1,0,0,0),   P1[14],P1[15],0.f,0.f,       pw3[2]=PKW(P1,12),pw3[3]=PKW(P1,14), pw3); \
    l_reg+=sacc; \
    if(GK){DMA_K((t)+3,sl_cur);} if(GV){DMA_V((t)+1,sl_next);} \
    CMASK(C0,C1,t); \
    { float a=MX3(C0[0],C0[1],C1[0]),b=MX3(C0[2],C0[3],C1[1]); a=MX3(a,C1[2],C1[3]); \
      _Pragma("unroll") for(int r=4;r<16;r+=4){a=MX3(a,C0[r],C0[r+1]);b=MX3(b,C0[r+2],C0[r+3]);a=MX3(a,C1[r],C1[r+1]);b=MX3(b,C1[r+2],C1[r+3]);} \
      float rm=__builtin_fmaxf(a,b); { auto rr=__builtin_amdgcn_permlane32_swap(__float_as_uint(rm),__float_as_uint(rm),false,false); rm=__builtin_fmaxf(__uint_as_float(rr[0]),__uint_as_float(rr[1])); } \
      resc=false; \
      if(__builtin_expect(__any(rm>(float)THRL),0)){ const float dl=__builtin_fmaxf(rm,0.f); mhat+=dl; \
        _Pragma("unroll") for(int r=0;r<16;++r){C0[r]-=dl;C1[r]-=dl;} \
        _Pragma("unroll") for(int r=0;r<16;++r)negm[r]=-mhat; asm volatile("":"+v"(negm)); \
        const float f=__builtin_amdgcn_exp2f(-dl); l_reg*=f; if(hi==0)wsf[r32]=f; resc=true; } } \
    SBAR(); \
    GAPB(o[0]=__builtin_amdgcn_mfma_f32_32x32x16_bf16(PAF(0),VFR(0),o[0],0,0,0), C0,0); \
    GAPB(o[1]=__builtin_amdgcn_mfma_f32_32x32x16_bf16(PAF(0),VFR(4),o[1],0,0,0), C0,4); \
    KRD(GL,0); GAPB(o[0]=__builtin_amdgcn_mfma_f32_32x32x16_bf16(PAF(1),VFR(1),o[0],0,0,0), C0,8); \
    KRD(GL,1); GAPB(o[1]=__builtin_amdgcn_mfma_f32_32x32x16_bf16(PAF(1),VFR(5),o[1],0,0,0), C0,12); \
    KRD(GL,2); GAPB(o[0]=__builtin_amdgcn_mfma_f32_32x32x16_bf16(PAF(2),VFR(2),o[0],0,0,0), C1,0); \
    KRD(GL,3); GAPB(o[1]=__builtin_amdgcn_mfma_f32_32x32x16_bf16(PAF(2),VFR(6),o[1],0,0,0), C1,4); \
    GAPB(o[0]=__builtin_amdgcn_mfma_f32_32x32x16_bf16(PAF(3),VFR(3),o[0],0,0,0), C1,8); \
    GAPB(o[1]=__builtin_amdgcn_mfma_f32_32x32x16_bf16(PAF(3),VFR(7),o[1],0,0,0), C1,12); \
    }while(0)
  int t=1;
  #undef CMASK
  #define CMASK(P0,P1,t) do{}while(0)
  for(;t+5<NT;t+=2){
    STEP(pB0,pB1,pA0,pA1,t,true,true,true);     WAIT_BAR(2); RESC(); ROT();
    STEP(pA0,pA1,pB0,pB1,t+1,true,true,true);   WAIT_BAR(2); RESC(); ROT();
  }
  #undef CMASK
  #define CMASK(P0,P1,t) do{ if((t)>=NT-2)kmask(P0,P1,L-64*(t),hi);}while(0)
  #define ENDW(tt) do{ if((tt)+3<NT){WAIT_BAR(2);} else if((tt)+2<NT){WAIT_BAR(1);} else {WAIT_BAR(0);} }while(0)
  for(;t+1<NT;t+=2){
    STEP(pB0,pB1,pA0,pA1,t,(t+3<NT),(t+1<NT),(t+1<NT));       ENDW(t);   RESC(); ROT();
    STEP(pA0,pA1,pB0,pB1,t+1,(t+4<NT),(t+2<NT),(t+2<NT));     ENDW(t+1); RESC(); ROT();
  }
  STEP(pB0,pB1,pA0,pA1,NT-1,false,false,false); RESC();
  { float sacc=pB0[0]+pB0[1]; _Pragma("unroll") for(int r=2;r<16;++r)sacc+=pB0[r]; _Pragma("unroll") for(int r=0;r<16;++r)sacc+=pB1[r]; l_reg+=sacc;
    pw0=(u32x4){PKW(pB0,0),PKW(pB0,2),PKW(pB0,4),PKW(pB0,6)};pw1=(u32x4){PKW(pB0,8),PKW(pB0,10),PKW(pB0,12),PKW(pB0,14)};pw2=(u32x4){PKW(pB1,0),PKW(pB1,2),PKW(pB1,4),PKW(pB1,6)};pw3=(u32x4){PKW(pB1,8),PKW(pB1,10),PKW(pB1,12),PKW(pB1,14)};
    SBAR(); pv(o,vb0+sl_cur,PAF(0),PAF(1),PAF(2),PAF(3)); }
  #undef PKW
  #undef PAF
  #undef VFR
  #undef PIN
  #undef MX3
  #undef GAPA
  #undef GAPB
  #undef EX
  #undef VRD
  #undef KRD
  #undef STEP
  #undef ENDW
  {auto rr=__builtin_amdgcn_permlane32_swap(__float_as_uint(l_reg),__float_as_uint(l_reg),false,false);l_reg=__uint_as_float(rr[0])+__uint_as_float(rr[1]);}
  if(hi==0)wsf[32+r32]=l_reg;asm volatile("s_waitcnt lgkmcnt(0)":::"memory");
  float rli[16];
  #pragma unroll
  for(int r=0;r<16;++r)rli[r]=__builtin_amdgcn_rcpf(wsf[32+crow(r,hi)]);
  bf16*Ow=O+(rowbase+q0+rh*QBLK)*QP+(4*kvh+qh)*D;
  { bf16*stg=(bf16*)(shm+LDS_OST)+wid*2048;
    #pragma unroll
    for(int r=0;r<16;++r){const int orow=crow(r,hi);
      #pragma unroll
      for(int d0=0;d0<2;++d0)stg[orow*64+d0*32+r32]=__float2bfloat16(o[d0][r]*rli[r]);}
    asm volatile("s_waitcnt lgkmcnt(0)":::"memory");
    #pragma unroll
    for(int i=0;i<4;++i){const int row=i*8+(lane>>3),ch=lane&7; const u32x4 v=*(const u32x4*)(stg+row*64+ch*8); if(q0+rh*QBLK+row<L)ATTN_STORE16(Ow+(long)row*QP+ch*8,v);} }
  asm volatile("s_waitcnt lgkmcnt(0)\n\ts_barrier":::"memory");
  #undef DMA_K
  #undef DMA_V
  #undef CMASK
  #undef START
  #undef RESC
  #undef ROT
}
constexpr int ATTN_LDS_BYTES=LDS_BYTES;
#undef SBAR
#undef WAIT_BAR
}
constexpr int DM = 1024, FF = 2816, NLAYER = 4;
constexpr int LP = 4112, LS = 2064, NSEQ_P = 4, NSEQ_S = 16, ROWS_P = NSEQ_P * LP  , T_ROWS = ROWS_P + NSEQ_S * LS  ;
constexpr int TPAD = 49664, NMT = TPAD / 256;
constexpr int NWIN = 4608;
constexpr float NORM_EPS = 1e-6f;
constexpr float QSCALE = 0.125f * 1.4426950408889634f;
constexpr int ATT_UNITS_P = NSEQ_P * 4 * 65, ATT_UNITS_S = NSEQ_S * 4 * 33, ATT_UNITS = ATT_UNITS_P + ATT_UNITS_S;

constexpr size_t MiB = 1u << 20;
constexpr int CW_BAR = 4096;
constexpr size_t WS_CTL = 0;
constexpr size_t WS_ROPE = MiB / 4;
constexpr size_t WS_HMETA = 3 * MiB / 2;
constexpr size_t WS_SSQ = 3 * MiB;
constexpr size_t WS_W = 8 * MiB;
constexpr size_t W_GU1 = 0, W_D1 = W_GU1 + (size_t)5632 * 1024 * 2, W_IN = W_D1 + (size_t)1024 * 2816 * 2, W_GC = W_IN + (size_t)NWIN * 1024 * 2, W_OC = W_GC + 2 * MiB,
                 W_GA = W_OC + 2 * MiB, W_OA = W_GA + 2 * MiB, W_M = W_OA + 2 * MiB, W_GU2 = W_M + 2 * MiB, W_D2 = W_GU2 + (size_t)5632 * 1024 * 2, W_END = W_D2 + (size_t)1024 * 2816 * 2;
constexpr size_t WBUF = 56 * MiB;
constexpr size_t WS_HB = 120 * MiB;
constexpr size_t ROWB = (size_t)TPAD * 1024 * 2;
constexpr size_t WS_BIG = WS_HB + 98 * MiB;
constexpr size_t WS_Q = WS_BIG, WS_K = WS_Q + ROWB, WS_V = WS_K + ROWB / 4, WS_CB = WS_V + ROWB / 4, WS_Z = WS_CB + ROWB, WS_END = WS_Z + ROWB;
constexpr size_t WS_HID = WS_BIG;
constexpr size_t WS_SCR = WS_K;
static_assert((CW_BAR + 3456) * 4 <= (int)WS_ROPE && WS_ROPE + (size_t)LP * 64 * 4 <= WS_HMETA && WS_HMETA + (size_t)20 * 16 * 1024 * 4 <= WS_SSQ && WS_SSQ + (size_t)TPAD * 16 * 4 <= WS_W, "d_ws map (small regions)");
static_assert(W_END <= 56 * MiB && ROWB <= 98 * MiB && (size_t)TPAD * FF * 2 <= WS_END - WS_BIG && 256 * 131072 <= ROWB / 2, "d_ws map");

constexpr int RING_BYTES = 131072, MISC_OFF = RING_BYTES + 320, PTAB_OFF = RING_BYTES + 1024, LDS_BYTES = 147456;
constexpr int NWAVES = 8;

#define GAS __attribute__((address_space(1)))
#define LAS __attribute__((address_space(3)))
typedef unsigned short bf16;
typedef unsigned v4u __attribute__((ext_vector_type(4)));
typedef float f32x4 __attribute__((ext_vector_type(4)));
__device__ __forceinline__ unsigned f2bf(float f) { unsigned u = __builtin_bit_cast(unsigned, f); return (u + 0x7fffu + ((u >> 16) & 1u)) >> 16; }
__device__ __forceinline__ unsigned pk2(float lo, float hi) { return pg8::cvt_pk_bf16(lo, hi); }
__device__ __forceinline__ float bflo(unsigned u) { return __builtin_bit_cast(float, u << 16); }
__device__ __forceinline__ float bfhi(unsigned u) { return __builtin_bit_cast(float, u & 0xffff0000u); }
__device__ __forceinline__ float wave_sum(float v) {
#pragma unroll
    for (int o = 1; o < 64; o <<= 1) v += __shfl_xor(v, o);
    return v;
}
__device__ __forceinline__ void rowinfo(int r, int& pos, int& L) {
    if (r < ROWS_P) { L = LP; pos = r % LP; } else if (r < T_ROWS) { L = LS; pos = (r - ROWS_P) % LS; } else { L = 1 << 30; pos = 0; }
}
__device__ __forceinline__ float sigmoidf_(float x) { return __builtin_amdgcn_rcpf(1.0f + __builtin_amdgcn_exp2f(-1.4426950408889634f * x)); }

struct PlainOrder : pg8::StaticOrder {
    const char* A; const char* Bt; size_t tstep;
    __device__ __forceinline__ const char* aptr(const pg8::Unit& u) const { return A + (size_t)u.pm * tstep; }
    __device__ __forceinline__ const char* bptr(const pg8::Unit& u) const { return Bt + (size_t)u.pn * tstep; }
};
struct ChainOrder {
    pg8::StaticOrder base; const char* A[4]; const char* B[4]; size_t tstep;
    __device__ __forceinline__ bool next(int i, pg8::Unit& u) const { if (!base.next(i >> 2, u)) return false; u.sub = i & 3; return true; }
    __device__ __forceinline__ const char* aptr(const pg8::Unit& u) const { const char* p = u.sub == 0 ? A[0] : u.sub == 1 ? A[1] : u.sub == 2 ? A[2] : A[3]; return p + (size_t)u.pm * tstep; }
    __device__ __forceinline__ const char* bptr(const pg8::Unit& u) const { const char* p = u.sub == 0 ? B[0] : u.sub == 1 ? B[1] : u.sub == 2 ? B[2] : B[3]; return p + (size_t)u.pn * tstep; }
    __device__ __forceinline__ void a_ready(const pg8::Unit&) const {}
    __device__ __forceinline__ void done(const pg8::Unit&) const {}
};

using pg8::f32x4; using pg8::u32x4; using pg8::Unit; using pg8::bf16_t;
typedef f32x4 Acc[2][2][4][2];
__device__ __forceinline__ u32x4 pack8(const f32x4 a, const f32x4 b) { u32x4 w; w.x = pk2(a[0], a[1]); w.y = pk2(a[2], a[3]); w.z = pk2(b[0], b[1]); w.w = pk2(b[2], b[3]); return w; }
__device__ __forceinline__ void unpack8(const u32x4 w, f32x4& a, f32x4& b) { a = (f32x4){bflo(w.x), bfhi(w.x), bflo(w.y), bfhi(w.y)}; b = (f32x4){bflo(w.z), bfhi(w.z), bflo(w.w), bfhi(w.w)}; }
__device__ __forceinline__ float rstd_of(const float* ssq, int row) { const f32x4* p = (const f32x4*)(ssq + (size_t)row * 16); const f32x4 a = p[0], b = p[1], c = p[2], d = p[3];
    const float s = (((a[0] + a[1]) + (a[2] + a[3])) + ((b[0] + b[1]) + (b[2] + b[3]))) + (((c[0] + c[1]) + (c[2] + c[3])) + ((d[0] + d[1]) + (d[2] + d[3])));
    return __builtin_amdgcn_rsqf(s * (1.0f / DM) + NORM_EPS); }

struct EpiSwiGLU {
    static constexpr bool PERM = true, AFTER_DRAIN = false;
    bf16_t* hid; const float* ssq;
    __device__ __forceinline__ void operator()(const Acc& acc, const Unit& u, int wr, int wc, int fr, int fq) const {
#pragma unroll
        for (int ai = 0; ai < 2; ++ai)
#pragma unroll
            for (int m = 0; m < 4; ++m) {
                const int row = u.pm * 256 + ai * 128 + wr * 64 + m * 16 + fr; const float rs = rstd_of(ssq, row);
                f32x4 o[2];
#pragma unroll
                for (int n = 0; n < 2; ++n)
#pragma unroll
                    for (int e = 0; e < 4; ++e) { const float g = acc[ai][0][m][n][e] * rs, up = acc[ai][1][m][n][e] * rs; o[n][e] = g * sigmoidf_(g) * up; }
                *(u32x4*)(hid + (size_t)row * FF + u.pn * 128 + wc * 32 + 8 * fq) = pack8(o[0], o[1]);
            }
    }
};
struct EpiResid {
    static constexpr bool PERM = true, AFTER_DRAIN = false;
    bf16_t* hb; float* ssq_out; float scale;
    __device__ __forceinline__ void operator()(const Acc& acc, const Unit& u, int wr, int wc, int fr, int fq) const {
#pragma unroll
        for (int ai = 0; ai < 2; ++ai)
#pragma unroll
            for (int m = 0; m < 4; ++m) {
                const int row = u.pm * 256 + ai * 128 + wr * 64 + m * 16 + fr; const bool ok = row < T_ROWS;
                float ss = 0.f;
                if (ok) {
                    bf16_t* bp = hb + (size_t)row * DM + u.pn * 256 + wc * 32 + 8 * fq;
#pragma unroll
                    for (int bj = 0; bj < 2; ++bj) {
                        f32x4 a, b; unpack8(*(const u32x4*)(bp + bj * 128), a, b);
                        a = a + acc[ai][bj][m][0] * scale; b = b + acc[ai][bj][m][1] * scale;
                        const u32x4 w = pack8(a, b); *(u32x4*)(bp + bj * 128) = w;
                        unpack8(w, a, b);
                        ss += (a[0] * a[0] + a[1] * a[1]) + (a[2] * a[2] + a[3] * a[3]) + (b[0] * b[0] + b[1] * b[1]) + (b[2] * b[2] + b[3] * b[3]);
                    }
                }
                ss += __shfl_xor(ss, 16); ss += __shfl_xor(ss, 32);
                if (ok && fq == 0) ssq_out[(size_t)row * 16 + u.pn * 4 + wc] = ss;
                if (m & 1) asm volatile("" ::: "memory");
            }
    }
};
struct EpiWin {
    static constexpr bool PERM = true, AFTER_DRAIN = false;
    bf16_t *q, *k, *v, *cb, *z; const float* ssq; const float* rope; const float* qg; const float* kg;
    __device__ __forceinline__ void operator()(const Acc& acc, const Unit& u, int wr, int wc, int fr, int fq) const {
        const int pn = u.pn;
        if (pn <= 4) {
            const float* g = pn < 4 ? qg : kg; const float osc = pn < 4 ? QSCALE : 1.0f;
            f32x4 G[2][2];
#pragma unroll
            for (int bj = 0; bj < 2; ++bj)
#pragma unroll
                for (int n = 0; n < 2; ++n) G[bj][n] = *(const f32x4*)(g + 32 * bj + 16 * n + 4 * fq) * osc;
#pragma unroll
            for (int ai = 0; ai < 2; ++ai)
#pragma unroll
                for (int m = 0; m < 4; ++m) {
                    const int row = u.pm * 256 + ai * 128 + wr * 64 + m * 16 + fr; const float rs = rstd_of(ssq, row);
                    int pos, L; rowinfo(row, pos, L);
                    f32x4 x[2][2]; float ss = 0.f;
#pragma unroll
                    for (int bj = 0; bj < 2; ++bj)
#pragma unroll
                        for (int n = 0; n < 2; ++n) { x[bj][n] = acc[ai][bj][m][n] * rs; const f32x4 t = x[bj][n] * x[bj][n]; ss += (t[0] + t[1]) + (t[2] + t[3]); }
                    ss += __shfl_xor(ss, 16); ss += __shfl_xor(ss, 32);
                    const float rn = __builtin_amdgcn_rsqf(ss * (1.0f / 64.0f) + NORM_EPS);
                    bf16_t* dst = pn < 4 ? q + (size_t)row * 1024 + (4 * pn + wc) * 64 + 8 * fq : k + (size_t)row * 256 + wc * 64 + 8 * fq;
#pragma unroll
                    for (int bj = 0; bj < 2; ++bj) {
                        const f32x4 c4 = *(const f32x4*)(rope + ((pos * 2 + bj) * 2 + 0) * 16 + 4 * fq), s4 = *(const f32x4*)(rope + ((pos * 2 + bj) * 2 + 1) * 16 + 4 * fq);
                        const f32x4 y1 = x[bj][0] * rn * G[bj][0], y2 = x[bj][1] * rn * G[bj][1];
                        const f32x4 o1 = y1 * c4 - y2 * s4, o2 = y2 * c4 + y1 * s4;
                        *(u32x4*)(dst + 32 * bj) = pack8(o1, o2);
                    }
                    if (m & 1) asm volatile("" ::: "memory");
                }
        } else if (pn < 10) {
            bf16_t* base; int pitch, c0;
            if (pn == 5) { base = v; pitch = 256; c0 = 0; } else { base = cb; pitch = 1024; c0 = 256 * (pn - 6); }
#pragma unroll
            for (int ai = 0; ai < 2; ++ai)
#pragma unroll
                for (int m = 0; m < 4; ++m) {
                    const int row = u.pm * 256 + ai * 128 + wr * 64 + m * 16 + fr; const float rs = rstd_of(ssq, row);
#pragma unroll
                    for (int bj = 0; bj < 2; ++bj) *(u32x4*)(base + (size_t)row * pitch + c0 + 128 * bj + wc * 32 + 8 * fq) = pack8(acc[ai][bj][m][0] * rs, acc[ai][bj][m][1] * rs);
                }
        } else {
#pragma unroll
            for (int ai = 0; ai < 2; ++ai)
#pragma unroll
                for (int m = 0; m < 4; ++m) {
                    const int row = u.pm * 256 + ai * 128 + wr * 64 + m * 16 + fr; const float rs = rstd_of(ssq, row), rs2 = rs * rs;
                    *(u32x4*)(z + (size_t)row * 1024 + 128 * (pn - 10) + wc * 32 + 8 * fq) = pack8(acc[ai][0][m][0] * acc[ai][1][m][0] * rs2, acc[ai][0][m][1] * acc[ai][1][m][1] * rs2);
                }
        }
    }
};
struct EpiMerge {
    static constexpr bool PERM = true, AFTER_DRAIN = false;
    bf16_t* merged; u32x4* scr; const float* ssq; int tid;
    __device__ __forceinline__ void operator()(const Acc& acc, const Unit& u, int wr, int wc, int fr, int fq) const {
        const int sub = u.sub;
#pragma unroll
        for (int ai = 0; ai < 2; ++ai)
#pragma unroll
            for (int m = 0; m < 4; ++m) {
                const int row = u.pm * 256 + ai * 128 + wr * 64 + m * 16 + fr;
                float rs = 1.f; if ((sub & 1) == 0) rs = rstd_of(ssq, row);
#pragma unroll
                for (int bj = 0; bj < 2; ++bj) {
                    u32x4* mp = (u32x4*)(merged + (size_t)row * DM + u.pn * 256 + bj * 128 + wc * 32 + 8 * fq);
                    u32x4* sp = scr + ((ai * 4 + m) * 2 + bj) * 512 + tid;
                    const f32x4 v0 = acc[ai][bj][m][0], v1 = acc[ai][bj][m][1];
                    if ((sub & 1) == 0) {
                        f32x4 s0, s1;
#pragma unroll
                        for (int e = 0; e < 4; ++e) { s0[e] = sigmoidf_(v0[e] * rs); s1[e] = sigmoidf_(v1[e] * rs); }
                        if (sub == 0) *mp = pack8(s0, s1); else *sp = pack8(s0, s1);
                    } else if (sub == 1) {
                        f32x4 g0, g1; unpack8(*mp, g0, g1); *mp = pack8(g0 * v0, g1 * v1);
                    } else {
                        f32x4 c0, c1, s0, s1; unpack8(*mp, c0, c1); unpack8(*sp, s0, s1); *mp = pack8(c0 + s0 * v0, c1 + s1 * v1);
                    }
                }
                if (m & 1) asm volatile("" ::: "memory");
            }
    }
};

__device__ __forceinline__ void cvt_item(const float* W, int Nsrc, int n0src, const float* gain, bool permqk, bf16* WT, int K, int nrow0, int k0, LAS float* scr, int lane) {
#pragma unroll 8
    for (int i = 0; i < 32; ++i) { const int kk = 2 * i + (lane >> 5); float w = W[(size_t)(k0 + kk) * Nsrc + n0src + (lane & 31)]; if (gain) w *= gain[k0 + kk]; scr[kk * 33 + (lane & 31)] = w; }
    asm volatile("s_waitcnt lgkmcnt(0)" ::: "memory");
    const int c = lane & 7;
#pragma unroll
    for (int j = 0; j < 4; ++j) { const int n = (lane >> 3) + 8 * j; const int ns = permqk ? (16 * ((n >> 2) & 1) + 4 * (n >> 3) + (n & 3)) : n; const LAS float* s = scr + (8 * c) * 33 + ns;
        v4u o; o.x = pk2(s[0 * 33], s[1 * 33]); o.y = pk2(s[2 * 33], s[3 * 33]); o.z = pk2(s[4 * 33], s[5 * 33]); o.w = pk2(s[6 * 33], s[7 * 33]);
        *(GAS v4u*)(WT + (size_t)(nrow0 + n) * K + k0 + 8 * c) = o; }
    asm volatile("s_waitcnt lgkmcnt(0)" ::: "memory");
}
#define RLX_AGENT __ATOMIC_RELAXED, __HIP_MEMORY_SCOPE_AGENT
#define XB_TMO      128
#define XB_XCNT(j)  (256  + 64 * (j))
#define XB_XSUB(j)  (1280 + 64 * (j))
#define XB_XGEN(j)  (2304 + 64 * (j))
#define XB_TOP      3328
#define XB_TOPGEN   3392
#define XCD_BAR_WORDS 3456
#define XB_SPIN_CAP (1u << 18)

__device__ __forceinline__ unsigned xb_ld(unsigned* p)              { return __hip_atomic_load(p, __ATOMIC_RELAXED, __HIP_MEMORY_SCOPE_AGENT); }
__device__ __forceinline__ unsigned xb_add(unsigned* p, unsigned v) { return __hip_atomic_fetch_add(p, v, __ATOMIC_RELAXED, __HIP_MEMORY_SCOPE_AGENT); }
__device__ __forceinline__ unsigned xb_xcc_id() { return (unsigned)__builtin_amdgcn_s_getreg((3 << 11) | 20) & 0xFu; }
#define XB_SPIN(cond, bar) do { unsigned _sp = 0; while (cond) { __builtin_amdgcn_s_sleep(1); \
    if ((++_sp & 255u) == 0u) { if (xb_ld(&(bar)[XB_TMO])) break; if (_sp > XB_SPIN_CAP) { atomicAdd(&(bar)[XB_TMO], 1u); break; } } } } while (0)

struct XcdBarrier {
    unsigned* bar; unsigned x;
    volatile LAS unsigned* st;
};

__device__ __forceinline__ XcdBarrier xcd_barrier_post(unsigned* bar, volatile LAS unsigned* st) {
    XcdBarrier b; b.bar = bar; b.x = xb_xcc_id(); b.st = st;
    if (threadIdx.x == 0) (void)xb_add(&bar[XB_XCNT(b.x)], 1u);
    return b;
}
__device__ __forceinline__ void xcd_barrier_complete(unsigned* bar, unsigned x, unsigned& nloc, unsigned& nx) {
    const unsigned G = gridDim.x * gridDim.y * gridDim.z;
    unsigned sum, cnt, mine, sp = 0u;
    for (;;) {
        sum = 0u; cnt = 0u; mine = 0u;
#pragma unroll
        for (unsigned j = 0; j < 16; ++j) { const unsigned c = xb_ld(&bar[XB_XCNT(j)]); sum += c; cnt += (c > 0u) ? 1u : 0u; mine = (j == x) ? c : mine; }
        if (sum == G) break;
        __builtin_amdgcn_s_sleep(1);
        if ((++sp & 255u) == 0u) { if (xb_ld(&bar[XB_TMO])) break; if (sp > XB_SPIN_CAP) { atomicAdd(&bar[XB_TMO], 1u); break; } }
    }
    nloc = mine > 0u ? mine : 1u; nx = cnt > 0u ? cnt : 1u;
}

__device__ __forceinline__ void xcd_barrier(const XcdBarrier& b) {
    asm volatile("s_waitcnt vmcnt(0)" ::: "memory");
    __syncthreads();
    if (threadIdx.x == 0) {
        unsigned* bar = b.bar;
        __builtin_amdgcn_s_waitcnt(0);
        unsigned nloc = b.st[0], nx = b.st[1];
        if (nloc == 0u) { xcd_barrier_complete(bar, b.x, nloc, nx); b.st[0] = nloc; b.st[1] = nx; }
        const unsigned old = xb_add(&bar[XB_XSUB(b.x)], 1u);
        const unsigned gen = old / nloc;
        if (old + 1u == (gen + 1u) * nloc) {
            __builtin_amdgcn_fence(__ATOMIC_RELEASE, "agent");
            asm volatile("s_waitcnt vmcnt(0)" ::: "memory");
            const unsigned og = xb_add(&bar[XB_TOP], 1u);
            const unsigned tg = og / nx;
            if (og + 1u == (tg + 1u) * nx) xb_add(&bar[XB_TOPGEN], 1u);
            else XB_SPIN(xb_ld(&bar[XB_TOPGEN]) == tg, bar);
            __builtin_amdgcn_fence(__ATOMIC_ACQUIRE, "agent");
            xb_add(&bar[XB_XGEN(b.x)], 1u);
            asm volatile("s_waitcnt vmcnt(0)" ::: "memory");
        } else {
            XB_SPIN(xb_ld(&bar[XB_XGEN(b.x)]) == gen, bar);
            __builtin_amdgcn_fence(__ATOMIC_ACQUIRE, "agent");
            asm volatile("s_waitcnt vmcnt(0)" ::: "memory");
        }
    }
    __syncthreads();
}
struct Args { const float* in[21]; float* out; unsigned char* ws; int ph_lo, ph_hi; };
struct PT {
    volatile LAS unsigned long long* t;
    __device__ __forceinline__ unsigned long long get(int i) const { const unsigned long long v = t[i]; const unsigned lo = __builtin_amdgcn_readfirstlane((unsigned)v), hi = __builtin_amdgcn_readfirstlane((unsigned)(v >> 32)); return ((unsigned long long)hi << 32) | lo; }
    __device__ __forceinline__ const float* in(int i) const { return (const float*)(const GAS float*)get(i); }
    __device__ __forceinline__ float* out() const { return (float*)(GAS float*)get(21); }
    __device__ __forceinline__ unsigned char* ws() const { return (unsigned char*)(GAS unsigned char*)get(22); }
};

__device__ __forceinline__ void cvt_one(const PT a, unsigned char* ws, int l, LAS unsigned char* lds, int it, int wave, int lane) {
    LAS float* scr = (LAS float*)(lds + wave * 16384);
    bf16* W = (bf16*)(ws + WS_W + (size_t)(l & 1) * WBUF);
    const size_t ffo = (size_t)l * DM * FF, sqo = (size_t)l * DM * DM;
    const float* win = a.in(8) + (size_t)l * DM * 6656; const float* mixg = a.in(7) + l * DM;
    {
        int r = it;
        if (r < 2816) { const int kb = r / 176, nb = r % 176, pn = nb >> 3, t = nb & 7; const float* src = (t >> 2) ? a.in(5) + ffo : a.in(4) + ffo;
            cvt_item(src, FF, 128 * pn + 32 * (t & 3), a.in(3) + l * DM, false, (bf16*)((char*)W + W_GU1), 1024, nb * 32, kb * 64, scr, lane); return; } r -= 2816;
        if (r < 1408) { const int kb = r / 32, nb = r % 32; cvt_item(a.in(6) + ffo, DM, nb * 32, nullptr, false, (bf16*)((char*)W + W_D1), FF, nb * 32, kb * 64, scr, lane); return; } r -= 1408;
        if (r < 2304) { const int kb = r / 144, nb = r % 144, pn = nb >> 3, t = nb & 7; int n0; bool pq = false;
            if (pn < 4) { n0 = 64 * (4 * pn + (t & 3)) + 32 * (t >> 2); pq = true; }
            else if (pn == 4) { n0 = 1024 + 64 * (t & 3) + 32 * (t >> 2); pq = true; }
            else if (pn == 5) n0 = 1280 + 32 * t;
            else if (pn < 10) n0 = 1536 + 256 * (pn - 6) + 32 * t;
            else n0 = ((t >> 2) ? 3584 : 2560) + 128 * (pn - 10) + 32 * (t & 3);
            cvt_item(win, 6656, n0, mixg, pq, (bf16*)((char*)W + W_IN), 1024, nb * 32, kb * 64, scr, lane); return; } r -= 2304;
        if (r < 2560) { const int seg = r / 512, q = r % 512, kb = q / 32, nb = q % 32;
            const float* src; int ns, n0; const float* gn = nullptr; size_t dst;
            if (seg == 0) { src = win; ns = 6656; n0 = 5632 + nb * 32; gn = mixg; dst = W_GC; }
            else if (seg == 1) { src = a.in(14) + sqo; ns = DM; n0 = nb * 32; dst = W_OC; }
            else if (seg == 2) { src = win; ns = 6656; n0 = 4608 + nb * 32; gn = mixg; dst = W_GA; }
            else if (seg == 3) { src = a.in(13) + sqo; ns = DM; n0 = nb * 32; dst = W_OA; }
            else { src = a.in(15) + sqo; ns = DM; n0 = nb * 32; dst = W_M; }
            cvt_item(src, ns, n0, gn, false, (bf16*)((char*)W + dst), 1024, nb * 32, kb * 64, scr, lane); return; } r -= 2560;
        if (r < 2816) { const int kb = r / 176, nb = r % 176, pn = nb >> 3, t = nb & 7; const float* src = (t >> 2) ? a.in(18) + ffo : a.in(17) + ffo;
            cvt_item(src, FF, 128 * pn + 32 * (t & 3), a.in(16) + l * DM, false, (bf16*)((char*)W + W_GU2), 1024, nb * 32, kb * 64, scr, lane); return; } r -= 2816;
        { const int kb = r / 32, nb = r % 32; cvt_item(a.in(19) + ffo, DM, nb * 32, nullptr, false, (bf16*)((char*)W + W_D2), FF, nb * 32, kb * 64, scr, lane); }
    }
}

constexpr int CVT_ITEMS = 13312;
__device__ __forceinline__ void convert_static(const PT a, unsigned char* ws, int l, LAS unsigned char* lds, int gw, int NGW, int wave, int lane) {
    for (int it = gw; it < CVT_ITEMS; it += NGW) cvt_one(a, ws, l, lds, it, wave, lane);
}
__device__ __forceinline__ void convert_dynamic(const PT a, unsigned char* ws, int l, LAS unsigned char* lds, unsigned* ctr, int lo, int hi, int wave, int lane) {
    for (;;) {
        unsigned b = 0; if (lane == 0) b = atomicAdd(ctr, 4u);
        const int base = lo + (int)__builtin_amdgcn_readfirstlane(b);
        if (base >= hi) break;
        for (int k = 0; k < 4; ++k) { if (base + k < hi) cvt_one(a, ws, l, lds, base + k, wave, lane); }
    }
}
__device__ __forceinline__ void prologue(const PT a, unsigned char* ws, int tid, int wave, int lane, int bid, int G) {
    const int gtid = bid * 512 + tid, GT = G * 512, gw = bid * NWAVES + wave, NGW = G * NWAVES;
    float* ssq = (float*)(ws + WS_SSQ); bf16* hb = (bf16*)(ws + WS_HB); float* rope = (float*)(ws + WS_ROPE);
    for (int i = gtid; i < (TPAD - T_ROWS) * 16; i += GT) ssq[(size_t)T_ROWS * 16 + i] = 0.f;
    for (int i = gtid; i < (TPAD - T_ROWS) * DM / 8; i += GT) ((v4u*)(hb + (size_t)T_ROWS * DM))[i] = (v4u){0u, 0u, 0u, 0u};
    if (gtid < 64) ((unsigned*)(ws + WS_CTL))[gtid] = 0u;
    for (int i = gtid; i < LP * 32; i += GT) {
        const int pos = i >> 5, axis = (i >> 4) & 1, f = i & 15;
        float coord; if (pos < 16) coord = axis ? (float)pos : -1.0f; else { const int t = pos - 16; coord = axis ? (float)(t & 63) : (float)(t >> 6); }
        const float inv = powf(10000.0f, -(float)f * (1.0f / 16.0f)); const float ang = coord * inv;
        float s, c; sincosf(ang, &s, &c);
        rope[((pos * 2 + axis) * 2 + 0) * 16 + f] = c; rope[((pos * 2 + axis) * 2 + 1) * 16 + f] = s;
    }
    for (int r = gw; r < T_ROWS; r += NGW) {
        int pos, L; rowinfo(r, pos, L);
        const float* src;
        if (pos < 16) src = a.in(2) + (size_t)pos * DM;
        else if (r < ROWS_P) src = a.in(0) + ((size_t)(r / LP) * 4096 + pos - 16) * DM;
        else src = a.in(1) + ((size_t)((r - ROWS_P) / LS) * 2048 + pos - 16) * DM;
        f32x4 v[4]; float s = 0.f;
        unsigned long long* o8 = (unsigned long long*)(hb + (size_t)r * DM) + lane;
#pragma unroll
        for (int j = 0; j < 4; ++j) { v[j] = ((const f32x4*)src)[lane + 64 * j];
            const unsigned lo = pk2(v[j][0], v[j][1]), hi = pk2(v[j][2], v[j][3]); o8[64 * j] = (unsigned long long)lo | ((unsigned long long)hi << 32);
            const float a0 = bflo(lo), a1 = bfhi(lo), a2 = bflo(hi), a3 = bfhi(hi); s += (a0 * a0 + a1 * a1) + (a2 * a2 + a3 * a3); }
        s = wave_sum(s);
        if (lane < 16) ssq[(size_t)r * 16 + lane] = lane == 0 ? s : 0.f;
    }
}

__device__ __forceinline__ void conv_phase(const PT a, unsigned char* ws, int l, int tid, int bid, int G) {
    bf16* cb = (bf16*)(ws + WS_CB); const bf16* z = (const bf16*)(ws + WS_Z);
    const float* cw = a.in(9) + (size_t)l * 3 * DM; const float* cbias = a.in(10) + (size_t)l * DM;
    const int chunk = tid & 127, sub = tid >> 7, c0 = chunk * 8;
    f32x4 w0[2], w1[2], w2[2], bb[2];
#pragma unroll
    for (int h = 0; h < 2; ++h) { w0[h] = *(const f32x4*)(cw + c0 + 4 * h); w1[h] = *(const f32x4*)(cw + DM + c0 + 4 * h); w2[h] = *(const f32x4*)(cw + 2 * DM + c0 + 4 * h); bb[h] = *(const f32x4*)(cbias + c0 + 4 * h); }
    const int nstrip = (T_ROWS + 63) / 64;
    for (int strip = bid; strip < nstrip; strip += G) {
        const int r0 = strip * 64 + sub * 16;
#pragma unroll 4
        for (int i = 0; i < 16; ++i) {
            const int r = r0 + i; if (r >= T_ROWS) break;
            int pos, L; rowinfo(r, pos, L);
            const u32x4 zero = (u32x4){0u, 0u, 0u, 0u};
            const u32x4 zc = *(const u32x4*)(z + (size_t)r * DM + c0);
            const u32x4 zp = pos > 0 ? *(const u32x4*)(z + (size_t)(r - 1) * DM + c0) : zero;
            const u32x4 zn = pos < L - 1 ? *(const u32x4*)(z + (size_t)(r + 1) * DM + c0) : zero;
            u32x4* cp = (u32x4*)(cb + (size_t)r * DM + c0); const u32x4 cv = *cp;
            f32x4 p0, p1, c0v, c1v, n0, n1, b0, b1; unpack8(zp, p0, p1); unpack8(zc, c0v, c1v); unpack8(zn, n0, n1); unpack8(cv, b0, b1);
            const f32x4 o0 = b0 * (w0[0] * p0 + w1[0] * c0v + w2[0] * n0 + bb[0]), o1 = b1 * (w0[1] * p1 + w1[1] * c1v + w2[1] * n1 + bb[1]);
            *cp = pack8(o0, o1);
        }
    }
}

__device__ __forceinline__ void attention_phase(const PT a, unsigned char* ws, int l, unsigned char* lds_generic, int tid, bool dry = false) {
    using abf = attn_body::bf16;
    const abf* Q = (const abf*)(ws + WS_Q); const abf* K = (const abf*)(ws + WS_K); const abf* V = (const abf*)(ws + WS_V); abf* O = dry ? (abf*)(ws + WS_END + MiB) : (abf*)(ws + WS_Q);
    unsigned* ctr = (unsigned*)(ws + WS_CTL) + l + (dry ? 8 : 0);
    volatile unsigned* slot = (volatile unsigned*)(lds_generic + MISC_OFF);
    for (;;) {
        if (tid == 0) *slot = atomicAdd(ctr, 1u);
        __syncthreads();
        const int u = (int)__builtin_amdgcn_readfirstlane(*slot);
        if (u >= ATT_UNITS) break;
        int tidu = tid; asm volatile("" : "+v"(tidu));
        if (u < ATT_UNITS_P) { const int s = u / 260, rem = u - s * 260, kvh = rem / 65, qblk = rem - kvh * 65;
            attn_body::attn_unit<8, LP, 66>((long)s * LP, kvh, qblk, Q, K, V, O, (char*)lds_generic, tidu); }
        else { const int u2 = u - ATT_UNITS_P, s = u2 / 132, rem = u2 - s * 132, kvh = rem / 33, qblk = rem - kvh * 33;
            attn_body::attn_unit<8, LS, 34>((long)ROWS_P + (long)s * LS, kvh, qblk, Q, K, V, O, (char*)lds_generic, tidu); }
    }
}

__device__ __forceinline__ void final_phase(const PT a, unsigned char* ws, int wave, int lane, int bid, int G) {
    const int gw = bid * NWAVES + wave, NGW = G * NWAVES;
    const float* ssq = (const float*)(ws + WS_SSQ); const bf16* hb = (const bf16*)(ws + WS_HB); float* out = a.out();
    f32x4 g[4];
#pragma unroll
    for (int j = 0; j < 4; ++j) g[j] = ((const f32x4*)a.in(20))[lane + 64 * j];
    for (int r = gw; r < T_ROWS; r += NGW) {
        int pos, L; rowinfo(r, pos, L); if (pos < 16) continue;
        float* p = r < ROWS_P ? out + ((size_t)(r / LP) * 4096 + pos - 16) * DM : out + (size_t)NSEQ_P * 4096 * DM + ((size_t)((r - ROWS_P) / LS) * 2048 + pos - 16) * DM;
        const float rs = rstd_of(ssq, r);
        const unsigned long long* i8 = (const unsigned long long*)(hb + (size_t)r * DM) + lane;
#pragma unroll
        for (int j = 0; j < 4; ++j) { const unsigned long long w = i8[64 * j]; const unsigned lo = (unsigned)w, hi = (unsigned)(w >> 32);
            const f32x4 v = (f32x4){bflo(lo), bfhi(lo), bflo(hi), bfhi(hi)}; ((f32x4*)p)[lane + 64 * j] = v * rs * g[j]; }
    }
}

constexpr int NSTEPS = 2 + 8 * NLAYER;

template <int STEP>
__device__ __forceinline__ void run_step(const PT pt, unsigned char* lds, cg::grid_group& grid, XcdBarrier& bar, const int ph_lo, const int ph_hi) {
#ifdef MAX_STEP
    if (STEP >= MAX_STEP && STEP != NSTEPS - 1) return;
#endif
    if (STEP < ph_lo || STEP >= ph_hi) return;
    if (STEP > ph_lo) {
        if (STEP == ph_lo + 1) {
            asm volatile("s_waitcnt vmcnt(0)" ::: "memory"); grid.sync();
            bar = xcd_barrier_post((unsigned*)(pt.ws() + WS_CTL) + CW_BAR, (volatile LAS unsigned*)((LAS unsigned char*)lds + MISC_OFF + 32));
        } else xcd_barrier(bar);
#ifdef DUP_SYNC
        xcd_barrier(bar); xcd_barrier(bar);
#endif
    }
    LAS unsigned char* l3 = (LAS unsigned char*)lds;
    int tid = threadIdx.x; asm volatile("" : "+v"(tid));
    int bid = blockIdx.x; asm volatile("" : "+s"(bid));
    int G = gridDim.x; asm volatile("" : "+s"(G));
    unsigned char* ws = pt.ws();
    const int lane = tid & 63, wave = __builtin_amdgcn_readfirstlane(tid >> 6);
    const int gw = bid * NWAVES + wave, NGW = G * NWAVES;
    float* ssq = (float*)(ws + WS_SSQ);
    bf16_t* hb = (bf16_t*)(ws + WS_HB);
    if constexpr (STEP == 0) { prologue(pt, ws, tid, wave, lane, bid, G); convert_static(pt, ws, 0, l3, gw, NGW, wave, lane); __syncthreads(); }
    else if constexpr (STEP == NSTEPS - 1) { final_phase(pt, ws, wave, lane, bid, G); }
    else {
        constexpr int l = (STEP - 1) / 8, ph = (STEP - 1) % 8 + 1;
        unsigned char* wl = ws + WS_W + (size_t)(l & 1) * WBUF;
        if constexpr (ph == 0) {
        } else if constexpr (ph == 1 || ph == 7) {
            constexpr int f = ph == 7;
            PlainOrder S; S.init(TPAD, 2 * FF, G, bid); S.A = (const char*)hb; S.Bt = (const char*)(wl + (f ? W_GU2 : W_GU1)); S.tstep = (size_t)256 * 1024 * 2;
            pg8::Gemm g{nullptr, nullptr, TPAD, 2 * FF, 1024};
            EpiSwiGLU E{(bf16_t*)(ws + WS_HID), ssq};
#ifndef NO_GU
            pg8::gemm_phase<EpiSwiGLU, PlainOrder, true, true>(l3, g, S, E, tid);
#ifdef DUP_GU
            __syncthreads();
            pg8::gemm_phase<EpiSwiGLU, PlainOrder, true, true>(l3, g, S, E, tid);
#endif
#endif
        } else if constexpr (ph == 2 || ph == 6 || ph == 8) {
            constexpr int f = ph == 8; constexpr int K = ph == 6 ? 1024 : FF;
            PlainOrder S; S.init(TPAD, DM, G, bid);
            S.A = ph == 6 ? (const char*)(ws + WS_Z) : (const char*)(ws + WS_HID);
            S.Bt = (const char*)(wl + (ph == 6 ? W_M : (f ? W_D2 : W_D1))); S.tstep = (size_t)256 * K * 2;
            pg8::Gemm g{nullptr, nullptr, TPAD, DM, K};
            EpiResid E{hb, ssq, ph == 6 ? 1.0f : 0.5f};
#ifndef NO_RES
            pg8::gemm_phase<EpiResid, PlainOrder, true, true>(l3, g, S, E, tid);
#endif
            if constexpr (l + 1 < NLAYER) {
                constexpr int part = ph == 2 ? 0 : (ph == 6 ? 1 : 2); constexpr int lo = part * (CVT_ITEMS / 3), hi = part == 2 ? CVT_ITEMS : (part + 1) * (CVT_ITEMS / 3);
                convert_dynamic(pt, ws, l + 1, l3, (unsigned*)(ws + WS_CTL) + 16 + 4 * l + part, lo, hi, wave, lane);
                __syncthreads();
            }
        } else if constexpr (ph == 3) {
            PlainOrder S; S.init(TPAD, NWIN, G, bid); S.A = (const char*)hb; S.Bt = (const char*)(wl + W_IN); S.tstep = (size_t)256 * 1024 * 2;
            pg8::Gemm g{nullptr, nullptr, TPAD, NWIN, 1024};
            EpiWin E{(bf16_t*)(ws + WS_Q), (bf16_t*)(ws + WS_K), (bf16_t*)(ws + WS_V), (bf16_t*)(ws + WS_CB), (bf16_t*)(ws + WS_Z), ssq,
                     (const float*)(ws + WS_ROPE), pt.in(11) + l * 64, pt.in(12) + l * 64};
#ifndef NO_WIN
            pg8::gemm_phase<EpiWin, PlainOrder, true, true>(l3, g, S, E, tid);
#ifdef DUP_WIN
            __syncthreads();
            pg8::gemm_phase<EpiWin, PlainOrder, true, true>(l3, g, S, E, tid);
#endif
#endif
        } else if constexpr (ph == 4) {
#ifndef NO_CONV
            conv_phase(pt, ws, l, tid, bid, G);
#endif
#ifdef DUP_ATT
            attention_phase(pt, ws, l, lds, tid, true); __syncthreads();
#endif
#ifndef NO_ATT
            attention_phase(pt, ws, l, lds, tid);
#endif
        } else {
            ChainOrder S; S.base.init(TPAD, DM, G, bid); S.tstep = (size_t)256 * 1024 * 2;
            S.A[0] = (const char*)hb; S.A[1] = (const char*)(ws + WS_CB); S.A[2] = (const char*)hb; S.A[3] = (const char*)(ws + WS_Q);
            S.B[0] = (const char*)(wl + W_GC); S.B[1] = (const char*)(wl + W_OC); S.B[2] = (const char*)(wl + W_GA); S.B[3] = (const char*)(wl + W_OA);
            pg8::Gemm g{nullptr, nullptr, TPAD, DM, 1024};
            EpiMerge E{(bf16_t*)(ws + WS_Z), (u32x4*)(ws + WS_SCR + (size_t)bid * 131072), ssq, tid};
#ifndef NO_MERGE
            pg8::gemm_phase<EpiMerge, ChainOrder, true, true>(l3, g, S, E, tid);
#ifdef DUP_MERGE
            __syncthreads();
            pg8::gemm_phase<EpiMerge, ChainOrder, true, true>(l3, g, S, E, tid);
#endif
#endif
        }
    }
}
template <int STEP>
__device__ __forceinline__ void run_from(const PT pt, unsigned char* lds, cg::grid_group& grid, XcdBarrier& bar, const int ph_lo, const int ph_hi) {
    run_step<STEP>(pt, lds, grid, bar, ph_lo, ph_hi);
    if constexpr (STEP + 1 < NSTEPS) run_from<STEP + 1>(pt, lds, grid, bar, ph_lo, ph_hi);
}

__global__ void __launch_bounds__(NWAVES * 64, 2) mega_fwd(Args args) {
    extern __shared__ __attribute__((aligned(16))) unsigned char lds[];
    cg::grid_group grid = cg::this_grid();
    PT pt; pt.t = (volatile LAS unsigned long long*)((LAS unsigned char*)lds + PTAB_OFF);
    if (threadIdx.x == 0) {
#pragma unroll
        for (int i = 0; i < 21; ++i) pt.t[i] = (unsigned long long)args.in[i];
        pt.t[21] = (unsigned long long)args.out; pt.t[22] = (unsigned long long)args.ws;
    }
    if (threadIdx.x < 8) ((volatile LAS unsigned*)((LAS unsigned char*)lds + MISC_OFF + 32))[threadIdx.x] = 0u;
    const int ph_lo = args.ph_lo, ph_hi = args.ph_hi;
    if (blockIdx.x == 0) { unsigned* bw = (unsigned*)(args.ws + WS_CTL) + CW_BAR; for (int i = threadIdx.x; i < XCD_BAR_WORDS; i += NWAVES * 64) bw[i] = 0u; }
    __syncthreads();
    XcdBarrier bar; bar.bar = nullptr; bar.x = 0; bar.st = nullptr;
    run_from<0>(pt, lds, grid, bar, ph_lo, ph_hi);
}

#ifndef LAUNCH_PER_STEP
#define LAUNCH_PER_STEP 0
#endif
extern "C" void kernel_launch(void* const* d_in, const int* in_sizes, int n_in, void* d_out, int out_size, void* d_ws, size_t ws_size, hipStream_t stream) {
    static int grid = 0;
    if (grid == 0) {
        if (n_in != 21 || ws_size < WS_END) { fprintf(stderr, "kernel_launch: need 21 inputs and >= %zu bytes of workspace; got %d, %zu\n", (size_t)WS_END, n_in, ws_size); grid = -1; return; }
        int dev = 0, cus = 0, per_cu = 0;
        hipGetDevice(&dev); hipDeviceGetAttribute(&cus, hipDeviceAttributeMultiprocessorCount, dev);
        if (hipFuncSetAttribute((const void*)mega_fwd, hipFuncAttributeMaxDynamicSharedMemorySize, LDS_BYTES) != hipSuccess) { fprintf(stderr, "kernel_launch: hipFuncSetAttribute failed\n"); grid = -1; return; }
        if (hipOccupancyMaxActiveBlocksPerMultiprocessor(&per_cu, (const void*)mega_fwd, NWAVES * 64, LDS_BYTES) != hipSuccess || per_cu < 1) per_cu = 1;
        (void)hipGetLastError();
        grid = cus * per_cu;
    }
    if (grid < 0) return;
    Args a{};
    for (int i = 0; i < 21; ++i) a.in[i] = (const float*)d_in[i];
    a.out = (float*)d_out; a.ws = (unsigned char*)d_ws;
#if LAUNCH_PER_STEP
    for (int s = 0; s < NSTEPS; ++s) { a.ph_lo = s; a.ph_hi = s + 1; void* kargs[] = {&a}; hipLaunchCooperativeKernel((void*)mega_fwd, dim3(grid), dim3(NWAVES * 64), kargs, LDS_BYTES, stream); }
#else
    a.ph_lo = 0; a.ph_hi = NSTEPS; void* kargs[] = {&a};
    hipError_t e = hipLaunchCooperativeKernel((void*)mega_fwd, dim3(grid), dim3(NWAVES * 64), kargs, LDS_BYTES, stream);
    if (e != hipSuccess) fprintf(stderr, "cooperative launch failed: %s (grid %d)\n", hipGetErrorString(e), grid);
#endif
}
```

```cpp
#include <hip/hip_runtime.h>
#include <hip/hip_cooperative_groups.h>
#include <hip/hip_bf16.h>
#include <cstdio>
#include <cstdint>
#include <cmath>
namespace cg = cooperative_groups;
namespace pg8 {
#define PG8_LAS __attribute__((address_space(3)))
typedef unsigned short bf16_t;
typedef short bf16x8 __attribute__((ext_vector_type(8)));
typedef float f32x4 __attribute__((ext_vector_type(4)));
typedef unsigned u32x4 __attribute__((ext_vector_type(4)));
constexpr int BM = 256, BK = 64, HALF = 128, HTB = HALF * BK * 2  , STAGE_BYTES = 8 * HTB, NXCD = 8, WGM = 8;

__host__ __device__ __forceinline__ int lds_byte(int r, int c) { const int st = (r >> 4) * 2 + (c >> 5), rr = r & 15, cc = c & 31, ob = rr * 64 + cc * 2; return st * 1024 + (ob ^ (((ob >> 9) & 1) << 5)); }
__host__ __device__ __forceinline__ void stage_rc(int b, int& R, int& C) { const int st = b / 1024, sb = b % 1024, swz = sb ^ (((sb >> 9) & 1) << 5); R = (st >> 1) * 16 + swz / 64; C = (st & 1) * 32 + (swz % 64) / 2; }
__host__ __device__ __forceinline__ int perm32(int rho) { const int n = rho >> 4, i = rho & 15; return 8 * (i >> 2) + 4 * n + (i & 3); }

struct Unit { int pm, pn, sub; };
struct Gemm { const bf16_t* A; const bf16_t* Bt; int M, N, K; };

struct StaticOrder {
    int nM, nN, nwg, G, c;
    __host__ __device__ void init(int M, int N, int G_, int c_) { nM = M / BM; nN = N / BM; nwg = nM * nN; G = G_; c = c_; }
    __host__ __device__ bool next(int i, Unit& u) const {
        const long L = (long)i * G + c; if (L >= nwg) return false;
        int wgid = (int)L; { const int q = nwg / NXCD, r = nwg % NXCD, xcd = wgid % NXCD, off = wgid / NXCD; wgid = (xcd < r ? xcd * (q + 1) : r * (q + 1) + (xcd - r) * q) + off; }
        const int nig = WGM * nN, gid = wgid / nig, fm = gid * WGM, gsz = (nM - fm) < WGM ? (nM - fm) : WGM;
        u.pm = fm + ((wgid % nig) % gsz); u.pn = (wgid % nig) / gsz; u.sub = 0; return true;
    }
    __device__ __forceinline__ void a_ready(const Unit&) const {}
    __device__ __forceinline__ void done(const Unit&) const {}
};

__device__ __forceinline__ unsigned cvt_pk_bf16(float lo, float hi) { unsigned r; asm volatile("v_cvt_pk_bf16_f32 %0, %1, %2" : "=v"(r) : "v"(lo), "v"(hi)); return r; }
typedef float f32x2 __attribute__((ext_vector_type(2)));
template <class Epi, class Sched, bool ALIGN_EPI = false, bool SP2 = false>
__device__ __forceinline__ void gemm_phase(PG8_LAS unsigned char* lds, const Gemm g, const Sched& S, const Epi& E, const int tid) {
    const int wid = __builtin_amdgcn_readfirstlane(tid >> 6), lane = tid & 63, wr = wid >> 2, wc = wid & 3, fr = lane & 15, fq = lane >> 4;
    const int K = g.K, nt = K / BK;
    unsigned voffA[2], voffB[2];
#pragma unroll
    for (int i = 0; i < 2; ++i) { int R, C; stage_rc(tid * 16 + i * 8192, R, C); const int Rb = Epi::PERM ? ((R & ~31) + perm32(R & 31)) : R;
        voffA[i] = (unsigned)(R * K + C) * 2u; voffB[i] = (unsigned)(Rb * K + C) * 2u; }
    const size_t kstep = (size_t)(BK * 2);
    const size_t hstep = (size_t)HALF * K * 2;
        const unsigned ldsw = (unsigned)wid * 1024u;
    const int aoff = lds_byte(wr * 64 + fr, fq * 8), boff = lds_byte(wc * 32 + fr, fq * 8);
#define PG8_SA(b, h) (((b) * 2 + (h)) * HTB)
#define PG8_SB(b, h) ((4 + (b) * 2 + (h)) * HTB)
#define PG8_STAGE(bufoff, gbase, voff) do { _Pragma("unroll") for (int _i = 0; _i < 2; ++_i) \
        __builtin_amdgcn_global_load_lds((const unsigned*)((const char*)(gbase) + (voff)[_i]), (PG8_LAS unsigned*)(lds + (bufoff) + ldsw + _i * 8192), 16, 0, 0); } while (0)
#define PG8_LDA(dst, b, h) do { _Pragma("unroll") for (int m = 0; m < 4; ++m) _Pragma("unroll") for (int k = 0; k < 2; ++k) dst[m][k] = *(const PG8_LAS bf16x8*)(lds + PG8_SA(b, h) + aoff + m * 2048 + k * 1024); } while (0)
#define PG8_LDB(dst, b, h) do { _Pragma("unroll") for (int n = 0; n < 2; ++n) _Pragma("unroll") for (int k = 0; k < 2; ++k) dst[n][k] = *(const PG8_LAS bf16x8*)(lds + PG8_SB(b, h) + boff + n * 2048 + k * 1024); } while (0)
#define PG8_MMA(ai, bj, At, Bt) do { __builtin_amdgcn_s_setprio(1); _Pragma("unroll") for (int m = 0; m < 4; ++m) _Pragma("unroll") for (int n = 0; n < 2; ++n) _Pragma("unroll") for (int k = 0; k < 2; ++k) \
        acc[ai][bj][m][n] = __builtin_amdgcn_mfma_f32_16x16x32_bf16(Bt[n][k], At[m][k], acc[ai][bj][m][n], 0, 0, 0); __builtin_amdgcn_s_setprio(0); } while (0)
#define PG8_WAIT_V(n) asm volatile("s_waitcnt vmcnt(" #n ")" ::: "memory")
#define PG8_WAIT_L(n) asm volatile("s_waitcnt lgkmcnt(" #n ")" ::: "memory")
#define PG8_BAR __builtin_amdgcn_s_barrier()
#define PG8_SCHED __builtin_amdgcn_sched_barrier(0)
    Unit cur, nxt; int ui = 0;
    if (!S.next(0, cur)) return;
    f32x4 acc[2][2][4][2];
#pragma unroll
    for (int a = 0; a < 2; ++a)
#pragma unroll
        for (int b = 0; b < 2; ++b)
#pragma unroll
            for (int m = 0; m < 4; ++m)
#pragma unroll
                for (int n = 0; n < 2; ++n) acc[a][b][m][n] = (f32x4){0.f, 0.f, 0.f, 0.f};
    bf16x8 At[4][2], B0[2][2], B1[2][2];
    const char* cA = S.aptr(cur); const char* cB = S.bptr(cur);
    S.a_ready(cur);
    if constexpr (SP2) {
        PG8_STAGE(PG8_SB(0, 0), cB, voffB); PG8_STAGE(PG8_SB(0, 1), cB + hstep, voffB); PG8_STAGE(PG8_SA(0, 0), cA, voffA); PG8_STAGE(PG8_SA(0, 1), cA + hstep, voffA);
        if (wr == 1) PG8_BAR;
        PG8_WAIT_V(2); PG8_BAR;
        PG8_STAGE(PG8_SB(1, 0), cB + kstep, voffB); PG8_STAGE(PG8_SA(1, 0), cA + kstep, voffA); PG8_STAGE(PG8_SB(1, 1), cB + hstep + kstep, voffB);
        PG8_WAIT_V(6); PG8_BAR;
    } else {
        PG8_STAGE(PG8_SB(0, 0), cB, voffB); PG8_STAGE(PG8_SA(0, 0), cA, voffA); PG8_STAGE(PG8_SB(0, 1), cB + hstep, voffB); PG8_STAGE(PG8_SA(0, 1), cA + hstep, voffA);
        if (wr == 1) PG8_BAR;
        PG8_WAIT_V(4); PG8_BAR;
        PG8_STAGE(PG8_SB(1, 0), cB + kstep, voffB); PG8_STAGE(PG8_SA(1, 0), cA + kstep, voffA); PG8_STAGE(PG8_SB(1, 1), cB + hstep + kstep, voffB);
        PG8_WAIT_V(6); PG8_BAR;
    }
    for (;;) {
        const bool has_next = S.next(ui + 1, nxt);
        const char* nA = has_next ? S.aptr(nxt) : cA; const char* nB = has_next ? S.bptr(nxt) : cB;
        for (int t = 0; t < nt; t += 2) {
            const bool last = (t == nt - 2);
            const char* a1 = cA + (size_t)(t + 1) * kstep;
            const char* a2 = last ? nA : cA + (size_t)(t + 2) * kstep; const char* b2 = last ? nB : cB + (size_t)(t + 2) * kstep;
            const char* a3 = a2 + kstep; const char* b3 = b2 + kstep;
            if (last && has_next) S.a_ready(nxt);
            if constexpr (SP2) {
            PG8_LDB(B0, 0, 0); PG8_LDB(B1, 0, 1); PG8_SCHED; PG8_LDA(At, 0, 0); PG8_STAGE(PG8_SA(1, 1), a1 + hstep, voffA);
            PG8_WAIT_V(8); PG8_WAIT_L(0); PG8_BAR; PG8_MMA(0, 0, At, B0); PG8_MMA(0, 1, At, B1); PG8_BAR; PG8_SCHED;
            PG8_LDA(At, 0, 1); PG8_STAGE(PG8_SB(0, 0), b2, voffB); PG8_STAGE(PG8_SB(0, 1), b2 + hstep, voffB); PG8_STAGE(PG8_SA(0, 0), a2, voffA);
            PG8_WAIT_V(8); PG8_WAIT_L(0); PG8_BAR; PG8_MMA(1, 0, At, B0); PG8_MMA(1, 1, At, B1); PG8_BAR; PG8_SCHED;
            PG8_LDB(B0, 1, 0); PG8_LDB(B1, 1, 1); PG8_SCHED; PG8_LDA(At, 1, 0); PG8_STAGE(PG8_SA(0, 1), a2 + hstep, voffA);
            PG8_WAIT_V(8); PG8_WAIT_L(0); PG8_BAR; PG8_MMA(0, 0, At, B0); PG8_MMA(0, 1, At, B1); PG8_BAR; PG8_SCHED;
            PG8_LDA(At, 1, 1); PG8_STAGE(PG8_SB(1, 0), b3, voffB); PG8_STAGE(PG8_SB(1, 1), b3 + hstep, voffB); PG8_STAGE(PG8_SA(1, 0), a3, voffA);
            PG8_WAIT_V(8); PG8_WAIT_L(0); PG8_BAR; PG8_MMA(1, 0, At, B0); PG8_MMA(1, 1, At, B1); PG8_BAR; PG8_SCHED;
            } else {
            PG8_LDB(B0, 0, 0); PG8_SCHED; PG8_LDA(At, 0, 0); PG8_STAGE(PG8_SA(1, 1), a1 + hstep, voffA);
            PG8_WAIT_L(8); PG8_BAR; PG8_WAIT_L(0); PG8_MMA(0, 0, At, B0); PG8_BAR; PG8_SCHED;
            PG8_LDB(B1, 0, 1); PG8_STAGE(PG8_SB(0, 0), b2, voffB);
            PG8_BAR; PG8_WAIT_L(0); PG8_MMA(0, 1, At, B1); PG8_BAR;
            PG8_LDA(At, 0, 1); PG8_STAGE(PG8_SA(0, 0), a2, voffA);
            PG8_BAR; PG8_WAIT_L(0); PG8_MMA(1, 0, At, B0); PG8_BAR; PG8_SCHED;
            PG8_STAGE(PG8_SB(0, 1), b2 + hstep, voffB);
            PG8_WAIT_V(6); PG8_BAR; PG8_MMA(1, 1, At, B1); PG8_BAR;
            PG8_LDB(B0, 1, 0); PG8_SCHED; PG8_LDA(At, 1, 0); PG8_STAGE(PG8_SA(0, 1), a2 + hstep, voffA);
            PG8_WAIT_L(8); PG8_BAR; PG8_WAIT_L(0); PG8_MMA(0, 0, At, B0); PG8_BAR; PG8_SCHED;
            PG8_LDB(B1, 1, 1); PG8_STAGE(PG8_SB(1, 0), b3, voffB);
            PG8_BAR; PG8_WAIT_L(0); PG8_MMA(0, 1, At, B1); PG8_BAR;
            PG8_LDA(At, 1, 1); PG8_STAGE(PG8_SA(1, 0), a3, voffA);
            PG8_BAR; PG8_WAIT_L(0); PG8_MMA(1, 0, At, B0); PG8_BAR; PG8_SCHED;
            PG8_STAGE(PG8_SB(1, 1), b3 + hstep, voffB);
            PG8_WAIT_V(6); PG8_BAR; PG8_MMA(1, 1, At, B1); PG8_BAR;
            }
        }
        if constexpr (ALIGN_EPI) { if (wr == 0) PG8_BAR; }
        if constexpr (!Epi::AFTER_DRAIN) { E(acc, cur, wr, wc, fr, fq); S.done(cur); }
        if (!has_next) break;
#pragma unroll
        for (int a = 0; a < 2; ++a)
#pragma unroll
            for (int b = 0; b < 2; ++b)
#pragma unroll
                for (int m = 0; m < 4; ++m)
#pragma unroll
                    for (int n = 0; n < 2; ++n) acc[a][b][m][n] = (f32x4){0.f, 0.f, 0.f, 0.f};
        cur = nxt; cA = nA; cB = nB; ++ui;
        if constexpr (ALIGN_EPI) { if (wr == 1) PG8_BAR; }
    }
    PG8_WAIT_V(0);
    if constexpr (!ALIGN_EPI) { if (wr == 0) PG8_BAR; }
    PG8_BAR;
    if constexpr (Epi::AFTER_DRAIN) { E.fused(acc, cur, wr, wc, fr, fq, lds, wid, lane); S.done(cur); }
#undef PG8_SA
#undef PG8_SB
#undef PG8_STAGE
#undef PG8_LDA
#undef PG8_LDB
#undef PG8_MMA
#undef PG8_WAIT_V
#undef PG8_WAIT_L
#undef PG8_BAR
#undef PG8_SCHED
}
}
namespace attn_body {
using bf16=__hip_bfloat16;
using bf16x8=__attribute__((ext_vector_type(8)))short;
using s16x4=__attribute__((ext_vector_type(4)))short;
using f32x16=__attribute__((ext_vector_type(16)))float;
using u32x4=__attribute__((ext_vector_type(4)))unsigned;
constexpr int D=64,QP=1024,KP=256;
constexpr int NW=8,QBLK=32,KVBLK=64;
__device__ __forceinline__ int crow(int r,int hi){return (r&3)+8*(r>>2)+4*hi;}
#define SBAR() __builtin_amdgcn_sched_barrier(0)
__device__ __forceinline__ void kmask(f32x16&p0,f32x16&p1,int rem,int hi){
  const float NEG=-INFINITY;
  #pragma unroll
  for(int r=0;r<16;++r){int kv=4*hi+(r&3)+8*(r>>2); if(kv>=rem)p0[r]=NEG; if(kv+32>=rem)p1[r]=NEG;}
}

constexpr int NSLOT=3, SLOTB=8192;
constexpr int LDS_K=0, LDS_V=NSLOT*SLOTB, LDS_WS=2*NSLOT*SLOTB, LDS_OST=LDS_WS+NW*64*4, LDS_BYTES=LDS_OST+NW*4096;
constexpr float C2=0.125f*1.4426950408889634f;
__device__ __forceinline__ void glds16(const void*gsrc,unsigned lds_dst){unsigned keep;
  asm volatile("s_mov_b32 %0, m0\n\ts_mov_b32 m0, %2\n\ts_nop 0\n\tglobal_load_lds_dwordx4 %1, off\n\ts_mov_b32 m0, %0":"=&s"(keep):"v"(gsrc),"s"(lds_dst):"memory");}
__device__ __forceinline__ float max3f(float a,float b,float c){float r;asm("v_max3_f32 %0, %1, %2, %3":"=v"(r):"v"(a),"v"(b),"v"(c));return r;}
__device__ __forceinline__ float max2f(float a,float b){float r;asm("v_max_f32_e32 %0, %1, %2":"=v"(r):"v"(a),"v"(b));return r;}
__device__ __forceinline__ float fadd_s(float a,float b){float r;asm("v_add_f32_e32 %0, %1, %2":"=v"(r):"v"(a),"v"(b));return r;}
__device__ __forceinline__ float fsub_s(float a,float b){float r;asm("v_sub_f32_e32 %0, %1, %2":"=v"(r):"v"(a),"v"(b));return r;}
typedef float f32x2_t __attribute__((ext_vector_type(2))); typedef __bf16 bf16x2_t __attribute__((ext_vector_type(2)));
__device__ __forceinline__ unsigned cvtpk_s(float lo,float hi){f32x2_t v={lo,hi};bf16x2_t b=__builtin_convertvector(v,bf16x2_t);return __builtin_bit_cast(unsigned,b);}
#define WAIT_BAR(N) asm volatile("s_waitcnt vmcnt(" #N ") lgkmcnt(0)\n\ts_barrier":::"memory")

__device__ __forceinline__ void qkt(f32x16&p0,f32x16&p1,const char*Kslot,const bf16x8*qr,const f32x16&negm,int r32,int hi){
  const char*kb=Kslot+hi*1024+r32*16;
  #pragma unroll
  for(int d0=0;d0<4;++d0){
    const bf16x8 b0=*reinterpret_cast<const bf16x8*>(kb+d0*2048);
    const bf16x8 b1=*reinterpret_cast<const bf16x8*>(kb+d0*2048+512);
    if(d0==0){p0=__builtin_amdgcn_mfma_f32_32x32x16_bf16(b0,qr[0],negm,0,0,0);p1=__builtin_amdgcn_mfma_f32_32x32x16_bf16(b1,qr[0],negm,0,0,0);}
    else{p0=__builtin_amdgcn_mfma_f32_32x32x16_bf16(b0,qr[d0],p0,0,0,0);p1=__builtin_amdgcn_mfma_f32_32x32x16_bf16(b1,qr[d0],p1,0,0,0);}}
}
typedef __attribute__((address_space(3))) const char* lds_cptr;
typedef short v4i16_t __attribute__((ext_vector_type(4)));
__device__ __forceinline__ void kload8(bf16x8*kf,lds_cptr kp){
  kf[0]=*(const __attribute__((address_space(3))) bf16x8*)(kp);      kf[1]=*(const __attribute__((address_space(3))) bf16x8*)(kp+512);
  kf[2]=*(const __attribute__((address_space(3))) bf16x8*)(kp+2048); kf[3]=*(const __attribute__((address_space(3))) bf16x8*)(kp+2560);
  kf[4]=*(const __attribute__((address_space(3))) bf16x8*)(kp+4096); kf[5]=*(const __attribute__((address_space(3))) bf16x8*)(kp+4608);
  kf[6]=*(const __attribute__((address_space(3))) bf16x8*)(kp+6144); kf[7]=*(const __attribute__((address_space(3))) bf16x8*)(kp+6656);
}
__device__ __forceinline__ void kload2(bf16x8*kf,lds_cptr kp,int j){ kf[2*j]=*(const __attribute__((address_space(3))) bf16x8*)(kp+j*2048); kf[2*j+1]=*(const __attribute__((address_space(3))) bf16x8*)(kp+j*2048+512); }
__device__ __forceinline__ s16x4 vtr(lds_cptr p){ return __builtin_bit_cast(s16x4,__builtin_amdgcn_ds_read_tr16_b64_v4i16((__attribute__((address_space(3))) v4i16_t*)p)); }
__device__ __forceinline__ float rowmax(const f32x16&p0,const f32x16&p1){
  float a=max3f(p0[0],p0[1],p1[0]),b=max3f(p0[2],p0[3],p1[1]);a=max3f(a,p1[2],p1[3]);
  #pragma unroll
  for(int r=4;r<16;r+=4){a=max3f(a,p0[r],p0[r+1]);b=max3f(b,p0[r+2],p0[r+3]);a=max3f(a,p1[r],p1[r+1]);b=max3f(b,p1[r+2],p1[r+3]);}
  const float m=max2f(a,b);
  auto rr=__builtin_amdgcn_permlane32_swap(__float_as_uint(m),__float_as_uint(m),false,false);
  return max2f(__uint_as_float(rr[0]),__uint_as_float(rr[1]));
}
__device__ __forceinline__ void pv(f32x16*o,int vb,bf16x8 pa0,bf16x8 pa1,bf16x8 pa2,bf16x8 pa3){
  #pragma unroll
  for(int d0=0;d0<2;++d0){s16x4 lo[4],hi[4];
    #pragma unroll
    for(int ks=0;ks<4;++ks){
      asm volatile("ds_read_b64_tr_b16 %0,%1 offset:%c2":"=&v"(lo[ks]):"v"(vb),"i"(d0*4096+ks*1024):"memory");
      asm volatile("ds_read_b64_tr_b16 %0,%1 offset:%c2":"=&v"(hi[ks]):"v"(vb),"i"(d0*4096+ks*1024+512):"memory");}
    asm volatile("s_waitcnt lgkmcnt(0)":::"memory");SBAR();
    #define PK(k) (bf16x8){lo[k][0],lo[k][1],lo[k][2],lo[k][3],hi[k][0],hi[k][1],hi[k][2],hi[k][3]}
    o[d0]=__builtin_amdgcn_mfma_f32_32x32x16_bf16(pa0,PK(0),o[d0],0,0,0);
    o[d0]=__builtin_amdgcn_mfma_f32_32x32x16_bf16(pa1,PK(1),o[d0],0,0,0);
    o[d0]=__builtin_amdgcn_mfma_f32_32x32x16_bf16(pa2,PK(2),o[d0],0,0,0);
    o[d0]=__builtin_amdgcn_mfma_f32_32x32x16_bf16(pa3,PK(3),o[d0],0,0,0);
    #undef PK
  }
}

#ifndef ATTN_STORE16
#define ATTN_STORE16(p,v) (*(u32x4*)(p)=(v))
#endif
template<int THRL,int L,int NT> __device__ __forceinline__ void attn_unit(long rowbase,int kvh,int qblk,const bf16*Q,const bf16*__restrict__ K,const bf16*__restrict__ V,bf16*O,char*shm,const int tid){
  const int lane=tid&63,r32=lane&31,hi=lane>>5; const int wid=__builtin_amdgcn_readfirstlane(tid>>6);
  const int q0=qblk*64, qh=wid>>1, rh=wid&1;
  const bf16*Qw=Q+(rowbase+q0+rh*QBLK)*QP+(4*kvh+qh)*D;
  const bf16*Kh=K+rowbase*KP+kvh*D,*Vh=V+rowbase*KP+kvh*D;
  const unsigned lds0=(unsigned)(uintptr_t)shm;
  float*wsf=(float*)(shm+LDS_WS)+wid*64;
  const bf16*ksrc=Kh+(long)lane*KP+wid*8;
  const bf16*vsrc=Vh+(long)(16*(wid&3)+(lane>>2))*KP+(wid>>2)*32+(lane&3)*8;
  const unsigned kdst=lds0+LDS_K+wid*1024, vdst=lds0+LDS_V+wid*1024;
  #define DMA_K(t,slot) glds16(ksrc+(long)(t)*KVBLK*KP,(unsigned)__builtin_amdgcn_readfirstlane(kdst+(slot)))
  #define DMA_V(t,slot) glds16(vsrc+(long)(t)*KVBLK*KP,(unsigned)__builtin_amdgcn_readfirstlane(vdst+(slot)))
  const int vb0=(int)(lds0+LDS_V)+((lane>>4)&1)*32+(lane&3)*8+(4*hi+((lane&15)>>2))*64;
  const char*Kbase=shm+LDS_K; bf16x8 kf[8];
  const lds_cptr shm3=(lds_cptr)shm; const lds_cptr kp0=shm3+LDS_K+hi*1024+r32*16; const lds_cptr vp0=shm3+LDS_V+((lane>>4)&1)*32+(lane&3)*8+(4*hi+((lane&15)>>2))*64;
  DMA_K(0,0);DMA_V(0,0);DMA_K(1,SLOTB);
  bf16x8 qr[4];
  #pragma unroll
  for(int d0=0;d0<4;++d0)qr[d0]=*reinterpret_cast<const bf16x8*>(&Qw[(long)r32*QP+d0*16+hi*8]);
  if(q0+rh*QBLK+r32>=L){
    #pragma unroll
    for(int d0=0;d0<4;++d0)qr[d0]=bf16x8{0,0,0,0,0,0,0,0}; }
  float mhat=0.f,l_reg=0.f;f32x16 o[2];o[0]=f32x16{};o[1]=f32x16{};f32x16 negm=f32x16{};asm volatile("":"+v"(negm));
  #define CMASK(P0,P1,t) do{ if((t)>=NT-2)kmask(P0,P1,L-64*(t),hi);}while(0)
  bool resc=false;
  #define START(P0,P1) do{ const float rm=rowmax(P0,P1); resc=false; \
    { const float dl=rm; mhat=fadd_s(mhat,dl); \
      _Pragma("unroll") for(int r=0;r<16;++r){P0[r]=fsub_s(P0[r],dl);P1[r]=fsub_s(P1[r],dl);} \
      _Pragma("unroll") for(int r=0;r<16;++r)negm[r]=-mhat; asm volatile("":"+v"(negm)); } \
    _Pragma("unroll") for(int r=0;r<16;++r)P0[r]=__builtin_amdgcn_exp2f(P0[r]); }while(0)
  #define RESC() do{ if(resc){ asm volatile("s_waitcnt lgkmcnt(0)":::"memory"); \
      _Pragma("unroll") for(int d_=0;d_<2;++d_) _Pragma("unroll") for(int r=0;r<16;++r)o[d_][r]*=wsf[crow(r,hi)]; } }while(0)
  f32x16 pA0,pA1,pB0,pB1;
  int sl_prev=0,sl_cur=0,sl_next=SLOTB;
  #define ROT() do{sl_prev=sl_cur;sl_cur=sl_next;sl_next=(sl_next==(NSLOT-1)*SLOTB)?0:sl_next+SLOTB;}while(0)
  DMA_K(2,2*SLOTB);
  WAIT_BAR(3);
  qkt(pA0,pA1,Kbase,qr,negm,r32,hi);asm volatile("s_nop 15\n\ts_nop 7":"+v"(pA0),"+v"(pA1));CMASK(pA0,pA1,0);
  START(pA0,pA1);
  _Pragma("unroll") for(int r=0;r<16;++r)pA1[r]=__builtin_amdgcn_exp2f(pA1[r]);
  WAIT_BAR(0);
  DMA_K(3,0);DMA_V(1,SLOTB);
  ROT();
  kload8(kf,kp0+sl_cur);
  WAIT_BAR(2);
  s16x4 vlo[8],vhi[8]; u32x4 pw0,pw1,pw2,pw3;
  #define PKW(P,B) cvtpk_s(P[B],P[B+1])
  #define PAF(k) __builtin_bit_cast(bf16x8,pw##k)
  #define VFR(i) (bf16x8){vlo[i][0],vlo[i][1],vlo[i][2],vlo[i][3],vhi[i][0],vhi[i][1],vhi[i][2],vhi[i][3]}
  #define PIN(x) asm volatile("":"+v"(x))
  #define MX3(a,b,c) __builtin_fmaxf(__builtin_fmaxf((a),(b)),(c))
  #define GAPA(MF,A0,A1,A2,A3,W0,W1,PW) do{ MF; sacc+=A0; sacc+=A1; sacc+=A2; sacc+=A3; PIN(sacc); W0; W1; PIN(PW); SBAR(); }while(0)
  #define EX(v) __builtin_amdgcn_exp2f(v)
  #define GAPB(MF,X,B) do{ MF; X[B]=EX(X[B]); X[B+1]=EX(X[B+1]); X[B+2]=EX(X[B+2]); X[B+3]=EX(X[B+3]); PIN(X); SBAR(); }while(0)
  #define VRD(i) do{ vlo[i]=vtr(vp_+(((i)>>2)*4096+((i)&3)*1024)); vhi[i]=vtr(vp_+(((i)>>2)*4096+((i)&3)*1024+512)); }while(0)
  #define KRD(G,j) do{ if(G){ kload2(kf,kp0+sl_next,j); SBAR(); } }while(0)
  #define STEP(C0,C1,P0,P1,t,GK,GV,GL) do{ SBAR(); \
    const lds_cptr vp_=vp0+sl_prev; \
    VRD(0); SBAR(); float sacc=(P0[0]+P0[1]); \
    GAPA(C0=__builtin_amdgcn_mfma_f32_32x32x16_bf16(kf[0],qr[0],negm,0,0,0), P0[2],P0[3],P0[4],P0[5],     pw0[0]=PKW(P0,0), pw0[1]=PKW(P0,2), pw0); \
    VRD(4); SBAR(); GAPA(C1=__builtin_amdgcn_mfma_f32_32x32x16_bf16(kf[1],qr[0],negm,0,0,0), P0[6],P0[7],P0[8],P0[9],     pw0[2]=PKW(P0,4), pw0[3]=PKW(P0,6), pw0); \
    VRD(1); SBAR(); GAPA(C0=__builtin_amdgcn_mfma_f32_32x32x16_bf16(kf[2],qr[1],C0,0,0,0),   P0[10],P0[11],P0[12],P0[13], pw1[0]=PKW(P0,8), pw1[1]=PKW(P0,10), pw1); \
    VRD(5); SBAR(); GAPA(C1=__builtin_amdgcn_mfma_f32_32x32x16_bf16(kf[3],qr[1],C1,0,0,0),   P0[14],P0[15],P1[0],P1[1],   pw1[2]=PKW(P0,12),pw1[3]=PKW(P0,14), pw1); \
    VRD(2); SBAR(); GAPA(C0=__builtin_amdgcn_mfma_f32_32x32x16_bf16(kf[4],qr[2],C0,0,0,0),   P1[2],P1[3],P1[4],P1[5],     pw2[0]=PKW(P1,0), pw2[1]=PKW(P1,2), pw2); \
    VRD(6); SBAR(); GAPA(C1=__builtin_amdgcn_mfma_f32_32x32x16_bf16(kf[5],qr[2],C1,0,0,0),   P1[6],P1[7],P1[8],P1[9],     pw2[2]=PKW(P1,4), pw2[3]=PKW(P1,6), pw2); \
    VRD(3); SBAR(); GAPA(C0=__builtin_amdgcn_mfma_f32_32x32x16_bf16(kf[6],qr[3],C0,0,0,0),   P1[10],P1[11],P1[12],P1[13], pw3[0]=PKW(P1,8), pw3[1]=PKW(P1,10), pw3); \
    VRD(7); SBAR(); GAPA(C1=__builtin_amdgcn_mfma_f32_32x32x16_bf16(kf[7],qr[3],C1,0,0,0),   P1[14],P1[15],0.f,0.f,       pw3[2]=PKW(P1,12),pw3[3]=PKW(P1,14), pw3); \
    l_reg+=sacc; \
    if(GK){DMA_K((t)+3,sl_cur);} if(GV){DMA_V((t)+1,sl_next);} \
    CMASK(C0,C1,t); \
    { float a=MX3(C0[0],C0[1],C1[0]),b=MX3(C0[2],C0[3],C1[1]); a=MX3(a,C1[2],C1[3]); \
      _Pragma("unroll") for(int r=4;r<16;r+=4){a=MX3(a,C0[r],C0[r+1]);b=MX3(b,C0[r+2],C0[r+3]);a=MX3(a,C1[r],C1[r+1]);b=MX3(b,C1[r+2],C1[r+3]);} \
      float rm=__builtin_fmaxf(a,b); { auto rr=__builtin_amdgcn_permlane32_swap(__float_as_uint(rm),__float_as_uint(rm),false,false); rm=__builtin_fmaxf(__uint_as_float(rr[0]),__uint_as_float(rr[1])); } \
      resc=false; \
      if(__builtin_expect(__any(rm>(float)THRL),0)){ const float dl=__builtin_fmaxf(rm,0.f); mhat+=dl; \
        _Pragma("unroll") for(int r=0;r<16;++r){C0[r]-=dl;C1[r]-=dl;} \
        _Pragma("unroll") for(int r=0;r<16;++r)negm[r]=-mhat; asm volatile("":"+v"(negm)); \
        const float f=__builtin_amdgcn_exp2f(-dl); l_reg*=f; if(hi==0)wsf[r32]=f; resc=true; } } \
    SBAR(); \
    GAPB(o[0]=__builtin_amdgcn_mfma_f32_32x32x16_bf16(PAF(0),VFR(0),o[0],0,0,0), C0,0); \
    GAPB(o[1]=__builtin_amdgcn_mfma_f32_32x32x16_bf16(PAF(0),VFR(4),o[1],0,0,0), C0,4); \
    KRD(GL,0); GAPB(o[0]=__builtin_amdgcn_mfma_f32_32x32x16_bf16(PAF(1),VFR(1),o[0],0,0,0), C0,8); \
    KRD(GL,1); GAPB(o[1]=__builtin_amdgcn_mfma_f32_32x32x16_bf16(PAF(1),VFR(5),o[1],0,0,0), C0,12); \
    KRD(GL,2); GAPB(o[0]=__builtin_amdgcn_mfma_f32_32x32x16_bf16(PAF(2),VFR(2),o[0],0,0,0), C1,0); \
    KRD(GL,3); GAPB(o[1]=__builtin_amdgcn_mfma_f32_32x32x16_bf16(PAF(2),VFR(6),o[1],0,0,0), C1,4); \
    GAPB(o[0]=__builtin_amdgcn_mfma_f32_32x32x16_bf16(PAF(3),VFR(3),o[0],0,0,0), C1,8); \
    GAPB(o[1]=__builtin_amdgcn_mfma_f32_32x32x16_bf16(PAF(3),VFR(7),o[1],0,0,0), C1,12); \
    }while(0)
  int t=1;
  #undef CMASK
  #define CMASK(P0,P1,t) do{}while(0)
  for(;t+5<NT;t+=2){
    STEP(pB0,pB1,pA0,pA1,t,true,true,true);     WAIT_BAR(2); RESC(); ROT();
    STEP(pA0,pA1,pB0,pB1,t+1,true,true,true);   WAIT_BAR(2); RESC(); ROT();
  }
  #undef CMASK
  #define CMASK(P0,P1,t) do{ if((t)>=NT-2)kmask(P0,P1,L-64*(t),hi);}while(0)
  #define ENDW(tt) do{ if((tt)+3<NT){WAIT_BAR(2);} else if((tt)+2<NT){WAIT_BAR(1);} else {WAIT_BAR(0);} }while(0)
  for(;t+1<NT;t+=2){
    STEP(pB0,pB1,pA0,pA1,t,(t+3<NT),(t+1<NT),(t+1<NT));       ENDW(t);   RESC(); ROT();
    STEP(pA0,pA1,pB0,pB1,t+1,(t+4<NT),(t+2<NT),(t+2<NT));     ENDW(t+1); RESC(); ROT();
  }
  STEP(pB0,pB1,pA0,pA1,NT-1,false,false,false); RESC();
  { float sacc=pB0[0]+pB0[1]; _Pragma("unroll") for(int r=2;r<16;++r)sacc+=pB0[r]; _Pragma("unroll") for(int r=0;r<16;++r)sacc+=pB1[r]; l_reg+=sacc;
    pw0=(u32x4){PKW(pB0,0),PKW(pB0,2),PKW(pB0,4),PKW(pB0,6)};pw1=(u32x4){PKW(pB0,8),PKW(pB0,10),PKW(pB0,12),PKW(pB0,14)};pw2=(u32x4){PKW(pB1,0),PKW(pB1,2),PKW(pB1,4),PKW(pB1,6)};pw3=(u32x4){PKW(pB1,8),PKW(pB1,10),PKW(pB1,12),PKW(pB1,14)};
    SBAR(); pv(o,vb0+sl_cur,PAF(0),PAF(1),PAF(2),PAF(3)); }
  #undef PKW
  #undef PAF
  #undef VFR
  #undef PIN
  #undef MX3
  #undef GAPA
  #undef GAPB
  #undef EX
  #undef VRD
  #undef KRD
  #undef STEP
  #undef ENDW
  {auto rr=__builtin_amdgcn_permlane32_swap(__float_as_uint(l_reg),__float_as_uint(l_reg),false,false);l_reg=__uint_as_float(rr[0])+__uint_as_float(rr[1]);}
  if(hi==0)wsf[32+r32]=l_reg;asm volatile("s_waitcnt lgkmcnt(0)":::"memory");
  float rli[16];
  #pragma unroll
  for(int r=0;r<16;++r)rli[r]=__builtin_amdgcn_rcpf(wsf[32+crow(r,hi)]);
  bf16*Ow=O+(rowbase+q0+rh*QBLK)*QP+(4*kvh+qh)*D;
  { bf16*stg=(bf16*)(shm+LDS_OST)+wid*2048;
    #pragma unroll
    for(int r=0;r<16;++r){const int orow=crow(r,hi);
      #pragma unroll
      for(int d0=0;d0<2;++d0)stg[orow*64+d0*32+r32]=__float2bfloat16(o[d0][r]*rli[r]);}
    asm volatile("s_waitcnt lgkmcnt(0)":::"memory");
    #pragma unroll
    for(int i=0;i<4;++i){const int row=i*8+(lane>>3),ch=lane&7; const u32x4 v=*(const u32x4*)(stg+row*64+ch*8); if(q0+rh*QBLK+row<L)ATTN_STORE16(Ow+(long)row*QP+ch*8,v);} }
  asm volatile("s_waitcnt lgkmcnt(0)\n\ts_barrier":::"memory");
  #undef DMA_K
  #undef DMA_V
  #undef CMASK
  #undef START
  #undef RESC
  #undef ROT
}
constexpr int ATTN_LDS_BYTES=LDS_BYTES;
#undef SBAR
#undef WAIT_BAR
}
constexpr int DM = 1024, FF = 2816, NLAYER = 4;
constexpr int LP = 4112, LS = 2064, NSEQ_P = 4, NSEQ_S = 16, ROWS_P = NSEQ_P * LP  , T_ROWS = ROWS_P + NSEQ_S * LS  ;
constexpr int TPAD = 49664, NMT = TPAD / 256;
constexpr int NWIN = 4608;
constexpr float NORM_EPS = 1e-6f;
constexpr float QSCALE = 0.125f * 1.4426950408889634f;
constexpr int ATT_UNITS_P = NSEQ_P * 4 * 65, ATT_UNITS_S = NSEQ_S * 4 * 33, ATT_UNITS = ATT_UNITS_P + ATT_UNITS_S;

constexpr size_t MiB = 1u << 20;
constexpr int CW_BAR = 4096;
constexpr size_t WS_CTL = 0;
constexpr size_t WS_ROPE = MiB / 4;
constexpr size_t WS_HMETA = 3 * MiB / 2;
constexpr size_t WS_SSQ = 3 * MiB;
constexpr size_t WS_W = 8 * MiB;
constexpr size_t W_GU1 = 0, W_D1 = W_GU1 + (size_t)5632 * 1024 * 2, W_IN = W_D1 + (size_t)1024 * 2816 * 2, W_GC = W_IN + (size_t)NWIN * 1024 * 2, W_OC = W_GC + 2 * MiB,
                 W_GA = W_OC + 2 * MiB, W_OA = W_GA + 2 * MiB, W_M = W_OA + 2 * MiB, W_GU2 = W_M + 2 * MiB, W_D2 = W_GU2 + (size_t)5632 * 1024 * 2, W_END = W_D2 + (size_t)1024 * 2816 * 2;
constexpr size_t WBUF = 56 * MiB;
constexpr size_t WS_HB = 120 * MiB;
constexpr size_t ROWB = (size_t)TPAD * 1024 * 2;
constexpr size_t WS_BIG = WS_HB + 98 * MiB;
constexpr size_t WS_Q = WS_BIG, WS_K = WS_Q + ROWB, WS_V = WS_K + ROWB / 4, WS_CB = WS_V + ROWB / 4, WS_Z = WS_CB + ROWB, WS_END = WS_Z + ROWB;
constexpr size_t WS_HID = WS_BIG;
constexpr size_t WS_SCR = WS_K;
static_assert((CW_BAR + 3456) * 4 <= (int)WS_ROPE && WS_ROPE + (size_t)LP * 64 * 4 <= WS_HMETA && WS_HMETA + (size_t)20 * 16 * 1024 * 4 <= WS_SSQ && WS_SSQ + (size_t)TPAD * 16 * 4 <= WS_W, "d_ws map (small regions)");
static_assert(W_END <= 56 * MiB && ROWB <= 98 * MiB && (size_t)TPAD * FF * 2 <= WS_END - WS_BIG && 256 * 131072 <= ROWB / 2, "d_ws map");

constexpr int RING_BYTES = 131072, MISC_OFF = RING_BYTES + 320, PTAB_OFF = RING_BYTES + 1024, LDS_BYTES = 147456;
constexpr int NWAVES = 8;

#define GAS __attribute__((address_space(1)))
#define LAS __attribute__((address_space(3)))
typedef unsigned short bf16;
typedef unsigned v4u __attribute__((ext_vector_type(4)));
typedef float f32x4 __attribute__((ext_vector_type(4)));
__device__ __forceinline__ unsigned f2bf(float f) { unsigned u = __builtin_bit_cast(unsigned, f); return (u + 0x7fffu + ((u >> 16) & 1u)) >> 16; }
__device__ __forceinline__ unsigned pk2(float lo, float hi) { return pg8::cvt_pk_bf16(lo, hi); }
__device__ __forceinline__ float bflo(unsigned u) { return __builtin_bit_cast(float, u << 16); }
__device__ __forceinline__ float bfhi(unsigned u) { return __builtin_bit_cast(float, u & 0xffff0000u); }
__device__ __forceinline__ float wave_sum(float v) {
#pragma unroll
    for (int o = 1; o < 64; o <<= 1) v += __shfl_xor(v, o);
    return v;
}
__device__ __forceinline__ void rowinfo(int r, int& pos, int& L) {
    if (r < ROWS_P) { L = LP; pos = r % LP; } else if (r < T_ROWS) { L = LS; pos = (r - ROWS_P) % LS; } else { L = 1 << 30; pos = 0; }
}
__device__ __forceinline__ float sigmoidf_(float x) { return __builtin_amdgcn_rcpf(1.0f + __builtin_amdgcn_exp2f(-1.4426950408889634f * x)); }

struct PlainOrder : pg8::StaticOrder {
    const char* A; const char* Bt; size_t tstep;
    __device__ __forceinline__ const char* aptr(const pg8::Unit& u) const { return A + (size_t)u.pm * tstep; }
    __device__ __forceinline__ const char* bptr(const pg8::Unit& u) const { return Bt + (size_t)u.pn * tstep; }
};
struct ChainOrder {
    pg8::StaticOrder base; const char* A[4]; const char* B[4]; size_t tstep;
    __device__ __forceinline__ bool next(int i, pg8::Unit& u) const { if (!base.next(i >> 2, u)) return false; u.sub = i & 3; return true; }
    __device__ __forceinline__ const char* aptr(const pg8::Unit& u) const { const char* p = u.sub == 0 ? A[0] : u.sub == 1 ? A[1] : u.sub == 2 ? A[2] : A[3]; return p + (size_t)u.pm * tstep; }
    __device__ __forceinline__ const char* bptr(const pg8::Unit& u) const { const char* p = u.sub == 0 ? B[0] : u.sub == 1 ? B[1] : u.sub == 2 ? B[2] : B[3]; return p + (size_t)u.pn * tstep; }
    __device__ __forceinline__ void a_ready(const pg8::Unit&) const {}
    __device__ __forceinline__ void done(const pg8::Unit&) const {}
};

using pg8::f32x4; using pg8::u32x4; using pg8::Unit; using pg8::bf16_t;
typedef f32x4 Acc[2][2][4][2];
__device__ __forceinline__ u32x4 pack8(const f32x4 a, const f32x4 b) { u32x4 w; w.x = pk2(a[0], a[1]); w.y = pk2(a[2], a[3]); w.z = pk2(b[0], b[1]); w.w = pk2(b[2], b[3]); return w; }
__device__ __forceinline__ void unpack8(const u32x4 w, f32x4& a, f32x4& b) { a = (f32x4){bflo(w.x), bfhi(w.x), bflo(w.y), bfhi(w.y)}; b = (f32x4){bflo(w.z), bfhi(w.z), bflo(w.w), bfhi(w.w)}; }
__device__ __forceinline__ float rstd_of(const float* ssq, int row) { const f32x4* p = (const f32x4*)(ssq + (size_t)row * 16); const f32x4 a = p[0], b = p[1], c = p[2], d = p[3];
    const float s = (((a[0] + a[1]) + (a[2] + a[3])) + ((b[0] + b[1]) + (b[2] + b[3]))) + (((c[0] + c[1]) + (c[2] + c[3])) + ((d[0] + d[1]) + (d[2] + d[3])));
    return __builtin_amdgcn_rsqf(s * (1.0f / DM) + NORM_EPS); }

__device__ __forceinline__ void rstd8(const float* ssq, int row0, int fq, float (&rs)[8]) {
    f32x4 pr[8];
#pragma unroll
    for (int i = 0; i < 8; ++i) pr[i] = *(const f32x4*)(ssq + (size_t)(row0 + (i >> 2) * 128 + (i & 3) * 16) * 16 + 4 * fq);
#pragma unroll
    for (int i = 0; i < 8; ++i) { float s = (pr[i][0] + pr[i][1]) + (pr[i][2] + pr[i][3]); s += __shfl_xor(s, 16); s += __shfl_xor(s, 32); rs[i] = __builtin_amdgcn_rsqf(s * (1.0f / DM) + NORM_EPS); }
}
struct EpiSwiGLU {
    static constexpr bool PERM = true, AFTER_DRAIN = false;
    bf16_t* hid; const float* ssq;
    __device__ __forceinline__ void operator()(const Acc& acc, const Unit& u, int wr, int wc, int fr, int fq) const {
        const int row0 = u.pm * 256 + wr * 64 + fr;
        float rs[8]; rstd8(ssq, row0, fq, rs);
#pragma unroll
        for (int ai = 0; ai < 2; ++ai)
#pragma unroll
            for (int m = 0; m < 4; ++m) {
                const int row = row0 + ai * 128 + m * 16; const float r1 = rs[ai * 4 + m];
                f32x4 o[2];
#pragma unroll
                for (int n = 0; n < 2; ++n)
#pragma unroll
                    for (int e = 0; e < 4; ++e) { const float g = acc[ai][0][m][n][e] * r1, up = acc[ai][1][m][n][e] * r1; o[n][e] = g * sigmoidf_(g) * up; }
                *(u32x4*)(hid + (size_t)row * FF + u.pn * 128 + wc * 32 + 8 * fq) = pack8(o[0], o[1]);
            }
    }
};
struct EpiResid {
    static constexpr bool PERM = true, AFTER_DRAIN = false;
    bf16_t* hb; float* ssq_out; float scale;
    __device__ __forceinline__ void operator()(const Acc& acc, const Unit& u, int wr, int wc, int fr, int fq) const {
        const int row0 = u.pm * 256 + wr * 64 + fr;
#pragma unroll
        for (int ai = 0; ai < 2; ++ai) {
            u32x4 old[4][2];
#pragma unroll
            for (int m = 0; m < 4; ++m) { const int row = row0 + ai * 128 + m * 16; const bf16_t* bp = hb + (size_t)row * DM + u.pn * 256 + wc * 32 + 8 * fq;
#pragma unroll
                for (int bj = 0; bj < 2; ++bj) old[m][bj] = row < T_ROWS ? *(const u32x4*)(bp + bj * 128) : (u32x4){0u, 0u, 0u, 0u}; }
#pragma unroll
            for (int m = 0; m < 4; ++m) {
                const int row = row0 + ai * 128 + m * 16; const bool ok = row < T_ROWS; bf16_t* bp = hb + (size_t)row * DM + u.pn * 256 + wc * 32 + 8 * fq;
                float ss = 0.f;
#pragma unroll
                for (int bj = 0; bj < 2; ++bj) {
                    f32x4 a, b; unpack8(old[m][bj], a, b);
                    a = a + acc[ai][bj][m][0] * scale; b = b + acc[ai][bj][m][1] * scale;
                    const u32x4 w = pack8(a, b); if (ok) *(u32x4*)(bp + bj * 128) = w;
                    unpack8(w, a, b);
                    ss += (a[0] * a[0] + a[1] * a[1]) + (a[2] * a[2] + a[3] * a[3]) + (b[0] * b[0] + b[1] * b[1]) + (b[2] * b[2] + b[3] * b[3]);
                }
                ss += __shfl_xor(ss, 16); ss += __shfl_xor(ss, 32);
                if (ok && fq == 0) ssq_out[(size_t)row * 16 + u.pn * 4 + wc] = ss;
            }
            asm volatile("" ::: "memory");
        }
    }
};
struct EpiWin {
    static constexpr bool PERM = true, AFTER_DRAIN = false;
    bf16_t *q, *k, *v, *cb, *z; const float* ssq; const float* rope; const float* qg; const float* kg;
    __device__ __forceinline__ void operator()(const Acc& acc, const Unit& u, int wr, int wc, int fr, int fq) const {
        const int pn = u.pn; const int row0 = u.pm * 256 + wr * 64 + fr;
        float rs[8]; rstd8(ssq, row0, fq, rs);
        if (pn <= 4) {
            const float* g = pn < 4 ? qg : kg; const float osc = pn < 4 ? QSCALE : 1.0f;
            f32x4 G[2][2];
#pragma unroll
            for (int bj = 0; bj < 2; ++bj)
#pragma unroll
                for (int n = 0; n < 2; ++n) G[bj][n] = *(const f32x4*)(g + 32 * bj + 16 * n + 4 * fq) * osc;
#pragma unroll
            for (int ai = 0; ai < 2; ++ai)
#pragma unroll
                for (int mp = 0; mp < 2; ++mp) {
                    f32x4 cs[2][2][2];
#pragma unroll
                    for (int mm = 0; mm < 2; ++mm) { int pos, L; rowinfo(row0 + ai * 128 + (2 * mp + mm) * 16, pos, L);
#pragma unroll
                        for (int bj = 0; bj < 2; ++bj) { cs[mm][bj][0] = *(const f32x4*)(rope + ((pos * 2 + bj) * 2 + 0) * 16 + 4 * fq); cs[mm][bj][1] = *(const f32x4*)(rope + ((pos * 2 + bj) * 2 + 1) * 16 + 4 * fq); } }
#pragma unroll
                    for (int mm = 0; mm < 2; ++mm) {
                        const int m = 2 * mp + mm; const int row = row0 + ai * 128 + m * 16; const float r1 = rs[ai * 4 + m];
                        f32x4 x[2][2]; float ss = 0.f;
#pragma unroll
                        for (int bj = 0; bj < 2; ++bj)
#pragma unroll
                            for (int n = 0; n < 2; ++n) { x[bj][n] = acc[ai][bj][m][n] * r1; const f32x4 t = x[bj][n] * x[bj][n]; ss += (t[0] + t[1]) + (t[2] + t[3]); }
                        ss += __shfl_xor(ss, 16); ss += __shfl_xor(ss, 32);
                        const float rn = __builtin_amdgcn_rsqf(ss * (1.0f / 64.0f) + NORM_EPS);
                        bf16_t* dst = pn < 4 ? q + (size_t)row * 1024 + (4 * pn + wc) * 64 + 8 * fq : k + (size_t)row * 256 + wc * 64 + 8 * fq;
#pragma unroll
                        for (int bj = 0; bj < 2; ++bj) {
                            const f32x4 c4 = cs[mm][bj][0], s4 = cs[mm][bj][1];
                            const f32x4 y1 = x[bj][0] * rn * G[bj][0], y2 = x[bj][1] * rn * G[bj][1];
                            const f32x4 o1 = y1 * c4 - y2 * s4, o2 = y2 * c4 + y1 * s4;
                            *(u32x4*)(dst + 32 * bj) = pack8(o1, o2);
                        }
                    }
                    asm volatile("" ::: "memory");
                }
        } else if (pn < 10) {
            bf16_t* base; int pitch, c0;
            if (pn == 5) { base = v; pitch = 256; c0 = 0; } else { base = cb; pitch = 1024; c0 = 256 * (pn - 6); }
#pragma unroll
            for (int ai = 0; ai < 2; ++ai)
#pragma unroll
                for (int m = 0; m < 4; ++m) {
                    const int row = row0 + ai * 128 + m * 16; const float r1 = rs[ai * 4 + m];
#pragma unroll
                    for (int bj = 0; bj < 2; ++bj) *(u32x4*)(base + (size_t)row * pitch + c0 + 128 * bj + wc * 32 + 8 * fq) = pack8(acc[ai][bj][m][0] * r1, acc[ai][bj][m][1] * r1);
                }
        } else {
#pragma unroll
            for (int ai = 0; ai < 2; ++ai)
#pragma unroll
                for (int m = 0; m < 4; ++m) {
                    const int row = row0 + ai * 128 + m * 16; const float r1 = rs[ai * 4 + m], rs2 = r1 * r1;
                    *(u32x4*)(z + (size_t)row * 1024 + 128 * (pn - 10) + wc * 32 + 8 * fq) = pack8(acc[ai][0][m][0] * acc[ai][1][m][0] * rs2, acc[ai][0][m][1] * acc[ai][1][m][1] * rs2);
                }
        }
    }
};
struct EpiMerge {
    static constexpr bool PERM = true, AFTER_DRAIN = false;
    bf16_t* merged; u32x4* scr; const float* ssq; int tid;
    __device__ __forceinline__ void operator()(const Acc& acc, const Unit& u, int wr, int wc, int fr, int fq) const {
        const int sub = u.sub; const int row0 = u.pm * 256 + wr * 64 + fr;
        char* mb = (char*)(merged + (size_t)row0 * DM + u.pn * 256 + wc * 32 + 8 * fq); asm volatile("" : "+v"(mb));
        char* sb = (char*)(scr + tid); asm volatile("" : "+v"(sb));
#define MP(ai, m, bj) ((u32x4*)(mb + ((ai) * 128 + (m) * 16) * (DM * 2) + (bj) * 256))
#define SP(ai, m, bj) ((u32x4*)(sb + ((((ai) * 4 + (m)) * 2 + (bj)) * 512) * 16))
        if ((sub & 1) == 0) {
            float rs[8]; rstd8(ssq, row0, fq, rs);
#pragma unroll
            for (int ai = 0; ai < 2; ++ai)
#pragma unroll
                for (int m = 0; m < 4; ++m) {
                    const float r1 = rs[ai * 4 + m];
#pragma unroll
                    for (int bj = 0; bj < 2; ++bj) {
                        f32x4 s0, s1; const f32x4 v0 = acc[ai][bj][m][0], v1 = acc[ai][bj][m][1];
#pragma unroll
                        for (int e = 0; e < 4; ++e) { s0[e] = sigmoidf_(v0[e] * r1); s1[e] = sigmoidf_(v1[e] * r1); }
                        if (sub == 0) *MP(ai, m, bj) = pack8(s0, s1); else *SP(ai, m, bj) = pack8(s0, s1);
                    }
                }
        } else if (sub == 1) {
#pragma unroll
            for (int ai = 0; ai < 2; ++ai) {
                u32x4 g[4][2];
#pragma unroll
                for (int m = 0; m < 4; ++m)
#pragma unroll
                    for (int bj = 0; bj < 2; ++bj) g[m][bj] = *MP(ai, m, bj);
#pragma unroll
                for (int m = 0; m < 4; ++m)
#pragma unroll
                    for (int bj = 0; bj < 2; ++bj) { f32x4 g0, g1; unpack8(g[m][bj], g0, g1); *MP(ai, m, bj) = pack8(g0 * acc[ai][bj][m][0], g1 * acc[ai][bj][m][1]); }
                asm volatile("" ::: "memory");
            }
        } else {
#pragma unroll
            for (int ai = 0; ai < 2; ++ai)
#pragma unroll
                for (int mp = 0; mp < 2; ++mp) {
                    u32x4 c[2][2], s[2][2];
#pragma unroll
                    for (int mm = 0; mm < 2; ++mm)
#pragma unroll
                        for (int bj = 0; bj < 2; ++bj) { c[mm][bj] = *MP(ai, 2 * mp + mm, bj); s[mm][bj] = *SP(ai, 2 * mp + mm, bj); }
#pragma unroll
                    for (int mm = 0; mm < 2; ++mm)
#pragma unroll
                        for (int bj = 0; bj < 2; ++bj) { const int m = 2 * mp + mm; f32x4 c0, c1, s0, s1; unpack8(c[mm][bj], c0, c1); unpack8(s[mm][bj], s0, s1);
                            *MP(ai, m, bj) = pack8(c0 + s0 * acc[ai][bj][m][0], c1 + s1 * acc[ai][bj][m][1]); }
                    asm volatile("" ::: "memory");
                }
        }
#undef MP
#undef SP
    }
};

__device__ __forceinline__ void cvt_item(const float* W, int Nsrc, int n0src, const float* gain, bool permqk, bf16* WT, int K, int nrow0, int k0, LAS float* scr, int lane) {
#pragma unroll 8
    for (int i = 0; i < 32; ++i) { const int kk = 2 * i + (lane >> 5); float w = W[(size_t)(k0 + kk) * Nsrc + n0src + (lane & 31)]; if (gain) w *= gain[k0 + kk]; scr[kk * 33 + (lane & 31)] = w; }
    asm volatile("s_waitcnt lgkmcnt(0)" ::: "memory");
    const int c = lane & 7;
#pragma unroll
    for (int j = 0; j < 4; ++j) { const int n = (lane >> 3) + 8 * j; const int ns = permqk ? (16 * ((n >> 2) & 1) + 4 * (n >> 3) + (n & 3)) : n; const LAS float* s = scr + (8 * c) * 33 + ns;
        v4u o; o.x = pk2(s[0 * 33], s[1 * 33]); o.y = pk2(s[2 * 33], s[3 * 33]); o.z = pk2(s[4 * 33], s[5 * 33]); o.w = pk2(s[6 * 33], s[7 * 33]);
        *(GAS v4u*)(WT + (size_t)(nrow0 + n) * K + k0 + 8 * c) = o; }
    asm volatile("s_waitcnt lgkmcnt(0)" ::: "memory");
}
#define RLX_AGENT __ATOMIC_RELAXED, __HIP_MEMORY_SCOPE_AGENT
#define XB_TMO      128
#define XB_XCNT(j)  (256  + 64 * (j))
#define XB_XSUB(j)  (1280 + 64 * (j))
#define XB_XGEN(j)  (2304 + 64 * (j))
#define XB_TOP      3328
#define XB_TOPGEN   3392
#define XCD_BAR_WORDS 3456
#define XB_SPIN_CAP (1u << 18)

__device__ __forceinline__ unsigned xb_ld(unsigned* p)              { return __hip_atomic_load(p, __ATOMIC_RELAXED, __HIP_MEMORY_SCOPE_AGENT); }
__device__ __forceinline__ unsigned xb_add(unsigned* p, unsigned v) { return __hip_atomic_fetch_add(p, v, __ATOMIC_RELAXED, __HIP_MEMORY_SCOPE_AGENT); }
__device__ __forceinline__ unsigned xb_xcc_id() { return (unsigned)__builtin_amdgcn_s_getreg((3 << 11) | 20) & 0xFu; }
#define XB_SPIN(cond, bar) do { unsigned _sp = 0; while (cond) { __builtin_amdgcn_s_sleep(1); \
    if ((++_sp & 255u) == 0u) { if (xb_ld(&(bar)[XB_TMO])) break; if (_sp > XB_SPIN_CAP) { atomicAdd(&(bar)[XB_TMO], 1u); break; } } } } while (0)

struct XcdBarrier {
    unsigned* bar; unsigned x;
    volatile LAS unsigned* st;
};

__device__ __forceinline__ XcdBarrier xcd_barrier_post(unsigned* bar, volatile LAS unsigned* st) {
    XcdBarrier b; b.bar = bar; b.x = xb_xcc_id(); b.st = st;
    if (threadIdx.x == 0) (void)xb_add(&bar[XB_XCNT(b.x)], 1u);
    return b;
}
__device__ __forceinline__ void xcd_barrier_complete(unsigned* bar, unsigned x, unsigned& nloc, unsigned& nx) {
    const unsigned G = gridDim.x * gridDim.y * gridDim.z;
    unsigned sum, cnt, mine, sp = 0u;
    for (;;) {
        sum = 0u; cnt = 0u; mine = 0u;
#pragma unroll
        for (unsigned j = 0; j < 16; ++j) { const unsigned c = xb_ld(&bar[XB_XCNT(j)]); sum += c; cnt += (c > 0u) ? 1u : 0u; mine = (j == x) ? c : mine; }
        if (sum == G) break;
        __builtin_amdgcn_s_sleep(1);
        if ((++sp & 255u) == 0u) { if (xb_ld(&bar[XB_TMO])) break; if (sp > XB_SPIN_CAP) { atomicAdd(&bar[XB_TMO], 1u); break; } }
    }
    nloc = mine > 0u ? mine : 1u; nx = cnt > 0u ? cnt : 1u;
}

__device__ __forceinline__ void xcd_barrier(const XcdBarrier& b) {
    asm volatile("s_waitcnt vmcnt(0)" ::: "memory");
    __syncthreads();
    if (threadIdx.x == 0) {
        unsigned* bar = b.bar;
        __builtin_amdgcn_s_waitcnt(0);
        unsigned nloc = b.st[0], nx = b.st[1];
        if (nloc == 0u) { xcd_barrier_complete(bar, b.x, nloc, nx); b.st[0] = nloc; b.st[1] = nx; }
        const unsigned old = xb_add(&bar[XB_XSUB(b.x)], 1u);
        const unsigned gen = old / nloc;
        if (old + 1u == (gen + 1u) * nloc) {
            __builtin_amdgcn_fence(__ATOMIC_RELEASE, "agent");
            asm volatile("s_waitcnt vmcnt(0)" ::: "memory");
            const unsigned og = xb_add(&bar[XB_TOP], 1u);
            const unsigned tg = og / nx;
            if (og + 1u == (tg + 1u) * nx) xb_add(&bar[XB_TOPGEN], 1u);
            else XB_SPIN(xb_ld(&bar[XB_TOPGEN]) == tg, bar);
            __builtin_amdgcn_fence(__ATOMIC_ACQUIRE, "agent");
            xb_add(&bar[XB_XGEN(b.x)], 1u);
            asm volatile("s_waitcnt vmcnt(0)" ::: "memory");
        } else {
            XB_SPIN(xb_ld(&bar[XB_XGEN(b.x)]) == gen, bar);
            __builtin_amdgcn_fence(__ATOMIC_ACQUIRE, "agent");
            asm volatile("s_waitcnt vmcnt(0)" ::: "memory");
        }
    }
    __syncthreads();
}
struct Args { const float* in[21]; float* out; unsigned char* ws; int ph_lo, ph_hi; };
struct PT {
    volatile LAS unsigned long long* t;
    __device__ __forceinline__ unsigned long long get(int i) const { const unsigned long long v = t[i]; const unsigned lo = __builtin_amdgcn_readfirstlane((unsigned)v), hi = __builtin_amdgcn_readfirstlane((unsigned)(v >> 32)); return ((unsigned long long)hi << 32) | lo; }
    __device__ __forceinline__ const float* in(int i) const { return (const float*)(const GAS float*)get(i); }
    __device__ __forceinline__ float* out() const { return (float*)(GAS float*)get(21); }
    __device__ __forceinline__ unsigned char* ws() const { return (unsigned char*)(GAS unsigned char*)get(22); }
};

__device__ __forceinline__ void cvt_one(const PT a, unsigned char* ws, int l, LAS unsigned char* lds, int it, int wave, int lane) {
    LAS float* scr = (LAS float*)(lds + wave * 16384);
    bf16* W = (bf16*)(ws + WS_W + (size_t)(l & 1) * WBUF);
    const size_t ffo = (size_t)l * DM * FF, sqo = (size_t)l * DM * DM;
    const float* win = a.in(8) + (size_t)l * DM * 6656; const float* mixg = a.in(7) + l * DM;
    {
        int r = it;
        if (r < 2816) { const int kb = r / 176, nb = r % 176, pn = nb >> 3, t = nb & 7; const float* src = (t >> 2) ? a.in(5) + ffo : a.in(4) + ffo;
            cvt_item(src, FF, 128 * pn + 32 * (t & 3), a.in(3) + l * DM, false, (bf16*)((char*)W + W_GU1), 1024, nb * 32, kb * 64, scr, lane); return; } r -= 2816;
        if (r < 1408) { const int kb = r / 32, nb = r % 32; cvt_item(a.in(6) + ffo, DM, nb * 32, nullptr, false, (bf16*)((char*)W + W_D1), FF, nb * 32, kb * 64, scr, lane); return; } r -= 1408;
        if (r < 2304) { const int kb = r / 144, nb = r % 144, pn = nb >> 3, t = nb & 7; int n0; bool pq = false;
            if (pn < 4) { n0 = 64 * (4 * pn + (t & 3)) + 32 * (t >> 2); pq = true; }
            else if (pn == 4) { n0 = 1024 + 64 * (t & 3) + 32 * (t >> 2); pq = true; }
            else if (pn == 5) n0 = 1280 + 32 * t;
            else if (pn < 10) n0 = 1536 + 256 * (pn - 6) + 32 * t;
            else n0 = ((t >> 2) ? 3584 : 2560) + 128 * (pn - 10) + 32 * (t & 3);
            cvt_item(win, 6656, n0, mixg, pq, (bf16*)((char*)W + W_IN), 1024, nb * 32, kb * 64, scr, lane); return; } r -= 2304;
        if (r < 2560) { const int seg = r / 512, q = r % 512, kb = q / 32, nb = q % 32;
            const float* src; int ns, n0; const float* gn = nullptr; size_t dst;
            if (seg == 0) { src = win; ns = 6656; n0 = 5632 + nb * 32; gn = mixg; dst = W_GC; }
            else if (seg == 1) { src = a.in(14) + sqo; ns = DM; n0 = nb * 32; dst = W_OC; }
            else if (seg == 2) { src = win; ns = 6656; n0 = 4608 + nb * 32; gn = mixg; dst = W_GA; }
            else if (seg == 3) { src = a.in(13) + sqo; ns = DM; n0 = nb * 32; dst = W_OA; }
            else { src = a.in(15) + sqo; ns = DM; n0 = nb * 32; dst = W_M; }
            cvt_item(src, ns, n0, gn, false, (bf16*)((char*)W + dst), 1024, nb * 32, kb * 64, scr, lane); return; } r -= 2560;
        if (r < 2816) { const int kb = r / 176, nb = r % 176, pn = nb >> 3, t = nb & 7; const float* src = (t >> 2) ? a.in(18) + ffo : a.in(17) + ffo;
            cvt_item(src, FF, 128 * pn + 32 * (t & 3), a.in(16) + l * DM, false, (bf16*)((char*)W + W_GU2), 1024, nb * 32, kb * 64, scr, lane); return; } r -= 2816;
        { const int kb = r / 32, nb = r % 32; cvt_item(a.in(19) + ffo, DM, nb * 32, nullptr, false, (bf16*)((char*)W + W_D2), FF, nb * 32, kb * 64, scr, lane); }
    }
}

constexpr int CVT_ITEMS = 13312;
__device__ __forceinline__ void convert_static(const PT a, unsigned char* ws, int l, LAS unsigned char* lds, int gw, int NGW, int wave, int lane) {
    for (int it = gw; it < CVT_ITEMS; it += NGW) cvt_one(a, ws, l, lds, it, wave, lane);
}
__device__ __forceinline__ void convert_dynamic(const PT a, unsigned char* ws, int l, LAS unsigned char* lds, unsigned* ctr, int lo, int hi, int wave, int lane) {
    for (;;) {
        unsigned b = 0; if (lane == 0) b = atomicAdd(ctr, 4u);
        const int base = lo + (int)__builtin_amdgcn_readfirstlane(b);
        if (base >= hi) break;
        for (int k = 0; k < 4; ++k) { if (base + k < hi) cvt_one(a, ws, l, lds, base + k, wave, lane); }
    }
}
__device__ __forceinline__ void prologue(const PT a, unsigned char* ws, int tid, int wave, int lane, int bid, int G) {
    const int gtid = bid * 512 + tid, GT = G * 512, gw = bid * NWAVES + wave, NGW = G * NWAVES;
    float* ssq = (float*)(ws + WS_SSQ); bf16* hb = (bf16*)(ws + WS_HB); float* rope = (float*)(ws + WS_ROPE);
    for (int i = gtid; i < (TPAD - T_ROWS) * 16; i += GT) ssq[(size_t)T_ROWS * 16 + i] = 0.f;
    for (int i = gtid; i < (TPAD - T_ROWS) * DM / 8; i += GT) ((v4u*)(hb + (size_t)T_ROWS * DM))[i] = (v4u){0u, 0u, 0u, 0u};
    if (gtid < 64) ((unsigned*)(ws + WS_CTL))[gtid] = 0u;
    for (int i = gtid; i < LP * 32; i += GT) {
        const int pos = i >> 5, axis = (i >> 4) & 1, f = i & 15;
        float coord; if (pos < 16) coord = axis ? (float)pos : -1.0f; else { const int t = pos - 16; coord = axis ? (float)(t & 63) : (float)(t >> 6); }
        const float inv = powf(10000.0f, -(float)f * (1.0f / 16.0f)); const float ang = coord * inv;
        float s, c; sincosf(ang, &s, &c);
        rope[((pos * 2 + axis) * 2 + 0) * 16 + f] = c; rope[((pos * 2 + axis) * 2 + 1) * 16 + f] = s;
    }
    for (int r = gw; r < T_ROWS; r += NGW) {
        int pos, L; rowinfo(r, pos, L);
        const float* src;
        if (pos < 16) src = a.in(2) + (size_t)pos * DM;
        else if (r < ROWS_P) src = a.in(0) + ((size_t)(r / LP) * 4096 + pos - 16) * DM;
        else src = a.in(1) + ((size_t)((r - ROWS_P) / LS) * 2048 + pos - 16) * DM;
        f32x4 v[4]; float s = 0.f;
        unsigned long long* o8 = (unsigned long long*)(hb + (size_t)r * DM) + lane;
#pragma unroll
        for (int j = 0; j < 4; ++j) { v[j] = ((const f32x4*)src)[lane + 64 * j];
            const unsigned lo = pk2(v[j][0], v[j][1]), hi = pk2(v[j][2], v[j][3]); o8[64 * j] = (unsigned long long)lo | ((unsigned long long)hi << 32);
            const float a0 = bflo(lo), a1 = bfhi(lo), a2 = bflo(hi), a3 = bfhi(hi); s += (a0 * a0 + a1 * a1) + (a2 * a2 + a3 * a3); }
        s = wave_sum(s);
        if (lane < 16) ssq[(size_t)r * 16 + lane] = lane == 0 ? s : 0.f;
    }
}

__device__ __forceinline__ void conv_phase(const PT a, unsigned char* ws, int l, int tid, int bid, int G) {
    bf16* cb = (bf16*)(ws + WS_CB); const bf16* z = (const bf16*)(ws + WS_Z);
    const float* cw = a.in(9) + (size_t)l * 3 * DM; const float* cbias = a.in(10) + (size_t)l * DM;
    const int chunk = tid & 127, sub = tid >> 7, c0 = chunk * 8;
    f32x4 w0[2], w1[2], w2[2], bb[2];
#pragma unroll
    for (int h = 0; h < 2; ++h) { w0[h] = *(const f32x4*)(cw + c0 + 4 * h); w1[h] = *(const f32x4*)(cw + DM + c0 + 4 * h); w2[h] = *(const f32x4*)(cw + 2 * DM + c0 + 4 * h); bb[h] = *(const f32x4*)(cbias + c0 + 4 * h); }
    const int nstrip = (T_ROWS + 63) / 64;
    for (int strip = bid; strip < nstrip; strip += G) {
        const int r0 = strip * 64 + sub * 16;
#pragma unroll 4
        for (int i = 0; i < 16; ++i) {
            const int r = r0 + i; if (r >= T_ROWS) break;
            int pos, L; rowinfo(r, pos, L);
            const u32x4 zero = (u32x4){0u, 0u, 0u, 0u};
            const u32x4 zc = *(const u32x4*)(z + (size_t)r * DM + c0);
            const u32x4 zp = pos > 0 ? *(const u32x4*)(z + (size_t)(r - 1) * DM + c0) : zero;
            const u32x4 zn = pos < L - 1 ? *(const u32x4*)(z + (size_t)(r + 1) * DM + c0) : zero;
            u32x4* cp = (u32x4*)(cb + (size_t)r * DM + c0); const u32x4 cv = *cp;
            f32x4 p0, p1, c0v, c1v, n0, n1, b0, b1; unpack8(zp, p0, p1); unpack8(zc, c0v, c1v); unpack8(zn, n0, n1); unpack8(cv, b0, b1);
            const f32x4 o0 = b0 * (w0[0] * p0 + w1[0] * c0v + w2[0] * n0 + bb[0]), o1 = b1 * (w0[1] * p1 + w1[1] * c1v + w2[1] * n1 + bb[1]);
            *cp = pack8(o0, o1);
        }
    }
}

__device__ __forceinline__ void attention_phase(const PT a, unsigned char* ws, int l, unsigned char* lds_generic, int tid, bool dry = false) {
    using abf = attn_body::bf16;
    const abf* Q = (const abf*)(ws + WS_Q); const abf* K = (const abf*)(ws + WS_K); const abf* V = (const abf*)(ws + WS_V); abf* O = dry ? (abf*)(ws + WS_END + MiB) : (abf*)(ws + WS_Q);
    unsigned* ctr = (unsigned*)(ws + WS_CTL) + l + (dry ? 8 : 0);
    volatile unsigned* slot = (volatile unsigned*)(lds_generic + MISC_OFF);
    for (;;) {
        if (tid == 0) *slot = atomicAdd(ctr, 1u);
        __syncthreads();
        const int u = (int)__builtin_amdgcn_readfirstlane(*slot);
        if (u >= ATT_UNITS) break;
        int tidu = tid; asm volatile("" : "+v"(tidu));
        if (u < ATT_UNITS_P) { const int s = u / 260, rem = u - s * 260, kvh = rem / 65, qblk = rem - kvh * 65;
            attn_body::attn_unit<8, LP, 66>((long)s * LP, kvh, qblk, Q, K, V, O, (char*)lds_generic, tidu); }
        else { const int u2 = u - ATT_UNITS_P, s = u2 / 132, rem = u2 - s * 132, kvh = rem / 33, qblk = rem - kvh * 33;
            attn_body::attn_unit<8, LS, 34>((long)ROWS_P + (long)s * LS, kvh, qblk, Q, K, V, O, (char*)lds_generic, tidu); }
    }
}

__device__ __forceinline__ void final_phase(const PT a, unsigned char* ws, int wave, int lane, int bid, int G) {
    const int gw = bid * NWAVES + wave, NGW = G * NWAVES;
    const float* ssq = (const float*)(ws + WS_SSQ); const bf16* hb = (const bf16*)(ws + WS_HB); float* out = a.out();
    f32x4 g[4];
#pragma unroll
    for (int j = 0; j < 4; ++j) g[j] = ((const f32x4*)a.in(20))[lane + 64 * j];
    for (int r = gw; r < T_ROWS; r += NGW) {
        int pos, L; rowinfo(r, pos, L); if (pos < 16) continue;
        float* p = r < ROWS_P ? out + ((size_t)(r / LP) * 4096 + pos - 16) * DM : out + (size_t)NSEQ_P * 4096 * DM + ((size_t)((r - ROWS_P) / LS) * 2048 + pos - 16) * DM;
        const float rs = rstd_of(ssq, r);
        const unsigned long long* i8 = (const unsigned long long*)(hb + (size_t)r * DM) + lane;
#pragma unroll
        for (int j = 0; j < 4; ++j) { const unsigned long long w = i8[64 * j]; const unsigned lo = (unsigned)w, hi = (unsigned)(w >> 32);
            const f32x4 v = (f32x4){bflo(lo), bfhi(lo), bflo(hi), bfhi(hi)}; ((f32x4*)p)[lane + 64 * j] = v * rs * g[j]; }
    }
}

constexpr int NSTEPS = 2 + 8 * NLAYER;

template <int STEP>
__device__ __forceinline__ void run_step(const PT pt, unsigned char* lds, cg::grid_group& grid, XcdBarrier& bar, const int ph_lo, const int ph_hi) {
#ifdef MAX_STEP
    if (STEP >= MAX_STEP && STEP != NSTEPS - 1) return;
#endif
    if (STEP < ph_lo || STEP >= ph_hi) return;
    if (STEP > ph_lo) {
        if (STEP == ph_lo + 1) {
            asm volatile("s_waitcnt vmcnt(0)" ::: "memory"); grid.sync();
            bar = xcd_barrier_post((unsigned*)(pt.ws() + WS_CTL) + CW_BAR, (volatile LAS unsigned*)((LAS unsigned char*)lds + MISC_OFF + 32));
        } else xcd_barrier(bar);
#ifdef DUP_SYNC
        xcd_barrier(bar); xcd_barrier(bar);
#endif
    }
    LAS unsigned char* l3 = (LAS unsigned char*)lds;
    int tid = threadIdx.x; asm volatile("" : "+v"(tid));
    int bid = blockIdx.x; asm volatile("" : "+s"(bid));
    int G = gridDim.x; asm volatile("" : "+s"(G));
    unsigned char* ws = pt.ws();
    const int lane = tid & 63, wave = __builtin_amdgcn_readfirstlane(tid >> 6);
    const int gw = bid * NWAVES + wave, NGW = G * NWAVES;
    float* ssq = (float*)(ws + WS_SSQ);
    bf16_t* hb = (bf16_t*)(ws + WS_HB);
    if constexpr (STEP == 0) { prologue(pt, ws, tid, wave, lane, bid, G); convert_static(pt, ws, 0, l3, gw, NGW, wave, lane); __syncthreads(); }
    else if constexpr (STEP == NSTEPS - 1) { final_phase(pt, ws, wave, lane, bid, G); }
    else {
        constexpr int l = (STEP - 1) / 8, ph = (STEP - 1) % 8 + 1;
        unsigned char* wl = ws + WS_W + (size_t)(l & 1) * WBUF;
        if constexpr (ph == 0) {
        } else if constexpr (ph == 1 || ph == 7) {
            constexpr int f = ph == 7;
            PlainOrder S; S.init(TPAD, 2 * FF, G, bid); S.A = (const char*)hb; S.Bt = (const char*)(wl + (f ? W_GU2 : W_GU1)); S.tstep = (size_t)256 * 1024 * 2;
            pg8::Gemm g{nullptr, nullptr, TPAD, 2 * FF, 1024};
            EpiSwiGLU E{(bf16_t*)(ws + WS_HID), ssq};
#ifndef NO_GU
            pg8::gemm_phase<EpiSwiGLU, PlainOrder, true, true>(l3, g, S, E, tid);
#ifdef DUP_GU
            __syncthreads();
            pg8::gemm_phase<EpiSwiGLU, PlainOrder, true, true>(l3, g, S, E, tid);
#endif
#endif
        } else if constexpr (ph == 2 || ph == 6 || ph == 8) {
            constexpr int f = ph == 8; constexpr int K = ph == 6 ? 1024 : FF;
            PlainOrder S; S.init(TPAD, DM, G, bid);
            S.A = ph == 6 ? (const char*)(ws + WS_Z) : (const char*)(ws + WS_HID);
            S.Bt = (const char*)(wl + (ph == 6 ? W_M : (f ? W_D2 : W_D1))); S.tstep = (size_t)256 * K * 2;
            pg8::Gemm g{nullptr, nullptr, TPAD, DM, K};
            EpiResid E{hb, ssq, ph == 6 ? 1.0f : 0.5f};
#ifndef NO_RES
            pg8::gemm_phase<EpiResid, PlainOrder, true, true>(l3, g, S, E, tid);
#endif
            if constexpr (l + 1 < NLAYER) {
                constexpr int part = ph == 2 ? 0 : (ph == 6 ? 1 : 2); constexpr int lo = part * (CVT_ITEMS / 3), hi = part == 2 ? CVT_ITEMS : (part + 1) * (CVT_ITEMS / 3);
                convert_dynamic(pt, ws, l + 1, l3, (unsigned*)(ws + WS_CTL) + 16 + 4 * l + part, lo, hi, wave, lane);
                __syncthreads();
            }
        } else if constexpr (ph == 3) {
            PlainOrder S; S.init(TPAD, NWIN, G, bid); S.A = (const char*)hb; S.Bt = (const char*)(wl + W_IN); S.tstep = (size_t)256 * 1024 * 2;
            pg8::Gemm g{nullptr, nullptr, TPAD, NWIN, 1024};
            EpiWin E{(bf16_t*)(ws + WS_Q), (bf16_t*)(ws + WS_K), (bf16_t*)(ws + WS_V), (bf16_t*)(ws + WS_CB), (bf16_t*)(ws + WS_Z), ssq,
                     (const float*)(ws + WS_ROPE), pt.in(11) + l * 64, pt.in(12) + l * 64};
#ifndef NO_WIN
            pg8::gemm_phase<EpiWin, PlainOrder, true, true>(l3, g, S, E, tid);
#ifdef DUP_WIN
            __syncthreads();
            pg8::gemm_phase<EpiWin, PlainOrder, true, true>(l3, g, S, E, tid);
#endif
#endif
        } else if constexpr (ph == 4) {
#ifndef NO_CONV
            conv_phase(pt, ws, l, tid, bid, G);
#endif
#ifdef DUP_ATT
            attention_phase(pt, ws, l, lds, tid, true); __syncthreads();
#endif
#ifndef NO_ATT
            attention_phase(pt, ws, l, lds, tid);
#endif
        } else {
            ChainOrder S; S.base.init(TPAD, DM, G, bid); S.tstep = (size_t)256 * 1024 * 2;
            S.A[0] = (const char*)hb; S.A[1] = (const char*)(ws + WS_CB); S.A[2] = (const char*)hb; S.A[3] = (const char*)(ws + WS_Q);
            S.B[0] = (const char*)(wl + W_GC); S.B[1] = (const char*)(wl + W_OC); S.B[2] = (const char*)(wl + W_GA); S.B[3] = (const char*)(wl + W_OA);
            pg8::Gemm g{nullptr, nullptr, TPAD, DM, 1024};
            EpiMerge E{(bf16_t*)(ws + WS_Z), (u32x4*)(ws + WS_SCR + (size_t)bid * 131072), ssq, tid};
#ifndef NO_MERGE
            pg8::gemm_phase<EpiMerge, ChainOrder, true, true>(l3, g, S, E, tid);
#ifdef DUP_MERGE
            __syncthreads();
            pg8::gemm_phase<EpiMerge, ChainOrder, true, true>(l3, g, S, E, tid);
#endif
#endif
        }
    }
}
template <int STEP>
__device__ __forceinline__ void run_from(const PT pt, unsigned char* lds, cg::grid_group& grid, XcdBarrier& bar, const int ph_lo, const int ph_hi) {
    run_step<STEP>(pt, lds, grid, bar, ph_lo, ph_hi);
    if constexpr (STEP + 1 < NSTEPS) run_from<STEP + 1>(pt, lds, grid, bar, ph_lo, ph_hi);
}

__global__ void __launch_bounds__(NWAVES * 64, 2) mega_fwd(Args args) {
    extern __shared__ __attribute__((aligned(16))) unsigned char lds[];
    cg::grid_group grid = cg::this_grid();
    PT pt; pt.t = (volatile LAS unsigned long long*)((LAS unsigned char*)lds + PTAB_OFF);
    if (threadIdx.x == 0) {
#pragma unroll
        for (int i = 0; i < 21; ++i) pt.t[i] = (unsigned long long)args.in[i];
        pt.t[21] = (unsigned long long)args.out; pt.t[22] = (unsigned long long)args.ws;
    }
    if (threadIdx.x < 8) ((volatile LAS unsigned*)((LAS unsigned char*)lds + MISC_OFF + 32))[threadIdx.x] = 0u;
    const int ph_lo = args.ph_lo, ph_hi = args.ph_hi;
    if (blockIdx.x == 0) { unsigned* bw = (unsigned*)(args.ws + WS_CTL) + CW_BAR; for (int i = threadIdx.x; i < XCD_BAR_WORDS; i += NWAVES * 64) bw[i] = 0u; }
    __syncthreads();
    XcdBarrier bar; bar.bar = nullptr; bar.x = 0; bar.st = nullptr;
    run_from<0>(pt, lds, grid, bar, ph_lo, ph_hi);
}

#ifndef LAUNCH_PER_STEP
#define LAUNCH_PER_STEP 0
#endif
extern "C" void kernel_launch(void* const* d_in, const int* in_sizes, int n_in, void* d_out, int out_size, void* d_ws, size_t ws_size, hipStream_t stream) {
    static int grid = 0;
    if (grid == 0) {
        if (n_in != 21 || ws_size < WS_END) { fprintf(stderr, "kernel_launch: need 21 inputs and >= %zu bytes of workspace; got %d, %zu\n", (size_t)WS_END, n_in, ws_size); grid = -1; return; }
        int dev = 0, cus = 0, per_cu = 0;
        hipGetDevice(&dev); hipDeviceGetAttribute(&cus, hipDeviceAttributeMultiprocessorCount, dev);
        if (hipFuncSetAttribute((const void*)mega_fwd, hipFuncAttributeMaxDynamicSharedMemorySize, LDS_BYTES) != hipSuccess) { fprintf(stderr, "kernel_launch: hipFuncSetAttribute failed\n"); grid = -1; return; }
        if (hipOccupancyMaxActiveBlocksPerMultiprocessor(&per_cu, (const void*)mega_fwd, NWAVES * 64, LDS_BYTES) != hipSuccess || per_cu < 1) per_cu = 1;
        (void)hipGetLastError();
        grid = cus * per_cu;
    }
    if (grid < 0) return;
    Args a{};
    for (int i = 0; i < 21; ++i) a.in[i] = (const float*)d_in[i];
    a.out = (float*)d_out; a.ws = (unsigned char*)d_ws;
#if LAUNCH_PER_STEP
    for (int s = 0; s < NSTEPS; ++s) { a.ph_lo = s; a.ph_hi = s + 1; void* kargs[] = {&a}; hipLaunchCooperativeKernel((void*)mega_fwd, dim3(grid), dim3(NWAVES * 64), kargs, LDS_BYTES, stream); }
#else
    a.ph_lo = 0; a.ph_hi = NSTEPS; void* kargs[] = {&a};
    hipError_t e = hipLaunchCooperativeKernel((void*)mega_fwd, dim3(grid), dim3(NWAVES * 64), kargs, LDS_BYTES, stream);
    if (e != hipSuccess) fprintf(stderr, "cooperative launch failed: %s (grid %d)\n", hipGetErrorString(e), grid);
#endif
}
```

```cpp
#include <hip/hip_runtime.h>
#include <hip/hip_cooperative_groups.h>
#include <hip/hip_bf16.h>
#include <cstdio>
#include <cstdint>
#include <cmath>
namespace cg = cooperative_groups;
namespace pg8 {
#define PG8_LAS __attribute__((address_space(3)))
typedef unsigned short bf16_t;
typedef short bf16x8 __attribute__((ext_vector_type(8)));
typedef float f32x4 __attribute__((ext_vector_type(4)));
typedef unsigned u32x4 __attribute__((ext_vector_type(4)));
constexpr int BM = 256, BK = 64, HALF = 128, HTB = HALF * BK * 2  , STAGE_BYTES = 8 * HTB, NXCD = 8, WGM = 8;

__host__ __device__ __forceinline__ int lds_byte(int r, int c) { const int st = (r >> 4) * 2 + (c >> 5), rr = r & 15, cc = c & 31, ob = rr * 64 + cc * 2; return st * 1024 + (ob ^ (((ob >> 9) & 1) << 5)); }
__host__ __device__ __forceinline__ void stage_rc(int b, int& R, int& C) { const int st = b / 1024, sb = b % 1024, swz = sb ^ (((sb >> 9) & 1) << 5); R = (st >> 1) * 16 + swz / 64; C = (st & 1) * 32 + (swz % 64) / 2; }
__host__ __device__ __forceinline__ int perm32(int rho) { const int n = rho >> 4, i = rho & 15; return 8 * (i >> 2) + 4 * n + (i & 3); }

struct Unit { int pm, pn, sub; };
struct Gemm { const bf16_t* A; const bf16_t* Bt; int M, N, K; };

struct StaticOrder {
    int nM, nN, nwg, G, c;
    __host__ __device__ void init(int M, int N, int G_, int c_) { nM = M / BM; nN = N / BM; nwg = nM * nN; G = G_; c = c_; }
    __host__ __device__ bool next(int i, Unit& u) const {
        const long L = (long)i * G + c; if (L >= nwg) return false;
        int wgid = (int)L; { const int q = nwg / NXCD, r = nwg % NXCD, xcd = wgid % NXCD, off = wgid / NXCD; wgid = (xcd < r ? xcd * (q + 1) : r * (q + 1) + (xcd - r) * q) + off; }
        const int nig = WGM * nN, gid = wgid / nig, fm = gid * WGM, gsz = (nM - fm) < WGM ? (nM - fm) : WGM;
        u.pm = fm + ((wgid % nig) % gsz); u.pn = (wgid % nig) / gsz; u.sub = 0; return true;
    }
    __device__ __forceinline__ void a_ready(const Unit&) const {}
    __device__ __forceinline__ void done(const Unit&) const {}
};

__device__ __forceinline__ unsigned cvt_pk_bf16(float lo, float hi) { unsigned r; asm volatile("v_cvt_pk_bf16_f32 %0, %1, %2" : "=v"(r) : "v"(lo), "v"(hi)); return r; }
typedef float f32x2 __attribute__((ext_vector_type(2)));
template <class Epi, class Sched, bool ALIGN_EPI = false, bool SP2 = false>
__device__ __forceinline__ void gemm_phase(PG8_LAS unsigned char* lds, const Gemm g, const Sched& S, const Epi& E, const int tid) {
    const int wid = __builtin_amdgcn_readfirstlane(tid >> 6), lane = tid & 63, wr = wid >> 2, wc = wid & 3, fr = lane & 15, fq = lane >> 4;
    const int K = g.K, nt = K / BK;
    unsigned voffA[2], voffB[2];
#pragma unroll
    for (int i = 0; i < 2; ++i) { int R, C; stage_rc(tid * 16 + i * 8192, R, C); const int Rb = Epi::PERM ? ((R & ~31) + perm32(R & 31)) : R;
        voffA[i] = (unsigned)(R * K + C) * 2u; voffB[i] = (unsigned)(Rb * K + C) * 2u; }
    const size_t kstep = (size_t)(BK * 2);
    const size_t hstep = (size_t)HALF * K * 2;
        const unsigned ldsw = (unsigned)wid * 1024u;
    const int aoff = lds_byte(wr * 64 + fr, fq * 8), boff = lds_byte(wc * 32 + fr, fq * 8);
#define PG8_SA(b, h) (((b) * 2 + (h)) * HTB)
#define PG8_SB(b, h) ((4 + (b) * 2 + (h)) * HTB)
#define PG8_STAGE(bufoff, gbase, voff) do { _Pragma("unroll") for (int _i = 0; _i < 2; ++_i) \
        __builtin_amdgcn_global_load_lds((const unsigned*)((const char*)(gbase) + (voff)[_i]), (PG8_LAS unsigned*)(lds + (bufoff) + ldsw + _i * 8192), 16, 0, 0); } while (0)
#define PG8_LDA(dst, b, h) do { _Pragma("unroll") for (int m = 0; m < 4; ++m) _Pragma("unroll") for (int k = 0; k < 2; ++k) dst[m][k] = *(const PG8_LAS bf16x8*)(lds + PG8_SA(b, h) + aoff + m * 2048 + k * 1024); } while (0)
#define PG8_LDB(dst, b, h) do { _Pragma("unroll") for (int n = 0; n < 2; ++n) _Pragma("unroll") for (int k = 0; k < 2; ++k) dst[n][k] = *(const PG8_LAS bf16x8*)(lds + PG8_SB(b, h) + boff + n * 2048 + k * 1024); } while (0)
#define PG8_MMA(ai, bj, At, Bt) do { __builtin_amdgcn_s_setprio(1); _Pragma("unroll") for (int m = 0; m < 4; ++m) _Pragma("unroll") for (int n = 0; n < 2; ++n) _Pragma("unroll") for (int k = 0; k < 2; ++k) \
        acc[ai][bj][m][n] = __builtin_amdgcn_mfma_f32_16x16x32_bf16(Bt[n][k], At[m][k], acc[ai][bj][m][n], 0, 0, 0); __builtin_amdgcn_s_setprio(0); } while (0)
#define PG8_WAIT_V(n) asm volatile("s_waitcnt vmcnt(" #n ")" ::: "memory")
#define PG8_WAIT_L(n) asm volatile("s_waitcnt lgkmcnt(" #n ")" ::: "memory")
#define PG8_BAR __builtin_amdgcn_s_barrier()
#define PG8_SCHED __builtin_amdgcn_sched_barrier(0)
    Unit cur, nxt; int ui = 0;
    if (!S.next(0, cur)) return;
    f32x4 acc[2][2][4][2];
#pragma unroll
    for (int a = 0; a < 2; ++a)
#pragma unroll
        for (int b = 0; b < 2; ++b)
#pragma unroll
            for (int m = 0; m < 4; ++m)
#pragma unroll
                for (int n = 0; n < 2; ++n) acc[a][b][m][n] = (f32x4){0.f, 0.f, 0.f, 0.f};
    bf16x8 At[4][2], B0[2][2], B1[2][2];
    const char* cA = S.aptr(cur); const char* cB = S.bptr(cur);
    S.a_ready(cur);
    if constexpr (SP2) {
        PG8_STAGE(PG8_SB(0, 0), cB, voffB); PG8_STAGE(PG8_SB(0, 1), cB + hstep, voffB); PG8_STAGE(PG8_SA(0, 0), cA, voffA); PG8_STAGE(PG8_SA(0, 1), cA + hstep, voffA);
        if (wr == 1) PG8_BAR;
        PG8_WAIT_V(2); PG8_BAR;
        PG8_STAGE(PG8_SB(1, 0), cB + kstep, voffB); PG8_STAGE(PG8_SA(1, 0), cA + kstep, voffA); PG8_STAGE(PG8_SB(1, 1), cB + hstep + kstep, voffB);
        PG8_WAIT_V(6); PG8_BAR;
    } else {
        PG8_STAGE(PG8_SB(0, 0), cB, voffB); PG8_STAGE(PG8_SA(0, 0), cA, voffA); PG8_STAGE(PG8_SB(0, 1), cB + hstep, voffB); PG8_STAGE(PG8_SA(0, 1), cA + hstep, voffA);
        if (wr == 1) PG8_BAR;
        PG8_WAIT_V(4); PG8_BAR;
        PG8_STAGE(PG8_SB(1, 0), cB + kstep, voffB); PG8_STAGE(PG8_SA(1, 0), cA + kstep, voffA); PG8_STAGE(PG8_SB(1, 1), cB + hstep + kstep, voffB);
        PG8_WAIT_V(6); PG8_BAR;
    }
    for (;;) {
        const bool has_next = S.next(ui + 1, nxt);
        const char* nA = has_next ? S.aptr(nxt) : cA; const char* nB = has_next ? S.bptr(nxt) : cB;
        for (int t = 0; t < nt; t += 2) {
            const bool last = (t == nt - 2);
            const char* a1 = cA + (size_t)(t + 1) * kstep;
            const char* a2 = last ? nA : cA + (size_t)(t + 2) * kstep; const char* b2 = last ? nB : cB + (size_t)(t + 2) * kstep;
            const char* a3 = a2 + kstep; const char* b3 = b2 + kstep;
            if (last && has_next) S.a_ready(nxt);
            if constexpr (SP2) {
            PG8_LDB(B0, 0, 0); PG8_LDB(B1, 0, 1); PG8_SCHED; PG8_LDA(At, 0, 0); PG8_STAGE(PG8_SA(1, 1), a1 + hstep, voffA);
            PG8_WAIT_V(8); PG8_WAIT_L(0); PG8_BAR; PG8_MMA(0, 0, At, B0); PG8_MMA(0, 1, At, B1); PG8_BAR; PG8_SCHED;
            PG8_LDA(At, 0, 1); PG8_STAGE(PG8_SB(0, 0), b2, voffB); PG8_STAGE(PG8_SB(0, 1), b2 + hstep, voffB); PG8_STAGE(PG8_SA(0, 0), a2, voffA);
            PG8_WAIT_V(8); PG8_WAIT_L(0); PG8_BAR; PG8_MMA(1, 0, At, B0); PG8_MMA(1, 1, At, B1); PG8_BAR; PG8_SCHED;
            PG8_LDB(B0, 1, 0); PG8_LDB(B1, 1, 1); PG8_SCHED; PG8_LDA(At, 1, 0); PG8_STAGE(PG8_SA(0, 1), a2 + hstep, voffA);
            PG8_WAIT_V(8); PG8_WAIT_L(0); PG8_BAR; PG8_MMA(0, 0, At, B0); PG8_MMA(0, 1, At, B1); PG8_BAR; PG8_SCHED;
            PG8_LDA(At, 1, 1); PG8_STAGE(PG8_SB(1, 0), b3, voffB); PG8_STAGE(PG8_SB(1, 1), b3 + hstep, voffB); PG8_STAGE(PG8_SA(1, 0), a3, voffA);
            PG8_WAIT_V(8); PG8_WAIT_L(0); PG8_BAR; PG8_MMA(1, 0, At, B0); PG8_MMA(1, 1, At, B1); PG8_BAR; PG8_SCHED;
            } else {
            PG8_LDB(B0, 0, 0); PG8_SCHED; PG8_LDA(At, 0, 0); PG8_STAGE(PG8_SA(1, 1), a1 + hstep, voffA);
            PG8_WAIT_L(8); PG8_BAR; PG8_WAIT_L(0); PG8_MMA(0, 0, At, B0); PG8_BAR; PG8_SCHED;
            PG8_LDB(B1, 0, 1); PG8_STAGE(PG8_SB(0, 0), b2, voffB);
            PG8_BAR; PG8_WAIT_L(0); PG8_MMA(0, 1, At, B1); PG8_BAR;
            PG8_LDA(At, 0, 1); PG8_STAGE(PG8_SA(0, 0), a2, voffA);
            PG8_BAR; PG8_WAIT_L(0); PG8_MMA(1, 0, At, B0); PG8_BAR; PG8_SCHED;
            PG8_STAGE(PG8_SB(0, 1), b2 + hstep, voffB);
            PG8_WAIT_V(6); PG8_BAR; PG8_MMA(1, 1, At, B1); PG8_BAR;
            PG8_LDB(B0, 1, 0); PG8_SCHED; PG8_LDA(At, 1, 0); PG8_STAGE(PG8_SA(0, 1), a2 + hstep, voffA);
            PG8_WAIT_L(8); PG8_BAR; PG8_WAIT_L(0); PG8_MMA(0, 0, At, B0); PG8_BAR; PG8_SCHED;
            PG8_LDB(B1, 1, 1); PG8_STAGE(PG8_SB(1, 0), b3, voffB);
            PG8_BAR; PG8_WAIT_L(0); PG8_MMA(0, 1, At, B1); PG8_BAR;
            PG8_LDA(At, 1, 1); PG8_STAGE(PG8_SA(1, 0), a3, voffA);
            PG8_BAR; PG8_WAIT_L(0); PG8_MMA(1, 0, At, B0); PG8_BAR; PG8_SCHED;
            PG8_STAGE(PG8_SB(1, 1), b3 + hstep, voffB);
            PG8_WAIT_V(6); PG8_BAR; PG8_MMA(1, 1, At, B1); PG8_BAR;
            }
        }
        if constexpr (ALIGN_EPI) { if (wr == 0) PG8_BAR; }
        if constexpr (!Epi::AFTER_DRAIN) { E(acc, cur, wr, wc, fr, fq); S.done(cur); }
        if (!has_next) break;
#pragma unroll
        for (int a = 0; a < 2; ++a)
#pragma unroll
            for (int b = 0; b < 2; ++b)
#pragma unroll
                for (int m = 0; m < 4; ++m)
#pragma unroll
                    for (int n = 0; n < 2; ++n) acc[a][b][m][n] = (f32x4){0.f, 0.f, 0.f, 0.f};
        cur = nxt; cA = nA; cB = nB; ++ui;
        if constexpr (ALIGN_EPI) { if (wr == 1) PG8_BAR; }
    }
    PG8_WAIT_V(0);
    if constexpr (!ALIGN_EPI) { if (wr == 0) PG8_BAR; }
    PG8_BAR;
    if constexpr (Epi::AFTER_DRAIN) { E.fused(acc, cur, wr, wc, fr, fq, lds, wid, lane); S.done(cur); }
#undef PG8_SA
#undef PG8_SB
#undef PG8_STAGE
#undef PG8_LDA
#undef PG8_LDB
#undef PG8_MMA
#undef PG8_WAIT_V
#undef PG8_WAIT_L
#undef PG8_BAR
#undef PG8_SCHED
}
}
namespace attn_body {
using bf16=__hip_bfloat16;
using bf16x8=__attribute__((ext_vector_type(8)))short;
using s16x4=__attribute__((ext_vector_type(4)))short;
using f32x16=__attribute__((ext_vector_type(16)))float;
using u32x4=__attribute__((ext_vector_type(4)))unsigned;
constexpr int D=64,QP=1024,KP=256;
constexpr int NW=8,QBLK=32,KVBLK=64;
__device__ __forceinline__ int crow(int r,int hi){return (r&3)+8*(r>>2)+4*hi;}
#define SBAR() __builtin_amdgcn_sched_barrier(0)
__device__ __forceinline__ void kmask(f32x16&p0,f32x16&p1,int rem,int hi){
  const float NEG=-INFINITY;
  #pragma unroll
  for(int r=0;r<16;++r){int kv=4*hi+(r&3)+8*(r>>2); if(kv>=rem)p0[r]=NEG; if(kv+32>=rem)p1[r]=NEG;}
}

constexpr int NSLOT=3, SLOTB=8192;
constexpr int LDS_K=0, LDS_V=NSLOT*SLOTB, LDS_WS=2*NSLOT*SLOTB, LDS_OST=LDS_WS+NW*64*4, LDS_BYTES=LDS_OST+NW*4096;
constexpr float C2=0.125f*1.4426950408889634f;
__device__ __forceinline__ void glds16(const void*gsrc,unsigned lds_dst){unsigned keep;
  asm volatile("s_mov_b32 %0, m0\n\ts_mov_b32 m0, %2\n\ts_nop 0\n\tglobal_load_lds_dwordx4 %1, off\n\ts_mov_b32 m0, %0":"=&s"(keep):"v"(gsrc),"s"(lds_dst):"memory");}
__device__ __forceinline__ float max3f(float a,float b,float c){float r;asm("v_max3_f32 %0, %1, %2, %3":"=v"(r):"v"(a),"v"(b),"v"(c));return r;}
__device__ __forceinline__ float max2f(float a,float b){float r;asm("v_max_f32_e32 %0, %1, %2":"=v"(r):"v"(a),"v"(b));return r;}
__device__ __forceinline__ float fadd_s(float a,float b){float r;asm("v_add_f32_e32 %0, %1, %2":"=v"(r):"v"(a),"v"(b));return r;}
__device__ __forceinline__ float fsub_s(float a,float b){float r;asm("v_sub_f32_e32 %0, %1, %2":"=v"(r):"v"(a),"v"(b));return r;}
typedef float f32x2_t __attribute__((ext_vector_type(2))); typedef __bf16 bf16x2_t __attribute__((ext_vector_type(2)));
__device__ __forceinline__ unsigned cvtpk_s(float lo,float hi){f32x2_t v={lo,hi};bf16x2_t b=__builtin_convertvector(v,bf16x2_t);return __builtin_bit_cast(unsigned,b);}
#define WAIT_BAR(N) asm volatile("s_waitcnt vmcnt(" #N ") lgkmcnt(0)\n\ts_barrier":::"memory")

__device__ __forceinline__ void qkt(f32x16&p0,f32x16&p1,const char*Kslot,const bf16x8*qr,const f32x16&negm,int r32,int hi){
  const char*kb=Kslot+hi*1024+r32*16;
  #pragma unroll
  for(int d0=0;d0<4;++d0){
    const bf16x8 b0=*reinterpret_cast<const bf16x8*>(kb+d0*2048);
    const bf16x8 b1=*reinterpret_cast<const bf16x8*>(kb+d0*2048+512);
    if(d0==0){p0=__builtin_amdgcn_mfma_f32_32x32x16_bf16(b0,qr[0],negm,0,0,0);p1=__builtin_amdgcn_mfma_f32_32x32x16_bf16(b1,qr[0],negm,0,0,0);}
    else{p0=__builtin_amdgcn_mfma_f32_32x32x16_bf16(b0,qr[d0],p0,0,0,0);p1=__builtin_amdgcn_mfma_f32_32x32x16_bf16(b1,qr[d0],p1,0,0,0);}}
}
typedef __attribute__((address_space(3))) const char* lds_cptr;
typedef short v4i16_t __attribute__((ext_vector_type(4)));
__device__ __forceinline__ void kload8(bf16x8*kf,lds_cptr kp){
  kf[0]=*(const __attribute__((address_space(3))) bf16x8*)(kp);      kf[1]=*(const __attribute__((address_space(3))) bf16x8*)(kp+512);
  kf[2]=*(const __attribute__((address_space(3))) bf16x8*)(kp+2048); kf[3]=*(const __attribute__((address_space(3))) bf16x8*)(kp+2560);
  kf[4]=*(const __attribute__((address_space(3))) bf16x8*)(kp+4096); kf[5]=*(const __attribute__((address_space(3))) bf16x8*)(kp+4608);
  kf[6]=*(const __attribute__((address_space(3))) bf16x8*)(kp+6144); kf[7]=*(const __attribute__((address_space(3))) bf16x8*)(kp+6656);
}
__device__ __forceinline__ void kload2(bf16x8*kf,lds_cptr kp,int j){ kf[2*j]=*(const __attribute__((address_space(3))) bf16x8*)(kp+j*2048); kf[2*j+1]=*(const __attribute__((address_space(3))) bf16x8*)(kp+j*2048+512); }
__device__ __forceinline__ s16x4 vtr(lds_cptr p){ return __builtin_bit_cast(s16x4,__builtin_amdgcn_ds_read_tr16_b64_v4i16((__attribute__((address_space(3))) v4i16_t*)p)); }
__device__ __forceinline__ float rowmax(const f32x16&p0,const f32x16&p1){
  float a=max3f(p0[0],p0[1],p1[0]),b=max3f(p0[2],p0[3],p1[1]);a=max3f(a,p1[2],p1[3]);
  #pragma unroll
  for(int r=4;r<16;r+=4){a=max3f(a,p0[r],p0[r+1]);b=max3f(b,p0[r+2],p0[r+3]);a=max3f(a,p1[r],p1[r+1]);b=max3f(b,p1[r+2],p1[r+3]);}
  const float m=max2f(a,b);
  auto rr=__builtin_amdgcn_permlane32_swap(__float_as_uint(m),__float_as_uint(m),false,false);
  return max2f(__uint_as_float(rr[0]),__uint_as_float(rr[1]));
}
__device__ __forceinline__ void pv(f32x16*o,int vb,bf16x8 pa0,bf16x8 pa1,bf16x8 pa2,bf16x8 pa3){
  #pragma unroll
  for(int d0=0;d0<2;++d0){s16x4 lo[4],hi[4];
    #pragma unroll
    for(int ks=0;ks<4;++ks){
      asm volatile("ds_read_b64_tr_b16 %0,%1 offset:%c2":"=&v"(lo[ks]):"v"(vb),"i"(d0*4096+ks*1024):"memory");
      asm volatile("ds_read_b64_tr_b16 %0,%1 offset:%c2":"=&v"(hi[ks]):"v"(vb),"i"(d0*4096+ks*1024+512):"memory");}
    asm volatile("s_waitcnt lgkmcnt(0)":::"memory");SBAR();
    #define PK(k) (bf16x8){lo[k][0],lo[k][1],lo[k][2],lo[k][3],hi[k][0],hi[k][1],hi[k][2],hi[k][3]}
    o[d0]=__builtin_amdgcn_mfma_f32_32x32x16_bf16(pa0,PK(0),o[d0],0,0,0);
    o[d0]=__builtin_amdgcn_mfma_f32_32x32x16_bf16(pa1,PK(1),o[d0],0,0,0);
    o[d0]=__builtin_amdgcn_mfma_f32_32x32x16_bf16(pa2,PK(2),o[d0],0,0,0);
    o[d0]=__builtin_amdgcn_mfma_f32_32x32x16_bf16(pa3,PK(3),o[d0],0,0,0);
    #undef PK
  }
}

#ifndef ATTN_STORE16
#define ATTN_STORE16(p,v) (*(u32x4*)(p)=(v))
#endif
template<int THRL,int L,int NT> __device__ __forceinline__ void attn_unit(long rowbase,int kvh,int qblk,const bf16*Q,const bf16*__restrict__ K,const bf16*__restrict__ V,bf16*O,char*shm,const int tid){
  const int lane=tid&63,r32=lane&31,hi=lane>>5; const int wid=__builtin_amdgcn_readfirstlane(tid>>6);
  const int q0=qblk*64, qh=wid>>1, rh=wid&1;
  const bf16*Qw=Q+(rowbase+q0+rh*QBLK)*QP+(4*kvh+qh)*D;
  const bf16*Kh=K+rowbase*KP+kvh*D,*Vh=V+rowbase*KP+kvh*D;
  const unsigned lds0=(unsigned)(uintptr_t)shm;
  float*wsf=(float*)(shm+LDS_WS)+wid*64;
  const bf16*ksrc=Kh+(long)lane*KP+wid*8;
  const bf16*vsrc=Vh+(long)(16*(wid&3)+(lane>>2))*KP+(wid>>2)*32+(lane&3)*8;
  const unsigned kdst=lds0+LDS_K+wid*1024, vdst=lds0+LDS_V+wid*1024;
  #define DMA_K(t,slot) glds16(ksrc+(long)(t)*KVBLK*KP,(unsigned)__builtin_amdgcn_readfirstlane(kdst+(slot)))
  #define DMA_V(t,slot) glds16(vsrc+(long)(t)*KVBLK*KP,(unsigned)__builtin_amdgcn_readfirstlane(vdst+(slot)))
  const int vb0=(int)(lds0+LDS_V)+((lane>>4)&1)*32+(lane&3)*8+(4*hi+((lane&15)>>2))*64;
  const char*Kbase=shm+LDS_K; bf16x8 kf[8];
  const lds_cptr shm3=(lds_cptr)shm; const lds_cptr kp0=shm3+LDS_K+hi*1024+r32*16; const lds_cptr vp0=shm3+LDS_V+((lane>>4)&1)*32+(lane&3)*8+(4*hi+((lane&15)>>2))*64;
  DMA_K(0,0);DMA_V(0,0);DMA_K(1,SLOTB);
  bf16x8 qr[4];
  #pragma unroll
  for(int d0=0;d0<4;++d0)qr[d0]=*reinterpret_cast<const bf16x8*>(&Qw[(long)r32*QP+d0*16+hi*8]);
  if(q0+rh*QBLK+r32>=L){
    #pragma unroll
    for(int d0=0;d0<4;++d0)qr[d0]=bf16x8{0,0,0,0,0,0,0,0}; }
  float mhat=0.f,l_reg=0.f;f32x16 o[2];o[0]=f32x16{};o[1]=f32x16{};f32x16 negm=f32x16{};asm volatile("":"+v"(negm));
  #define CMASK(P0,P1,t) do{ if((t)>=NT-2)kmask(P0,P1,L-64*(t),hi);}while(0)
  bool resc=false;
  #define START(P0,P1) do{ const float rm=rowmax(P0,P1); resc=false; \
    { const float dl=rm; mhat=fadd_s(mhat,dl); \
      _Pragma("unroll") for(int r=0;r<16;++r){P0[r]=fsub_s(P0[r],dl);P1[r]=fsub_s(P1[r],dl);} \
      _Pragma("unroll") for(int r=0;r<16;++r)negm[r]=-mhat; asm volatile("":"+v"(negm)); } \
    _Pragma("unroll") for(int r=0;r<16;++r)P0[r]=__builtin_amdgcn_exp2f(P0[r]); }while(0)
  #define RESC() do{ if(resc){ asm volatile("s_waitcnt lgkmcnt(0)":::"memory"); \
      _Pragma("unroll") for(int d_=0;d_<2;++d_) _Pragma("unroll") for(int r=0;r<16;++r)o[d_][r]*=wsf[crow(r,hi)]; } }while(0)
  f32x16 pA0,pA1,pB0,pB1;
  int sl_prev=0,sl_cur=0,sl_next=SLOTB;
  #define ROT() do{sl_prev=sl_cur;sl_cur=sl_next;sl_next=(sl_next==(NSLOT-1)*SLOTB)?0:sl_next+SLOTB;}while(0)
  DMA_K(2,2*SLOTB);
  WAIT_BAR(3);
  qkt(pA0,pA1,Kbase,qr,negm,r32,hi);asm volatile("s_nop 15\n\ts_nop 7":"+v"(pA0),"+v"(pA1));CMASK(pA0,pA1,0);
  START(pA0,pA1);
  _Pragma("unroll") for(int r=0;r<16;++r)pA1[r]=__builtin_amdgcn_exp2f(pA1[r]);
  WAIT_BAR(0);
  DMA_K(3,0);DMA_V(1,SLOTB);
  ROT();
  kload8(kf,kp0+sl_cur);
  WAIT_BAR(2);
  s16x4 vlo[8],vhi[8]; u32x4 pw0,pw1,pw2,pw3;
  #define PKW(P,B) cvtpk_s(P[B],P[B+1])
  #define PAF(k) __builtin_bit_cast(bf16x8,pw##k)
  #define VFR(i) (bf16x8){vlo[i][0],vlo[i][1],vlo[i][2],vlo[i][3],vhi[i][0],vhi[i][1],vhi[i][2],vhi[i][3]}
  #define PIN(x) asm volatile("":"+v"(x))
  #define MX3(a,b,c) __builtin_fmaxf(__builtin_fmaxf((a),(b)),(c))
  #define GAPA(MF,A0,A1,A2,A3,W0,W1,PW) do{ MF; sacc+=A0; sacc+=A1; sacc+=A2; sacc+=A3; PIN(sacc); W0; W1; PIN(PW); SBAR(); }while(0)
  #define EX(v) __builtin_amdgcn_exp2f(v)
  #define GAPB(MF,X,B) do{ MF; X[B]=EX(X[B]); X[B+1]=EX(X[B+1]); X[B+2]=EX(X[B+2]); X[B+3]=EX(X[B+3]); PIN(X); SBAR(); }while(0)
  #define VRD(i) do{ vlo[i]=vtr(vp_+(((i)>>2)*4096+((i)&3)*1024)); vhi[i]=vtr(vp_+(((i)>>2)*4096+((i)&3)*1024+512)); }while(0)
  #define KRD(G,j) do{ if(G){ kload2(kf,kp0+sl_next,j); SBAR(); } }while(0)
  #define STEP(C0,C1,P0,P1,t,GK,GV,GL) do{ SBAR(); \
    const lds_cptr vp_=vp0+sl_prev; \
    VRD(0); SBAR(); float sacc=(P0[0]+P0[1]); \
    GAPA(C0=__builtin_amdgcn_mfma_f32_32x32x16_bf16(kf[0],qr[0],negm,0,0,0), P0[2],P0[3],P0[4],P0[5],     pw0[0]=PKW(P0,0), pw0[1]=PKW(P0,2), pw0); \
    VRD(4); SBAR(); GAPA(C1=__builtin_amdgcn_mfma_f32_32x32x16_bf16(kf[1],qr[0],negm,0,0,0), P0[6],P0[7],P0[8],P0[9],     pw0[2]=PKW(P0,4), pw0[3]=PKW(P0,6), pw0); \
    VRD(1); SBAR(); GAPA(C0=__builtin_amdgcn_mfma_f32_32x32x16_bf16(kf[2],qr[1],C0,0,0,0),   P0[10],P0[11],P0[12],P0[13], pw1[0]=PKW(P0,8), pw1[1]=PKW(P0,10), pw1); \
    VRD(5); SBAR(); GAPA(C1=__builtin_amdgcn_mfma_f32_32x32x16_bf16(kf[3],qr[1],C1,0,0,0),   P0[14],P0[15],P1[0],P1[1],   pw1[2]=PKW(P0,12),pw1[3]=PKW(P0,14), pw1); \
    VRD(2); SBAR(); GAPA(C0=__builtin_amdgcn_mfma_f32_32x32x16_bf16(kf[4],qr[2],C0,0,0,0),   P1[2],P1[3],P1[4],P1[5],     pw2[0]=PKW(P1,0), pw2[1]=PKW(P1,2), pw2); \
    VRD(6); SBAR(); GAPA(C1=__builtin_amdgcn_mfma_f32_32x32x16_bf16(kf[5],qr[2],C1,0,0,0),   P1[6],P1[7],P1[8],P1[9],     pw2[2]=PKW(P1,4), pw2[3]=PKW(P1,6), pw2); \
    VRD(3); SBAR(); GAPA(C0=__builtin_amdgcn_mfma_f32_32x32x16_bf16(kf[6],qr[3],C0,0,0,0),   P1[10],P1[11],P1[12],P1[13], pw3[0]=PKW(P1,8), pw3[1]=PKW(P1,10), pw3); \
    VRD(7); SBAR(); GAPA(C1=__builtin_amdgcn_mfma_f32_32x32x16_bf16(kf[7],qr[3],C1,0,0,0),   P1[14],P1[15],0.f,0.f,       pw3[2]=PKW(P1,12),pw3[3]=PKW(P1,14), pw3); \
    l_reg+=sacc; \
    if(GK){DMA_K((t)+3,sl_cur);} if(GV){DMA_V((t)+1,sl_next);} \
    CMASK(C0,C1,t); \
    { float a=MX3(C0[0],C0[1],C1[0]),b=MX3(C0[2],C0[3],C1[1]); a=MX3(a,C1[2],C1[3]); \
      _Pragma("unroll") for(int r=4;r<16;r+=4){a=MX3(a,C0[r],C0[r+1]);b=MX3(b,C0[r+2],C0[r+3]);a=MX3(a,C1[r],C1[r+1]);b=MX3(b,C1[r+2],C1[r+3]);} \
      float rm=__builtin_fmaxf(a,b); { auto rr=__builtin_amdgcn_permlane32_swap(__float_as_uint(rm),__float_as_uint(rm),false,false); rm=__builtin_fmaxf(__uint_as_float(rr[0]),__uint_as_float(rr[1])); } \
      resc=false; \
      if(__builtin_expect(__any(rm>(float)THRL),0)){ const float dl=__builtin_fmaxf(rm,0.f); mhat+=dl; \
        _Pragma("unroll") for(int r=0;r<16;++r){C0[r]-=dl;C1[r]-=dl;} \
        _Pragma("unroll") for(int r=0;r<16;++r)negm[r]=-mhat; asm volatile("":"+v"(negm)); \
        const float f=__builtin_amdgcn_exp2f(-dl); l_reg*=f; if(hi==0)wsf[r32]=f; resc=true; } } \
    SBAR(); \
    GAPB(o[0]=__builtin_amdgcn_mfma_f32_32x32x16_bf16(PAF(0),VFR(0),o[0],0,0,0), C0,0); \
    GAPB(o[1]=__builtin_amdgcn_mfma_f32_32x32x16_bf16(PAF(0),VFR(4),o[1],0,0,0), C0,4); \
    KRD(GL,0); GAPB(o[0]=__builtin_amdgcn_mfma_f32_32x32x16_bf16(PAF(1),VFR(1),o[0],0,0,0), C0,8); \
    KRD(GL,1); GAPB(o[1]=__builtin_amdgcn_mfma_f32_32x32x16_bf16(PAF(1),VFR(5),o[1],0,0,0), C0,12); \
    KRD(GL,2); GAPB(o[0]=__builtin_amdgcn_mfma_f32_32x32x16_bf16(PAF(2),VFR(2),o[0],0,0,0), C1,0); \
    KRD(GL,3); GAPB(o[1]=__builtin_amdgcn_mfma_f32_32x32x16_bf16(PAF(2),VFR(6),o[1],0,0,0), C1,4); \
    GAPB(o[0]=__builtin_amdgcn_mfma_f32_32x32x16_bf16(PAF(3),VFR(3),o[0],0,0,0), C1,8); \
    GAPB(o[1]=__builtin_amdgcn_mfma_f32_32x32x16_bf16(PAF(3),VFR(7),o[1],0,0,0), C1,12); \
    }while(0)
  int t=1;
  #undef CMASK
  #define CMASK(P0,P1,t) do{}while(0)
  for(;t+5<NT;t+=2){
    STEP(pB0,pB1,pA0,pA1,t,true,true,true);     WAIT_BAR(2); RESC(); ROT();
    STEP(pA0,pA1,pB0,pB1,t+1,true,true,true);   WAIT_BAR(2); RESC(); ROT();
  }
  #undef CMASK
  #define CMASK(P0,P1,t) do{ if((t)>=NT-2)kmask(P0,P1,L-64*(t),hi);}while(0)
  #define ENDW(tt) do{ if((tt)+3<NT){WAIT_BAR(2);} else if((tt)+2<NT){WAIT_BAR(1);} else {WAIT_BAR(0);} }while(0)
  for(;t+1<NT;t+=2){
    STEP(pB0,pB1,pA0,pA1,t,(t+3<NT),(t+1<NT),(t+1<NT));       ENDW(t);   RESC(); ROT();
    STEP(pA0,pA1,pB0,pB1,t+1,(t+4<NT),(t+2<NT),(t+2<NT));     ENDW(t+1); RESC(); ROT();
  }
  STEP(pB0,pB1,pA0,pA1,NT-1,false,false,false); RESC();
  { float sacc=pB0[0]+pB0[1]; _Pragma("unroll") for(int r=2;r<16;++r)sacc+=pB0[r]; _Pragma("unroll") for(int r=0;r<16;++r)sacc+=pB1[r]; l_reg+=sacc;
    pw0=(u32x4){PKW(pB0,0),PKW(pB0,2),PKW(pB0,4),PKW(pB0,6)};pw1=(u32x4){PKW(pB0,8),PKW(pB0,10),PKW(pB0,12),PKW(pB0,14)};pw2=(u32x4){PKW(pB1,0),PKW(pB1,2),PKW(pB1,4),PKW(pB1,6)};pw3=(u32x4){PKW(pB1,8),PKW(pB1,10),PKW(pB1,12),PKW(pB1,14)};
    SBAR(); pv(o,vb0+sl_cur,PAF(0),PAF(1),PAF(2),PAF(3)); }
  #undef PKW
  #undef PAF
  #undef VFR
  #undef PIN
  #undef MX3
  #undef GAPA
  #undef GAPB
  #undef EX
  #undef VRD
  #undef KRD
  #undef STEP
  #undef ENDW
  {auto rr=__builtin_amdgcn_permlane32_swap(__float_as_uint(l_reg),__float_as_uint(l_reg),false,false);l_reg=__uint_as_float(rr[0])+__uint_as_float(rr[1]);}
  if(hi==0)wsf[32+r32]=l_reg;asm volatile("s_waitcnt lgkmcnt(0)":::"memory");
  float rli[16];
  #pragma unroll
  for(int r=0;r<16;++r)rli[r]=__builtin_amdgcn_rcpf(wsf[32+crow(r,hi)]);
  bf16*Ow=O+(rowbase+q0+rh*QBLK)*QP+(4*kvh+qh)*D;
  { bf16*stg=(bf16*)(shm+LDS_OST)+wid*2048;
    #pragma unroll
    for(int r=0;r<16;++r){const int orow=crow(r,hi);
      #pragma unroll
      for(int d0=0;d0<2;++d0)stg[orow*64+d0*32+r32]=__float2bfloat16(o[d0][r]*rli[r]);}
    asm volatile("s_waitcnt lgkmcnt(0)":::"memory");
    #pragma unroll
    for(int i=0;i<4;++i){const int row=i*8+(lane>>3),ch=lane&7; const u32x4 v=*(const u32x4*)(stg+row*64+ch*8); if(q0+rh*QBLK+row<L)ATTN_STORE16(Ow+(long)row*QP+ch*8,v);} }
  asm volatile("s_waitcnt lgkmcnt(0)\n\ts_barrier":::"memory");
  #undef DMA_K
  #undef DMA_V
  #undef CMASK
  #undef START
  #undef RESC
  #undef ROT
}
constexpr int ATTN_LDS_BYTES=LDS_BYTES;
#undef SBAR
#undef WAIT_BAR
}
constexpr int DM = 1024, FF = 2816, NLAYER = 4;
constexpr int LP = 4112, LS = 2064, NSEQ_P = 4, NSEQ_S = 16, ROWS_P = NSEQ_P * LP  , T_ROWS = ROWS_P + NSEQ_S * LS  ;
constexpr int TPAD = 49664, NMT = TPAD / 256;
constexpr int NWIN = 4608;
constexpr float NORM_EPS = 1e-6f;
constexpr float QSCALE = 0.125f * 1.4426950408889634f;
constexpr int ATT_UNITS_P = NSEQ_P * 4 * 65, ATT_UNITS_S = NSEQ_S * 4 * 33, ATT_UNITS = ATT_UNITS_P + ATT_UNITS_S;

constexpr size_t MiB = 1u << 20;
constexpr int CW_BAR = 4096;
constexpr size_t WS_CTL = 0;
constexpr size_t WS_ROPE = MiB / 4;
constexpr size_t WS_HMETA = 3 * MiB / 2;
constexpr size_t WS_SSQ = 3 * MiB;
constexpr size_t WS_W = 8 * MiB;
constexpr size_t W_GU1 = 0, W_D1 = W_GU1 + (size_t)5632 * 1024 * 2, W_IN = W_D1 + (size_t)1024 * 2816 * 2, W_GC = W_IN + (size_t)NWIN * 1024 * 2, W_OC = W_GC + 2 * MiB,
                 W_GA = W_OC + 2 * MiB, W_OA = W_GA + 2 * MiB, W_M = W_OA + 2 * MiB, W_GU2 = W_M + 2 * MiB, W_D2 = W_GU2 + (size_t)5632 * 1024 * 2, W_END = W_D2 + (size_t)1024 * 2816 * 2;
constexpr size_t WBUF = 56 * MiB;
constexpr size_t WS_HB = 120 * MiB;
constexpr size_t ROWB = (size_t)TPAD * 1024 * 2;
constexpr size_t WS_BIG = WS_HB + 98 * MiB;
constexpr size_t WS_Q = WS_BIG, WS_K = WS_Q + ROWB, WS_V = WS_K + ROWB / 4, WS_CB = WS_V + ROWB / 4, WS_Z = WS_CB + ROWB, WS_END = WS_Z + ROWB;
constexpr size_t WS_HID = WS_BIG;
constexpr size_t WS_SCR = WS_K;
static_assert((CW_BAR + 3456) * 4 <= (int)WS_ROPE && WS_ROPE + (size_t)LP * 64 * 4 <= WS_HMETA && WS_HMETA + (size_t)20 * 16 * 1024 * 4 <= WS_SSQ && WS_SSQ + (size_t)TPAD * 16 * 4 <= WS_W, "d_ws map (small regions)");
static_assert(W_END <= 56 * MiB && ROWB <= 98 * MiB && (size_t)TPAD * FF * 2 <= WS_END - WS_BIG && 256 * 131072 <= ROWB / 2, "d_ws map");

constexpr int RING_BYTES = 131072, MISC_OFF = RING_BYTES + 320, PTAB_OFF = RING_BYTES + 1024, LDS_BYTES = 147456;
constexpr int NWAVES = 8;

#define GAS __attribute__((address_space(1)))
#define LAS __attribute__((address_space(3)))
typedef unsigned short bf16;
typedef unsigned v4u __attribute__((ext_vector_type(4)));
typedef float f32x4 __attribute__((ext_vector_type(4)));
__device__ __forceinline__ unsigned f2bf(float f) { unsigned u = __builtin_bit_cast(unsigned, f); return (u + 0x7fffu + ((u >> 16) & 1u)) >> 16; }
__device__ __forceinline__ unsigned pk2(float lo, float hi) { return pg8::cvt_pk_bf16(lo, hi); }
__device__ __forceinline__ float bflo(unsigned u) { return __builtin_bit_cast(float, u << 16); }
__device__ __forceinline__ float bfhi(unsigned u) { return __builtin_bit_cast(float, u & 0xffff0000u); }
__device__ __forceinline__ float wave_sum(float v) {
#pragma unroll
    for (int o = 1; o < 64; o <<= 1) v += __shfl_xor(v, o);
    return v;
}
__device__ __forceinline__ void rowinfo(int r, int& pos, int& L) {
    if (r < ROWS_P) { L = LP; pos = r % LP; } else if (r < T_ROWS) { L = LS; pos = (r - ROWS_P) % LS; } else { L = 1 << 30; pos = 0; }
}
__device__ __forceinline__ float sigmoidf_(float x) { return __builtin_amdgcn_rcpf(1.0f + __builtin_amdgcn_exp2f(-1.4426950408889634f * x)); }

struct PlainOrder : pg8::StaticOrder {
    const char* A; const char* Bt; size_t tstep;
    __device__ __forceinline__ const char* aptr(const pg8::Unit& u) const { return A + (size_t)u.pm * tstep; }
    __device__ __forceinline__ const char* bptr(const pg8::Unit& u) const { return Bt + (size_t)u.pn * tstep; }
};
struct ChainOrder {
    pg8::StaticOrder base; const char* A[4]; const char* B[4]; size_t tstep;
    __device__ __forceinline__ bool next(int i, pg8::Unit& u) const { if (!base.next(i >> 2, u)) return false; u.sub = i & 3; return true; }
    __device__ __forceinline__ const char* aptr(const pg8::Unit& u) const { const char* p = u.sub == 0 ? A[0] : u.sub == 1 ? A[1] : u.sub == 2 ? A[2] : A[3]; return p + (size_t)u.pm * tstep; }
    __device__ __forceinline__ const char* bptr(const pg8::Unit& u) const { const char* p = u.sub == 0 ? B[0] : u.sub == 1 ? B[1] : u.sub == 2 ? B[2] : B[3]; return p + (size_t)u.pn * tstep; }
    __device__ __forceinline__ void a_ready(const pg8::Unit&) const {}
    __device__ __forceinline__ void done(const pg8::Unit&) const {}
};

using pg8::f32x4; using pg8::u32x4; using pg8::Unit; using pg8::bf16_t;
typedef f32x4 Acc[2][2][4][2];
__device__ __forceinline__ u32x4 pack8(const f32x4 a, const f32x4 b) { u32x4 w; w.x = pk2(a[0], a[1]); w.y = pk2(a[2], a[3]); w.z = pk2(b[0], b[1]); w.w = pk2(b[2], b[3]); return w; }
__device__ __forceinline__ void unpack8(const u32x4 w, f32x4& a, f32x4& b) { a = (f32x4){bflo(w.x), bfhi(w.x), bflo(w.y), bfhi(w.y)}; b = (f32x4){bflo(w.z), bfhi(w.z), bflo(w.w), bfhi(w.w)}; }
__device__ __forceinline__ float rstd_of(const float* ssq, int row) { const f32x4* p = (const f32x4*)(ssq + (size_t)row * 16); const f32x4 a = p[0], b = p[1], c = p[2], d = p[3];
    const float s = (((a[0] + a[1]) + (a[2] + a[3])) + ((b[0] + b[1]) + (b[2] + b[3]))) + (((c[0] + c[1]) + (c[2] + c[3])) + ((d[0] + d[1]) + (d[2] + d[3])));
    return __builtin_amdgcn_rsqf(s * (1.0f / DM) + NORM_EPS); }

__device__ __forceinline__ void rstd8(const float* ssq, int row0, int fq, float (&rs)[8]) {
    f32x4 pr[8];
#pragma unroll
    for (int i = 0; i < 8; ++i) pr[i] = *(const f32x4*)(ssq + (size_t)(row0 + (i >> 2) * 128 + (i & 3) * 16) * 16 + 4 * fq);
#pragma unroll
    for (int i = 0; i < 8; ++i) { float s = (pr[i][0] + pr[i][1]) + (pr[i][2] + pr[i][3]); s += __shfl_xor(s, 16); s += __shfl_xor(s, 32); rs[i] = __builtin_amdgcn_rsqf(s * (1.0f / DM) + NORM_EPS); }
}
struct EpiSwiGLU {
    static constexpr bool PERM = true, AFTER_DRAIN = false;
    bf16_t* hid; const float* ssq;
    __device__ __forceinline__ void operator()(const Acc& acc, const Unit& u, int wr, int wc, int fr, int fq) const {
        const int row0 = u.pm * 256 + wr * 64 + fr;
        float rs[8]; rstd8(ssq, row0, fq, rs);
#pragma unroll
        for (int ai = 0; ai < 2; ++ai)
#pragma unroll
            for (int m = 0; m < 4; ++m) {
                const int row = row0 + ai * 128 + m * 16; const float r1 = rs[ai * 4 + m];
                f32x4 o[2];
#pragma unroll
                for (int n = 0; n < 2; ++n)
#pragma unroll
                    for (int e = 0; e < 4; ++e) { const float g = acc[ai][0][m][n][e] * r1, up = acc[ai][1][m][n][e] * r1; o[n][e] = g * sigmoidf_(g) * up; }
                *(u32x4*)(hid + (size_t)row * FF + u.pn * 128 + wc * 32 + 8 * fq) = pack8(o[0], o[1]);
            }
    }
};
struct EpiResid {
    static constexpr bool PERM = true, AFTER_DRAIN = false;
    bf16_t* hb; float* ssq_out; float scale;
    __device__ __forceinline__ void operator()(const Acc& acc, const Unit& u, int wr, int wc, int fr, int fq) const {
        const int row0 = u.pm * 256 + wr * 64 + fr;
#pragma unroll
        for (int ai = 0; ai < 2; ++ai) {
            u32x4 old[4][2];
#pragma unroll
            for (int m = 0; m < 4; ++m) { const int row = row0 + ai * 128 + m * 16; const bf16_t* bp = hb + (size_t)row * DM + u.pn * 256 + wc * 32 + 8 * fq;
#pragma unroll
                for (int bj = 0; bj < 2; ++bj) old[m][bj] = row < T_ROWS ? *(const u32x4*)(bp + bj * 128) : (u32x4){0u, 0u, 0u, 0u}; }
#pragma unroll
            for (int m = 0; m < 4; ++m) {
                const int row = row0 + ai * 128 + m * 16; const bool ok = row < T_ROWS; bf16_t* bp = hb + (size_t)row * DM + u.pn * 256 + wc * 32 + 8 * fq;
                float ss = 0.f;
#pragma unroll
                for (int bj = 0; bj < 2; ++bj) {
                    f32x4 a, b; unpack8(old[m][bj], a, b);
                    a = a + acc[ai][bj][m][0] * scale; b = b + acc[ai][bj][m][1] * scale;
                    const u32x4 w = pack8(a, b); if (ok) *(u32x4*)(bp + bj * 128) = w;
                    unpack8(w, a, b);
                    ss += (a[0] * a[0] + a[1] * a[1]) + (a[2] * a[2] + a[3] * a[3]) + (b[0] * b[0] + b[1] * b[1]) + (b[2] * b[2] + b[3] * b[3]);
                }
                ss += __shfl_xor(ss, 16); ss += __shfl_xor(ss, 32);
                if (ok && fq == 0) ssq_out[(size_t)row * 16 + u.pn * 4 + wc] = ss;
            }
            asm volatile("" ::: "memory");
        }
    }
};
struct EpiWin {
    static constexpr bool PERM = true, AFTER_DRAIN = false;
    bf16_t *q, *k, *v, *cb, *z; const float* ssq; const float* rope; const float* qg; const float* kg;
    __device__ __forceinline__ void operator()(const Acc& acc, const Unit& u, int wr, int wc, int fr, int fq) const {
        const int pn = u.pn; const int row0 = u.pm * 256 + wr * 64 + fr;
        float rs[8]; rstd8(ssq, row0, fq, rs);
        if (pn <= 4) {
            const float* g = pn < 4 ? qg : kg; const float osc = pn < 4 ? QSCALE : 1.0f;
            f32x4 G[2][2];
#pragma unroll
            for (int bj = 0; bj < 2; ++bj)
#pragma unroll
                for (int n = 0; n < 2; ++n) G[bj][n] = *(const f32x4*)(g + 32 * bj + 16 * n + 4 * fq) * osc;
#pragma unroll
            for (int ai = 0; ai < 2; ++ai)
#pragma unroll
                for (int mp = 0; mp < 2; ++mp) {
                    f32x4 cs[2][2][2];
#pragma unroll
                    for (int mm = 0; mm < 2; ++mm) { int pos, L; rowinfo(row0 + ai * 128 + (2 * mp + mm) * 16, pos, L);
#pragma unroll
                        for (int bj = 0; bj < 2; ++bj) { cs[mm][bj][0] = *(const f32x4*)(rope + ((pos * 2 + bj) * 2 + 0) * 16 + 4 * fq); cs[mm][bj][1] = *(const f32x4*)(rope + ((pos * 2 + bj) * 2 + 1) * 16 + 4 * fq); } }
#pragma unroll
                    for (int mm = 0; mm < 2; ++mm) {
                        const int m = 2 * mp + mm; const int row = row0 + ai * 128 + m * 16; const float r1 = rs[ai * 4 + m];
                        f32x4 x[2][2]; float ss = 0.f;
#pragma unroll
                        for (int bj = 0; bj < 2; ++bj)
#pragma unroll
                            for (int n = 0; n < 2; ++n) { x[bj][n] = acc[ai][bj][m][n] * r1; const f32x4 t = x[bj][n] * x[bj][n]; ss += (t[0] + t[1]) + (t[2] + t[3]); }
                        ss += __shfl_xor(ss, 16); ss += __shfl_xor(ss, 32);
                        const float rn = __builtin_amdgcn_rsqf(ss * (1.0f / 64.0f) + NORM_EPS);
                        bf16_t* dst = pn < 4 ? q + (size_t)row * 1024 + (4 * pn + wc) * 64 + 8 * fq : k + (size_t)row * 256 + wc * 64 + 8 * fq;
#pragma unroll
                        for (int bj = 0; bj < 2; ++bj) {
                            const f32x4 c4 = cs[mm][bj][0], s4 = cs[mm][bj][1];
                            const f32x4 y1 = x[bj][0] * rn * G[bj][0], y2 = x[bj][1] * rn * G[bj][1];
                            const f32x4 o1 = y1 * c4 - y2 * s4, o2 = y2 * c4 + y1 * s4;
                            *(u32x4*)(dst + 32 * bj) = pack8(o1, o2);
                        }
                    }
                    asm volatile("" ::: "memory");
                }
        } else if (pn < 10) {
            bf16_t* base; int pitch, c0;
            if (pn == 5) { base = v; pitch = 256; c0 = 0; } else { base = cb; pitch = 1024; c0 = 256 * (pn - 6); }
#pragma unroll
            for (int ai = 0; ai < 2; ++ai)
#pragma unroll
                for (int m = 0; m < 4; ++m) {
                    const int row = row0 + ai * 128 + m * 16; const float r1 = rs[ai * 4 + m];
#pragma unroll
                    for (int bj = 0; bj < 2; ++bj) *(u32x4*)(base + (size_t)row * pitch + c0 + 128 * bj + wc * 32 + 8 * fq) = pack8(acc[ai][bj][m][0] * r1, acc[ai][bj][m][1] * r1);
                }
        } else {
#pragma unroll
            for (int ai = 0; ai < 2; ++ai)
#pragma unroll
                for (int m = 0; m < 4; ++m) {
                    const int row = row0 + ai * 128 + m * 16; const float r1 = rs[ai * 4 + m], rs2 = r1 * r1;
                    *(u32x4*)(z + (size_t)row * 1024 + 128 * (pn - 10) + wc * 32 + 8 * fq) = pack8(acc[ai][0][m][0] * acc[ai][1][m][0] * rs2, acc[ai][0][m][1] * acc[ai][1][m][1] * rs2);
                }
        }
    }
};
struct EpiMerge {
    static constexpr bool PERM = true, AFTER_DRAIN = false;
    bf16_t* merged; u32x4* scr; const float* ssq; int tid;
    __device__ __forceinline__ void operator()(const Acc& acc, const Unit& u, int wr, int wc, int fr, int fq) const {
        const int sub = u.sub; const int row0 = u.pm * 256 + wr * 64 + fr;
        char* mb = (char*)(merged + (size_t)row0 * DM + u.pn * 256 + wc * 32 + 8 * fq); asm volatile("" : "+v"(mb));
        char* sb = (char*)(scr + tid); asm volatile("" : "+v"(sb));
#define MP(ai, m, bj) ((u32x4*)(mb + ((ai) * 128 + (m) * 16) * (DM * 2) + (bj) * 256))
#define SP(ai, m, bj) ((u32x4*)(sb + ((((ai) * 4 + (m)) * 2 + (bj)) * 512) * 16))
        if ((sub & 1) == 0) {
            float rs[8]; rstd8(ssq, row0, fq, rs);
#pragma unroll
            for (int ai = 0; ai < 2; ++ai)
#pragma unroll
                for (int m = 0; m < 4; ++m) {
                    const float r1 = rs[ai * 4 + m];
#pragma unroll
                    for (int bj = 0; bj < 2; ++bj) {
                        f32x4 s0, s1; const f32x4 v0 = acc[ai][bj][m][0], v1 = acc[ai][bj][m][1];
#pragma unroll
                        for (int e = 0; e < 4; ++e) { s0[e] = sigmoidf_(v0[e] * r1); s1[e] = sigmoidf_(v1[e] * r1); }
                        if (sub == 0) *MP(ai, m, bj) = pack8(s0, s1); else *SP(ai, m, bj) = pack8(s0, s1);
                    }
                }
        } else if (sub == 1) {
#pragma unroll
            for (int ai = 0; ai < 2; ++ai) {
                u32x4 g[4][2];
#pragma unroll
                for (int m = 0; m < 4; ++m)
#pragma unroll
                    for (int bj = 0; bj < 2; ++bj) g[m][bj] = *MP(ai, m, bj);
#pragma unroll
                for (int m = 0; m < 4; ++m)
#pragma unroll
                    for (int bj = 0; bj < 2; ++bj) { f32x4 g0, g1; unpack8(g[m][bj], g0, g1); *MP(ai, m, bj) = pack8(g0 * acc[ai][bj][m][0], g1 * acc[ai][bj][m][1]); }
                asm volatile("" ::: "memory");
            }
        } else {
#pragma unroll
            for (int ai = 0; ai < 2; ++ai)
#pragma unroll
                for (int mp = 0; mp < 2; ++mp) {
                    u32x4 c[2][2], s[2][2];
#pragma unroll
                    for (int mm = 0; mm < 2; ++mm)
#pragma unroll
                        for (int bj = 0; bj < 2; ++bj) { c[mm][bj] = *MP(ai, 2 * mp + mm, bj); s[mm][bj] = *SP(ai, 2 * mp + mm, bj); }
#pragma unroll
                    for (int mm = 0; mm < 2; ++mm)
#pragma unroll
                        for (int bj = 0; bj < 2; ++bj) { const int m = 2 * mp + mm; f32x4 c0, c1, s0, s1; unpack8(c[mm][bj], c0, c1); unpack8(s[mm][bj], s0, s1);
                            *MP(ai, m, bj) = pack8(c0 + s0 * acc[ai][bj][m][0], c1 + s1 * acc[ai][bj][m][1]); }
                    asm volatile("" ::: "memory");
                }
        }
#undef MP
#undef SP
    }
};

__device__ __forceinline__ void cvt_item(const float* W, int Nsrc, int n0src, const float* gain, bool permqk, bf16* WT, int K, int nrow0, int k0, LAS float* scr, int lane) {
#pragma unroll 8
    for (int i = 0; i < 32; ++i) { const int kk = 2 * i + (lane >> 5); float w = W[(size_t)(k0 + kk) * Nsrc + n0src + (lane & 31)]; if (gain) w *= gain[k0 + kk]; scr[kk * 33 + (lane & 31)] = w; }
    asm volatile("s_waitcnt lgkmcnt(0)" ::: "memory");
    const int c = lane & 7;
#pragma unroll
    for (int j = 0; j < 4; ++j) { const int n = (lane >> 3) + 8 * j; const int ns = permqk ? (16 * ((n >> 2) & 1) + 4 * (n >> 3) + (n & 3)) : n; const LAS float* s = scr + (8 * c) * 33 + ns;
        v4u o; o.x = pk2(s[0 * 33], s[1 * 33]); o.y = pk2(s[2 * 33], s[3 * 33]); o.z = pk2(s[4 * 33], s[5 * 33]); o.w = pk2(s[6 * 33], s[7 * 33]);
        *(GAS v4u*)(WT + (size_t)(nrow0 + n) * K + k0 + 8 * c) = o; }
    asm volatile("s_waitcnt lgkmcnt(0)" ::: "memory");
}
#define RLX_AGENT __ATOMIC_RELAXED, __HIP_MEMORY_SCOPE_AGENT
#define XB_TMO      128
#define XB_XCNT(j)  (256  + 64 * (j))
#define XB_XSUB(j)  (1280 + 64 * (j))
#define XB_XGEN(j)  (2304 + 64 * (j))
#define XB_TOP      3328
#define XB_TOPGEN   3392
#define XCD_BAR_WORDS 3456
#define XB_SPIN_CAP (1u << 18)

__device__ __forceinline__ unsigned xb_ld(unsigned* p)              { return __hip_atomic_load(p, __ATOMIC_RELAXED, __HIP_MEMORY_SCOPE_AGENT); }
__device__ __forceinline__ unsigned xb_add(unsigned* p, unsigned v) { return __hip_atomic_fetch_add(p, v, __ATOMIC_RELAXED, __HIP_MEMORY_SCOPE_AGENT); }
__device__ __forceinline__ unsigned xb_xcc_id() { return (unsigned)__builtin_amdgcn_s_getreg((3 << 11) | 20) & 0xFu; }
#define XB_SPIN(cond, bar) do { unsigned _sp = 0; while (cond) { __builtin_amdgcn_s_sleep(1); \
    if ((++_sp & 255u) == 0u) { if (xb_ld(&(bar)[XB_TMO])) break; if (_sp > XB_SPIN_CAP) { atomicAdd(&(bar)[XB_TMO], 1u); break; } } } } while (0)

struct XcdBarrier {
    unsigned* bar; unsigned x;
    volatile LAS unsigned* st;
};

__device__ __forceinline__ XcdBarrier xcd_barrier_post(unsigned* bar, volatile LAS unsigned* st) {
    XcdBarrier b; b.bar = bar; b.x = xb_xcc_id(); b.st = st;
    if (threadIdx.x == 0) (void)xb_add(&bar[XB_XCNT(b.x)], 1u);
    return b;
}
__device__ __forceinline__ void xcd_barrier_complete(unsigned* bar, unsigned x, unsigned& nloc, unsigned& nx) {
    const unsigned G = gridDim.x * gridDim.y * gridDim.z;
    unsigned sum, cnt, mine, sp = 0u;
    for (;;) {
        sum = 0u; cnt = 0u; mine = 0u;
#pragma unroll
        for (unsigned j = 0; j < 16; ++j) { const unsigned c = xb_ld(&bar[XB_XCNT(j)]); sum += c; cnt += (c > 0u) ? 1u : 0u; mine = (j == x) ? c : mine; }
        if (sum == G) break;
        __builtin_amdgcn_s_sleep(1);
        if ((++sp & 255u) == 0u) { if (xb_ld(&bar[XB_TMO])) break; if (sp > XB_SPIN_CAP) { atomicAdd(&bar[XB_TMO], 1u); break; } }
    }
    nloc = mine > 0u ? mine : 1u; nx = cnt > 0u ? cnt : 1u;
}

__device__ __forceinline__ void xcd_barrier(const XcdBarrier& b) {
    asm volatile("s_waitcnt vmcnt(0)" ::: "memory");
    __syncthreads();
    if (threadIdx.x == 0) {
        unsigned* bar = b.bar;
        __builtin_amdgcn_s_waitcnt(0);
        unsigned nloc = b.st[0], nx = b.st[1];
        if (nloc == 0u) { xcd_barrier_complete(bar, b.x, nloc, nx); b.st[0] = nloc; b.st[1] = nx; }
        const unsigned old = xb_add(&bar[XB_XSUB(b.x)], 1u);
        const unsigned gen = old / nloc;
        if (old + 1u == (gen + 1u) * nloc) {
            __builtin_amdgcn_fence(__ATOMIC_RELEASE, "agent");
            asm volatile("s_waitcnt vmcnt(0)" ::: "memory");
            const unsigned og = xb_add(&bar[XB_TOP], 1u);
            const unsigned tg = og / nx;
            if (og + 1u == (tg + 1u) * nx) xb_add(&bar[XB_TOPGEN], 1u);
            else XB_SPIN(xb_ld(&bar[XB_TOPGEN]) == tg, bar);
            __builtin_amdgcn_fence(__ATOMIC_ACQUIRE, "agent");
            xb_add(&bar[XB_XGEN(b.x)], 1u);
            asm volatile("s_waitcnt vmcnt(0)" ::: "memory");
        } else {
            XB_SPIN(xb_ld(&bar[XB_XGEN(b.x)]) == gen, bar);
            __builtin_amdgcn_fence(__ATOMIC_ACQUIRE, "agent");
            asm volatile("s_waitcnt vmcnt(0)" ::: "memory");
        }
    }
    __syncthreads();
}
struct Args { const float* in[21]; float* out; unsigned char* ws; int ph_lo, ph_hi; };
struct PT {
    volatile LAS unsigned long long* t;
    __device__ __forceinline__ unsigned long long get(int i) const { const unsigned long long v = t[i]; const unsigned lo = __builtin_amdgcn_readfirstlane((unsigned)v), hi = __builtin_amdgcn_readfirstlane((unsigned)(v >> 32)); return ((unsigned long long)hi << 32) | lo; }
    __device__ __forceinline__ const float* in(int i) const { return (const float*)(const GAS float*)get(i); }
    __device__ __forceinline__ float* out() const { return (float*)(GAS float*)get(21); }
    __device__ __forceinline__ unsigned char* ws() const { return (unsigned char*)(GAS unsigned char*)get(22); }
};

__device__ __forceinline__ void cvt_one(const PT a, unsigned char* ws, int l, LAS unsigned char* lds, int it, int wave, int lane) {
    LAS float* scr = (LAS float*)(lds + wave * 16384);
    bf16* W = (bf16*)(ws + WS_W + (size_t)(l & 1) * WBUF);
    const size_t ffo = (size_t)l * DM * FF, sqo = (size_t)l * DM * DM;
    const float* win = a.in(8) + (size_t)l * DM * 6656; const float* mixg = a.in(7) + l * DM;
    {
        int r = it;
        if (r < 2816) { const int kb = r / 176, nb = r % 176, pn = nb >> 3, t = nb & 7; const float* src = (t >> 2) ? a.in(5) + ffo : a.in(4) + ffo;
            cvt_item(src, FF, 128 * pn + 32 * (t & 3), a.in(3) + l * DM, false, (bf16*)((char*)W + W_GU1), 1024, nb * 32, kb * 64, scr, lane); return; } r -= 2816;
        if (r < 1408) { const int kb = r / 32, nb = r % 32; cvt_item(a.in(6) + ffo, DM, nb * 32, nullptr, false, (bf16*)((char*)W + W_D1), FF, nb * 32, kb * 64, scr, lane); return; } r -= 1408;
        if (r < 2304) { const int kb = r / 144, nb = r % 144, pn = nb >> 3, t = nb & 7; int n0; bool pq = false;
            if (pn < 4) { n0 = 64 * (4 * pn + (t & 3)) + 32 * (t >> 2); pq = true; }
            else if (pn == 4) { n0 = 1024 + 64 * (t & 3) + 32 * (t >> 2); pq = true; }
            else if (pn == 5) n0 = 1280 + 32 * t;
            else if (pn < 10) n0 = 1536 + 256 * (pn - 6) + 32 * t;
            else n0 = ((t >> 2) ? 3584 : 2560) + 128 * (pn - 10) + 32 * (t & 3);
            cvt_item(win, 6656, n0, mixg, pq, (bf16*)((char*)W + W_IN), 1024, nb * 32, kb * 64, scr, lane); return; } r -= 2304;
        if (r < 2560) { const int seg = r / 512, q = r % 512, kb = q / 32, nb = q % 32;
            const float* src; int ns, n0; const float* gn = nullptr; size_t dst;
            if (seg == 0) { src = win; ns = 6656; n0 = 5632 + nb * 32; gn = mixg; dst = W_GC; }
            else if (seg == 1) { src = a.in(14) + sqo; ns = DM; n0 = nb * 32; dst = W_OC; }
            else if (seg == 2) { src = win; ns = 6656; n0 = 4608 + nb * 32; gn = mixg; dst = W_GA; }
            else if (seg == 3) { src = a.in(13) + sqo; ns = DM; n0 = nb * 32; dst = W_OA; }
            else { src = a.in(15) + sqo; ns = DM; n0 = nb * 32; dst = W_M; }
            cvt_item(src, ns, n0, gn, false, (bf16*)((char*)W + dst), 1024, nb * 32, kb * 64, scr, lane); return; } r -= 2560;
        if (r < 2816) { const int kb = r / 176, nb = r % 176, pn = nb >> 3, t = nb & 7; const float* src = (t >> 2) ? a.in(18) + ffo : a.in(17) + ffo;
            cvt_item(src, FF, 128 * pn + 32 * (t & 3), a.in(16) + l * DM, false, (bf16*)((char*)W + W_GU2), 1024, nb * 32, kb * 64, scr, lane); return; } r -= 2816;
        { const int kb = r / 32, nb = r % 32; cvt_item(a.in(19) + ffo, DM, nb * 32, nullptr, false, (bf16*)((char*)W + W_D2), FF, nb * 32, kb * 64, scr, lane); }
    }
}

constexpr int CVT_ITEMS = 13312;
__device__ __forceinline__ void convert_static(const PT a, unsigned char* ws, int l, LAS unsigned char* lds, int gw, int NGW, int wave, int lane) {
    for (int it = gw; it < CVT_ITEMS; it += NGW) cvt_one(a, ws, l, lds, it, wave, lane);
}
__device__ __forceinline__ void convert_dynamic(const PT a, unsigned char* ws, int l, LAS unsigned char* lds, unsigned* ctr, int lo, int hi, int wave, int lane) {
    for (;;) {
        unsigned b = 0; if (lane == 0) b = atomicAdd(ctr, 4u);
        const int base = lo + (int)__builtin_amdgcn_readfirstlane(b);
        if (base >= hi) break;
        for (int k = 0; k < 4; ++k) { if (base + k < hi) cvt_one(a, ws, l, lds, base + k, wave, lane); }
    }
}
__device__ __forceinline__ void prologue(const PT a, unsigned char* ws, int tid, int wave, int lane, int bid, int G) {
    const int gtid = bid * 512 + tid, GT = G * 512, gw = bid * NWAVES + wave, NGW = G * NWAVES;
    float* ssq = (float*)(ws + WS_SSQ); bf16* hb = (bf16*)(ws + WS_HB); float* rope = (float*)(ws + WS_ROPE);
    for (int i = gtid; i < (TPAD - T_ROWS) * 16; i += GT) ssq[(size_t)T_ROWS * 16 + i] = 0.f;
    for (int i = gtid; i < (TPAD - T_ROWS) * DM / 8; i += GT) ((v4u*)(hb + (size_t)T_ROWS * DM))[i] = (v4u){0u, 0u, 0u, 0u};
    if (gtid < 64) ((unsigned*)(ws + WS_CTL))[gtid] = 0u;
    for (int i = gtid; i < LP * 32; i += GT) {
        const int pos = i >> 5, axis = (i >> 4) & 1, f = i & 15;
        float coord; if (pos < 16) coord = axis ? (float)pos : -1.0f; else { const int t = pos - 16; coord = axis ? (float)(t & 63) : (float)(t >> 6); }
        const float inv = powf(10000.0f, -(float)f * (1.0f / 16.0f)); const float ang = coord * inv;
        float s, c; sincosf(ang, &s, &c);
        rope[((pos * 2 + axis) * 2 + 0) * 16 + f] = c; rope[((pos * 2 + axis) * 2 + 1) * 16 + f] = s;
    }
    for (int r = gw; r < T_ROWS; r += NGW) {
        int pos, L; rowinfo(r, pos, L);
        const float* src;
        if (pos < 16) src = a.in(2) + (size_t)pos * DM;
        else if (r < ROWS_P) src = a.in(0) + ((size_t)(r / LP) * 4096 + pos - 16) * DM;
        else src = a.in(1) + ((size_t)((r - ROWS_P) / LS) * 2048 + pos - 16) * DM;
        f32x4 v[4]; float s = 0.f;
        unsigned long long* o8 = (unsigned long long*)(hb + (size_t)r * DM) + lane;
#pragma unroll
        for (int j = 0; j < 4; ++j) { v[j] = ((const f32x4*)src)[lane + 64 * j];
            const unsigned lo = pk2(v[j][0], v[j][1]), hi = pk2(v[j][2], v[j][3]); o8[64 * j] = (unsigned long long)lo | ((unsigned long long)hi << 32);
            const float a0 = bflo(lo), a1 = bfhi(lo), a2 = bflo(hi), a3 = bfhi(hi); s += (a0 * a0 + a1 * a1) + (a2 * a2 + a3 * a3); }
        s = wave_sum(s);
        if (lane < 16) ssq[(size_t)r * 16 + lane] = lane == 0 ? s : 0.f;
    }
}

constexpr int NSTRIP = (T_ROWS + 63) / 64;
__device__ __forceinline__ void conv_strip(const PT a, unsigned char* ws, int l, int tid, int strip) {
    bf16* cb = (bf16*)(ws + WS_CB); const bf16* z = (const bf16*)(ws + WS_Z);
    const float* cw = a.in(9) + (size_t)l * 3 * DM; const float* cbias = a.in(10) + (size_t)l * DM;
    const int chunk = tid & 127, sub = tid >> 7, c0 = chunk * 8;
    f32x4 w0[2], w1[2], w2[2], bb[2];
#pragma unroll
    for (int h = 0; h < 2; ++h) { w0[h] = *(const f32x4*)(cw + c0 + 4 * h); w1[h] = *(const f32x4*)(cw + DM + c0 + 4 * h); w2[h] = *(const f32x4*)(cw + 2 * DM + c0 + 4 * h); bb[h] = *(const f32x4*)(cbias + c0 + 4 * h); }
    const int r0 = strip * 64 + sub * 16;
#pragma unroll 4
    for (int i = 0; i < 16; ++i) {
        const int r = r0 + i; if (r >= T_ROWS) break;
        int pos, L; rowinfo(r, pos, L);
        const u32x4 zero = (u32x4){0u, 0u, 0u, 0u};
        const u32x4 zc = *(const u32x4*)(z + (size_t)r * DM + c0);
        const u32x4 zp = pos > 0 ? *(const u32x4*)(z + (size_t)(r - 1) * DM + c0) : zero;
        const u32x4 zn = pos < L - 1 ? *(const u32x4*)(z + (size_t)(r + 1) * DM + c0) : zero;
        u32x4* cp = (u32x4*)(cb + (size_t)r * DM + c0); const u32x4 cv = *cp;
        f32x4 p0, p1, c0v, c1v, n0, n1, b0, b1; unpack8(zp, p0, p1); unpack8(zc, c0v, c1v); unpack8(zn, n0, n1); unpack8(cv, b0, b1);
        const f32x4 o0 = b0 * (w0[0] * p0 + w1[0] * c0v + w2[0] * n0 + bb[0]), o1 = b1 * (w0[1] * p1 + w1[1] * c1v + w2[1] * n1 + bb[1]);
        *cp = pack8(o0, o1);
    }
}

__device__ __forceinline__ void attention_phase(const PT a, unsigned char* ws, int l, unsigned char* lds_generic, int tid, bool dry = false) {
    using abf = attn_body::bf16;
    const abf* Q = (const abf*)(ws + WS_Q); const abf* K = (const abf*)(ws + WS_K); const abf* V = (const abf*)(ws + WS_V); abf* O = dry ? (abf*)(ws + WS_END + MiB) : (abf*)(ws + WS_Q);
    unsigned* ctr = (unsigned*)(ws + WS_CTL) + l + (dry ? 8 : 0);
    volatile unsigned* slot = (volatile unsigned*)(lds_generic + MISC_OFF);
    for (;;) {
        if (tid == 0) *slot = atomicAdd(ctr, 1u);
        __syncthreads();
        const int idx = (int)__builtin_amdgcn_readfirstlane(*slot);
        if (idx >= ATT_UNITS + NSTRIP) break;
        int u;
        if (idx < 5 * NSTRIP) { if (idx % 5 == 0) { int tidc = tid; asm volatile("" : "+v"(tidc)); conv_strip(a, ws, l, tidc, idx / 5); __syncthreads(); continue; } u = idx - (idx + 4) / 5; }
        else u = idx - NSTRIP;
        int tidu = tid; asm volatile("" : "+v"(tidu));
        if (u < ATT_UNITS_P) { const int s = u / 260, rem = u - s * 260, kvh = rem / 65, qblk = rem - kvh * 65;
            attn_body::attn_unit<8, LP, 66>((long)s * LP, kvh, qblk, Q, K, V, O, (char*)lds_generic, tidu); }
        else { const int u2 = u - ATT_UNITS_P, s = u2 / 132, rem = u2 - s * 132, kvh = rem / 33, qblk = rem - kvh * 33;
            attn_body::attn_unit<8, LS, 34>((long)ROWS_P + (long)s * LS, kvh, qblk, Q, K, V, O, (char*)lds_generic, tidu); }
    }
}

__device__ __forceinline__ void final_phase(const PT a, unsigned char* ws, int wave, int lane, int bid, int G) {
    const int gw = bid * NWAVES + wave, NGW = G * NWAVES;
    const float* ssq = (const float*)(ws + WS_SSQ); const bf16* hb = (const bf16*)(ws + WS_HB); float* out = a.out();
    f32x4 g[4];
#pragma unroll
    for (int j = 0; j < 4; ++j) g[j] = ((const f32x4*)a.in(20))[lane + 64 * j];
    for (int r = gw; r < T_ROWS; r += NGW) {
        int pos, L; rowinfo(r, pos, L); if (pos < 16) continue;
        float* p = r < ROWS_P ? out + ((size_t)(r / LP) * 4096 + pos - 16) * DM : out + (size_t)NSEQ_P * 4096 * DM + ((size_t)((r - ROWS_P) / LS) * 2048 + pos - 16) * DM;
        const float rs = rstd_of(ssq, r);
        const unsigned long long* i8 = (const unsigned long long*)(hb + (size_t)r * DM) + lane;
#pragma unroll
        for (int j = 0; j < 4; ++j) { const unsigned long long w = i8[64 * j]; const unsigned lo = (unsigned)w, hi = (unsigned)(w >> 32);
            const f32x4 v = (f32x4){bflo(lo), bfhi(lo), bflo(hi), bfhi(hi)}; ((f32x4*)p)[lane + 64 * j] = v * rs * g[j]; }
    }
}

constexpr int NSTEPS = 2 + 8 * NLAYER;

template <int STEP>
__device__ __forceinline__ void run_step(const PT pt, unsigned char* lds, cg::grid_group& grid, XcdBarrier& bar, const int ph_lo, const int ph_hi) {
#ifdef MAX_STEP
    if (STEP >= MAX_STEP && STEP != NSTEPS - 1) return;
#endif
    if (STEP < ph_lo || STEP >= ph_hi) return;
    if (STEP > ph_lo) {
        if (STEP == ph_lo + 1) {
            asm volatile("s_waitcnt vmcnt(0)" ::: "memory"); grid.sync();
            bar = xcd_barrier_post((unsigned*)(pt.ws() + WS_CTL) + CW_BAR, (volatile LAS unsigned*)((LAS unsigned char*)lds + MISC_OFF + 32));
        } else xcd_barrier(bar);
#ifdef DUP_SYNC
        xcd_barrier(bar); xcd_barrier(bar);
#endif
    }
    LAS unsigned char* l3 = (LAS unsigned char*)lds;
    int tid = threadIdx.x; asm volatile("" : "+v"(tid));
    int bid = blockIdx.x; asm volatile("" : "+s"(bid));
    int G = gridDim.x; asm volatile("" : "+s"(G));
    unsigned char* ws = pt.ws();
    const int lane = tid & 63, wave = __builtin_amdgcn_readfirstlane(tid >> 6);
    const int gw = bid * NWAVES + wave, NGW = G * NWAVES;
    float* ssq = (float*)(ws + WS_SSQ);
    bf16_t* hb = (bf16_t*)(ws + WS_HB);
    if constexpr (STEP == 0) { prologue(pt, ws, tid, wave, lane, bid, G); convert_static(pt, ws, 0, l3, gw, NGW, wave, lane); __syncthreads(); }
    else if constexpr (STEP == NSTEPS - 1) { final_phase(pt, ws, wave, lane, bid, G); }
    else {
        constexpr int l = (STEP - 1) / 8, ph = (STEP - 1) % 8 + 1;
        unsigned char* wl = ws + WS_W + (size_t)(l & 1) * WBUF;
        if constexpr (ph == 0) {
        } else if constexpr (ph == 1 || ph == 7) {
            constexpr int f = ph == 7;
            PlainOrder S; S.init(TPAD, 2 * FF, G, bid); S.A = (const char*)hb; S.Bt = (const char*)(wl + (f ? W_GU2 : W_GU1)); S.tstep = (size_t)256 * 1024 * 2;
            pg8::Gemm g{nullptr, nullptr, TPAD, 2 * FF, 1024};
            EpiSwiGLU E{(bf16_t*)(ws + WS_HID), ssq};
#ifndef NO_GU
            pg8::gemm_phase<EpiSwiGLU, PlainOrder, true, true>(l3, g, S, E, tid);
#ifdef DUP_GU
            __syncthreads();
            pg8::gemm_phase<EpiSwiGLU, PlainOrder, true, true>(l3, g, S, E, tid);
#endif
#endif
        } else if constexpr (ph == 2 || ph == 6 || ph == 8) {
            constexpr int f = ph == 8; constexpr int K = ph == 6 ? 1024 : FF;
            PlainOrder S; S.init(TPAD, DM, G, bid);
            S.A = ph == 6 ? (const char*)(ws + WS_Z) : (const char*)(ws + WS_HID);
            S.Bt = (const char*)(wl + (ph == 6 ? W_M : (f ? W_D2 : W_D1))); S.tstep = (size_t)256 * K * 2;
            pg8::Gemm g{nullptr, nullptr, TPAD, DM, K};
#ifdef DUP_DOWN
            EpiResid E{hb, ssq, ph == 6 ? 0.5f : 0.25f};
            pg8::gemm_phase<EpiResid, PlainOrder, true, true>(l3, g, S, E, tid); __syncthreads();
#else
            EpiResid E{hb, ssq, ph == 6 ? 1.0f : 0.5f};
#endif
#ifndef NO_RES
            pg8::gemm_phase<EpiResid, PlainOrder, true, true>(l3, g, S, E, tid);
#endif
            if constexpr (l + 1 < NLAYER) {
                constexpr int part = ph == 2 ? 0 : (ph == 6 ? 1 : 2); constexpr int lo = part * (CVT_ITEMS / 3), hi = part == 2 ? CVT_ITEMS : (part + 1) * (CVT_ITEMS / 3);
                convert_dynamic(pt, ws, l + 1, l3, (unsigned*)(ws + WS_CTL) + 16 + 4 * l + part, lo, hi, wave, lane);
                __syncthreads();
            }
        } else if constexpr (ph == 3) {
            PlainOrder S; S.init(TPAD, NWIN, G, bid); S.A = (const char*)hb; S.Bt = (const char*)(wl + W_IN); S.tstep = (size_t)256 * 1024 * 2;
            pg8::Gemm g{nullptr, nullptr, TPAD, NWIN, 1024};
            EpiWin E{(bf16_t*)(ws + WS_Q), (bf16_t*)(ws + WS_K), (bf16_t*)(ws + WS_V), (bf16_t*)(ws + WS_CB), (bf16_t*)(ws + WS_Z), ssq,
                     (const float*)(ws + WS_ROPE), pt.in(11) + l * 64, pt.in(12) + l * 64};
#ifndef NO_WIN
            pg8::gemm_phase<EpiWin, PlainOrder, true, true>(l3, g, S, E, tid);
#ifdef DUP_WIN
            __syncthreads();
            pg8::gemm_phase<EpiWin, PlainOrder, true, true>(l3, g, S, E, tid);
#endif
#endif
        } else if constexpr (ph == 4) {
#ifdef DUP_ATT
            attention_phase(pt, ws, l, lds, tid, true); __syncthreads();
#endif
#ifndef NO_ATT
            attention_phase(pt, ws, l, lds, tid);
#endif
        } else {
            ChainOrder S; S.base.init(TPAD, DM, G, bid); S.tstep = (size_t)256 * 1024 * 2;
            S.A[0] = (const char*)hb; S.A[1] = (const char*)(ws + WS_CB); S.A[2] = (const char*)hb; S.A[3] = (const char*)(ws + WS_Q);
            S.B[0] = (const char*)(wl + W_GC); S.B[1] = (const char*)(wl + W_OC); S.B[2] = (const char*)(wl + W_GA); S.B[3] = (const char*)(wl + W_OA);
            pg8::Gemm g{nullptr, nullptr, TPAD, DM, 1024};
            EpiMerge E{(bf16_t*)(ws + WS_Z), (u32x4*)(ws + WS_SCR + (size_t)bid * 131072), ssq, tid};
#ifndef NO_MERGE
            pg8::gemm_phase<EpiMerge, ChainOrder, true, true>(l3, g, S, E, tid);
#ifdef DUP_MERGE
            __syncthreads();
            pg8::gemm_phase<EpiMerge, ChainOrder, true, true>(l3, g, S, E, tid);
#endif
#endif
        }
    }
}
template <int STEP>
__device__ __forceinline__ void run_from(const PT pt, unsigned char* lds, cg::grid_group& grid, XcdBarrier& bar, const int ph_lo, const int ph_hi) {
    run_step<STEP>(pt, lds, grid, bar, ph_lo, ph_hi);
    if constexpr (STEP + 1 < NSTEPS) run_from<STEP + 1>(pt, lds, grid, bar, ph_lo, ph_hi);
}

__global__ void __launch_bounds__(NWAVES * 64, 2) mega_fwd(Args args) {
    extern __shared__ __attribute__((aligned(16))) unsigned char lds[];
    cg::grid_group grid = cg::this_grid();
    PT pt; pt.t = (volatile LAS unsigned long long*)((LAS unsigned char*)lds + PTAB_OFF);
    if (threadIdx.x == 0) {
#pragma unroll
        for (int i = 0; i < 21; ++i) pt.t[i] = (unsigned long long)args.in[i];
        pt.t[21] = (unsigned long long)args.out; pt.t[22] = (unsigned long long)args.ws;
    }
    if (threadIdx.x < 8) ((volatile LAS unsigned*)((LAS unsigned char*)lds + MISC_OFF + 32))[threadIdx.x] = 0u;
    const int ph_lo = args.ph_lo, ph_hi = args.ph_hi;
    if (blockIdx.x == 0) { unsigned* bw = (unsigned*)(args.ws + WS_CTL) + CW_BAR; for (int i = threadIdx.x; i < XCD_BAR_WORDS; i += NWAVES * 64) bw[i] = 0u; }
    __syncthreads();
    XcdBarrier bar; bar.bar = nullptr; bar.x = 0; bar.st = nullptr;
    run_from<0>(pt, lds, grid, bar, ph_lo, ph_hi);
}

#ifndef LAUNCH_PER_STEP
#define LAUNCH_PER_STEP 0
#endif
extern "C" void kernel_launch(void* const* d_in, const int* in_sizes, int n_in, void* d_out, int out_size, void* d_ws, size_t ws_size, hipStream_t stream) {
    static int grid = 0;
    if (grid == 0) {
        if (n_in != 21 || ws_size < WS_END) { fprintf(stderr, "kernel_launch: need 21 inputs and >= %zu bytes of workspace; got %d, %zu\n", (size_t)WS_END, n_in, ws_size); grid = -1; return; }
        int dev = 0, cus = 0, per_cu = 0;
        hipGetDevice(&dev); hipDeviceGetAttribute(&cus, hipDeviceAttributeMultiprocessorCount, dev);
        if (hipFuncSetAttribute((const void*)mega_fwd, hipFuncAttributeMaxDynamicSharedMemorySize, LDS_BYTES) != hipSuccess) { fprintf(stderr, "kernel_launch: hipFuncSetAttribute failed\n"); grid = -1; return; }
        if (hipOccupancyMaxActiveBlocksPerMultiprocessor(&per_cu, (const void*)mega_fwd, NWAVES * 64, LDS_BYTES) != hipSuccess || per_cu < 1) per_cu = 1;
        (void)hipGetLastError();
        grid = cus * per_cu;
    }
    if (grid < 0) return;
    Args a{};
    for (int i = 0; i < 21; ++i) a.in[i] = (const float*)d_in[i];
    a.out = (float*)d_out; a.ws = (unsigned char*)d_ws;
#if LAUNCH_PER_STEP
    for (int s = 0; s < NSTEPS; ++s) { a.ph_lo = s; a.ph_hi = s + 1; void* kargs[] = {&a}; hipLaunchCooperativeKernel((void*)mega_fwd, dim3(grid), dim3(NWAVES * 64), kargs, LDS_BYTES, stream); }
#else
    a.ph_lo = 0; a.ph_hi = NSTEPS; void* kargs[] = {&a};
    hipError_t e = hipLaunchCooperativeKernel((void*)mega_fwd, dim3(grid), dim3(NWAVES * 64), kargs, LDS_BYTES, stream);
    if (e != hipSuccess) fprintf(stderr, "cooperative launch failed: %s (grid %d)\n", hipGetErrorString(e), grid);
#endif
}
```

```cpp
#include <hip/hip_runtime.h>
#include <hip/hip_cooperative_groups.h>
#include <hip/hip_bf16.h>
#include <cstdio>
#include <cstdint>
#include <cmath>
namespace cg = cooperative_groups;
namespace pg8 {
#define PG8_LAS __attribute__((address_space(3)))
typedef unsigned short bf16_t;
typedef short bf16x8 __attribute__((ext_vector_type(8)));
typedef float f32x4 __attribute__((ext_vector_type(4)));
typedef unsigned u32x4 __attribute__((ext_vector_type(4)));
constexpr int BM = 256, BK = 64, HALF = 128, HTB = HALF * BK * 2  , STAGE_BYTES = 8 * HTB, NXCD = 8, WGM = 8;

__host__ __device__ __forceinline__ int lds_byte(int r, int c) { const int st = (r >> 4) * 2 + (c >> 5), rr = r & 15, cc = c & 31, ob = rr * 64 + cc * 2; return st * 1024 + (ob ^ (((ob >> 9) & 1) << 5)); }
__host__ __device__ __forceinline__ void stage_rc(int b, int& R, int& C) { const int st = b / 1024, sb = b % 1024, swz = sb ^ (((sb >> 9) & 1) << 5); R = (st >> 1) * 16 + swz / 64; C = (st & 1) * 32 + (swz % 64) / 2; }
__host__ __device__ __forceinline__ int perm32(int rho) { const int n = rho >> 4, i = rho & 15; return 8 * (i >> 2) + 4 * n + (i & 3); }

struct Unit { int pm, pn, sub; };
struct Gemm { const bf16_t* A; const bf16_t* Bt; int M, N, K; };

struct StaticOrder {
    int nM, nN, nwg, G, c;
    __host__ __device__ void init(int M, int N, int G_, int c_) { nM = M / BM; nN = N / BM; nwg = nM * nN; G = G_; c = c_; }
    __host__ __device__ bool next(int i, Unit& u) const {
        const long L = (long)i * G + c; if (L >= nwg) return false;
        int wgid = (int)L; { const int q = nwg / NXCD, r = nwg % NXCD, xcd = wgid % NXCD, off = wgid / NXCD; wgid = (xcd < r ? xcd * (q + 1) : r * (q + 1) + (xcd - r) * q) + off; }
        const int nig = WGM * nN, gid = wgid / nig, fm = gid * WGM, gsz = (nM - fm) < WGM ? (nM - fm) : WGM;
        u.pm = fm + ((wgid % nig) % gsz); u.pn = (wgid % nig) / gsz; u.sub = 0; return true;
    }
    __device__ __forceinline__ void a_ready(const Unit&) const {}
    __device__ __forceinline__ void done(const Unit&) const {}
};

__device__ __forceinline__ unsigned cvt_pk_bf16(float lo, float hi) { unsigned r; asm volatile("v_cvt_pk_bf16_f32 %0, %1, %2" : "=v"(r) : "v"(lo), "v"(hi)); return r; }
typedef float f32x2 __attribute__((ext_vector_type(2)));
template <class Epi, class Sched, bool ALIGN_EPI = false, bool SP2 = false>
__device__ __forceinline__ void gemm_phase(PG8_LAS unsigned char* lds, const Gemm g, const Sched& S, const Epi& E, const int tid) {
    const int wid = __builtin_amdgcn_readfirstlane(tid >> 6), lane = tid & 63, wr = wid >> 2, wc = wid & 3, fr = lane & 15, fq = lane >> 4;
    const int K = g.K, nt = K / BK;
    unsigned voffA[2], voffB[2];
#pragma unroll
    for (int i = 0; i < 2; ++i) { int R, C; stage_rc(tid * 16 + i * 8192, R, C); const int Rb = Epi::PERM ? ((R & ~31) + perm32(R & 31)) : R;
        voffA[i] = (unsigned)(R * K + C) * 2u; voffB[i] = (unsigned)(Rb * K + C) * 2u; }
    const size_t kstep = (size_t)(BK * 2);
    const size_t hstep = (size_t)HALF * K * 2;
        const unsigned ldsw = (unsigned)wid * 1024u;
    const int aoff = lds_byte(wr * 64 + fr, fq * 8), boff = lds_byte(wc * 32 + fr, fq * 8);
#define PG8_SA(b, h) (((b) * 2 + (h)) * HTB)
#define PG8_SB(b, h) ((4 + (b) * 2 + (h)) * HTB)
#define PG8_STAGE(bufoff, gbase, voff) do { _Pragma("unroll") for (int _i = 0; _i < 2; ++_i) \
        __builtin_amdgcn_global_load_lds((const unsigned*)((const char*)(gbase) + (voff)[_i]), (PG8_LAS unsigned*)(lds + (bufoff) + ldsw + _i * 8192), 16, 0, 0); } while (0)
#define PG8_LDA(dst, b, h) do { _Pragma("unroll") for (int m = 0; m < 4; ++m) _Pragma("unroll") for (int k = 0; k < 2; ++k) dst[m][k] = *(const PG8_LAS bf16x8*)(lds + PG8_SA(b, h) + aoff + m * 2048 + k * 1024); } while (0)
#define PG8_LDB(dst, b, h) do { _Pragma("unroll") for (int n = 0; n < 2; ++n) _Pragma("unroll") for (int k = 0; k < 2; ++k) dst[n][k] = *(const PG8_LAS bf16x8*)(lds + PG8_SB(b, h) + boff + n * 2048 + k * 1024); } while (0)
#define PG8_MMA(ai, bj, At, Bt) do { __builtin_amdgcn_s_setprio(1); _Pragma("unroll") for (int m = 0; m < 4; ++m) _Pragma("unroll") for (int n = 0; n < 2; ++n) _Pragma("unroll") for (int k = 0; k < 2; ++k) \
        acc[ai][bj][m][n] = __builtin_amdgcn_mfma_f32_16x16x32_bf16(Bt[n][k], At[m][k], acc[ai][bj][m][n], 0, 0, 0); __builtin_amdgcn_s_setprio(0); } while (0)
#define PG8_WAIT_V(n) asm volatile("s_waitcnt vmcnt(" #n ")" ::: "memory")
#define PG8_WAIT_L(n) asm volatile("s_waitcnt lgkmcnt(" #n ")" ::: "memory")
#define PG8_BAR __builtin_amdgcn_s_barrier()
#define PG8_SCHED __builtin_amdgcn_sched_barrier(0)
    Unit cur, nxt; int ui = 0;
    if (!S.next(0, cur)) return;
    f32x4 acc[2][2][4][2];
#pragma unroll
    for (int a = 0; a < 2; ++a)
#pragma unroll
        for (int b = 0; b < 2; ++b)
#pragma unroll
            for (int m = 0; m < 4; ++m)
#pragma unroll
                for (int n = 0; n < 2; ++n) acc[a][b][m][n] = (f32x4){0.f, 0.f, 0.f, 0.f};
    bf16x8 At[4][2], B0[2][2], B1[2][2];
    const char* cA = S.aptr(cur); const char* cB = S.bptr(cur);
    S.a_ready(cur);
    if constexpr (SP2) {
        PG8_STAGE(PG8_SB(0, 0), cB, voffB); PG8_STAGE(PG8_SB(0, 1), cB + hstep, voffB); PG8_STAGE(PG8_SA(0, 0), cA, voffA); PG8_STAGE(PG8_SA(0, 1), cA + hstep, voffA);
        if (wr == 1) PG8_BAR;
        PG8_WAIT_V(2); PG8_BAR;
        PG8_STAGE(PG8_SB(1, 0), cB + kstep, voffB); PG8_STAGE(PG8_SA(1, 0), cA + kstep, voffA); PG8_STAGE(PG8_SB(1, 1), cB + hstep + kstep, voffB);
        PG8_WAIT_V(6); PG8_BAR;
    } else {
        PG8_STAGE(PG8_SB(0, 0), cB, voffB); PG8_STAGE(PG8_SA(0, 0), cA, voffA); PG8_STAGE(PG8_SB(0, 1), cB + hstep, voffB); PG8_STAGE(PG8_SA(0, 1), cA + hstep, voffA);
        if (wr == 1) PG8_BAR;
        PG8_WAIT_V(4); PG8_BAR;
        PG8_STAGE(PG8_SB(1, 0), cB + kstep, voffB); PG8_STAGE(PG8_SA(1, 0), cA + kstep, voffA); PG8_STAGE(PG8_SB(1, 1), cB + hstep + kstep, voffB);
        PG8_WAIT_V(6); PG8_BAR;
    }
    for (;;) {
        const bool has_next = S.next(ui + 1, nxt);
        const char* nA = has_next ? S.aptr(nxt) : cA; const char* nB = has_next ? S.bptr(nxt) : cB;
        for (int t = 0; t < nt; t += 2) {
            const bool last = (t == nt - 2);
            const char* a1 = cA + (size_t)(t + 1) * kstep;
            const char* a2 = last ? nA : cA + (size_t)(t + 2) * kstep; const char* b2 = last ? nB : cB + (size_t)(t + 2) * kstep;
            const char* a3 = a2 + kstep; const char* b3 = b2 + kstep;
            if (last && has_next) S.a_ready(nxt);
            if constexpr (SP2) {
            PG8_LDB(B0, 0, 0); PG8_LDB(B1, 0, 1); PG8_SCHED; PG8_LDA(At, 0, 0); PG8_STAGE(PG8_SA(1, 1), a1 + hstep, voffA);
            PG8_WAIT_V(8); PG8_WAIT_L(0); PG8_BAR; PG8_MMA(0, 0, At, B0); PG8_MMA(0, 1, At, B1); PG8_BAR; PG8_SCHED;
            PG8_LDA(At, 0, 1); PG8_STAGE(PG8_SB(0, 0), b2, voffB); PG8_STAGE(PG8_SB(0, 1), b2 + hstep, voffB); PG8_STAGE(PG8_SA(0, 0), a2, voffA);
            PG8_WAIT_V(8); PG8_WAIT_L(0); PG8_BAR; PG8_MMA(1, 0, At, B0); PG8_MMA(1, 1, At, B1); PG8_BAR; PG8_SCHED;
            PG8_LDB(B0, 1, 0); PG8_LDB(B1, 1, 1); PG8_SCHED; PG8_LDA(At, 1, 0); PG8_STAGE(PG8_SA(0, 1), a2 + hstep, voffA);
            PG8_WAIT_V(8); PG8_WAIT_L(0); PG8_BAR; PG8_MMA(0, 0, At, B0); PG8_MMA(0, 1, At, B1); PG8_BAR; PG8_SCHED;
            PG8_LDA(At, 1, 1); PG8_STAGE(PG8_SB(1, 0), b3, voffB); PG8_STAGE(PG8_SB(1, 1), b3 + hstep, voffB); PG8_STAGE(PG8_SA(1, 0), a3, voffA);
            PG8_WAIT_V(8); PG8_WAIT_L(0); PG8_BAR; PG8_MMA(1, 0, At, B0); PG8_MMA(1, 1, At, B1); PG8_BAR; PG8_SCHED;
            } else {
            PG8_LDB(B0, 0, 0); PG8_SCHED; PG8_LDA(At, 0, 0); PG8_STAGE(PG8_SA(1, 1), a1 + hstep, voffA);
            PG8_WAIT_L(8); PG8_BAR; PG8_WAIT_L(0); PG8_MMA(0, 0, At, B0); PG8_BAR; PG8_SCHED;
            PG8_LDB(B1, 0, 1); PG8_STAGE(PG8_SB(0, 0), b2, voffB);
            PG8_BAR; PG8_WAIT_L(0); PG8_MMA(0, 1, At, B1); PG8_BAR;
            PG8_LDA(At, 0, 1); PG8_STAGE(PG8_SA(0, 0), a2, voffA);
            PG8_BAR; PG8_WAIT_L(0); PG8_MMA(1, 0, At, B0); PG8_BAR; PG8_SCHED;
            PG8_STAGE(PG8_SB(0, 1), b2 + hstep, voffB);
            PG8_WAIT_V(6); PG8_BAR; PG8_MMA(1, 1, At, B1); PG8_BAR;
            PG8_LDB(B0, 1, 0); PG8_SCHED; PG8_LDA(At, 1, 0); PG8_STAGE(PG8_SA(0, 1), a2 + hstep, voffA);
            PG8_WAIT_L(8); PG8_BAR; PG8_WAIT_L(0); PG8_MMA(0, 0, At, B0); PG8_BAR; PG8_SCHED;
            PG8_LDB(B1, 1, 1); PG8_STAGE(PG8_SB(1, 0), b3, voffB);
            PG8_BAR; PG8_WAIT_L(0); PG8_MMA(0, 1, At, B1); PG8_BAR;
            PG8_LDA(At, 1, 1); PG8_STAGE(PG8_SA(1, 0), a3, voffA);
            PG8_BAR; PG8_WAIT_L(0); PG8_MMA(1, 0, At, B0); PG8_BAR; PG8_SCHED;
            PG8_STAGE(PG8_SB(1, 1), b3 + hstep, voffB);
            PG8_WAIT_V(6); PG8_BAR; PG8_MMA(1, 1, At, B1); PG8_BAR;
            }
        }
        if constexpr (ALIGN_EPI) { if (wr == 0) PG8_BAR; }
        if constexpr (!Epi::AFTER_DRAIN) { E(acc, cur, wr, wc, fr, fq); S.done(cur); }
        if (!has_next) break;
#pragma unroll
        for (int a = 0; a < 2; ++a)
#pragma unroll
            for (int b = 0; b < 2; ++b)
#pragma unroll
                for (int m = 0; m < 4; ++m)
#pragma unroll
                    for (int n = 0; n < 2; ++n) acc[a][b][m][n] = (f32x4){0.f, 0.f, 0.f, 0.f};
        cur = nxt; cA = nA; cB = nB; ++ui;
        if constexpr (ALIGN_EPI) { if (wr == 1) PG8_BAR; }
    }
    PG8_WAIT_V(0);
    if constexpr (!ALIGN_EPI) { if (wr == 0) PG8_BAR; }
    PG8_BAR;
    if constexpr (Epi::AFTER_DRAIN) { E.fused(acc, cur, wr, wc, fr, fq, lds, wid, lane); S.done(cur); }
#undef PG8_SA
#undef PG8_SB
#undef PG8_STAGE
#undef PG8_LDA
#undef PG8_LDB
#undef PG8_MMA
#undef PG8_WAIT_V
#undef PG8_WAIT_L
#undef PG8_BAR
#undef PG8_SCHED
}
}
namespace attn_body {
using bf16=__hip_bfloat16;
using bf16x8=__attribute__((ext_vector_type(8)))short;
using s16x4=__attribute__((ext_vector_type(4)))short;
using f32x16=__attribute__((ext_vector_type(16)))float;
using u32x4=__attribute__((ext_vector_type(4)))unsigned;
constexpr int D=64,QP=1024,KP=256;
constexpr int NW=8,QBLK=32,KVBLK=64;
__device__ __forceinline__ int crow(int r,int hi){return (r&3)+8*(r>>2)+4*hi;}
#define SBAR() __builtin_amdgcn_sched_barrier(0)
__device__ __forceinline__ void kmask(f32x16&p0,f32x16&p1,int rem,int hi){
  const float NEG=-INFINITY;
  #pragma unroll
  for(int r=0;r<16;++r){int kv=4*hi+(r&3)+8*(r>>2); if(kv>=rem)p0[r]=NEG; if(kv+32>=rem)p1[r]=NEG;}
}

constexpr int NSLOT=3, SLOTB=8192;
constexpr int LDS_K=0, LDS_V=NSLOT*SLOTB, LDS_WS=2*NSLOT*SLOTB, LDS_OST=LDS_WS+NW*64*4, LDS_BYTES=LDS_OST+NW*4096;
constexpr float C2=0.125f*1.4426950408889634f;
__device__ __forceinline__ void glds16(const void*gsrc,unsigned lds_dst){unsigned keep;
  asm volatile("s_mov_b32 %0, m0\n\ts_mov_b32 m0, %2\n\ts_nop 0\n\tglobal_load_lds_dwordx4 %1, off\n\ts_mov_b32 m0, %0":"=&s"(keep):"v"(gsrc),"s"(lds_dst):"memory");}
__device__ __forceinline__ float max3f(float a,float b,float c){float r;asm("v_max3_f32 %0, %1, %2, %3":"=v"(r):"v"(a),"v"(b),"v"(c));return r;}
__device__ __forceinline__ float max2f(float a,float b){float r;asm("v_max_f32_e32 %0, %1, %2":"=v"(r):"v"(a),"v"(b));return r;}
__device__ __forceinline__ float fadd_s(float a,float b){float r;asm("v_add_f32_e32 %0, %1, %2":"=v"(r):"v"(a),"v"(b));return r;}
__device__ __forceinline__ float fsub_s(float a,float b){float r;asm("v_sub_f32_e32 %0, %1, %2":"=v"(r):"v"(a),"v"(b));return r;}
typedef float f32x2_t __attribute__((ext_vector_type(2))); typedef __bf16 bf16x2_t __attribute__((ext_vector_type(2)));
__device__ __forceinline__ unsigned cvtpk_s(float lo,float hi){f32x2_t v={lo,hi};bf16x2_t b=__builtin_convertvector(v,bf16x2_t);return __builtin_bit_cast(unsigned,b);}
#define WAIT_BAR(N) asm volatile("s_waitcnt vmcnt(" #N ") lgkmcnt(0)\n\ts_barrier":::"memory")

__device__ __forceinline__ void qkt(f32x16&p0,f32x16&p1,const char*Kslot,const bf16x8*qr,const f32x16&negm,int r32,int hi){
  const char*kb=Kslot+hi*1024+r32*16;
  #pragma unroll
  for(int d0=0;d0<4;++d0){
    const bf16x8 b0=*reinterpret_cast<const bf16x8*>(kb+d0*2048);
    const bf16x8 b1=*reinterpret_cast<const bf16x8*>(kb+d0*2048+512);
    if(d0==0){p0=__builtin_amdgcn_mfma_f32_32x32x16_bf16(b0,qr[0],negm,0,0,0);p1=__builtin_amdgcn_mfma_f32_32x32x16_bf16(b1,qr[0],negm,0,0,0);}
    else{p0=__builtin_amdgcn_mfma_f32_32x32x16_bf16(b0,qr[d0],p0,0,0,0);p1=__builtin_amdgcn_mfma_f32_32x32x16_bf16(b1,qr[d0],p1,0,0,0);}}
}
typedef __attribute__((address_space(3))) const char* lds_cptr;
typedef short v4i16_t __attribute__((ext_vector_type(4)));
__device__ __forceinline__ void kload8(bf16x8*kf,lds_cptr kp){
  kf[0]=*(const __attribute__((address_space(3))) bf16x8*)(kp);      kf[1]=*(const __attribute__((address_space(3))) bf16x8*)(kp+512);
  kf[2]=*(const __attribute__((address_space(3))) bf16x8*)(kp+2048); kf[3]=*(const __attribute__((address_space(3))) bf16x8*)(kp+2560);
  kf[4]=*(const __attribute__((address_space(3))) bf16x8*)(kp+4096); kf[5]=*(const __attribute__((address_space(3))) bf16x8*)(kp+4608);
  kf[6]=*(const __attribute__((address_space(3))) bf16x8*)(kp+6144); kf[7]=*(const __attribute__((address_space(3))) bf16x8*)(kp+6656);
}
__device__ __forceinline__ void kload2(bf16x8*kf,lds_cptr kp,int j){ kf[2*j]=*(const __attribute__((address_space(3))) bf16x8*)(kp+j*2048); kf[2*j+1]=*(const __attribute__((address_space(3))) bf16x8*)(kp+j*2048+512); }
__device__ __forceinline__ s16x4 vtr(lds_cptr p){ return __builtin_bit_cast(s16x4,__builtin_amdgcn_ds_read_tr16_b64_v4i16((__attribute__((address_space(3))) v4i16_t*)p)); }
__device__ __forceinline__ float rowmax(const f32x16&p0,const f32x16&p1){
  float a=max3f(p0[0],p0[1],p1[0]),b=max3f(p0[2],p0[3],p1[1]);a=max3f(a,p1[2],p1[3]);
  #pragma unroll
  for(int r=4;r<16;r+=4){a=max3f(a,p0[r],p0[r+1]);b=max3f(b,p0[r+2],p0[r+3]);a=max3f(a,p1[r],p1[r+1]);b=max3f(b,p1[r+2],p1[r+3]);}
  const float m=max2f(a,b);
  auto rr=__builtin_amdgcn_permlane32_swap(__float_as_uint(m),__float_as_uint(m),false,false);
  return max2f(__uint_as_float(rr[0]),__uint_as_float(rr[1]));
}
__device__ __forceinline__ void pv(f32x16*o,int vb,bf16x8 pa0,bf16x8 pa1,bf16x8 pa2,bf16x8 pa3){
  #pragma unroll
  for(int d0=0;d0<2;++d0){s16x4 lo[4],hi[4];
    #pragma unroll
    for(int ks=0;ks<4;++ks){
      asm volatile("ds_read_b64_tr_b16 %0,%1 offset:%c2":"=&v"(lo[ks]):"v"(vb),"i"(d0*4096+ks*1024):"memory");
      asm volatile("ds_read_b64_tr_b16 %0,%1 offset:%c2":"=&v"(hi[ks]):"v"(vb),"i"(d0*4096+ks*1024+512):"memory");}
    asm volatile("s_waitcnt lgkmcnt(0)":::"memory");SBAR();
    #define PK(k) (bf16x8){lo[k][0],lo[k][1],lo[k][2],lo[k][3],hi[k][0],hi[k][1],hi[k][2],hi[k][3]}
    o[d0]=__builtin_amdgcn_mfma_f32_32x32x16_bf16(pa0,PK(0),o[d0],0,0,0);
    o[d0]=__builtin_amdgcn_mfma_f32_32x32x16_bf16(pa1,PK(1),o[d0],0,0,0);
    o[d0]=__builtin_amdgcn_mfma_f32_32x32x16_bf16(pa2,PK(2),o[d0],0,0,0);
    o[d0]=__builtin_amdgcn_mfma_f32_32x32x16_bf16(pa3,PK(3),o[d0],0,0,0);
    #undef PK
  }
}

#ifndef ATTN_STORE16
#define ATTN_STORE16(p,v) (*(u32x4*)(p)=(v))
#endif
template<int THRL,int L,int NT> __device__ __forceinline__ void attn_unit(long rowbase,int kvh,int qblk,const bf16*Q,const bf16*__restrict__ K,const bf16*__restrict__ V,bf16*O,char*shm,const int tid){
  const int lane=tid&63,r32=lane&31,hi=lane>>5; const int wid=__builtin_amdgcn_readfirstlane(tid>>6);
  const int q0=qblk*64, qh=wid>>1, rh=wid&1;
  const bf16*Qw=Q+(rowbase+q0+rh*QBLK)*QP+(4*kvh+qh)*D;
  const bf16*Kh=K+rowbase*KP+kvh*D,*Vh=V+rowbase*KP+kvh*D;
  const unsigned lds0=(unsigned)(uintptr_t)shm;
  float*wsf=(float*)(shm+LDS_WS)+wid*64;
  const bf16*ksrc=Kh+(long)lane*KP+wid*8;
  const bf16*vsrc=Vh+(long)(16*(wid&3)+(lane>>2))*KP+(wid>>2)*32+(lane&3)*8;
  const unsigned kdst=lds0+LDS_K+wid*1024, vdst=lds0+LDS_V+wid*1024;
  #define DMA_K(t,slot) glds16(ksrc+(long)(t)*KVBLK*KP,(unsigned)__builtin_amdgcn_readfirstlane(kdst+(slot)))
  #define DMA_V(t,slot) glds16(vsrc+(long)(t)*KVBLK*KP,(unsigned)__builtin_amdgcn_readfirstlane(vdst+(slot)))
  const int vb0=(int)(lds0+LDS_V)+((lane>>4)&1)*32+(lane&3)*8+(4*hi+((lane&15)>>2))*64;
  const char*Kbase=shm+LDS_K; bf16x8 kf[8];
  const lds_cptr shm3=(lds_cptr)shm; const lds_cptr kp0=shm3+LDS_K+hi*1024+r32*16; const lds_cptr vp0=shm3+LDS_V+((lane>>4)&1)*32+(lane&3)*8+(4*hi+((lane&15)>>2))*64;
  DMA_K(0,0);DMA_V(0,0);DMA_K(1,SLOTB);
  bf16x8 qr[4];
  #pragma unroll
  for(int d0=0;d0<4;++d0)qr[d0]=*reinterpret_cast<const bf16x8*>(&Qw[(long)r32*QP+d0*16+hi*8]);
  if(q0+rh*QBLK+r32>=L){
    #pragma unroll
    for(int d0=0;d0<4;++d0)qr[d0]=bf16x8{0,0,0,0,0,0,0,0}; }
  float mhat=0.f,l_reg=0.f;f32x16 o[2];o[0]=f32x16{};o[1]=f32x16{};f32x16 negm=f32x16{};asm volatile("":"+v"(negm));
  #define CMASK(P0,P1,t) do{ if((t)>=NT-2)kmask(P0,P1,L-64*(t),hi);}while(0)
  bool resc=false;
  #define START(P0,P1) do{ const float rm=rowmax(P0,P1); resc=false; \
    { const float dl=rm; mhat=fadd_s(mhat,dl); \
      _Pragma("unroll") for(int r=0;r<16;++r){P0[r]=fsub_s(P0[r],dl);P1[r]=fsub_s(P1[r],dl);} \
      _Pragma("unroll") for(int r=0;r<16;++r)negm[r]=-mhat; asm volatile("":"+v"(negm)); } \
    _Pragma("unroll") for(int r=0;r<16;++r)P0[r]=__builtin_amdgcn_exp2f(P0[r]); }while(0)
  #define RESC() do{ if(resc){ asm volatile("s_waitcnt lgkmcnt(0)":::"memory"); \
      _Pragma("unroll") for(int d_=0;d_<2;++d_) _Pragma("unroll") for(int r=0;r<16;++r)o[d_][r]*=wsf[crow(r,hi)]; } }while(0)
  f32x16 pA0,pA1,pB0,pB1;
  int sl_prev=0,sl_cur=0,sl_next=SLOTB;
  #define ROT() do{sl_prev=sl_cur;sl_cur=sl_next;sl_next=(sl_next==(NSLOT-1)*SLOTB)?0:sl_next+SLOTB;}while(0)
  DMA_K(2,2*SLOTB);
  WAIT_BAR(3);
  qkt(pA0,pA1,Kbase,qr,negm,r32,hi);asm volatile("s_nop 15\n\ts_nop 7":"+v"(pA0),"+v"(pA1));CMASK(pA0,pA1,0);
  START(pA0,pA1);
  _Pragma("unroll") for(int r=0;r<16;++r)pA1[r]=__builtin_amdgcn_exp2f(pA1[r]);
  WAIT_BAR(0);
  DMA_K(3,0);DMA_V(1,SLOTB);
  ROT();
  kload8(kf,kp0+sl_cur);
  WAIT_BAR(2);
  s16x4 vlo[8],vhi[8]; u32x4 pw0,pw1,pw2,pw3;
  #define PKW(P,B) cvtpk_s(P[B],P[B+1])
  #define PAF(k) __builtin_bit_cast(bf16x8,pw##k)
  #define VFR(i) (bf16x8){vlo[i][0],vlo[i][1],vlo[i][2],vlo[i][3],vhi[i][0],vhi[i][1],vhi[i][2],vhi[i][3]}
  #define PIN(x) asm volatile("":"+v"(x))
  #define MX3(a,b,c) __builtin_fmaxf(__builtin_fmaxf((a),(b)),(c))
  #define GAPA(MF,A0,A1,A2,A3,W0,W1,PW) do{ MF; sacc+=A0; sacc+=A1; sacc+=A2; sacc+=A3; PIN(sacc); W0; W1; PIN(PW); SBAR(); }while(0)
  #define EX(v) __builtin_amdgcn_exp2f(v)
  #define GAPB(MF,X,B) do{ MF; X[B]=EX(X[B]); X[B+1]=EX(X[B+1]); X[B+2]=EX(X[B+2]); X[B+3]=EX(X[B+3]); PIN(X); SBAR(); }while(0)
  #define VRD(i) do{ vlo[i]=vtr(vp_+(((i)>>2)*4096+((i)&3)*1024)); vhi[i]=vtr(vp_+(((i)>>2)*4096+((i)&3)*1024+512)); }while(0)
  #define KRD(G,j) do{ if(G){ kload2(kf,kp0+sl_next,j); SBAR(); } }while(0)
  #define STEP(C0,C1,P0,P1,t,GK,GV,GL) do{ SBAR(); \
    const lds_cptr vp_=vp0+sl_prev; \
    VRD(0); SBAR(); float sacc=(P0[0]+P0[1]); \
    GAPA(C0=__builtin_amdgcn_mfma_f32_32x32x16_bf16(kf[0],qr[0],negm,0,0,0), P0[2],P0[3],P0[4],P0[5],     pw0[0]=PKW(P0,0), pw0[1]=PKW(P0,2), pw0); \
    VRD(4); SBAR(); GAPA(C1=__builtin_amdgcn_mfma_f32_32x32x16_bf16(kf[1],qr[0],negm,0,0,0), P0[6],P0[7],P0[8],P0[9],     pw0[2]=PKW(P0,4), pw0[3]=PKW(P0,6), pw0); \
    VRD(1); SBAR(); GAPA(C0=__builtin_amdgcn_mfma_f32_32x32x16_bf16(kf[2],qr[1],C0,0,0,0),   P0[10],P0[11],P0[12],P0[13], pw1[0]=PKW(P0,8), pw1[1]=PKW(P0,10), pw1); \
    VRD(5); SBAR(); GAPA(C1=__builtin_amdgcn_mfma_f32_32x32x16_bf16(kf[3],qr[1],C1,0,0,0),   P0[14],P0[15],P1[0],P1[1],   pw1[2]=PKW(P0,12),pw1[3]=PKW(P0,14), pw1); \
    VRD(2); SBAR(); GAPA(C0=__builtin_amdgcn_mfma_f32_32x32x16_bf16(kf[4],qr[2],C0,0,0,0),   P1[2],P1[3],P1[4],P1[5],     pw2[0]=PKW(P1,0), pw2[1]=PKW(P1,2), pw2); \
    VRD(6); SBAR(); GAPA(C1=__builtin_amdgcn_mfma_f32_32x32x16_bf16(kf[5],qr[2],C1,0,0,0),   P1[6],P1[7],P1[8],P1[9],     pw2[2]=PKW(P1,4), pw2[3]=PKW(P1,6), pw2); \
    VRD(3); SBAR(); GAPA(C0=__builtin_amdgcn_mfma_f32_32x32x16_bf16(kf[6],qr[3],C0,0,0,0),   P1[10],P1[11],P1[12],P1[13], pw3[0]=PKW(P1,8), pw3[1]=PKW(P1,10), pw3); \
    VRD(7); SBAR(); GAPA(C1=__builtin_amdgcn_mfma_f32_32x32x16_bf16(kf[7],qr[3],C1,0,0,0),   P1[14],P1[15],0.f,0.f,       pw3[2]=PKW(P1,12),pw3[3]=PKW(P1,14), pw3); \
    l_reg+=sacc; \
    if(GK){DMA_K((t)+3,sl_cur);} if(GV){DMA_V((t)+1,sl_next);} \
    CMASK(C0,C1,t); \
    { float a=MX3(C0[0],C0[1],C1[0]),b=MX3(C0[2],C0[3],C1[1]); a=MX3(a,C1[2],C1[3]); \
      _Pragma("unroll") for(int r=4;r<16;r+=4){a=MX3(a,C0[r],C0[r+1]);b=MX3(b,C0[r+2],C0[r+3]);a=MX3(a,C1[r],C1[r+1]);b=MX3(b,C1[r+2],C1[r+3]);} \
      float rm=__builtin_fmaxf(a,b); { auto rr=__builtin_amdgcn_permlane32_swap(__float_as_uint(rm),__float_as_uint(rm),false,false); rm=__builtin_fmaxf(__uint_as_float(rr[0]),__uint_as_float(rr[1])); } \
      resc=false; \
      if(__builtin_expect(__any(rm>(float)THRL),0)){ const float dl=__builtin_fmaxf(rm,0.f); mhat+=dl; \
        _Pragma("unroll") for(int r=0;r<16;++r){C0[r]-=dl;C1[r]-=dl;} \
        _Pragma("unroll") for(int r=0;r<16;++r)negm[r]=-mhat; asm volatile("":"+v"(negm)); \
        const float f=__builtin_amdgcn_exp2f(-dl); l_reg*=f; if(hi==0)wsf[r32]=f; resc=true; } } \
    SBAR(); \
    GAPB(o[0]=__builtin_amdgcn_mfma_f32_32x32x16_bf16(PAF(0),VFR(0),o[0],0,0,0), C0,0); \
    GAPB(o[1]=__builtin_amdgcn_mfma_f32_32x32x16_bf16(PAF(0),VFR(4),o[1],0,0,0), C0,4); \
    KRD(GL,0); GAPB(o[0]=__builtin_amdgcn_mfma_f32_32x32x16_bf16(PAF(1),VFR(1),o[0],0,0,0), C0,8); \
    KRD(GL,1); GAPB(o[1]=__builtin_amdgcn_mfma_f32_32x32x16_bf16(PAF(1),VFR(5),o[1],0,0,0), C0,12); \
    KRD(GL,2); GAPB(o[0]=__builtin_amdgcn_mfma_f32_32x32x16_bf16(PAF(2),VFR(2),o[0],0,0,0), C1,0); \
    KRD(GL,3); GAPB(o[1]=__builtin_amdgcn_mfma_f32_32x32x16_bf16(PAF(2),VFR(6),o[1],0,0,0), C1,4); \
    GAPB(o[0]=__builtin_amdgcn_mfma_f32_32x32x16_bf16(PAF(3),VFR(3),o[0],0,0,0), C1,8); \
    GAPB(o[1]=__builtin_amdgcn_mfma_f32_32x32x16_bf16(PAF(3),VFR(7),o[1],0,0,0), C1,12); \
    }while(0)
  int t=1;
  #undef CMASK
  #define CMASK(P0,P1,t) do{}while(0)
  for(;t+5<NT;t+=2){
    STEP(pB0,pB1,pA0,pA1,t,true,true,true);     WAIT_BAR(2); RESC(); ROT();
    STEP(pA0,pA1,pB0,pB1,t+1,true,true,true);   WAIT_BAR(2); RESC(); ROT();
  }
  #undef CMASK
  #define CMASK(P0,P1,t) do{ if((t)>=NT-2)kmask(P0,P1,L-64*(t),hi);}while(0)
  #define ENDW(tt) do{ if((tt)+3<NT){WAIT_BAR(2);} else if((tt)+2<NT){WAIT_BAR(1);} else {WAIT_BAR(0);} }while(0)
  for(;t+1<NT;t+=2){
    STEP(pB0,pB1,pA0,pA1,t,(t+3<NT),(t+1<NT),(t+1<NT));       ENDW(t);   RESC(); ROT();
    STEP(pA0,pA1,pB0,pB1,t+1,(t+4<NT),(t+2<NT),(t+2<NT));     ENDW(t+1); RESC(); ROT();
  }
  STEP(pB0,pB1,pA0,pA1,NT-1,false,false,false); RESC();
  { float sacc=pB0[0]+pB0[1]; _Pragma("unroll") for(int r=2;r<16;++r)sacc+=pB0[r]; _Pragma("unroll") for(int r=0;r<16;++r)sacc+=pB1[r]; l_reg+=sacc;
    pw0=(u32x4){PKW(pB0,0),PKW(pB0,2),PKW(pB0,4),PKW(pB0,6)};pw1=(u32x4){PKW(pB0,8),PKW(pB0,10),PKW(pB0,12),PKW(pB0,14)};pw2=(u32x4){PKW(pB1,0),PKW(pB1,2),PKW(pB1,4),PKW(pB1,6)};pw3=(u32x4){PKW(pB1,8),PKW(pB1,10),PKW(pB1,12),PKW(pB1,14)};
    SBAR(); pv(o,vb0+sl_cur,PAF(0),PAF(1),PAF(2),PAF(3)); }
  #undef PKW
  #undef PAF
  #undef VFR
  #undef PIN
  #undef MX3
  #undef GAPA
  #undef GAPB
  #undef EX
  #undef VRD
  #undef KRD
  #undef STEP
  #undef ENDW
  {auto rr=__builtin_amdgcn_permlane32_swap(__float_as_uint(l_reg),__float_as_uint(l_reg),false,false);l_reg=__uint_as_float(rr[0])+__uint_as_float(rr[1]);}
  if(hi==0)wsf[32+r32]=l_reg;asm volatile("s_waitcnt lgkmcnt(0)":::"memory");
  float rli[16];
  #pragma unroll
  for(int r=0;r<16;++r)rli[r]=__builtin_amdgcn_rcpf(wsf[32+crow(r,hi)]);
  bf16*Ow=O+(rowbase+q0+rh*QBLK)*QP+(4*kvh+qh)*D;
  { bf16*stg=(bf16*)(shm+LDS_OST)+wid*2048;
    #pragma unroll
    for(int r=0;r<16;++r){const int orow=crow(r,hi);
      #pragma unroll
      for(int d0=0;d0<2;++d0)stg[orow*64+d0*32+r32]=__float2bfloat16(o[d0][r]*rli[r]);}
    asm volatile("s_waitcnt lgkmcnt(0)":::"memory");
    #pragma unroll
    for(int i=0;i<4;++i){const int row=i*8+(lane>>3),ch=lane&7; const u32x4 v=*(const u32x4*)(stg+row*64+ch*8); if(q0+rh*QBLK+row<L)ATTN_STORE16(Ow+(long)row*QP+ch*8,v);} }
  asm volatile("s_waitcnt lgkmcnt(0)\n\ts_barrier":::"memory");
  #undef DMA_K
  #undef DMA_V
  #undef CMASK
  #undef START
  #undef RESC
  #undef ROT
}
constexpr int ATTN_LDS_BYTES=LDS_BYTES;
#undef SBAR
#undef WAIT_BAR
}
constexpr int DM = 1024, FF = 2816, NLAYER = 4;
constexpr int LP = 4112, LS = 2064, NSEQ_P = 4, NSEQ_S = 16, ROWS_P = NSEQ_P * LP  , T_ROWS = ROWS_P + NSEQ_S * LS  ;
constexpr int TPAD = 49664, NMT = TPAD / 256;
constexpr int NWIN = 4608;
constexpr float NORM_EPS = 1e-6f;
constexpr float QSCALE = 0.125f * 1.4426950408889634f;
constexpr int ATT_UNITS_P = NSEQ_P * 4 * 65, ATT_UNITS_S = NSEQ_S * 4 * 33, ATT_UNITS = ATT_UNITS_P + ATT_UNITS_S;

constexpr size_t MiB = 1u << 20;
constexpr int CW_BAR = 4096;
constexpr size_t WS_CTL = 0;
constexpr size_t WS_ROPE = MiB / 4;
constexpr size_t WS_HMETA = 3 * MiB / 2;
constexpr size_t WS_SSQ = 3 * MiB;
constexpr size_t WS_W = 8 * MiB;
constexpr size_t W_GU1 = 0, W_D1 = W_GU1 + (size_t)5632 * 1024 * 2, W_IN = W_D1 + (size_t)1024 * 2816 * 2, W_GC = W_IN + (size_t)NWIN * 1024 * 2, W_OC = W_GC + 2 * MiB,
                 W_GA = W_OC + 2 * MiB, W_OA = W_GA + 2 * MiB, W_M = W_OA + 2 * MiB, W_GU2 = W_M + 2 * MiB, W_D2 = W_GU2 + (size_t)5632 * 1024 * 2, W_END = W_D2 + (size_t)1024 * 2816 * 2;
constexpr size_t WBUF = 56 * MiB;
constexpr size_t WS_HB = 120 * MiB;
constexpr size_t ROWB = (size_t)TPAD * 1024 * 2;
constexpr size_t WS_BIG = WS_HB + 98 * MiB;
constexpr size_t WS_Q = WS_BIG, WS_K = WS_Q + ROWB, WS_V = WS_K + ROWB / 4, WS_CB = WS_V + ROWB / 4, WS_Z = WS_CB + ROWB, WS_END = WS_Z + ROWB;
constexpr size_t WS_HID = WS_BIG;
constexpr size_t WS_SCR = WS_K;
static_assert((CW_BAR + 3456) * 4 <= (int)WS_ROPE && WS_ROPE + (size_t)LP * 64 * 4 <= WS_HMETA && WS_HMETA + (size_t)20 * 16 * 1024 * 4 <= WS_SSQ && WS_SSQ + (size_t)TPAD * 16 * 4 <= WS_W, "d_ws map (small regions)");
static_assert(W_END <= 56 * MiB && ROWB <= 98 * MiB && (size_t)TPAD * FF * 2 <= WS_END - WS_BIG && 256 * 131072 <= ROWB / 2, "d_ws map");

constexpr int RING_BYTES = 131072, MISC_OFF = RING_BYTES + 320, PTAB_OFF = RING_BYTES + 1024, LDS_BYTES = 147456;
constexpr int NWAVES = 8;

#define GAS __attribute__((address_space(1)))
#define LAS __attribute__((address_space(3)))
typedef unsigned short bf16;
typedef unsigned v4u __attribute__((ext_vector_type(4)));
typedef float f32x4 __attribute__((ext_vector_type(4)));
__device__ __forceinline__ unsigned f2bf(float f) { unsigned u = __builtin_bit_cast(unsigned, f); return (u + 0x7fffu + ((u >> 16) & 1u)) >> 16; }
__device__ __forceinline__ unsigned pk2(float lo, float hi) { return pg8::cvt_pk_bf16(lo, hi); }
__device__ __forceinline__ float bflo(unsigned u) { return __builtin_bit_cast(float, u << 16); }
__device__ __forceinline__ float bfhi(unsigned u) { return __builtin_bit_cast(float, u & 0xffff0000u); }
__device__ __forceinline__ float wave_sum(float v) {
#pragma unroll
    for (int o = 1; o < 64; o <<= 1) v += __shfl_xor(v, o);
    return v;
}
__device__ __forceinline__ void rowinfo(int r, int& pos, int& L) {
    if (r < ROWS_P) { L = LP; pos = r % LP; } else if (r < T_ROWS) { L = LS; pos = (r - ROWS_P) % LS; } else { L = 1 << 30; pos = 0; }
}
__device__ __forceinline__ float sigmoidf_(float x) { return __builtin_amdgcn_rcpf(1.0f + __builtin_amdgcn_exp2f(-1.4426950408889634f * x)); }

struct PlainOrder : pg8::StaticOrder {
    const char* A; const char* Bt; size_t tstep;
    __device__ __forceinline__ const char* aptr(const pg8::Unit& u) const { return A + (size_t)u.pm * tstep; }
    __device__ __forceinline__ const char* bptr(const pg8::Unit& u) const { return Bt + (size_t)u.pn * tstep; }
};
struct ChainOrder {
    pg8::StaticOrder base; const char* A[4]; const char* B[4]; size_t tstep;
    __device__ __forceinline__ bool next(int i, pg8::Unit& u) const { if (!base.next(i >> 2, u)) return false; u.sub = i & 3; return true; }
    __device__ __forceinline__ const char* aptr(const pg8::Unit& u) const { const char* p = u.sub == 0 ? A[0] : u.sub == 1 ? A[1] : u.sub == 2 ? A[2] : A[3]; return p + (size_t)u.pm * tstep; }
    __device__ __forceinline__ const char* bptr(const pg8::Unit& u) const { const char* p = u.sub == 0 ? B[0] : u.sub == 1 ? B[1] : u.sub == 2 ? B[2] : B[3]; return p + (size_t)u.pn * tstep; }
    __device__ __forceinline__ void a_ready(const pg8::Unit&) const {}
    __device__ __forceinline__ void done(const pg8::Unit&) const {}
};

using pg8::f32x4; using pg8::u32x4; using pg8::Unit; using pg8::bf16_t;
typedef f32x4 Acc[2][2][4][2];
__device__ __forceinline__ u32x4 pack8(const f32x4 a, const f32x4 b) { u32x4 w; w.x = pk2(a[0], a[1]); w.y = pk2(a[2], a[3]); w.z = pk2(b[0], b[1]); w.w = pk2(b[2], b[3]); return w; }
__device__ __forceinline__ void unpack8(const u32x4 w, f32x4& a, f32x4& b) { a = (f32x4){bflo(w.x), bfhi(w.x), bflo(w.y), bfhi(w.y)}; b = (f32x4){bflo(w.z), bfhi(w.z), bflo(w.w), bfhi(w.w)}; }
__device__ __forceinline__ float rstd_of(const float* ssq, int row) { const f32x4* p = (const f32x4*)(ssq + (size_t)row * 16); const f32x4 a = p[0], b = p[1], c = p[2], d = p[3];
    const float s = (((a[0] + a[1]) + (a[2] + a[3])) + ((b[0] + b[1]) + (b[2] + b[3]))) + (((c[0] + c[1]) + (c[2] + c[3])) + ((d[0] + d[1]) + (d[2] + d[3])));
    return __builtin_amdgcn_rsqf(s * (1.0f / DM) + NORM_EPS); }

__device__ __forceinline__ void rstd8(const float* ssq, int row0, int fq, float (&rs)[8]) {
    f32x4 pr[8];
#pragma unroll
    for (int i = 0; i < 8; ++i) pr[i] = *(const f32x4*)(ssq + (size_t)(row0 + (i >> 2) * 128 + (i & 3) * 16) * 16 + 4 * fq);
#pragma unroll
    for (int i = 0; i < 8; ++i) { float s = (pr[i][0] + pr[i][1]) + (pr[i][2] + pr[i][3]); s += __shfl_xor(s, 16); s += __shfl_xor(s, 32); rs[i] = __builtin_amdgcn_rsqf(s * (1.0f / DM) + NORM_EPS); }
}
struct EpiSwiGLU {
    static constexpr bool PERM = true, AFTER_DRAIN = false;
    bf16_t* hid; const float* ssq;
    __device__ __forceinline__ void operator()(const Acc& acc, const Unit& u, int wr, int wc, int fr, int fq) const {
        const int row0 = u.pm * 256 + wr * 64 + fr;
        float rs[8]; rstd8(ssq, row0, fq, rs);
#pragma unroll
        for (int ai = 0; ai < 2; ++ai)
#pragma unroll
            for (int m = 0; m < 4; ++m) {
                const int row = row0 + ai * 128 + m * 16; const float r1 = rs[ai * 4 + m];
                f32x4 o[2];
#pragma unroll
                for (int n = 0; n < 2; ++n) {
                    const f32x4 gs = acc[ai][0][m][n] * r1, us = acc[ai][1][m][n] * r1, t = gs * -1.4426950408889634f;
                    f32x4 d; d[0] = __builtin_amdgcn_exp2f(t[0]); d[1] = __builtin_amdgcn_exp2f(t[1]); d[2] = __builtin_amdgcn_exp2f(t[2]); d[3] = __builtin_amdgcn_exp2f(t[3]);
                    d = d + 1.0f;
                    f32x4 r; r[0] = __builtin_amdgcn_rcpf(d[0]); r[1] = __builtin_amdgcn_rcpf(d[1]); r[2] = __builtin_amdgcn_rcpf(d[2]); r[3] = __builtin_amdgcn_rcpf(d[3]);
                    o[n] = (gs * us) * r;
                }
                *(u32x4*)(hid + (size_t)row * FF + u.pn * 128 + wc * 32 + 8 * fq) = pack8(o[0], o[1]);
            }
    }
};
struct EpiResid {
    static constexpr bool PERM = true, AFTER_DRAIN = false;
    bf16_t* hb; float* ssq_out; float scale;
    __device__ __forceinline__ void operator()(const Acc& acc, const Unit& u, int wr, int wc, int fr, int fq) const {
        const int row0 = u.pm * 256 + wr * 64 + fr;
#pragma unroll
        for (int ai = 0; ai < 2; ++ai) {
            u32x4 old[4][2];
#pragma unroll
            for (int m = 0; m < 4; ++m) { const int row = row0 + ai * 128 + m * 16; const bf16_t* bp = hb + (size_t)row * DM + u.pn * 256 + wc * 32 + 8 * fq;
#pragma unroll
                for (int bj = 0; bj < 2; ++bj) old[m][bj] = row < T_ROWS ? *(const u32x4*)(bp + bj * 128) : (u32x4){0u, 0u, 0u, 0u}; }
#pragma unroll
            for (int m = 0; m < 4; ++m) {
                const int row = row0 + ai * 128 + m * 16; const bool ok = row < T_ROWS; bf16_t* bp = hb + (size_t)row * DM + u.pn * 256 + wc * 32 + 8 * fq;
                float ss = 0.f;
#pragma unroll
                for (int bj = 0; bj < 2; ++bj) {
                    f32x4 a, b; unpack8(old[m][bj], a, b);
                    a = a + acc[ai][bj][m][0] * scale; b = b + acc[ai][bj][m][1] * scale;
                    const u32x4 w = pack8(a, b); if (ok) *(u32x4*)(bp + bj * 128) = w;
                    unpack8(w, a, b);
                    ss += (a[0] * a[0] + a[1] * a[1]) + (a[2] * a[2] + a[3] * a[3]) + (b[0] * b[0] + b[1] * b[1]) + (b[2] * b[2] + b[3] * b[3]);
                }
                ss += __shfl_xor(ss, 16); ss += __shfl_xor(ss, 32);
                if (ok && fq == 0) ssq_out[(size_t)row * 16 + u.pn * 4 + wc] = ss;
            }
            asm volatile("" ::: "memory");
        }
    }
};
struct EpiWin {
    static constexpr bool PERM = true, AFTER_DRAIN = false;
    bf16_t *q, *k, *v, *cb, *z; const float* ssq; const float* rope; const float* qg; const float* kg;
    __device__ __forceinline__ void operator()(const Acc& acc, const Unit& u, int wr, int wc, int fr, int fq) const {
        const int pn = u.pn; const int row0 = u.pm * 256 + wr * 64 + fr;
        float rs[8]; rstd8(ssq, row0, fq, rs);
        if (pn <= 4) {
            const float* g = pn < 4 ? qg : kg; const float osc = pn < 4 ? QSCALE : 1.0f;
            f32x4 G[2][2];
#pragma unroll
            for (int bj = 0; bj < 2; ++bj)
#pragma unroll
                for (int n = 0; n < 2; ++n) G[bj][n] = *(const f32x4*)(g + 32 * bj + 16 * n + 4 * fq) * osc;
#pragma unroll
            for (int ai = 0; ai < 2; ++ai)
#pragma unroll
                for (int mp = 0; mp < 2; ++mp) {
                    f32x4 cs[2][2][2];
#pragma unroll
                    for (int mm = 0; mm < 2; ++mm) { int pos, L; rowinfo(row0 + ai * 128 + (2 * mp + mm) * 16, pos, L);
#pragma unroll
                        for (int bj = 0; bj < 2; ++bj) { cs[mm][bj][0] = *(const f32x4*)(rope + ((pos * 2 + bj) * 2 + 0) * 16 + 4 * fq); cs[mm][bj][1] = *(const f32x4*)(rope + ((pos * 2 + bj) * 2 + 1) * 16 + 4 * fq); } }
#pragma unroll
                    for (int mm = 0; mm < 2; ++mm) {
                        const int m = 2 * mp + mm; const int row = row0 + ai * 128 + m * 16; const float r1 = rs[ai * 4 + m];
                        f32x4 x[2][2]; float ss = 0.f;
#pragma unroll
                        for (int bj = 0; bj < 2; ++bj)
#pragma unroll
                            for (int n = 0; n < 2; ++n) { x[bj][n] = acc[ai][bj][m][n] * r1; const f32x4 t = x[bj][n] * x[bj][n]; ss += (t[0] + t[1]) + (t[2] + t[3]); }
                        ss += __shfl_xor(ss, 16); ss += __shfl_xor(ss, 32);
                        const float rn = __builtin_amdgcn_rsqf(ss * (1.0f / 64.0f) + NORM_EPS);
                        bf16_t* dst = pn < 4 ? q + (size_t)row * 1024 + (4 * pn + wc) * 64 + 8 * fq : k + (size_t)row * 256 + wc * 64 + 8 * fq;
#pragma unroll
                        for (int bj = 0; bj < 2; ++bj) {
                            const f32x4 c4 = cs[mm][bj][0], s4 = cs[mm][bj][1];
                            const f32x4 y1 = x[bj][0] * rn * G[bj][0], y2 = x[bj][1] * rn * G[bj][1];
                            const f32x4 o1 = y1 * c4 - y2 * s4, o2 = y2 * c4 + y1 * s4;
                            *(u32x4*)(dst + 32 * bj) = pack8(o1, o2);
                        }
                    }
                    asm volatile("" ::: "memory");
                }
        } else if (pn < 10) {
            bf16_t* base; int pitch, c0;
            if (pn == 5) { base = v; pitch = 256; c0 = 0; } else { base = cb; pitch = 1024; c0 = 256 * (pn - 6); }
#pragma unroll
            for (int ai = 0; ai < 2; ++ai)
#pragma unroll
                for (int m = 0; m < 4; ++m) {
                    const int row = row0 + ai * 128 + m * 16; const float r1 = rs[ai * 4 + m];
#pragma unroll
                    for (int bj = 0; bj < 2; ++bj) *(u32x4*)(base + (size_t)row * pitch + c0 + 128 * bj + wc * 32 + 8 * fq) = pack8(acc[ai][bj][m][0] * r1, acc[ai][bj][m][1] * r1);
                }
        } else {
#pragma unroll
            for (int ai = 0; ai < 2; ++ai)
#pragma unroll
                for (int m = 0; m < 4; ++m) {
                    const int row = row0 + ai * 128 + m * 16; const float r1 = rs[ai * 4 + m], rs2 = r1 * r1;
                    *(u32x4*)(z + (size_t)row * 1024 + 128 * (pn - 10) + wc * 32 + 8 * fq) = pack8(acc[ai][0][m][0] * acc[ai][1][m][0] * rs2, acc[ai][0][m][1] * acc[ai][1][m][1] * rs2);
                }
        }
    }
};
struct EpiMerge {
    static constexpr bool PERM = true, AFTER_DRAIN = false;
    bf16_t* merged; u32x4* scr; const float* ssq; int tid;
    __device__ __forceinline__ void operator()(const Acc& acc, const Unit& u, int wr, int wc, int fr, int fq) const {
        const int sub = u.sub; const int row0 = u.pm * 256 + wr * 64 + fr;
        char* mb = (char*)(merged + (size_t)row0 * DM + u.pn * 256 + wc * 32 + 8 * fq); asm volatile("" : "+v"(mb));
        char* sb = (char*)(scr + tid); asm volatile("" : "+v"(sb));
#define MP(ai, m, bj) ((u32x4*)(mb + ((ai) * 128 + (m) * 16) * (DM * 2) + (bj) * 256))
#define SP(ai, m, bj) ((u32x4*)(sb + ((((ai) * 4 + (m)) * 2 + (bj)) * 512) * 16))
        if ((sub & 1) == 0) {
            float rs[8]; rstd8(ssq, row0, fq, rs);
#pragma unroll
            for (int ai = 0; ai < 2; ++ai)
#pragma unroll
                for (int m = 0; m < 4; ++m) {
                    const float r1 = rs[ai * 4 + m];
#pragma unroll
                    for (int bj = 0; bj < 2; ++bj) {
                        f32x4 s0, s1; const f32x4 v0 = acc[ai][bj][m][0], v1 = acc[ai][bj][m][1];
#pragma unroll
                        for (int e = 0; e < 4; ++e) { s0[e] = sigmoidf_(v0[e] * r1); s1[e] = sigmoidf_(v1[e] * r1); }
                        if (sub == 0) *MP(ai, m, bj) = pack8(s0, s1); else *SP(ai, m, bj) = pack8(s0, s1);
                    }
                }
        } else if (sub == 1) {
#pragma unroll
            for (int ai = 0; ai < 2; ++ai) {
                u32x4 g[4][2];
#pragma unroll
                for (int m = 0; m < 4; ++m)
#pragma unroll
                    for (int bj = 0; bj < 2; ++bj) g[m][bj] = *MP(ai, m, bj);
#pragma unroll
                for (int m = 0; m < 4; ++m)
#pragma unroll
                    for (int bj = 0; bj < 2; ++bj) { f32x4 g0, g1; unpack8(g[m][bj], g0, g1); *MP(ai, m, bj) = pack8(g0 * acc[ai][bj][m][0], g1 * acc[ai][bj][m][1]); }
                asm volatile("" ::: "memory");
            }
        } else {
#pragma unroll
            for (int ai = 0; ai < 2; ++ai)
#pragma unroll
                for (int mp = 0; mp < 2; ++mp) {
                    u32x4 c[2][2], s[2][2];
#pragma unroll
                    for (int mm = 0; mm < 2; ++mm)
#pragma unroll
                        for (int bj = 0; bj < 2; ++bj) { c[mm][bj] = *MP(ai, 2 * mp + mm, bj); s[mm][bj] = *SP(ai, 2 * mp + mm, bj); }
#pragma unroll
                    for (int mm = 0; mm < 2; ++mm)
#pragma unroll
                        for (int bj = 0; bj < 2; ++bj) { const int m = 2 * mp + mm; f32x4 c0, c1, s0, s1; unpack8(c[mm][bj], c0, c1); unpack8(s[mm][bj], s0, s1);
                            *MP(ai, m, bj) = pack8(c0 + s0 * acc[ai][bj][m][0], c1 + s1 * acc[ai][bj][m][1]); }
                    asm volatile("" ::: "memory");
                }
        }
#undef MP
#undef SP
    }
};

__device__ __forceinline__ void cvt_item(const float* W, int Nsrc, int n0src, const float* gain, bool permqk, bf16* WT, int K, int nrow0, int k0, LAS float* scr, int lane) {
#pragma unroll 8
    for (int i = 0; i < 32; ++i) { const int kk = 2 * i + (lane >> 5); float w = W[(size_t)(k0 + kk) * Nsrc + n0src + (lane & 31)]; if (gain) w *= gain[k0 + kk]; scr[kk * 33 + (lane & 31)] = w; }
    asm volatile("s_waitcnt lgkmcnt(0)" ::: "memory");
    const int c = lane & 7;
#pragma unroll
    for (int j = 0; j < 4; ++j) { const int n = (lane >> 3) + 8 * j; const int ns = permqk ? (16 * ((n >> 2) & 1) + 4 * (n >> 3) + (n & 3)) : n; const LAS float* s = scr + (8 * c) * 33 + ns;
        v4u o; o.x = pk2(s[0 * 33], s[1 * 33]); o.y = pk2(s[2 * 33], s[3 * 33]); o.z = pk2(s[4 * 33], s[5 * 33]); o.w = pk2(s[6 * 33], s[7 * 33]);
        *(GAS v4u*)(WT + (size_t)(nrow0 + n) * K + k0 + 8 * c) = o; }
    asm volatile("s_waitcnt lgkmcnt(0)" ::: "memory");
}
#define RLX_AGENT __ATOMIC_RELAXED, __HIP_MEMORY_SCOPE_AGENT
#define XB_TMO      128
#define XB_XCNT(j)  (256  + 64 * (j))
#define XB_XSUB(j)  (1280 + 64 * (j))
#define XB_XGEN(j)  (2304 + 64 * (j))
#define XB_TOP      3328
#define XB_TOPGEN   3392
#define XCD_BAR_WORDS 3456
#define XB_SPIN_CAP (1u << 18)

__device__ __forceinline__ unsigned xb_ld(unsigned* p)              { return __hip_atomic_load(p, __ATOMIC_RELAXED, __HIP_MEMORY_SCOPE_AGENT); }
__device__ __forceinline__ unsigned xb_add(unsigned* p, unsigned v) { return __hip_atomic_fetch_add(p, v, __ATOMIC_RELAXED, __HIP_MEMORY_SCOPE_AGENT); }
__device__ __forceinline__ unsigned xb_xcc_id() { return (unsigned)__builtin_amdgcn_s_getreg((3 << 11) | 20) & 0xFu; }
#define XB_SPIN(cond, bar) do { unsigned _sp = 0; while (cond) { __builtin_amdgcn_s_sleep(1); \
    if ((++_sp & 255u) == 0u) { if (xb_ld(&(bar)[XB_TMO])) break; if (_sp > XB_SPIN_CAP) { atomicAdd(&(bar)[XB_TMO], 1u); break; } } } } while (0)

struct XcdBarrier {
    unsigned* bar; unsigned x;
    volatile LAS unsigned* st;
};

__device__ __forceinline__ XcdBarrier xcd_barrier_post(unsigned* bar, volatile LAS unsigned* st) {
    XcdBarrier b; b.bar = bar; b.x = xb_xcc_id(); b.st = st;
    if (threadIdx.x == 0) (void)xb_add(&bar[XB_XCNT(b.x)], 1u);
    return b;
}
__device__ __forceinline__ void xcd_barrier_complete(unsigned* bar, unsigned x, unsigned& nloc, unsigned& nx) {
    const unsigned G = gridDim.x * gridDim.y * gridDim.z;
    unsigned sum, cnt, mine, sp = 0u;
    for (;;) {
        sum = 0u; cnt = 0u; mine = 0u;
#pragma unroll
        for (unsigned j = 0; j < 16; ++j) { const unsigned c = xb_ld(&bar[XB_XCNT(j)]); sum += c; cnt += (c > 0u) ? 1u : 0u; mine = (j == x) ? c : mine; }
        if (sum == G) break;
        __builtin_amdgcn_s_sleep(1);
        if ((++sp & 255u) == 0u) { if (xb_ld(&bar[XB_TMO])) break; if (sp > XB_SPIN_CAP) { atomicAdd(&bar[XB_TMO], 1u); break; } }
    }
    nloc = mine > 0u ? mine : 1u; nx = cnt > 0u ? cnt : 1u;
}

__device__ __forceinline__ void xcd_barrier(const XcdBarrier& b) {
    asm volatile("s_waitcnt vmcnt(0)" ::: "memory");
    __syncthreads();
    if (threadIdx.x == 0) {
        unsigned* bar = b.bar;
        __builtin_amdgcn_s_waitcnt(0);
        unsigned nloc = b.st[0], nx = b.st[1];
        if (nloc == 0u) { xcd_barrier_complete(bar, b.x, nloc, nx); b.st[0] = nloc; b.st[1] = nx; }
        const unsigned old = xb_add(&bar[XB_XSUB(b.x)], 1u);
        const unsigned gen = old / nloc;
        if (old + 1u == (gen + 1u) * nloc) {
            __builtin_amdgcn_fence(__ATOMIC_RELEASE, "agent");
            asm volatile("s_waitcnt vmcnt(0)" ::: "memory");
            const unsigned og = xb_add(&bar[XB_TOP], 1u);
            const unsigned tg = og / nx;
            if (og + 1u == (tg + 1u) * nx) xb_add(&bar[XB_TOPGEN], 1u);
            else XB_SPIN(xb_ld(&bar[XB_TOPGEN]) == tg, bar);
            __builtin_amdgcn_fence(__ATOMIC_ACQUIRE, "agent");
            xb_add(&bar[XB_XGEN(b.x)], 1u);
            asm volatile("s_waitcnt vmcnt(0)" ::: "memory");
        } else {
            XB_SPIN(xb_ld(&bar[XB_XGEN(b.x)]) == gen, bar);
            __builtin_amdgcn_fence(__ATOMIC_ACQUIRE, "agent");
            asm volatile("s_waitcnt vmcnt(0)" ::: "memory");
        }
    }
    __syncthreads();
}
struct Args { const float* in[21]; float* out; unsigned char* ws; int ph_lo, ph_hi; };
struct PT {
    volatile LAS unsigned long long* t;
    __device__ __forceinline__ unsigned long long get(int i) const { const unsigned long long v = t[i]; const unsigned lo = __builtin_amdgcn_readfirstlane((unsigned)v), hi = __builtin_amdgcn_readfirstlane((unsigned)(v >> 32)); return ((unsigned long long)hi << 32) | lo; }
    __device__ __forceinline__ const float* in(int i) const { return (const float*)(const GAS float*)get(i); }
    __device__ __forceinline__ float* out() const { return (float*)(GAS float*)get(21); }
    __device__ __forceinline__ unsigned char* ws() const { return (unsigned char*)(GAS unsigned char*)get(22); }
};

__device__ __forceinline__ void cvt_one(const PT a, unsigned char* ws, int l, LAS unsigned char* lds, int it, int wave, int lane) {
    LAS float* scr = (LAS float*)(lds + wave * 16384);
    bf16* W = (bf16*)(ws + WS_W + (size_t)(l & 1) * WBUF);
    const size_t ffo = (size_t)l * DM * FF, sqo = (size_t)l * DM * DM;
    const float* win = a.in(8) + (size_t)l * DM * 6656; const float* mixg = a.in(7) + l * DM;
    {
        int r = it;
        if (r < 2816) { const int kb = r / 176, nb = r % 176, pn = nb >> 3, t = nb & 7; const float* src = (t >> 2) ? a.in(5) + ffo : a.in(4) + ffo;
            cvt_item(src, FF, 128 * pn + 32 * (t & 3), a.in(3) + l * DM, false, (bf16*)((char*)W + W_GU1), 1024, nb * 32, kb * 64, scr, lane); return; } r -= 2816;
        if (r < 1408) { const int kb = r / 32, nb = r % 32; cvt_item(a.in(6) + ffo, DM, nb * 32, nullptr, false, (bf16*)((char*)W + W_D1), FF, nb * 32, kb * 64, scr, lane); return; } r -= 1408;
        if (r < 2304) { const int kb = r / 144, nb = r % 144, pn = nb >> 3, t = nb & 7; int n0; bool pq = false;
            if (pn < 4) { n0 = 64 * (4 * pn + (t & 3)) + 32 * (t >> 2); pq = true; }
            else if (pn == 4) { n0 = 1024 + 64 * (t & 3) + 32 * (t >> 2); pq = true; }
            else if (pn == 5) n0 = 1280 + 32 * t;
            else if (pn < 10) n0 = 1536 + 256 * (pn - 6) + 32 * t;
            else n0 = ((t >> 2) ? 3584 : 2560) + 128 * (pn - 10) + 32 * (t & 3);
            cvt_item(win, 6656, n0, mixg, pq, (bf16*)((char*)W + W_IN), 1024, nb * 32, kb * 64, scr, lane); return; } r -= 2304;
        if (r < 2560) { const int seg = r / 512, q = r % 512, kb = q / 32, nb = q % 32;
            const float* src; int ns, n0; const float* gn = nullptr; size_t dst;
            if (seg == 0) { src = win; ns = 6656; n0 = 5632 + nb * 32; gn = mixg; dst = W_GC; }
            else if (seg == 1) { src = a.in(14) + sqo; ns = DM; n0 = nb * 32; dst = W_OC; }
            else if (seg == 2) { src = win; ns = 6656; n0 = 4608 + nb * 32; gn = mixg; dst = W_GA; }
            else if (seg == 3) { src = a.in(13) + sqo; ns = DM; n0 = nb * 32; dst = W_OA; }
            else { src = a.in(15) + sqo; ns = DM; n0 = nb * 32; dst = W_M; }
            cvt_item(src, ns, n0, gn, false, (bf16*)((char*)W + dst), 1024, nb * 32, kb * 64, scr, lane); return; } r -= 2560;
        if (r < 2816) { const int kb = r / 176, nb = r % 176, pn = nb >> 3, t = nb & 7; const float* src = (t >> 2) ? a.in(18) + ffo : a.in(17) + ffo;
            cvt_item(src, FF, 128 * pn + 32 * (t & 3), a.in(16) + l * DM, false, (bf16*)((char*)W + W_GU2), 1024, nb * 32, kb * 64, scr, lane); return; } r -= 2816;
        { const int kb = r / 32, nb = r % 32; cvt_item(a.in(19) + ffo, DM, nb * 32, nullptr, false, (bf16*)((char*)W + W_D2), FF, nb * 32, kb * 64, scr, lane); }
    }
}

constexpr int CVT_ITEMS = 13312;
__device__ __forceinline__ void convert_static(const PT a, unsigned char* ws, int l, LAS unsigned char* lds, int gw, int NGW, int wave, int lane) {
    for (int it = gw; it < CVT_ITEMS; it += NGW) cvt_one(a, ws, l, lds, it, wave, lane);
}
__device__ __forceinline__ void convert_dynamic(const PT a, unsigned char* ws, int l, LAS unsigned char* lds, unsigned* ctr, int lo, int hi, int wave, int lane) {
    for (;;) {
        unsigned b = 0; if (lane == 0) b = atomicAdd(ctr, 4u);
        const int base = lo + (int)__builtin_amdgcn_readfirstlane(b);
        if (base >= hi) break;
        for (int k = 0; k < 4; ++k) { if (base + k < hi) cvt_one(a, ws, l, lds, base + k, wave, lane); }
    }
}
__device__ __forceinline__ void prologue(const PT a, unsigned char* ws, int tid, int wave, int lane, int bid, int G) {
    const int gtid = bid * 512 + tid, GT = G * 512, gw = bid * NWAVES + wave, NGW = G * NWAVES;
    float* ssq = (float*)(ws + WS_SSQ); bf16* hb = (bf16*)(ws + WS_HB); float* rope = (float*)(ws + WS_ROPE);
    for (int i = gtid; i < (TPAD - T_ROWS) * 16; i += GT) ssq[(size_t)T_ROWS * 16 + i] = 0.f;
    for (int i = gtid; i < (TPAD - T_ROWS) * DM / 8; i += GT) ((v4u*)(hb + (size_t)T_ROWS * DM))[i] = (v4u){0u, 0u, 0u, 0u};
    if (gtid < 64) ((unsigned*)(ws + WS_CTL))[gtid] = 0u;
    for (int i = gtid; i < LP * 32; i += GT) {
        const int pos = i >> 5, axis = (i >> 4) & 1, f = i & 15;
        float coord; if (pos < 16) coord = axis ? (float)pos : -1.0f; else { const int t = pos - 16; coord = axis ? (float)(t & 63) : (float)(t >> 6); }
        const float inv = powf(10000.0f, -(float)f * (1.0f / 16.0f)); const float ang = coord * inv;
        float s, c; sincosf(ang, &s, &c);
        rope[((pos * 2 + axis) * 2 + 0) * 16 + f] = c; rope[((pos * 2 + axis) * 2 + 1) * 16 + f] = s;
    }
    for (int r = gw; r < T_ROWS; r += NGW) {
        int pos, L; rowinfo(r, pos, L);
        const float* src;
        if (pos < 16) src = a.in(2) + (size_t)pos * DM;
        else if (r < ROWS_P) src = a.in(0) + ((size_t)(r / LP) * 4096 + pos - 16) * DM;
        else src = a.in(1) + ((size_t)((r - ROWS_P) / LS) * 2048 + pos - 16) * DM;
        f32x4 v[4]; float s = 0.f;
        unsigned long long* o8 = (unsigned long long*)(hb + (size_t)r * DM) + lane;
#pragma unroll
        for (int j = 0; j < 4; ++j) { v[j] = ((const f32x4*)src)[lane + 64 * j];
            const unsigned lo = pk2(v[j][0], v[j][1]), hi = pk2(v[j][2], v[j][3]); o8[64 * j] = (unsigned long long)lo | ((unsigned long long)hi << 32);
            const float a0 = bflo(lo), a1 = bfhi(lo), a2 = bflo(hi), a3 = bfhi(hi); s += (a0 * a0 + a1 * a1) + (a2 * a2 + a3 * a3); }
        s = wave_sum(s);
        if (lane < 16) ssq[(size_t)r * 16 + lane] = lane == 0 ? s : 0.f;
    }
}

constexpr int NSTRIP = (T_ROWS + 63) / 64;
__device__ __forceinline__ void conv_strip(const PT a, unsigned char* ws, int l, int tid, int strip) {
    bf16* cb = (bf16*)(ws + WS_CB); const bf16* z = (const bf16*)(ws + WS_Z);
    const float* cw = a.in(9) + (size_t)l * 3 * DM; const float* cbias = a.in(10) + (size_t)l * DM;
    const int chunk = tid & 127, sub = tid >> 7, c0 = chunk * 8;
    f32x4 w0[2], w1[2], w2[2], bb[2];
#pragma unroll
    for (int h = 0; h < 2; ++h) { w0[h] = *(const f32x4*)(cw + c0 + 4 * h); w1[h] = *(const f32x4*)(cw + DM + c0 + 4 * h); w2[h] = *(const f32x4*)(cw + 2 * DM + c0 + 4 * h); bb[h] = *(const f32x4*)(cbias + c0 + 4 * h); }
    const int r0 = strip * 64 + sub * 16;
#pragma unroll 4
    for (int i = 0; i < 16; ++i) {
        const int r = r0 + i; if (r >= T_ROWS) break;
        int pos, L; rowinfo(r, pos, L);
        const u32x4 zero = (u32x4){0u, 0u, 0u, 0u};
        const u32x4 zc = *(const u32x4*)(z + (size_t)r * DM + c0);
        const u32x4 zp = pos > 0 ? *(const u32x4*)(z + (size_t)(r - 1) * DM + c0) : zero;
        const u32x4 zn = pos < L - 1 ? *(const u32x4*)(z + (size_t)(r + 1) * DM + c0) : zero;
        u32x4* cp = (u32x4*)(cb + (size_t)r * DM + c0); const u32x4 cv = *cp;
        f32x4 p0, p1, c0v, c1v, n0, n1, b0, b1; unpack8(zp, p0, p1); unpack8(zc, c0v, c1v); unpack8(zn, n0, n1); unpack8(cv, b0, b1);
        const f32x4 o0 = b0 * (w0[0] * p0 + w1[0] * c0v + w2[0] * n0 + bb[0]), o1 = b1 * (w0[1] * p1 + w1[1] * c1v + w2[1] * n1 + bb[1]);
        *cp = pack8(o0, o1);
    }
}

__device__ __forceinline__ void attention_phase(const PT a, unsigned char* ws, int l, unsigned char* lds_generic, int tid, bool dry = false) {
    using abf = attn_body::bf16;
    const abf* Q = (const abf*)(ws + WS_Q); const abf* K = (const abf*)(ws + WS_K); const abf* V = (const abf*)(ws + WS_V); abf* O = dry ? (abf*)(ws + WS_END + MiB) : (abf*)(ws + WS_Q);
    unsigned* ctr = (unsigned*)(ws + WS_CTL) + l + (dry ? 8 : 0);
    volatile unsigned* slot = (volatile unsigned*)(lds_generic + MISC_OFF);
    unsigned pre = 0u; if (tid == 0) pre = atomicAdd(ctr, 1u);
    for (;;) {
        if (tid == 0) { *slot = pre; pre = atomicAdd(ctr, 1u); }
        __syncthreads();
        const int idx = (int)__builtin_amdgcn_readfirstlane(*slot);
        if (idx >= ATT_UNITS + NSTRIP) break;
        int u;
        if (idx < 5 * NSTRIP) { if (idx % 5 == 0) { int tidc = tid; asm volatile("" : "+v"(tidc)); conv_strip(a, ws, l, tidc, idx / 5); __syncthreads(); continue; } u = idx - (idx + 4) / 5; }
        else u = idx - NSTRIP;
        int tidu = tid; asm volatile("" : "+v"(tidu));
        if (u < ATT_UNITS_P) { const int s = u / 260, rem = u - s * 260, kvh = rem / 65, qblk = rem - kvh * 65;
            attn_body::attn_unit<8, LP, 66>((long)s * LP, kvh, qblk, Q, K, V, O, (char*)lds_generic, tidu); }
        else { const int u2 = u - ATT_UNITS_P, s = u2 / 132, rem = u2 - s * 132, kvh = rem / 33, qblk = rem - kvh * 33;
            attn_body::attn_unit<8, LS, 34>((long)ROWS_P + (long)s * LS, kvh, qblk, Q, K, V, O, (char*)lds_generic, tidu); }
    }
}

__device__ __forceinline__ void final_phase(const PT a, unsigned char* ws, int wave, int lane, int bid, int G) {
    const int gw = bid * NWAVES + wave, NGW = G * NWAVES;
    const float* ssq = (const float*)(ws + WS_SSQ); const bf16* hb = (const bf16*)(ws + WS_HB); float* out = a.out();
    f32x4 g[4];
#pragma unroll
    for (int j = 0; j < 4; ++j) g[j] = ((const f32x4*)a.in(20))[lane + 64 * j];
    for (int r = gw; r < T_ROWS; r += NGW) {
        int pos, L; rowinfo(r, pos, L); if (pos < 16) continue;
        float* p = r < ROWS_P ? out + ((size_t)(r / LP) * 4096 + pos - 16) * DM : out + (size_t)NSEQ_P * 4096 * DM + ((size_t)((r - ROWS_P) / LS) * 2048 + pos - 16) * DM;
        const float rs = rstd_of(ssq, r);
        const unsigned long long* i8 = (const unsigned long long*)(hb + (size_t)r * DM) + lane;
#pragma unroll
        for (int j = 0; j < 4; ++j) { const unsigned long long w = i8[64 * j]; const unsigned lo = (unsigned)w, hi = (unsigned)(w >> 32);
            const f32x4 v = (f32x4){bflo(lo), bfhi(lo), bflo(hi), bfhi(hi)}; ((f32x4*)p)[lane + 64 * j] = v * rs * g[j]; }
    }
}

constexpr int NSTEPS = 2 + 8 * NLAYER;

template <int STEP>
__device__ __forceinline__ void run_step(const PT pt, unsigned char* lds, cg::grid_group& grid, XcdBarrier& bar, const int ph_lo, const int ph_hi) {
#ifdef MAX_STEP
    if (STEP >= MAX_STEP && STEP != NSTEPS - 1) return;
#endif
    if (STEP < ph_lo || STEP >= ph_hi) return;
    if (STEP > ph_lo) {
        if (STEP == ph_lo + 1) {
            asm volatile("s_waitcnt vmcnt(0)" ::: "memory"); grid.sync();
            bar = xcd_barrier_post((unsigned*)(pt.ws() + WS_CTL) + CW_BAR, (volatile LAS unsigned*)((LAS unsigned char*)lds + MISC_OFF + 32));
        } else xcd_barrier(bar);
#ifdef DUP_SYNC
        xcd_barrier(bar); xcd_barrier(bar);
#endif
    }
    LAS unsigned char* l3 = (LAS unsigned char*)lds;
    int tid = threadIdx.x; asm volatile("" : "+v"(tid));
    int bid = blockIdx.x; asm volatile("" : "+s"(bid));
    int G = gridDim.x; asm volatile("" : "+s"(G));
    unsigned char* ws = pt.ws();
    const int lane = tid & 63, wave = __builtin_amdgcn_readfirstlane(tid >> 6);
    const int gw = bid * NWAVES + wave, NGW = G * NWAVES;
    float* ssq = (float*)(ws + WS_SSQ);
    bf16_t* hb = (bf16_t*)(ws + WS_HB);
    if constexpr (STEP == 0) { prologue(pt, ws, tid, wave, lane, bid, G); convert_static(pt, ws, 0, l3, gw, NGW, wave, lane); __syncthreads(); }
    else if constexpr (STEP == NSTEPS - 1) { final_phase(pt, ws, wave, lane, bid, G); }
    else {
        constexpr int l = (STEP - 1) / 8, ph = (STEP - 1) % 8 + 1;
        unsigned char* wl = ws + WS_W + (size_t)(l & 1) * WBUF;
        if constexpr (ph == 0) {
        } else if constexpr (ph == 1 || ph == 7) {
            constexpr int f = ph == 7;
            PlainOrder S; S.init(TPAD, 2 * FF, G, bid); S.A = (const char*)hb; S.Bt = (const char*)(wl + (f ? W_GU2 : W_GU1)); S.tstep = (size_t)256 * 1024 * 2;
            pg8::Gemm g{nullptr, nullptr, TPAD, 2 * FF, 1024};
            EpiSwiGLU E{(bf16_t*)(ws + WS_HID), ssq};
#ifndef NO_GU
            pg8::gemm_phase<EpiSwiGLU, PlainOrder, true, true>(l3, g, S, E, tid);
#ifdef DUP_GU
            __syncthreads();
            pg8::gemm_phase<EpiSwiGLU, PlainOrder, true, true>(l3, g, S, E, tid);
#endif
#endif
        } else if constexpr (ph == 2 || ph == 6 || ph == 8) {
            constexpr int f = ph == 8; constexpr int K = ph == 6 ? 1024 : FF;
            PlainOrder S; S.init(TPAD, DM, G, bid);
            S.A = ph == 6 ? (const char*)(ws + WS_Z) : (const char*)(ws + WS_HID);
            S.Bt = (const char*)(wl + (ph == 6 ? W_M : (f ? W_D2 : W_D1))); S.tstep = (size_t)256 * K * 2;
            pg8::Gemm g{nullptr, nullptr, TPAD, DM, K};
#ifdef DUP_DOWN
            EpiResid E{hb, ssq, ph == 6 ? 0.5f : 0.25f};
            pg8::gemm_phase<EpiResid, PlainOrder, true, true>(l3, g, S, E, tid); __syncthreads();
#else
            EpiResid E{hb, ssq, ph == 6 ? 1.0f : 0.5f};
#endif
#ifndef NO_RES
            pg8::gemm_phase<EpiResid, PlainOrder, true, true>(l3, g, S, E, tid);
#endif
            if constexpr (l + 1 < NLAYER) {
                constexpr int part = ph == 2 ? 0 : (ph == 6 ? 1 : 2); constexpr int lo = part * (CVT_ITEMS / 3), hi = part == 2 ? CVT_ITEMS : (part + 1) * (CVT_ITEMS / 3);
                convert_dynamic(pt, ws, l + 1, l3, (unsigned*)(ws + WS_CTL) + 16 + 4 * l + part, lo, hi, wave, lane);
                __syncthreads();
            }
        } else if constexpr (ph == 3) {
            PlainOrder S; S.init(TPAD, NWIN, G, bid); S.A = (const char*)hb; S.Bt = (const char*)(wl + W_IN); S.tstep = (size_t)256 * 1024 * 2;
            pg8::Gemm g{nullptr, nullptr, TPAD, NWIN, 1024};
            EpiWin E{(bf16_t*)(ws + WS_Q), (bf16_t*)(ws + WS_K), (bf16_t*)(ws + WS_V), (bf16_t*)(ws + WS_CB), (bf16_t*)(ws + WS_Z), ssq,
                     (const float*)(ws + WS_ROPE), pt.in(11) + l * 64, pt.in(12) + l * 64};
#ifndef NO_WIN
            pg8::gemm_phase<EpiWin, PlainOrder, true, true>(l3, g, S, E, tid);
#ifdef DUP_WIN
            __syncthreads();
            pg8::gemm_phase<EpiWin, PlainOrder, true, true>(l3, g, S, E, tid);
#endif
#endif
        } else if constexpr (ph == 4) {
#ifdef DUP_ATT
            attention_phase(pt, ws, l, lds, tid, true); __syncthreads();
#endif
#ifndef NO_ATT
            attention_phase(pt, ws, l, lds, tid);
#endif
        } else {
            ChainOrder S; S.base.init(TPAD, DM, G, bid); S.tstep = (size_t)256 * 1024 * 2;
            S.A[0] = (const char*)hb; S.A[1] = (const char*)(ws + WS_CB); S.A[2] = (const char*)hb; S.A[3] = (const char*)(ws + WS_Q);
            S.B[0] = (const char*)(wl + W_GC); S.B[1] = (const char*)(wl + W_OC); S.B[2] = (const char*)(wl + W_GA); S.B[3] = (const char*)(wl + W_OA);
            pg8::Gemm g{nullptr, nullptr, TPAD, DM, 1024};
            EpiMerge E{(bf16_t*)(ws + WS_Z), (u32x4*)(ws + WS_SCR + (size_t)bid * 131072), ssq, tid};
#ifndef NO_MERGE
            pg8::gemm_phase<EpiMerge, ChainOrder, true, true>(l3, g, S, E, tid);
#ifdef DUP_MERGE
            __syncthreads();
            pg8::gemm_phase<EpiMerge, ChainOrder, true, true>(l3, g, S, E, tid);
#endif
#endif
        }
    }
}
template <int STEP>
__device__ __forceinline__ void run_from(const PT pt, unsigned char* lds, cg::grid_group& grid, XcdBarrier& bar, const int ph_lo, const int ph_hi) {
    run_step<STEP>(pt, lds, grid, bar, ph_lo, ph_hi);
    if constexpr (STEP + 1 < NSTEPS) run_from<STEP + 1>(pt, lds, grid, bar, ph_lo, ph_hi);
}

__global__ void __launch_bounds__(NWAVES * 64, 2) mega_fwd(Args args) {
    extern __shared__ __attribute__((aligned(16))) unsigned char lds[];
    cg::grid_group grid = cg::this_grid();
    PT pt; pt.t = (volatile LAS unsigned long long*)((LAS unsigned char*)lds + PTAB_OFF);
    if (threadIdx.x == 0) {
#pragma unroll
        for (int i = 0; i < 21; ++i) pt.t[i] = (unsigned long long)args.in[i];
        pt.t[21] = (unsigned long long)args.out; pt.t[22] = (unsigned long long)args.ws;
    }
    if (threadIdx.x < 8) ((volatile LAS unsigned*)((LAS unsigned char*)lds + MISC_OFF + 32))[threadIdx.x] = 0u;
    const int ph_lo = args.ph_lo, ph_hi = args.ph_hi;
    if (blockIdx.x == 0) { unsigned* bw = (unsigned*)(args.ws + WS_CTL) + CW_BAR; for (int i = threadIdx.x; i < XCD_BAR_WORDS; i += NWAVES * 64) bw[i] = 0u; }
    __syncthreads();
    XcdBarrier bar; bar.bar = nullptr; bar.x = 0; bar.st = nullptr;
    run_from<0>(pt, lds, grid, bar, ph_lo, ph_hi);
}

#ifndef LAUNCH_PER_STEP
#define LAUNCH_PER_STEP 0
#endif
extern "C" void kernel_launch(void* const* d_in, const int* in_sizes, int n_in, void* d_out, int out_size, void* d_ws, size_t ws_size, hipStream_t stream) {
    static int grid = 0;
    if (grid == 0) {
        if (n_in != 21 || ws_size < WS_END) { fprintf(stderr, "kernel_launch: need 21 inputs and >= %zu bytes of workspace; got %d, %zu\n", (size_t)WS_END, n_in, ws_size); grid = -1; return; }
        int dev = 0, cus = 0, per_cu = 0;
        hipGetDevice(&dev); hipDeviceGetAttribute(&cus, hipDeviceAttributeMultiprocessorCount, dev);
        if (hipFuncSetAttribute((const void*)mega_fwd, hipFuncAttributeMaxDynamicSharedMemorySize, LDS_BYTES) != hipSuccess) { fprintf(stderr, "kernel_launch: hipFuncSetAttribute failed\n"); grid = -1; return; }
        if (hipOccupancyMaxActiveBlocksPerMultiprocessor(&per_cu, (const void*)mega_fwd, NWAVES * 64, LDS_BYTES) != hipSuccess || per_cu < 1) per_cu = 1;
        (void)hipGetLastError();
        grid = cus * per_cu;
    }
    if (grid < 0) return;
    Args a{};
    for (int i = 0; i < 21; ++i) a.in[i] = (const float*)d_in[i];
    a.out = (float*)d_out; a.ws = (unsigned char*)d_ws;
#if LAUNCH_PER_STEP
    for (int s = 0; s < NSTEPS; ++s) { a.ph_lo = s; a.ph_hi = s + 1; void* kargs[] = {&a}; hipLaunchCooperativeKernel((void*)mega_fwd, dim3(grid), dim3(NWAVES * 64), kargs, LDS_BYTES, stream); }
#else
    a.ph_lo = 0; a.ph_hi = NSTEPS; void* kargs[] = {&a};
    hipError_t e = hipLaunchCooperativeKernel((void*)mega_fwd, dim3(grid), dim3(NWAVES * 64), kargs, LDS_BYTES, stream);
    if (e != hipSuccess) fprintf(stderr, "cooperative launch failed: %s (grid %d)\n", hipGetErrorString(e), grid);
#endif
}
```

```cpp
#include <hip/hip_runtime.h>
#include <hip/hip_cooperative_groups.h>
#include <hip/hip_bf16.h>
#include <cstdio>
#include <cstdint>
#include <cmath>
namespace cg = cooperative_groups;
namespace pg8 {
#define PG8_LAS __attribute__((address_space(3)))
typedef unsigned short bf16_t;
typedef short bf16x8 __attribute__((ext_vector_type(8)));
typedef float f32x4 __attribute__((ext_vector_type(4)));
typedef unsigned u32x4 __attribute__((ext_vector_type(4)));
constexpr int BM = 256, BK = 64, HALF = 128, HTB = HALF * BK * 2  , STAGE_BYTES = 8 * HTB, NXCD = 8, WGM = 8;

__host__ __device__ __forceinline__ int lds_byte(int r, int c) { const int st = (r >> 4) * 2 + (c >> 5), rr = r & 15, cc = c & 31, ob = rr * 64 + cc * 2; return st * 1024 + (ob ^ (((ob >> 9) & 1) << 5)); }
__host__ __device__ __forceinline__ void stage_rc(int b, int& R, int& C) { const int st = b / 1024, sb = b % 1024, swz = sb ^ (((sb >> 9) & 1) << 5); R = (st >> 1) * 16 + swz / 64; C = (st & 1) * 32 + (swz % 64) / 2; }
__host__ __device__ __forceinline__ int perm32(int rho) { const int n = rho >> 4, i = rho & 15; return 8 * (i >> 2) + 4 * n + (i & 3); }

struct Unit { int pm, pn, sub; };
struct Gemm { const bf16_t* A; const bf16_t* Bt; int M, N, K; };

struct StaticOrder {
    int nM, nN, nwg, G, c;
    __host__ __device__ void init(int M, int N, int G_, int c_) { nM = M / BM; nN = N / BM; nwg = nM * nN; G = G_; c = c_; }
    __host__ __device__ bool next(int i, Unit& u) const {
        const long L = (long)i * G + c; if (L >= nwg) return false;
        int wgid = (int)L; { const int q = nwg / NXCD, r = nwg % NXCD, xcd = wgid % NXCD, off = wgid / NXCD; wgid = (xcd < r ? xcd * (q + 1) : r * (q + 1) + (xcd - r) * q) + off; }
        const int nig = WGM * nN, gid = wgid / nig, fm = gid * WGM, gsz = (nM - fm) < WGM ? (nM - fm) : WGM;
        u.pm = fm + ((wgid % nig) % gsz); u.pn = (wgid % nig) / gsz; u.sub = 0; return true;
    }
    __device__ __forceinline__ void a_ready(const Unit&) const {}
    __device__ __forceinline__ void done(const Unit&) const {}
};

__device__ __forceinline__ unsigned cvt_pk_bf16(float lo, float hi) { unsigned r; asm volatile("v_cvt_pk_bf16_f32 %0, %1, %2" : "=v"(r) : "v"(lo), "v"(hi)); return r; }
typedef float f32x2 __attribute__((ext_vector_type(2)));
template <class Epi, class Sched, bool ALIGN_EPI = false, bool SP2 = false>
__device__ __forceinline__ void gemm_phase(PG8_LAS unsigned char* lds, const Gemm g, const Sched& S, const Epi& E, const int tid) {
    const int wid = __builtin_amdgcn_readfirstlane(tid >> 6), lane = tid & 63, wr = wid >> 2, wc = wid & 3, fr = lane & 15, fq = lane >> 4;
    const int K = g.K, nt = K / BK;
    unsigned voffA[2], voffB[2];
#pragma unroll
    for (int i = 0; i < 2; ++i) { int R, C; stage_rc(tid * 16 + i * 8192, R, C); const int Rb = Epi::PERM ? ((R & ~31) + perm32(R & 31)) : R;
        voffA[i] = (unsigned)(R * K + C) * 2u; voffB[i] = (unsigned)(Rb * K + C) * 2u; }
    const size_t kstep = (size_t)(BK * 2);
    const size_t hstep = (size_t)HALF * K * 2;
        const unsigned ldsw = (unsigned)wid * 1024u;
    const int aoff = lds_byte(wr * 64 + fr, fq * 8), boff = lds_byte(wc * 32 + fr, fq * 8);
#define PG8_SA(b, h) (((b) * 2 + (h)) * HTB)
#define PG8_SB(b, h) ((4 + (b) * 2 + (h)) * HTB)
#define PG8_STAGE(bufoff, gbase, voff) do { _Pragma("unroll") for (int _i = 0; _i < 2; ++_i) \
        __builtin_amdgcn_global_load_lds((const unsigned*)((const char*)(gbase) + (voff)[_i]), (PG8_LAS unsigned*)(lds + (bufoff) + ldsw + _i * 8192), 16, 0, 0); } while (0)
#define PG8_LDA(dst, b, h) do { _Pragma("unroll") for (int m = 0; m < 4; ++m) _Pragma("unroll") for (int k = 0; k < 2; ++k) dst[m][k] = *(const PG8_LAS bf16x8*)(lds + PG8_SA(b, h) + aoff + m * 2048 + k * 1024); } while (0)
#define PG8_LDB(dst, b, h) do { _Pragma("unroll") for (int n = 0; n < 2; ++n) _Pragma("unroll") for (int k = 0; k < 2; ++k) dst[n][k] = *(const PG8_LAS bf16x8*)(lds + PG8_SB(b, h) + boff + n * 2048 + k * 1024); } while (0)
#define PG8_MMA(ai, bj, At, Bt) do { __builtin_amdgcn_s_setprio(1); _Pragma("unroll") for (int m = 0; m < 4; ++m) _Pragma("unroll") for (int n = 0; n < 2; ++n) _Pragma("unroll") for (int k = 0; k < 2; ++k) \
        acc[ai][bj][m][n] = __builtin_amdgcn_mfma_f32_16x16x32_bf16(Bt[n][k], At[m][k], acc[ai][bj][m][n], 0, 0, 0); __builtin_amdgcn_s_setprio(0); } while (0)
#define PG8_WAIT_V(n) asm volatile("s_waitcnt vmcnt(" #n ")" ::: "memory")
#define PG8_WAIT_L(n) asm volatile("s_waitcnt lgkmcnt(" #n ")" ::: "memory")
#define PG8_BAR __builtin_amdgcn_s_barrier()
#define PG8_SCHED __builtin_amdgcn_sched_barrier(0)
    Unit cur, nxt; int ui = 0;
    if (!S.next(0, cur)) return;
    f32x4 acc[2][2][4][2];
#pragma unroll
    for (int a = 0; a < 2; ++a)
#pragma unroll
        for (int b = 0; b < 2; ++b)
#pragma unroll
            for (int m = 0; m < 4; ++m)
#pragma unroll
                for (int n = 0; n < 2; ++n) acc[a][b][m][n] = (f32x4){0.f, 0.f, 0.f, 0.f};
    bf16x8 At[4][2], B0[2][2], B1[2][2];
    const char* cA = S.aptr(cur); const char* cB = S.bptr(cur);
    S.a_ready(cur);
    if constexpr (SP2) {
        PG8_STAGE(PG8_SB(0, 0), cB, voffB); PG8_STAGE(PG8_SB(0, 1), cB + hstep, voffB); PG8_STAGE(PG8_SA(0, 0), cA, voffA); PG8_STAGE(PG8_SA(0, 1), cA + hstep, voffA);
        if (wr == 1) PG8_BAR;
        PG8_WAIT_V(2); PG8_BAR;
        PG8_STAGE(PG8_SB(1, 0), cB + kstep, voffB); PG8_STAGE(PG8_SA(1, 0), cA + kstep, voffA); PG8_STAGE(PG8_SB(1, 1), cB + hstep + kstep, voffB);
        PG8_WAIT_V(6); PG8_BAR;
    } else {
        PG8_STAGE(PG8_SB(0, 0), cB, voffB); PG8_STAGE(PG8_SA(0, 0), cA, voffA); PG8_STAGE(PG8_SB(0, 1), cB + hstep, voffB); PG8_STAGE(PG8_SA(0, 1), cA + hstep, voffA);
        if (wr == 1) PG8_BAR;
        PG8_WAIT_V(4); PG8_BAR;
        PG8_STAGE(PG8_SB(1, 0), cB + kstep, voffB); PG8_STAGE(PG8_SA(1, 0), cA + kstep, voffA); PG8_STAGE(PG8_SB(1, 1), cB + hstep + kstep, voffB);
        PG8_WAIT_V(6); PG8_BAR;
    }
    for (;;) {
        const bool has_next = S.next(ui + 1, nxt);
        const char* nA = has_next ? S.aptr(nxt) : cA; const char* nB = has_next ? S.bptr(nxt) : cB;
        for (int t = 0; t < nt; t += 2) {
            const bool last = (t == nt - 2);
            const char* a1 = cA + (size_t)(t + 1) * kstep;
            const char* a2 = last ? nA : cA + (size_t)(t + 2) * kstep; const char* b2 = last ? nB : cB + (size_t)(t + 2) * kstep;
            const char* a3 = a2 + kstep; const char* b3 = b2 + kstep;
            if (last && has_next) S.a_ready(nxt);
            if constexpr (SP2) {
            PG8_LDB(B0, 0, 0); PG8_LDB(B1, 0, 1); PG8_SCHED; PG8_LDA(At, 0, 0); PG8_STAGE(PG8_SA(1, 1), a1 + hstep, voffA);
            PG8_WAIT_V(8); PG8_WAIT_L(0); PG8_BAR; PG8_MMA(0, 0, At, B0); PG8_MMA(0, 1, At, B1); PG8_BAR; PG8_SCHED;
            PG8_LDA(At, 0, 1); PG8_STAGE(PG8_SB(0, 0), b2, voffB); PG8_STAGE(PG8_SB(0, 1), b2 + hstep, voffB); PG8_STAGE(PG8_SA(0, 0), a2, voffA);
            PG8_WAIT_V(8); PG8_WAIT_L(0); PG8_BAR; PG8_MMA(1, 0, At, B0); PG8_MMA(1, 1, At, B1); PG8_BAR; PG8_SCHED;
            PG8_LDB(B0, 1, 0); PG8_LDB(B1, 1, 1); PG8_SCHED; PG8_LDA(At, 1, 0); PG8_STAGE(PG8_SA(0, 1), a2 + hstep, voffA);
            PG8_WAIT_V(8); PG8_WAIT_L(0); PG8_BAR; PG8_MMA(0, 0, At, B0); PG8_MMA(0, 1, At, B1); PG8_BAR; PG8_SCHED;
            PG8_LDA(At, 1, 1); PG8_STAGE(PG8_SB(1, 0), b3, voffB); PG8_STAGE(PG8_SB(1, 1), b3 + hstep, voffB); PG8_STAGE(PG8_SA(1, 0), a3, voffA);
            PG8_WAIT_V(8); PG8_WAIT_L(0); PG8_BAR; PG8_MMA(1, 0, At, B0); PG8_MMA(1, 1, At, B1); PG8_BAR; PG8_SCHED;
            } else {
            PG8_LDB(B0, 0, 0); PG8_SCHED; PG8_LDA(At, 0, 0); PG8_STAGE(PG8_SA(1, 1), a1 + hstep, voffA);
            PG8_WAIT_L(8); PG8_BAR; PG8_WAIT_L(0); PG8_MMA(0, 0, At, B0); PG8_BAR; PG8_SCHED;
            PG8_LDB(B1, 0, 1); PG8_STAGE(PG8_SB(0, 0), b2, voffB);
            PG8_BAR; PG8_WAIT_L(0); PG8_MMA(0, 1, At, B1); PG8_BAR;
            PG8_LDA(At, 0, 1); PG8_STAGE(PG8_SA(0, 0), a2, voffA);
            PG8_BAR; PG8_WAIT_L(0); PG8_MMA(1, 0, At, B0); PG8_BAR; PG8_SCHED;
            PG8_STAGE(PG8_SB(0, 1), b2 + hstep, voffB);
            PG8_WAIT_V(6); PG8_BAR; PG8_MMA(1, 1, At, B1); PG8_BAR;
            PG8_LDB(B0, 1, 0); PG8_SCHED; PG8_LDA(At, 1, 0); PG8_STAGE(PG8_SA(0, 1), a2 + hstep, voffA);
            PG8_WAIT_L(8); PG8_BAR; PG8_WAIT_L(0); PG8_MMA(0, 0, At, B0); PG8_BAR; PG8_SCHED;
            PG8_LDB(B1, 1, 1); PG8_STAGE(PG8_SB(1, 0), b3, voffB);
            PG8_BAR; PG8_WAIT_L(0); PG8_MMA(0, 1, At, B1); PG8_BAR;
            PG8_LDA(At, 1, 1); PG8_STAGE(PG8_SA(1, 0), a3, voffA);
            PG8_BAR; PG8_WAIT_L(0); PG8_MMA(1, 0, At, B0); PG8_BAR; PG8_SCHED;
            PG8_STAGE(PG8_SB(1, 1), b3 + hstep, voffB);
            PG8_WAIT_V(6); PG8_BAR; PG8_MMA(1, 1, At, B1); PG8_BAR;
            }
        }
        if constexpr (ALIGN_EPI) { if (wr == 0) PG8_BAR; }
        if constexpr (!Epi::AFTER_DRAIN) { E(acc, cur, wr, wc, fr, fq); S.done(cur); }
        if (!has_next) break;
#pragma unroll
        for (int a = 0; a < 2; ++a)
#pragma unroll
            for (int b = 0; b < 2; ++b)
#pragma unroll
                for (int m = 0; m < 4; ++m)
#pragma unroll
                    for (int n = 0; n < 2; ++n) acc[a][b][m][n] = (f32x4){0.f, 0.f, 0.f, 0.f};
        cur = nxt; cA = nA; cB = nB; ++ui;
        if constexpr (ALIGN_EPI) { if (wr == 1) PG8_BAR; }
    }
    PG8_WAIT_V(0);
    if constexpr (!ALIGN_EPI) { if (wr == 0) PG8_BAR; }
    PG8_BAR;
    if constexpr (Epi::AFTER_DRAIN) { E.fused(acc, cur, wr, wc, fr, fq, lds, wid, lane); S.done(cur); }
#undef PG8_SA
#undef PG8_SB
#undef PG8_STAGE
#undef PG8_LDA
#undef PG8_LDB
#undef PG8_MMA
#undef PG8_WAIT_V
#undef PG8_WAIT_L
#undef PG8_BAR
#undef PG8_SCHED
}
}
namespace attn_body {
using bf16=__hip_bfloat16;
using bf16x8=__attribute__((ext_vector_type(8)))short;
using s16x4=__attribute__((ext_vector_type(4)))short;
using f32x16=__attribute__((ext_vector_type(16)))float;
using u32x4=__attribute__((ext_vector_type(4)))unsigned;
constexpr int D=64,QP=1024,KP=256;
constexpr int NW=8,QBLK=32,KVBLK=64;
__device__ __forceinline__ int crow(int r,int hi){return (r&3)+8*(r>>2)+4*hi;}
#define SBAR() __builtin_amdgcn_sched_barrier(0)
__device__ __forceinline__ void kmask(f32x16&p0,f32x16&p1,int rem,int hi){
  const float NEG=-INFINITY;
  #pragma unroll
  for(int r=0;r<16;++r){int kv=4*hi+(r&3)+8*(r>>2); if(kv>=rem)p0[r]=NEG; if(kv+32>=rem)p1[r]=NEG;}
}

constexpr int NSLOT=3, SLOTB=8192;
constexpr int LDS_K=0, LDS_V=NSLOT*SLOTB, LDS_WS=2*NSLOT*SLOTB, LDS_OST=LDS_WS+NW*64*4, LDS_BYTES=LDS_OST+NW*4096;
constexpr float C2=0.125f*1.4426950408889634f;
__device__ __forceinline__ void glds16(const void*gsrc,unsigned lds_dst){unsigned keep;
  asm volatile("s_mov_b32 %0, m0\n\ts_mov_b32 m0, %2\n\ts_nop 0\n\tglobal_load_lds_dwordx4 %1, off\n\ts_mov_b32 m0, %0":"=&s"(keep):"v"(gsrc),"s"(lds_dst):"memory");}
__device__ __forceinline__ float max3f(float a,float b,float c){float r;asm("v_max3_f32 %0, %1, %2, %3":"=v"(r):"v"(a),"v"(b),"v"(c));return r;}
__device__ __forceinline__ float max2f(float a,float b){float r;asm("v_max_f32_e32 %0, %1, %2":"=v"(r):"v"(a),"v"(b));return r;}
__device__ __forceinline__ float fadd_s(float a,float b){float r;asm("v_add_f32_e32 %0, %1, %2":"=v"(r):"v"(a),"v"(b));return r;}
__device__ __forceinline__ float fsub_s(float a,float b){float r;asm("v_sub_f32_e32 %0, %1, %2":"=v"(r):"v"(a),"v"(b));return r;}
typedef float f32x2_t __attribute__((ext_vector_type(2))); typedef __bf16 bf16x2_t __attribute__((ext_vector_type(2)));
__device__ __forceinline__ unsigned cvtpk_s(float lo,float hi){f32x2_t v={lo,hi};bf16x2_t b=__builtin_convertvector(v,bf16x2_t);return __builtin_bit_cast(unsigned,b);}
#define WAIT_BAR(N) asm volatile("s_waitcnt vmcnt(" #N ") lgkmcnt(0)\n\ts_barrier":::"memory")

__device__ __forceinline__ void qkt(f32x16&p0,f32x16&p1,const char*Kslot,const bf16x8*qr,const f32x16&negm,int r32,int hi){
  const char*kb=Kslot+hi*1024+r32*16;
  #pragma unroll
  for(int d0=0;d0<4;++d0){
    const bf16x8 b0=*reinterpret_cast<const bf16x8*>(kb+d0*2048);
    const bf16x8 b1=*reinterpret_cast<const bf16x8*>(kb+d0*2048+512);
    if(d0==0){p0=__builtin_amdgcn_mfma_f32_32x32x16_bf16(b0,qr[0],negm,0,0,0);p1=__builtin_amdgcn_mfma_f32_32x32x16_bf16(b1,qr[0],negm,0,0,0);}
    else{p0=__builtin_amdgcn_mfma_f32_32x32x16_bf16(b0,qr[d0],p0,0,0,0);p1=__builtin_amdgcn_mfma_f32_32x32x16_bf16(b1,qr[d0],p1,0,0,0);}}
}
typedef __attribute__((address_space(3))) const char* lds_cptr;
typedef short v4i16_t __attribute__((ext_vector_type(4)));
__device__ __forceinline__ void kload8(bf16x8*kf,lds_cptr kp){
  kf[0]=*(const __attribute__((address_space(3))) bf16x8*)(kp);      kf[1]=*(const __attribute__((address_space(3))) bf16x8*)(kp+512);
  kf[2]=*(const __attribute__((address_space(3))) bf16x8*)(kp+2048); kf[3]=*(const __attribute__((address_space(3))) bf16x8*)(kp+2560);
  kf[4]=*(const __attribute__((address_space(3))) bf16x8*)(kp+4096); kf[5]=*(const __attribute__((address_space(3))) bf16x8*)(kp+4608);
  kf[6]=*(const __attribute__((address_space(3))) bf16x8*)(kp+6144); kf[7]=*(const __attribute__((address_space(3))) bf16x8*)(kp+6656);
}
__device__ __forceinline__ void kload2(bf16x8*kf,lds_cptr kp,int j){ kf[2*j]=*(const __attribute__((address_space(3))) bf16x8*)(kp+j*2048); kf[2*j+1]=*(const __attribute__((address_space(3))) bf16x8*)(kp+j*2048+512); }
__device__ __forceinline__ s16x4 vtr(lds_cptr p){ return __builtin_bit_cast(s16x4,__builtin_amdgcn_ds_read_tr16_b64_v4i16((__attribute__((address_space(3))) v4i16_t*)p)); }
__device__ __forceinline__ float rowmax(const f32x16&p0,const f32x16&p1){
  float a=max3f(p0[0],p0[1],p1[0]),b=max3f(p0[2],p0[3],p1[1]);a=max3f(a,p1[2],p1[3]);
  #pragma unroll
  for(int r=4;r<16;r+=4){a=max3f(a,p0[r],p0[r+1]);b=max3f(b,p0[r+2],p0[r+3]);a=max3f(a,p1[r],p1[r+1]);b=max3f(b,p1[r+2],p1[r+3]);}
  const float m=max2f(a,b);
  auto rr=__builtin_amdgcn_permlane32_swap(__float_as_uint(m),__float_as_uint(m),false,false);
  return max2f(__uint_as_float(rr[0]),__uint_as_float(rr[1]));
}
__device__ __forceinline__ void pv(f32x16*o,int vb,bf16x8 pa0,bf16x8 pa1,bf16x8 pa2,bf16x8 pa3){
  #pragma unroll
  for(int d0=0;d0<2;++d0){s16x4 lo[4],hi[4];
    #pragma unroll
    for(int ks=0;ks<4;++ks){
      asm volatile("ds_read_b64_tr_b16 %0,%1 offset:%c2":"=&v"(lo[ks]):"v"(vb),"i"(d0*4096+ks*1024):"memory");
      asm volatile("ds_read_b64_tr_b16 %0,%1 offset:%c2":"=&v"(hi[ks]):"v"(vb),"i"(d0*4096+ks*1024+512):"memory");}
    asm volatile("s_waitcnt lgkmcnt(0)":::"memory");SBAR();
    #define PK(k) (bf16x8){lo[k][0],lo[k][1],lo[k][2],lo[k][3],hi[k][0],hi[k][1],hi[k][2],hi[k][3]}
    o[d0]=__builtin_amdgcn_mfma_f32_32x32x16_bf16(pa0,PK(0),o[d0],0,0,0);
    o[d0]=__builtin_amdgcn_mfma_f32_32x32x16_bf16(pa1,PK(1),o[d0],0,0,0);
    o[d0]=__builtin_amdgcn_mfma_f32_32x32x16_bf16(pa2,PK(2),o[d0],0,0,0);
    o[d0]=__builtin_amdgcn_mfma_f32_32x32x16_bf16(pa3,PK(3),o[d0],0,0,0);
    #undef PK
  }
}

#ifndef ATTN_STORE16
#define ATTN_STORE16(p,v) (*(u32x4*)(p)=(v))
#endif
template<int THRL,int L,int NT> __device__ __forceinline__ void attn_unit(long rowbase,int kvh,int qblk,const bf16*Q,const bf16*__restrict__ K,const bf16*__restrict__ V,bf16*O,char*shm,const int tid){
  const int lane=tid&63,r32=lane&31,hi=lane>>5; const int wid=__builtin_amdgcn_readfirstlane(tid>>6);
  const int q0=qblk*64, qh=wid>>1, rh=wid&1;
  const bf16*Qw=Q+(rowbase+q0+rh*QBLK)*QP+(4*kvh+qh)*D;
  const bf16*Kh=K+rowbase*KP+kvh*D,*Vh=V+rowbase*KP+kvh*D;
  const unsigned lds0=(unsigned)(uintptr_t)shm;
  float*wsf=(float*)(shm+LDS_WS)+wid*64;
  const bf16*ksrc=Kh+(long)lane*KP+wid*8;
  const bf16*vsrc=Vh+(long)(16*(wid&3)+(lane>>2))*KP+(wid>>2)*32+(lane&3)*8;
  const unsigned kdst=lds0+LDS_K+wid*1024, vdst=lds0+LDS_V+wid*1024;
  #define DMA_K(t,slot) glds16(ksrc+(long)(t)*KVBLK*KP,(unsigned)__builtin_amdgcn_readfirstlane(kdst+(slot)))
  #define DMA_V(t,slot) glds16(vsrc+(long)(t)*KVBLK*KP,(unsigned)__builtin_amdgcn_readfirstlane(vdst+(slot)))
  const int vb0=(int)(lds0+LDS_V)+((lane>>4)&1)*32+(lane&3)*8+(4*hi+((lane&15)>>2))*64;
  const char*Kbase=shm+LDS_K; bf16x8 kf[8];
  const lds_cptr shm3=(lds_cptr)shm; const lds_cptr kp0=shm3+LDS_K+hi*1024+r32*16; const lds_cptr vp0=shm3+LDS_V+((lane>>4)&1)*32+(lane&3)*8+(4*hi+((lane&15)>>2))*64;
  DMA_K(0,0);DMA_V(0,0);DMA_K(1,SLOTB);
  bf16x8 qr[4];
  #pragma unroll
  for(int d0=0;d0<4;++d0)qr[d0]=*reinterpret_cast<const bf16x8*>(&Qw[(long)r32*QP+d0*16+hi*8]);
  if(q0+rh*QBLK+r32>=L){
    #pragma unroll
    for(int d0=0;d0<4;++d0)qr[d0]=bf16x8{0,0,0,0,0,0,0,0}; }
  float mhat=0.f,l_reg=0.f;f32x16 o[2];o[0]=f32x16{};o[1]=f32x16{};f32x16 negm=f32x16{};asm volatile("":"+v"(negm));
  #define CMASK(P0,P1,t) do{ if((t)>=NT-2)kmask(P0,P1,L-64*(t),hi);}while(0)
  bool resc=false;
  #define START(P0,P1) do{ const float rm=rowmax(P0,P1); resc=false; \
    { const float dl=rm; mhat=fadd_s(mhat,dl); \
      _Pragma("unroll") for(int r=0;r<16;++r){P0[r]=fsub_s(P0[r],dl);P1[r]=fsub_s(P1[r],dl);} \
      _Pragma("unroll") for(int r=0;r<16;++r)negm[r]=-mhat; asm volatile("":"+v"(negm)); } \
    _Pragma("unroll") for(int r=0;r<16;++r)P0[r]=__builtin_amdgcn_exp2f(P0[r]); }while(0)
  #define RESC() do{ if(resc){ asm volatile("s_waitcnt lgkmcnt(0)":::"memory"); \
      _Pragma("unroll") for(int d_=0;d_<2;++d_) _Pragma("unroll") for(int r=0;r<16;++r)o[d_][r]*=wsf[crow(r,hi)]; } }while(0)
  f32x16 pA0,pA1,pB0,pB1;
  int sl_prev=0,sl_cur=0,sl_next=SLOTB;
  #define ROT() do{sl_prev=sl_cur;sl_cur=sl_next;sl_next=(sl_next==(NSLOT-1)*SLOTB)?0:sl_next+SLOTB;}while(0)
  DMA_K(2,2*SLOTB);
  WAIT_BAR(3);
  qkt(pA0,pA1,Kbase,qr,negm,r32,hi);asm volatile("s_nop 15\n\ts_nop 7":"+v"(pA0),"+v"(pA1));CMASK(pA0,pA1,0);
  START(pA0,pA1);
  _Pragma("unroll") for(int r=0;r<16;++r)pA1[r]=__builtin_amdgcn_exp2f(pA1[r]);
  WAIT_BAR(0);
  DMA_K(3,0);DMA_V(1,SLOTB);
  ROT();
  kload8(kf,kp0+sl_cur);
  WAIT_BAR(2);
  s16x4 vlo[8],vhi[8]; u32x4 pw0,pw1,pw2,pw3;
  #define PKW(P,B) cvtpk_s(P[B],P[B+1])
  #define PAF(k) __builtin_bit_cast(bf16x8,pw##k)
  #define VFR(i) (bf16x8){vlo[i][0],vlo[i][1],vlo[i][2],vlo[i][3],vhi[i][0],vhi[i][1],vhi[i][2],vhi[i][3]}
  #define PIN(x) asm volatile("":"+v"(x))
  #define MX3(a,b,c) __builtin_fmaxf(__builtin_fmaxf((a),(b)),(c))
  #define GAPA(MF,A0,A1,A2,A3,W0,W1,PW) do{ MF; sacc+=A0; sacc+=A1; sacc+=A2; sacc+=A3; PIN(sacc); W0; W1; PIN(PW); SBAR(); }while(0)
  #define EX(v) __builtin_amdgcn_exp2f(v)
  #define GAPB(MF,X,B) do{ MF; X[B]=EX(X[B]); X[B+1]=EX(X[B+1]); X[B+2]=EX(X[B+2]); X[B+3]=EX(X[B+3]); PIN(X); SBAR(); }while(0)
  #define VRD(i) do{ vlo[i]=vtr(vp_+(((i)>>2)*4096+((i)&3)*1024)); vhi[i]=vtr(vp_+(((i)>>2)*4096+((i)&3)*1024+512)); }while(0)
  #define KRD(G,j) do{ if(G){ kload2(kf,kp0+sl_next,j); SBAR(); } }while(0)
  #define STEP(C0,C1,P0,P1,t,GK,GV,GL) do{ SBAR(); \
    const lds_cptr vp_=vp0+sl_prev; \
    VRD(0); SBAR(); float sacc=(P0[0]+P0[1]); \
    GAPA(C0=__builtin_amdgcn_mfma_f32_32x32x16_bf16(kf[0],qr[0],negm,0,0,0), P0[2],P0[3],P0[4],P0[5],     pw0[0]=PKW(P0,0), pw0[1]=PKW(P0,2), pw0); \
    VRD(4); SBAR(); GAPA(C1=__builtin_amdgcn_mfma_f32_32x32x16_bf16(kf[1],qr[0],negm,0,0,0), P0[6],P0[7],P0[8],P0[9],     pw0[2]=PKW(P0,4), pw0[3]=PKW(P0,6), pw0); \
    VRD(1); SBAR(); GAPA(C0=__builtin_amdgcn_mfma_f32_32x32x16_bf16(kf[2],qr[1],C0,0,0,0),   P0[10],P0[11],P0[12],P0[13], pw1[0]=PKW(P0,8), pw1[1]=PKW(P0,10), pw1); \
    VRD(5); SBAR(); GAPA(C1=__builtin_amdgcn_mfma_f32_32x32x16_bf16(kf[3],qr[1],C1,0,0,0),   P0[14],P0[15],P1[0],P1[1],   pw1[2]=PKW(P0,12),pw1[3]=PKW(P0,14), pw1); \
    VRD(2); SBAR(); GAPA(C0=__builtin_amdgcn_mfma_f32_32x32x16_bf16(kf[4],qr[2],C0,0,0,0),   P1[2],P1[3],P1[4],P1[5],     pw2[0]=PKW(P1,0), pw2[1]=PKW(P1,2), pw2); \
    VRD(6); SBAR(); GAPA(C1=__builtin_amdgcn_mfma_f32_32x32x16_bf16(kf[5],qr[2],C1,0,0,0),   P1[6],P1[7],P1[8],P1[9],     pw2[2]=PKW(P1,4), pw2[3]=PKW(P1,6), pw2); \
    VRD(3); SBAR(); GAPA(C0=__builtin_amdgcn_mfma_f32_32x32x16_bf16(kf[6],qr[3],C0,0,0,0),   P1[10],P1[11],P1[12],P1[13], pw3[0]=PKW(P1,8), pw3[1]=PKW(P1,10), pw3); \
    VRD(7); SBAR(); GAPA(C1=__builtin_amdgcn_mfma_f32_32x32x16_bf16(kf[7],qr[3],C1,0,0,0),   P1[14],P1[15],0.f,0.f,       pw3[2]=PKW(P1,12),pw3[3]=PKW(P1,14), pw3); \
    l_reg+=sacc; \
    if(GK){DMA_K((t)+3,sl_cur);} if(GV){DMA_V((t)+1,sl_next);} \
    CMASK(C0,C1,t); \
    { float a=MX3(C0[0],C0[1],C1[0]),b=MX3(C0[2],C0[3],C1[1]); a=MX3(a,C1[2],C1[3]); \
      _Pragma("unroll") for(int r=4;r<16;r+=4){a=MX3(a,C0[r],C0[r+1]);b=MX3(b,C0[r+2],C0[r+3]);a=MX3(a,C1[r],C1[r+1]);b=MX3(b,C1[r+2],C1[r+3]);} \
      float rm=__builtin_fmaxf(a,b); { auto rr=__builtin_amdgcn_permlane32_swap(__float_as_uint(rm),__float_as_uint(rm),false,false); rm=__builtin_fmaxf(__uint_as_float(rr[0]),__uint_as_float(rr[1])); } \
      resc=false; \
      if(__builtin_expect(__any(rm>(float)THRL),0)){ const float dl=__builtin_fmaxf(rm,0.f); mhat+=dl; \
        _Pragma("unroll") for(int r=0;r<16;++r){C0[r]-=dl;C1[r]-=dl;} \
        _Pragma("unroll") for(int r=0;r<16;++r)negm[r]=-mhat; asm volatile("":"+v"(negm)); \
        const float f=__builtin_amdgcn_exp2f(-dl); l_reg*=f; if(hi==0)wsf[r32]=f; resc=true; } } \
    SBAR(); \
    GAPB(o[0]=__builtin_amdgcn_mfma_f32_32x32x16_bf16(PAF(0),VFR(0),o[0],0,0,0), C0,0); \
    GAPB(o[1]=__builtin_amdgcn_mfma_f32_32x32x16_bf16(PAF(0),VFR(4),o[1],0,0,0), C0,4); \
    KRD(GL,0); GAPB(o[0]=__builtin_amdgcn_mfma_f32_32x32x16_bf16(PAF(1),VFR(1),o[0],0,0,0), C0,8); \
    KRD(GL,1); GAPB(o[1]=__builtin_amdgcn_mfma_f32_32x32x16_bf16(PAF(1),VFR(5),o[1],0,0,0), C0,12); \
    KRD(GL,2); GAPB(o[0]=__builtin_amdgcn_mfma_f32_32x32x16_bf16(PAF(2),VFR(2),o[0],0,0,0), C1,0); \
    KRD(GL,3); GAPB(o[1]=__builtin_amdgcn_mfma_f32_32x32x16_bf16(PAF(2),VFR(6),o[1],0,0,0), C1,4); \
    GAPB(o[0]=__builtin_amdgcn_mfma_f32_32x32x16_bf16(PAF(3),VFR(3),o[0],0,0,0), C1,8); \
    GAPB(o[1]=__builtin_amdgcn_mfma_f32_32x32x16_bf16(PAF(3),VFR(7),o[1],0,0,0), C1,12); \
    }while(0)
  int t=1;
  #undef CMASK
  #define CMASK(P0,P1,t) do{}while(0)
  for(;t+5<NT;t+=2){
    STEP(pB0,pB1,pA0,pA1,t,true,true,true);     WAIT_BAR(2); RESC(); ROT();
    STEP(pA0,pA1,pB0,pB1,t+1,true,true,true);   WAIT_BAR(2); RESC(); ROT();
  }
  #undef CMASK
  #define CMASK(P0,P1,t) do{ if((t)>=NT-2)kmask(P0,P1,L-64*(t),hi);}while(0)
  #define ENDW(tt) do{ if((tt)+3<NT){WAIT_BAR(2);} else if((tt)+2<NT){WAIT_BAR(1);} else {WAIT_BAR(0);} }while(0)
  for(;t+1<NT;t+=2){
    STEP(pB0,pB1,pA0,pA1,t,(t+3<NT),(t+1<NT),(t+1<NT));       ENDW(t);   RESC(); ROT();
    STEP(pA0,pA1,pB0,pB1,t+1,(t+4<NT),(t+2<NT),(t+2<NT));     ENDW(t+1); RESC(); ROT();
  }
  STEP(pB0,pB1,pA0,pA1,NT-1,false,false,false); RESC();
  { float sacc=pB0[0]+pB0[1]; _Pragma("unroll") for(int r=2;r<16;++r)sacc+=pB0[r]; _Pragma("unroll") for(int r=0;r<16;++r)sacc+=pB1[r]; l_reg+=sacc;
    pw0=(u32x4){PKW(pB0,0),PKW(pB0,2),PKW(pB0,4),PKW(pB0,6)};pw1=(u32x4){PKW(pB0,8),PKW(pB0,10),PKW(pB0,12),PKW(pB0,14)};pw2=(u32x4){PKW(pB1,0),PKW(pB1,2),PKW(pB1,4),PKW(pB1,6)};pw3=(u32x4){PKW(pB1,8),PKW(pB1,10),PKW(pB1,12),PKW(pB1,14)};
    SBAR(); pv(o,vb0+sl_cur,PAF(0),PAF(1),PAF(2),PAF(3)); }
  #undef PKW
  #undef PAF
  #undef VFR
  #undef PIN
  #undef MX3
  #undef GAPA
  #undef GAPB
  #undef EX
  #undef VRD
  #undef KRD
  #undef STEP
  #undef ENDW
  {auto rr=__builtin_amdgcn_permlane32_swap(__float_as_uint(l_reg),__float_as_uint(l_reg),false,false);l_reg=__uint_as_float(rr[0])+__uint_as_float(rr[1]);}
  if(hi==0)wsf[32+r32]=l_reg;asm volatile("s_waitcnt lgkmcnt(0)":::"memory");
  float rli[16];
  #pragma unroll
  for(int r=0;r<16;++r)rli[r]=__builtin_amdgcn_rcpf(wsf[32+crow(r,hi)]);
  bf16*Ow=O+(rowbase+q0+rh*QBLK)*QP+(4*kvh+qh)*D;
  { bf16*stg=(bf16*)(shm+LDS_OST)+wid*2048;
    #pragma unroll
    for(int r=0;r<16;++r){const int orow=crow(r,hi);
      #pragma unroll
      for(int d0=0;d0<2;++d0)stg[orow*64+d0*32+r32]=__float2bfloat16(o[d0][r]*rli[r]);}
    asm volatile("s_waitcnt lgkmcnt(0)":::"memory");
    #pragma unroll
    for(int i=0;i<4;++i){const int row=i*8+(lane>>3),ch=lane&7; const u32x4 v=*(const u32x4*)(stg+row*64+ch*8); if(q0+rh*QBLK+row<L)ATTN_STORE16(Ow+(long)row*QP+ch*8,v);} }
  asm volatile("s_waitcnt lgkmcnt(0)\n\ts_barrier":::"memory");
  #undef DMA_K
  #undef DMA_V
  #undef CMASK
  #undef START
  #undef RESC
  #undef ROT
}
constexpr int ATTN_LDS_BYTES=LDS_BYTES;
#undef SBAR
#undef WAIT_BAR
}
constexpr int DM = 1024, FF = 2816, NLAYER = 4;
constexpr int LP = 4112, LS = 2064, NSEQ_P = 4, NSEQ_S = 16, ROWS_P = NSEQ_P * LP  , T_ROWS = ROWS_P + NSEQ_S * LS  ;
constexpr int TPAD = 49664, NMT = TPAD / 256;
constexpr int NWIN = 4608;
constexpr float NORM_EPS = 1e-6f;
constexpr float QSCALE = 0.125f * 1.4426950408889634f;
constexpr int ATT_UNITS_P = NSEQ_P * 4 * 65, ATT_UNITS_S = NSEQ_S * 4 * 33, ATT_UNITS = ATT_UNITS_P + ATT_UNITS_S;

constexpr size_t MiB = 1u << 20;
constexpr int CW_BAR = 4096;
constexpr size_t WS_CTL = 0;
constexpr size_t WS_ROPE = MiB / 4;
constexpr size_t WS_HMETA = 3 * MiB / 2;
constexpr size_t WS_SSQ = 3 * MiB;
constexpr size_t WS_W = 8 * MiB;
constexpr size_t W_GU1 = 0, W_D1 = W_GU1 + (size_t)5632 * 1024 * 2, W_IN = W_D1 + (size_t)1024 * 2816 * 2, W_GC = W_IN + (size_t)NWIN * 1024 * 2, W_OC = W_GC + 2 * MiB,
                 W_GA = W_OC + 2 * MiB, W_OA = W_GA + 2 * MiB, W_M = W_OA + 2 * MiB, W_GU2 = W_M + 2 * MiB, W_D2 = W_GU2 + (size_t)5632 * 1024 * 2, W_END = W_D2 + (size_t)1024 * 2816 * 2;
constexpr size_t WBUF = 56 * MiB;
constexpr size_t WS_HB = 120 * MiB;
constexpr size_t ROWB = (size_t)TPAD * 1024 * 2;
constexpr size_t WS_BIG = WS_HB + 98 * MiB;
constexpr size_t WS_Q = WS_BIG, WS_K = WS_Q + ROWB, WS_V = WS_K + ROWB / 4, WS_CB = WS_V + ROWB / 4, WS_Z = WS_CB + ROWB, WS_END = WS_Z + ROWB;
constexpr size_t WS_HID = WS_BIG;
constexpr size_t WS_SCR = WS_K;
static_assert((CW_BAR + 3456) * 4 <= (int)WS_ROPE && WS_ROPE + (size_t)LP * 64 * 4 <= WS_HMETA && WS_HMETA + (size_t)20 * 16 * 1024 * 4 <= WS_SSQ && WS_SSQ + (size_t)TPAD * 16 * 4 <= WS_W, "d_ws map (small regions)");
static_assert(W_END <= 56 * MiB && ROWB <= 98 * MiB && (size_t)TPAD * FF * 2 <= WS_END - WS_BIG && 256 * 131072 <= ROWB / 2, "d_ws map");

constexpr int RING_BYTES = 131072, MISC_OFF = RING_BYTES + 320, PTAB_OFF = RING_BYTES + 1024, LDS_BYTES = 147456;
constexpr int NWAVES = 8;

#define GAS __attribute__((address_space(1)))
#define LAS __attribute__((address_space(3)))
typedef unsigned short bf16;
typedef unsigned v4u __attribute__((ext_vector_type(4)));
typedef float f32x4 __attribute__((ext_vector_type(4)));
__device__ __forceinline__ unsigned f2bf(float f) { unsigned u = __builtin_bit_cast(unsigned, f); return (u + 0x7fffu + ((u >> 16) & 1u)) >> 16; }
__device__ __forceinline__ unsigned pk2(float lo, float hi) { return pg8::cvt_pk_bf16(lo, hi); }
__device__ __forceinline__ float bflo(unsigned u) { return __builtin_bit_cast(float, u << 16); }
__device__ __forceinline__ float bfhi(unsigned u) { return __builtin_bit_cast(float, u & 0xffff0000u); }
__device__ __forceinline__ float wave_sum(float v) {
#pragma unroll
    for (int o = 1; o < 64; o <<= 1) v += __shfl_xor(v, o);
    return v;
}
__device__ __forceinline__ void rowinfo(int r, int& pos, int& L) {
    if (r < ROWS_P) { L = LP; pos = r % LP; } else if (r < T_ROWS) { L = LS; pos = (r - ROWS_P) % LS; } else { L = 1 << 30; pos = 0; }
}
__device__ __forceinline__ float sigmoidf_(float x) { return __builtin_amdgcn_rcpf(1.0f + __builtin_amdgcn_exp2f(-1.4426950408889634f * x)); }

struct PlainOrder : pg8::StaticOrder {
    const char* A; const char* Bt; size_t tstep;
    __device__ __forceinline__ const char* aptr(const pg8::Unit& u) const { return A + (size_t)u.pm * tstep; }
    __device__ __forceinline__ const char* bptr(const pg8::Unit& u) const { return Bt + (size_t)u.pn * tstep; }
};
struct ChainOrder {
    pg8::StaticOrder base; const char* A[4]; const char* B[4]; size_t tstep;
    __device__ __forceinline__ bool next(int i, pg8::Unit& u) const { if (!base.next(i >> 2, u)) return false; u.sub = i & 3; return true; }
    __device__ __forceinline__ const char* aptr(const pg8::Unit& u) const { const char* p = u.sub == 0 ? A[0] : u.sub == 1 ? A[1] : u.sub == 2 ? A[2] : A[3]; return p + (size_t)u.pm * tstep; }
    __device__ __forceinline__ const char* bptr(const pg8::Unit& u) const { const char* p = u.sub == 0 ? B[0] : u.sub == 1 ? B[1] : u.sub == 2 ? B[2] : B[3]; return p + (size_t)u.pn * tstep; }
    __device__ __forceinline__ void a_ready(const pg8::Unit&) const {}
    __device__ __forceinline__ void done(const pg8::Unit&) const {}
};

using pg8::f32x4; using pg8::u32x4; using pg8::Unit; using pg8::bf16_t;
typedef f32x4 Acc[2][2][4][2];
__device__ __forceinline__ u32x4 pack8(const f32x4 a, const f32x4 b) { u32x4 w; w.x = pk2(a[0], a[1]); w.y = pk2(a[2], a[3]); w.z = pk2(b[0], b[1]); w.w = pk2(b[2], b[3]); return w; }
__device__ __forceinline__ void unpack8(const u32x4 w, f32x4& a, f32x4& b) { a = (f32x4){bflo(w.x), bfhi(w.x), bflo(w.y), bfhi(w.y)}; b = (f32x4){bflo(w.z), bfhi(w.z), bflo(w.w), bfhi(w.w)}; }
__device__ __forceinline__ float rstd_of(const float* ssq, int row) { const f32x4* p = (const f32x4*)(ssq + (size_t)row * 16); const f32x4 a = p[0], b = p[1], c = p[2], d = p[3];
    const float s = (((a[0] + a[1]) + (a[2] + a[3])) + ((b[0] + b[1]) + (b[2] + b[3]))) + (((c[0] + c[1]) + (c[2] + c[3])) + ((d[0] + d[1]) + (d[2] + d[3])));
    return __builtin_amdgcn_rsqf(s * (1.0f / DM) + NORM_EPS); }

__device__ __forceinline__ void rstd8(const float* ssq, int row0, int fq, float (&rs)[8]) {
    f32x4 pr[8];
#pragma unroll
    for (int i = 0; i < 8; ++i) pr[i] = *(const f32x4*)(ssq + (size_t)(row0 + (i >> 2) * 128 + (i & 3) * 16) * 16 + 4 * fq);
#pragma unroll
    for (int i = 0; i < 8; ++i) { float s = (pr[i][0] + pr[i][1]) + (pr[i][2] + pr[i][3]); s += __shfl_xor(s, 16); s += __shfl_xor(s, 32); rs[i] = __builtin_amdgcn_rsqf(s * (1.0f / DM) + NORM_EPS); }
}
struct EpiSwiGLU {
    static constexpr bool PERM = true, AFTER_DRAIN = false;
    bf16_t* hid; const float* ssq;
    __device__ __forceinline__ void operator()(const Acc& acc, const Unit& u, int wr, int wc, int fr, int fq) const {
        const int row0 = u.pm * 256 + wr * 64 + fr;
        float rs[8]; rstd8(ssq, row0, fq, rs);
#pragma unroll
        for (int ai = 0; ai < 2; ++ai)
#pragma unroll
            for (int m = 0; m < 4; ++m) {
                const int row = row0 + ai * 128 + m * 16; const float r1 = rs[ai * 4 + m];
                f32x4 o[2];
#pragma unroll
                for (int n = 0; n < 2; ++n) {
                    const f32x4 gs = acc[ai][0][m][n] * r1, us = acc[ai][1][m][n] * r1, t = gs * -1.4426950408889634f;
                    f32x4 d; d[0] = __builtin_amdgcn_exp2f(t[0]); d[1] = __builtin_amdgcn_exp2f(t[1]); d[2] = __builtin_amdgcn_exp2f(t[2]); d[3] = __builtin_amdgcn_exp2f(t[3]);
                    d = d + 1.0f;
                    f32x4 r; r[0] = __builtin_amdgcn_rcpf(d[0]); r[1] = __builtin_amdgcn_rcpf(d[1]); r[2] = __builtin_amdgcn_rcpf(d[2]); r[3] = __builtin_amdgcn_rcpf(d[3]);
                    o[n] = (gs * us) * r;
                }
                *(u32x4*)(hid + (size_t)row * FF + u.pn * 128 + wc * 32 + 8 * fq) = pack8(o[0], o[1]);
            }
    }
};
struct EpiResid {
    static constexpr bool PERM = true, AFTER_DRAIN = false;
    bf16_t* hb; float* ssq_out; float scale;
    __device__ __forceinline__ void operator()(const Acc& acc, const Unit& u, int wr, int wc, int fr, int fq) const {
        const int row0 = u.pm * 256 + wr * 64 + fr;
#pragma unroll
        for (int ai = 0; ai < 2; ++ai) {
            u32x4 old[4][2];
#pragma unroll
            for (int m = 0; m < 4; ++m) { const int row = row0 + ai * 128 + m * 16; const bf16_t* bp = hb + (size_t)row * DM + u.pn * 256 + wc * 32 + 8 * fq;
#pragma unroll
                for (int bj = 0; bj < 2; ++bj) old[m][bj] = row < T_ROWS ? *(const u32x4*)(bp + bj * 128) : (u32x4){0u, 0u, 0u, 0u}; }
#pragma unroll
            for (int m = 0; m < 4; ++m) {
                const int row = row0 + ai * 128 + m * 16; const bool ok = row < T_ROWS; bf16_t* bp = hb + (size_t)row * DM + u.pn * 256 + wc * 32 + 8 * fq;
                float ss = 0.f;
#pragma unroll
                for (int bj = 0; bj < 2; ++bj) {
                    f32x4 a, b; unpack8(old[m][bj], a, b);
                    a = a + acc[ai][bj][m][0] * scale; b = b + acc[ai][bj][m][1] * scale;
                    const u32x4 w = pack8(a, b); if (ok) *(u32x4*)(bp + bj * 128) = w;
                    unpack8(w, a, b);
                    ss += (a[0] * a[0] + a[1] * a[1]) + (a[2] * a[2] + a[3] * a[3]) + (b[0] * b[0] + b[1] * b[1]) + (b[2] * b[2] + b[3] * b[3]);
                }
                ss += __shfl_xor(ss, 16); ss += __shfl_xor(ss, 32);
                if (ok && fq == 0) ssq_out[(size_t)row * 16 + u.pn * 4 + wc] = ss;
            }
            asm volatile("" ::: "memory");
        }
    }
};
struct EpiWin {
    static constexpr bool PERM = true, AFTER_DRAIN = false;
    bf16_t *q, *k, *v, *cb, *z; const float* ssq; const float* rope; const float* qg; const float* kg;
    __device__ __forceinline__ void operator()(const Acc& acc, const Unit& u, int wr, int wc, int fr, int fq) const {
        const int pn = u.pn; const int row0 = u.pm * 256 + wr * 64 + fr;
        float rs[8]; rstd8(ssq, row0, fq, rs);
        if (pn <= 4) {
            const float* g = pn < 4 ? qg : kg; const float osc = pn < 4 ? QSCALE : 1.0f;
            f32x4 G[2][2];
#pragma unroll
            for (int bj = 0; bj < 2; ++bj)
#pragma unroll
                for (int n = 0; n < 2; ++n) G[bj][n] = *(const f32x4*)(g + 32 * bj + 16 * n + 4 * fq) * osc;
#pragma unroll
            for (int ai = 0; ai < 2; ++ai)
#pragma unroll
                for (int mp = 0; mp < 2; ++mp) {
                    f32x4 cs[2][2][2];
#pragma unroll
                    for (int mm = 0; mm < 2; ++mm) { int pos, L; rowinfo(row0 + ai * 128 + (2 * mp + mm) * 16, pos, L);
#pragma unroll
                        for (int bj = 0; bj < 2; ++bj) { cs[mm][bj][0] = *(const f32x4*)(rope + ((pos * 2 + bj) * 2 + 0) * 16 + 4 * fq); cs[mm][bj][1] = *(const f32x4*)(rope + ((pos * 2 + bj) * 2 + 1) * 16 + 4 * fq); } }
#pragma unroll
                    for (int mm = 0; mm < 2; ++mm) {
                        const int m = 2 * mp + mm; const int row = row0 + ai * 128 + m * 16; const float r1 = rs[ai * 4 + m];
                        f32x4 x[2][2]; float ss = 0.f;
#pragma unroll
                        for (int bj = 0; bj < 2; ++bj)
#pragma unroll
                            for (int n = 0; n < 2; ++n) { x[bj][n] = acc[ai][bj][m][n] * r1; const f32x4 t = x[bj][n] * x[bj][n]; ss += (t[0] + t[1]) + (t[2] + t[3]); }
                        ss += __shfl_xor(ss, 16); ss += __shfl_xor(ss, 32);
                        const float rn = __builtin_amdgcn_rsqf(ss * (1.0f / 64.0f) + NORM_EPS);
                        bf16_t* dst = pn < 4 ? q + (size_t)row * 1024 + (4 * pn + wc) * 64 + 8 * fq : k + (size_t)row * 256 + wc * 64 + 8 * fq;
#pragma unroll
                        for (int bj = 0; bj < 2; ++bj) {
                            const f32x4 c4 = cs[mm][bj][0], s4 = cs[mm][bj][1];
                            const f32x4 y1 = x[bj][0] * rn * G[bj][0], y2 = x[bj][1] * rn * G[bj][1];
                            const f32x4 o1 = y1 * c4 - y2 * s4, o2 = y2 * c4 + y1 * s4;
                            *(u32x4*)(dst + 32 * bj) = pack8(o1, o2);
                        }
                    }
                    asm volatile("" ::: "memory");
                }
        } else if (pn < 10) {
            bf16_t* base; int pitch, c0;
            if (pn == 5) { base = v; pitch = 256; c0 = 0; } else { base = cb; pitch = 1024; c0 = 256 * (pn - 6); }
#pragma unroll
            for (int ai = 0; ai < 2; ++ai)
#pragma unroll
                for (int m = 0; m < 4; ++m) {
                    const int row = row0 + ai * 128 + m * 16; const float r1 = rs[ai * 4 + m];
#pragma unroll
                    for (int bj = 0; bj < 2; ++bj) *(u32x4*)(base + (size_t)row * pitch + c0 + 128 * bj + wc * 32 + 8 * fq) = pack8(acc[ai][bj][m][0] * r1, acc[ai][bj][m][1] * r1);
                }
        } else {
#pragma unroll
            for (int ai = 0; ai < 2; ++ai)
#pragma unroll
                for (int m = 0; m < 4; ++m) {
                    const int row = row0 + ai * 128 + m * 16; const float r1 = rs[ai * 4 + m], rs2 = r1 * r1;
                    *(u32x4*)(z + (size_t)row * 1024 + 128 * (pn - 10) + wc * 32 + 8 * fq) = pack8(acc[ai][0][m][0] * acc[ai][1][m][0] * rs2, acc[ai][0][m][1] * acc[ai][1][m][1] * rs2);
                }
        }
    }
};
struct EpiMerge {
    static constexpr bool PERM = true, AFTER_DRAIN = false;
    bf16_t* merged; u32x4* scr; const float* ssq; int tid;
    __device__ __forceinline__ void operator()(const Acc& acc, const Unit& u, int wr, int wc, int fr, int fq) const {
        const int sub = u.sub; const int row0 = u.pm * 256 + wr * 64 + fr;
        char* mb = (char*)(merged + (size_t)row0 * DM + u.pn * 256 + wc * 32 + 8 * fq); asm volatile("" : "+v"(mb));
        char* sb = (char*)(scr + tid); asm volatile("" : "+v"(sb));
#define MP(ai, m, bj) ((u32x4*)(mb + ((ai) * 128 + (m) * 16) * (DM * 2) + (bj) * 256))
#define SP(ai, m, bj) ((u32x4*)(sb + ((((ai) * 4 + (m)) * 2 + (bj)) * 512) * 16))
        if ((sub & 1) == 0) {
            float rs[8]; rstd8(ssq, row0, fq, rs);
#pragma unroll
            for (int ai = 0; ai < 2; ++ai)
#pragma unroll
                for (int m = 0; m < 4; ++m) {
                    const float r1 = rs[ai * 4 + m];
#pragma unroll
                    for (int bj = 0; bj < 2; ++bj) {
                        f32x4 s0, s1; const f32x4 v0 = acc[ai][bj][m][0], v1 = acc[ai][bj][m][1];
#pragma unroll
                        for (int e = 0; e < 4; ++e) { s0[e] = sigmoidf_(v0[e] * r1); s1[e] = sigmoidf_(v1[e] * r1); }
                        if (sub == 0) *MP(ai, m, bj) = pack8(s0, s1); else *SP(ai, m, bj) = pack8(s0, s1);
                    }
                }
        } else if (sub == 1) {
#pragma unroll
            for (int ai = 0; ai < 2; ++ai) {
                u32x4 g[4][2];
#pragma unroll
                for (int m = 0; m < 4; ++m)
#pragma unroll
                    for (int bj = 0; bj < 2; ++bj) g[m][bj] = *MP(ai, m, bj);
#pragma unroll
                for (int m = 0; m < 4; ++m)
#pragma unroll
                    for (int bj = 0; bj < 2; ++bj) { f32x4 g0, g1; unpack8(g[m][bj], g0, g1); *MP(ai, m, bj) = pack8(g0 * acc[ai][bj][m][0], g1 * acc[ai][bj][m][1]); }
                asm volatile("" ::: "memory");
            }
        } else {
#pragma unroll
            for (int ai = 0; ai < 2; ++ai)
#pragma unroll
                for (int mp = 0; mp < 2; ++mp) {
                    u32x4 c[2][2], s[2][2];
#pragma unroll
                    for (int mm = 0; mm < 2; ++mm)
#pragma unroll
                        for (int bj = 0; bj < 2; ++bj) { c[mm][bj] = *MP(ai, 2 * mp + mm, bj); s[mm][bj] = *SP(ai, 2 * mp + mm, bj); }
#pragma unroll
                    for (int mm = 0; mm < 2; ++mm)
#pragma unroll
                        for (int bj = 0; bj < 2; ++bj) { const int m = 2 * mp + mm; f32x4 c0, c1, s0, s1; unpack8(c[mm][bj], c0, c1); unpack8(s[mm][bj], s0, s1);
                            *MP(ai, m, bj) = pack8(c0 + s0 * acc[ai][bj][m][0], c1 + s1 * acc[ai][bj][m][1]); }
                    asm volatile("" ::: "memory");
                }
        }
#undef MP
#undef SP
    }
};

__device__ __forceinline__ void cvt_item(const float* W, int Nsrc, int n0src, const float* gain, bool permqk, bf16* WT, int K, int nrow0, int k0, LAS float* scr, int lane) {
#pragma unroll 8
    for (int i = 0; i < 32; ++i) { const int kk = 2 * i + (lane >> 5); float w = W[(size_t)(k0 + kk) * Nsrc + n0src + (lane & 31)]; if (gain) w *= gain[k0 + kk]; scr[kk * 33 + (lane & 31)] = w; }
    asm volatile("s_waitcnt lgkmcnt(0)" ::: "memory");
    const int c = lane & 7;
#pragma unroll
    for (int j = 0; j < 4; ++j) { const int n = (lane >> 3) + 8 * j; const int ns = permqk ? (16 * ((n >> 2) & 1) + 4 * (n >> 3) + (n & 3)) : n; const LAS float* s = scr + (8 * c) * 33 + ns;
        v4u o; o.x = pk2(s[0 * 33], s[1 * 33]); o.y = pk2(s[2 * 33], s[3 * 33]); o.z = pk2(s[4 * 33], s[5 * 33]); o.w = pk2(s[6 * 33], s[7 * 33]);
        *(GAS v4u*)(WT + (size_t)(nrow0 + n) * K + k0 + 8 * c) = o; }
    asm volatile("s_waitcnt lgkmcnt(0)" ::: "memory");
}
#define RLX_AGENT __ATOMIC_RELAXED, __HIP_MEMORY_SCOPE_AGENT
#define XB_TMO      128
#define XB_XCNT(j)  (256  + 64 * (j))
#define XB_XSUB(j)  (1280 + 64 * (j))
#define XB_XGEN(j)  (2304 + 64 * (j))
#define XB_TOP      3328
#define XB_TOPGEN   3392
#define XCD_BAR_WORDS 3456
#define XB_SPIN_CAP (1u << 18)

__device__ __forceinline__ unsigned xb_ld(unsigned* p)              { return __hip_atomic_load(p, __ATOMIC_RELAXED, __HIP_MEMORY_SCOPE_AGENT); }
__device__ __forceinline__ unsigned xb_add(unsigned* p, unsigned v) { return __hip_atomic_fetch_add(p, v, __ATOMIC_RELAXED, __HIP_MEMORY_SCOPE_AGENT); }
__device__ __forceinline__ unsigned xb_xcc_id() { return (unsigned)__builtin_amdgcn_s_getreg((3 << 11) | 20) & 0xFu; }
#define XB_SPIN(cond, bar) do { unsigned _sp = 0; while (cond) { __builtin_amdgcn_s_sleep(1); \
    if ((++_sp & 255u) == 0u) { if (xb_ld(&(bar)[XB_TMO])) break; if (_sp > XB_SPIN_CAP) { atomicAdd(&(bar)[XB_TMO], 1u); break; } } } } while (0)

struct XcdBarrier {
    unsigned* bar; unsigned x;
    volatile LAS unsigned* st;
};

__device__ __forceinline__ XcdBarrier xcd_barrier_post(unsigned* bar, volatile LAS unsigned* st) {
    XcdBarrier b; b.bar = bar; b.x = xb_xcc_id(); b.st = st;
    if (threadIdx.x == 0) (void)xb_add(&bar[XB_XCNT(b.x)], 1u);
    return b;
}
__device__ __forceinline__ void xcd_barrier_complete(unsigned* bar, unsigned x, unsigned& nloc, unsigned& nx) {
    const unsigned G = gridDim.x * gridDim.y * gridDim.z;
    unsigned sum, cnt, mine, sp = 0u;
    for (;;) {
        sum = 0u; cnt = 0u; mine = 0u;
#pragma unroll
        for (unsigned j = 0; j < 16; ++j) { const unsigned c = xb_ld(&bar[XB_XCNT(j)]); sum += c; cnt += (c > 0u) ? 1u : 0u; mine = (j == x) ? c : mine; }
        if (sum == G) break;
        __builtin_amdgcn_s_sleep(1);
        if ((++sp & 255u) == 0u) { if (xb_ld(&bar[XB_TMO])) break; if (sp > XB_SPIN_CAP) { atomicAdd(&bar[XB_TMO], 1u); break; } }
    }
    nloc = mine > 0u ? mine : 1u; nx = cnt > 0u ? cnt : 1u;
}

__device__ __forceinline__ void xcd_barrier(const XcdBarrier& b) {
    asm volatile("s_waitcnt vmcnt(0)" ::: "memory");
    __syncthreads();
    if (threadIdx.x == 0) {
        unsigned* bar = b.bar;
        __builtin_amdgcn_s_waitcnt(0);
        unsigned nloc = b.st[0], nx = b.st[1];
        if (nloc == 0u) { xcd_barrier_complete(bar, b.x, nloc, nx); b.st[0] = nloc; b.st[1] = nx; }
        const unsigned old = xb_add(&bar[XB_XSUB(b.x)], 1u);
        const unsigned gen = old / nloc;
        if (old + 1u == (gen + 1u) * nloc) {
            __builtin_amdgcn_fence(__ATOMIC_RELEASE, "agent");
            asm volatile("s_waitcnt vmcnt(0)" ::: "memory");
            const unsigned og = xb_add(&bar[XB_TOP], 1u);
            const unsigned tg = og / nx;
            if (og + 1u == (tg + 1u) * nx) xb_add(&bar[XB_TOPGEN], 1u);
            else XB_SPIN(xb_ld(&bar[XB_TOPGEN]) == tg, bar);
            __builtin_amdgcn_fence(__ATOMIC_ACQUIRE, "agent");
            xb_add(&bar[XB_XGEN(b.x)], 1u);
            asm volatile("s_waitcnt vmcnt(0)" ::: "memory");
        } else {
            XB_SPIN(xb_ld(&bar[XB_XGEN(b.x)]) == gen, bar);
            __builtin_amdgcn_fence(__ATOMIC_ACQUIRE, "agent");
            asm volatile("s_waitcnt vmcnt(0)" ::: "memory");
        }
    }
    __syncthreads();
}
struct Args { const float* in[21]; float* out; unsigned char* ws; int ph_lo, ph_hi; };
struct PT {
    volatile LAS unsigned long long* t;
    __device__ __forceinline__ unsigned long long get(int i) const { const unsigned long long v = t[i]; const unsigned lo = __builtin_amdgcn_readfirstlane((unsigned)v), hi = __builtin_amdgcn_readfirstlane((unsigned)(v >> 32)); return ((unsigned long long)hi << 32) | lo; }
    __device__ __forceinline__ const float* in(int i) const { return (const float*)(const GAS float*)get(i); }
    __device__ __forceinline__ float* out() const { return (float*)(GAS float*)get(21); }
    __device__ __forceinline__ unsigned char* ws() const { return (unsigned char*)(GAS unsigned char*)get(22); }
};

__device__ __forceinline__ void cvt_one(const PT a, unsigned char* ws, int l, LAS unsigned char* lds, int it, int wave, int lane) {
    LAS float* scr = (LAS float*)(lds + wave * 16384);
    bf16* W = (bf16*)(ws + WS_W + (size_t)(l & 1) * WBUF);
    const size_t ffo = (size_t)l * DM * FF, sqo = (size_t)l * DM * DM;
    const float* win = a.in(8) + (size_t)l * DM * 6656; const float* mixg = a.in(7) + l * DM;
    {
        int r = it;
        if (r < 2816) { const int kb = r / 176, nb = r % 176, pn = nb >> 3, t = nb & 7; const float* src = (t >> 2) ? a.in(5) + ffo : a.in(4) + ffo;
            cvt_item(src, FF, 128 * pn + 32 * (t & 3), a.in(3) + l * DM, false, (bf16*)((char*)W + W_GU1), 1024, nb * 32, kb * 64, scr, lane); return; } r -= 2816;
        if (r < 1408) { const int kb = r / 32, nb = r % 32; cvt_item(a.in(6) + ffo, DM, nb * 32, nullptr, false, (bf16*)((char*)W + W_D1), FF, nb * 32, kb * 64, scr, lane); return; } r -= 1408;
        if (r < 2304) { const int kb = r / 144, nb = r % 144, pn = nb >> 3, t = nb & 7; int n0; bool pq = false;
            if (pn < 4) { n0 = 64 * (4 * pn + (t & 3)) + 32 * (t >> 2); pq = true; }
            else if (pn == 4) { n0 = 1024 + 64 * (t & 3) + 32 * (t >> 2); pq = true; }
            else if (pn == 5) n0 = 1280 + 32 * t;
            else if (pn < 10) n0 = 1536 + 256 * (pn - 6) + 32 * t;
            else n0 = ((t >> 2) ? 3584 : 2560) + 128 * (pn - 10) + 32 * (t & 3);
            cvt_item(win, 6656, n0, mixg, pq, (bf16*)((char*)W + W_IN), 1024, nb * 32, kb * 64, scr, lane); return; } r -= 2304;
        if (r < 2560) { const int seg = r / 512, q = r % 512, kb = q / 32, nb = q % 32;
            const float* src; int ns, n0; const float* gn = nullptr; size_t dst;
            if (seg == 0) { src = win; ns = 6656; n0 = 5632 + nb * 32; gn = mixg; dst = W_GC; }
            else if (seg == 1) { src = a.in(14) + sqo; ns = DM; n0 = nb * 32; dst = W_OC; }
            else if (seg == 2) { src = win; ns = 6656; n0 = 4608 + nb * 32; gn = mixg; dst = W_GA; }
            else if (seg == 3) { src = a.in(13) + sqo; ns = DM; n0 = nb * 32; dst = W_OA; }
            else { src = a.in(15) + sqo; ns = DM; n0 = nb * 32; dst = W_M; }
            cvt_item(src, ns, n0, gn, false, (bf16*)((char*)W + dst), 1024, nb * 32, kb * 64, scr, lane); return; } r -= 2560;
        if (r < 2816) { const int kb = r / 176, nb = r % 176, pn = nb >> 3, t = nb & 7; const float* src = (t >> 2) ? a.in(18) + ffo : a.in(17) + ffo;
            cvt_item(src, FF, 128 * pn + 32 * (t & 3), a.in(16) + l * DM, false, (bf16*)((char*)W + W_GU2), 1024, nb * 32, kb * 64, scr, lane); return; } r -= 2816;
        { const int kb = r / 32, nb = r % 32; cvt_item(a.in(19) + ffo, DM, nb * 32, nullptr, false, (bf16*)((char*)W + W_D2), FF, nb * 32, kb * 64, scr, lane); }
    }
}

constexpr int CVT_ITEMS = 13312;
__device__ __forceinline__ void convert_static(const PT a, unsigned char* ws, int l, LAS unsigned char* lds, int gw, int NGW, int wave, int lane) {
    for (int it = gw; it < CVT_ITEMS; it += NGW) cvt_one(a, ws, l, lds, it, wave, lane);
}
__device__ __forceinline__ void convert_dynamic(const PT a, unsigned char* ws, int l, LAS unsigned char* lds, unsigned* ctr, int lo, int hi, int wave, int lane) {
    for (;;) {
        unsigned b = 0; if (lane == 0) b = atomicAdd(ctr, 4u);
        const int base = lo + (int)__builtin_amdgcn_readfirstlane(b);
        if (base >= hi) break;
        for (int k = 0; k < 4; ++k) { if (base + k < hi) cvt_one(a, ws, l, lds, base + k, wave, lane); }
    }
}
__device__ __forceinline__ void prologue(const PT a, unsigned char* ws, int tid, int wave, int lane, int bid, int G) {
    const int gtid = bid * 512 + tid, GT = G * 512, gw = bid * NWAVES + wave, NGW = G * NWAVES;
    float* ssq = (float*)(ws + WS_SSQ); bf16* hb = (bf16*)(ws + WS_HB); float* rope = (float*)(ws + WS_ROPE);
    for (int i = gtid; i < (TPAD - T_ROWS) * 16; i += GT) ssq[(size_t)T_ROWS * 16 + i] = 0.f;
    for (int i = gtid; i < (TPAD - T_ROWS) * DM / 8; i += GT) ((v4u*)(hb + (size_t)T_ROWS * DM))[i] = (v4u){0u, 0u, 0u, 0u};
    if (gtid < 64) ((unsigned*)(ws + WS_CTL))[gtid] = 0u;
    for (int i = gtid; i < LP * 32; i += GT) {
        const int pos = i >> 5, axis = (i >> 4) & 1, f = i & 15;
        float coord; if (pos < 16) coord = axis ? (float)pos : -1.0f; else { const int t = pos - 16; coord = axis ? (float)(t & 63) : (float)(t >> 6); }
        const float inv = powf(10000.0f, -(float)f * (1.0f / 16.0f)); const float ang = coord * inv;
        float s, c; sincosf(ang, &s, &c);
        rope[((pos * 2 + axis) * 2 + 0) * 16 + f] = c; rope[((pos * 2 + axis) * 2 + 1) * 16 + f] = s;
    }
    for (int r = gw; r < T_ROWS; r += NGW) {
        int pos, L; rowinfo(r, pos, L);
        const float* src;
        if (pos < 16) src = a.in(2) + (size_t)pos * DM;
        else if (r < ROWS_P) src = a.in(0) + ((size_t)(r / LP) * 4096 + pos - 16) * DM;
        else src = a.in(1) + ((size_t)((r - ROWS_P) / LS) * 2048 + pos - 16) * DM;
        f32x4 v[4]; float s = 0.f;
        unsigned long long* o8 = (unsigned long long*)(hb + (size_t)r * DM) + lane;
#pragma unroll
        for (int j = 0; j < 4; ++j) { v[j] = ((const f32x4*)src)[lane + 64 * j];
            const unsigned lo = pk2(v[j][0], v[j][1]), hi = pk2(v[j][2], v[j][3]); o8[64 * j] = (unsigned long long)lo | ((unsigned long long)hi << 32);
            const float a0 = bflo(lo), a1 = bfhi(lo), a2 = bflo(hi), a3 = bfhi(hi); s += (a0 * a0 + a1 * a1) + (a2 * a2 + a3 * a3); }
        s = wave_sum(s);
        if (lane < 16) ssq[(size_t)r * 16 + lane] = lane == 0 ? s : 0.f;
    }
}

constexpr int NSTRIP = (T_ROWS + 63) / 64;
__device__ __forceinline__ void conv_strip(const PT a, unsigned char* ws, int l, int tid, int strip) {
    bf16* cb = (bf16*)(ws + WS_CB); const bf16* z = (const bf16*)(ws + WS_Z);
    const float* cw = a.in(9) + (size_t)l * 3 * DM; const float* cbias = a.in(10) + (size_t)l * DM;
    const int chunk = tid & 127, sub = tid >> 7, c0 = chunk * 8;
    f32x4 w0[2], w1[2], w2[2], bb[2];
#pragma unroll
    for (int h = 0; h < 2; ++h) { w0[h] = *(const f32x4*)(cw + c0 + 4 * h); w1[h] = *(const f32x4*)(cw + DM + c0 + 4 * h); w2[h] = *(const f32x4*)(cw + 2 * DM + c0 + 4 * h); bb[h] = *(const f32x4*)(cbias + c0 + 4 * h); }
    const int r0 = strip * 64 + sub * 16;
#pragma unroll 4
    for (int i = 0; i < 16; ++i) {
        const int r = r0 + i; if (r >= T_ROWS) break;
        int pos, L; rowinfo(r, pos, L);
        const u32x4 zero = (u32x4){0u, 0u, 0u, 0u};
        const u32x4 zc = *(const u32x4*)(z + (size_t)r * DM + c0);
        const u32x4 zp = pos > 0 ? *(const u32x4*)(z + (size_t)(r - 1) * DM + c0) : zero;
        const u32x4 zn = pos < L - 1 ? *(const u32x4*)(z + (size_t)(r + 1) * DM + c0) : zero;
        u32x4* cp = (u32x4*)(cb + (size_t)r * DM + c0); const u32x4 cv = *cp;
        f32x4 p0, p1, c0v, c1v, n0, n1, b0, b1; unpack8(zp, p0, p1); unpack8(zc, c0v, c1v); unpack8(zn, n0, n1); unpack8(cv, b0, b1);
        const f32x4 o0 = b0 * (w0[0] * p0 + w1[0] * c0v + w2[0] * n0 + bb[0]), o1 = b1 * (w0[1] * p1 + w1[1] * c1v + w2[1] * n1 + bb[1]);
        *cp = pack8(o0, o1);
    }
}

__device__ __forceinline__ void attention_phase(const PT a, unsigned char* ws, int l, unsigned char* lds_generic, int tid, bool dry = false) {
    using abf = attn_body::bf16;
    const abf* Q = (const abf*)(ws + WS_Q); const abf* K = (const abf*)(ws + WS_K); const abf* V = (const abf*)(ws + WS_V); abf* O = dry ? (abf*)(ws + WS_END + MiB) : (abf*)(ws + WS_Q);
    unsigned* ctr = (unsigned*)(ws + WS_CTL) + l + (dry ? 8 : 0);
    volatile unsigned* slot = (volatile unsigned*)(lds_generic + MISC_OFF);
    unsigned pre = 0u; if (tid == 0) pre = atomicAdd(ctr, 1u);
    for (;;) {
        if (tid == 0) { *slot = pre; pre = atomicAdd(ctr, 1u); }
        __syncthreads();
        const int idx = (int)__builtin_amdgcn_readfirstlane(*slot);
        if (idx >= ATT_UNITS + NSTRIP) break;
        int u;
        if (idx < 5 * NSTRIP) { if (idx % 5 == 0) { int tidc = tid; asm volatile("" : "+v"(tidc)); conv_strip(a, ws, l, tidc, idx / 5); __syncthreads(); continue; } u = idx - (idx + 4) / 5; }
        else u = idx - NSTRIP;
        int tidu = tid; asm volatile("" : "+v"(tidu));
        if (u < ATT_UNITS_P) { const int s = u / 260, rem = u - s * 260, kvh = rem / 65, qblk = rem - kvh * 65;
            attn_body::attn_unit<8, LP, 66>((long)s * LP, kvh, qblk, Q, K, V, O, (char*)lds_generic, tidu); }
        else { const int u2 = u - ATT_UNITS_P, s = u2 / 132, rem = u2 - s * 132, kvh = rem / 33, qblk = rem - kvh * 33;
            attn_body::attn_unit<8, LS, 34>((long)ROWS_P + (long)s * LS, kvh, qblk, Q, K, V, O, (char*)lds_generic, tidu); }
    }
}

__device__ __forceinline__ void final_phase(const PT a, unsigned char* ws, int wave, int lane, int bid, int G) {
    const int gw = bid * NWAVES + wave, NGW = G * NWAVES;
    const float* ssq = (const float*)(ws + WS_SSQ); const bf16* hb = (const bf16*)(ws + WS_HB); float* out = a.out();
    f32x4 g[4];
#pragma unroll
    for (int j = 0; j < 4; ++j) g[j] = ((const f32x4*)a.in(20))[lane + 64 * j];
    for (int r = gw; r < T_ROWS; r += NGW) {
        int pos, L; rowinfo(r, pos, L); if (pos < 16) continue;
        float* p = r < ROWS_P ? out + ((size_t)(r / LP) * 4096 + pos - 16) * DM : out + (size_t)NSEQ_P * 4096 * DM + ((size_t)((r - ROWS_P) / LS) * 2048 + pos - 16) * DM;
        const float rs = rstd_of(ssq, r);
        const unsigned long long* i8 = (const unsigned long long*)(hb + (size_t)r * DM) + lane;
#pragma unroll
        for (int j = 0; j < 4; ++j) { const unsigned long long w = i8[64 * j]; const unsigned lo = (unsigned)w, hi = (unsigned)(w >> 32);
            const f32x4 v = (f32x4){bflo(lo), bfhi(lo), bflo(hi), bfhi(hi)}; ((f32x4*)p)[lane + 64 * j] = v * rs * g[j]; }
    }
}

constexpr int NSTEPS = 2 + 8 * NLAYER;

template <int STEP>
__device__ __forceinline__ void run_step(const PT pt, unsigned char* lds, cg::grid_group& grid, XcdBarrier& bar, const int ph_lo, const int ph_hi) {
#ifdef MAX_STEP
    if (STEP >= MAX_STEP && STEP != NSTEPS - 1) return;
#endif
    if (STEP < ph_lo || STEP >= ph_hi) return;
    if (STEP > ph_lo) {
        if (STEP == ph_lo + 1) {
            asm volatile("s_waitcnt vmcnt(0)" ::: "memory"); grid.sync();
            bar = xcd_barrier_post((unsigned*)(pt.ws() + WS_CTL) + CW_BAR, (volatile LAS unsigned*)((LAS unsigned char*)lds + MISC_OFF + 32));
        } else xcd_barrier(bar);
#ifdef DUP_SYNC
        xcd_barrier(bar); xcd_barrier(bar);
#endif
    }
    LAS unsigned char* l3 = (LAS unsigned char*)lds;
    int tid = threadIdx.x; asm volatile("" : "+v"(tid));
    int bid = blockIdx.x; asm volatile("" : "+s"(bid));
    int G = gridDim.x; asm volatile("" : "+s"(G));
    unsigned char* ws = pt.ws();
    const int lane = tid & 63, wave = __builtin_amdgcn_readfirstlane(tid >> 6);
    const int gw = bid * NWAVES + wave, NGW = G * NWAVES;
    float* ssq = (float*)(ws + WS_SSQ);
    bf16_t* hb = (bf16_t*)(ws + WS_HB);
    if constexpr (STEP == 0) { prologue(pt, ws, tid, wave, lane, bid, G); convert_static(pt, ws, 0, l3, gw, NGW, wave, lane); __syncthreads(); }
    else if constexpr (STEP == NSTEPS - 1) { final_phase(pt, ws, wave, lane, bid, G); }
    else {
        constexpr int l = (STEP - 1) / 8, ph = (STEP - 1) % 8 + 1;
        unsigned char* wl = ws + WS_W + (size_t)(l & 1) * WBUF;
        if constexpr (ph == 0) {
        } else if constexpr (ph == 1 || ph == 7) {
            constexpr int f = ph == 7;
            PlainOrder S; S.init(TPAD, 2 * FF, G, bid); S.A = (const char*)hb; S.Bt = (const char*)(wl + (f ? W_GU2 : W_GU1)); S.tstep = (size_t)256 * 1024 * 2;
            pg8::Gemm g{nullptr, nullptr, TPAD, 2 * FF, 1024};
            EpiSwiGLU E{(bf16_t*)(ws + WS_HID), ssq};
#ifndef NO_GU
            pg8::gemm_phase<EpiSwiGLU, PlainOrder, true, true>(l3, g, S, E, tid);
#ifdef DUP_GU
            __syncthreads();
            pg8::gemm_phase<EpiSwiGLU, PlainOrder, true, true>(l3, g, S, E, tid);
#endif
#endif
        } else if constexpr (ph == 2 || ph == 6 || ph == 8) {
            constexpr int f = ph == 8; constexpr int K = ph == 6 ? 1024 : FF;
            PlainOrder S; S.init(TPAD, DM, G, bid);
            S.A = ph == 6 ? (const char*)(ws + WS_Z) : (const char*)(ws + WS_HID);
            S.Bt = (const char*)(wl + (ph == 6 ? W_M : (f ? W_D2 : W_D1))); S.tstep = (size_t)256 * K * 2;
            pg8::Gemm g{nullptr, nullptr, TPAD, DM, K};
#ifdef DUP_DOWN
            EpiResid E{hb, ssq, ph == 6 ? 0.5f : 0.25f};
            pg8::gemm_phase<EpiResid, PlainOrder, true, true>(l3, g, S, E, tid); __syncthreads();
#else
            EpiResid E{hb, ssq, ph == 6 ? 1.0f : 0.5f};
#endif
#ifndef NO_RES
            pg8::gemm_phase<EpiResid, PlainOrder, true, true>(l3, g, S, E, tid);
#endif
            if constexpr (l + 1 < NLAYER && ph != 6) {
                constexpr int part = ph == 2 ? 1 : 2; constexpr int lo = part == 1 ? CVT_ITEMS / 2 : 3 * (CVT_ITEMS / 4), hi = part == 1 ? 3 * (CVT_ITEMS / 4) : CVT_ITEMS;
                convert_dynamic(pt, ws, l + 1, l3, (unsigned*)(ws + WS_CTL) + 16 + 4 * l + part, lo, hi, wave, lane);
                __syncthreads();
            }
        } else if constexpr (ph == 3) {
            PlainOrder S; S.init(TPAD, NWIN, G, bid); S.A = (const char*)hb; S.Bt = (const char*)(wl + W_IN); S.tstep = (size_t)256 * 1024 * 2;
            pg8::Gemm g{nullptr, nullptr, TPAD, NWIN, 1024};
            EpiWin E{(bf16_t*)(ws + WS_Q), (bf16_t*)(ws + WS_K), (bf16_t*)(ws + WS_V), (bf16_t*)(ws + WS_CB), (bf16_t*)(ws + WS_Z), ssq,
                     (const float*)(ws + WS_ROPE), pt.in(11) + l * 64, pt.in(12) + l * 64};
#ifndef NO_WIN
            pg8::gemm_phase<EpiWin, PlainOrder, true, true>(l3, g, S, E, tid);
#ifdef DUP_WIN
            __syncthreads();
            pg8::gemm_phase<EpiWin, PlainOrder, true, true>(l3, g, S, E, tid);
#endif
#endif
        } else if constexpr (ph == 4) {
#ifdef DUP_ATT
            attention_phase(pt, ws, l, lds, tid, true); __syncthreads();
#endif
#ifndef NO_ATT
            attention_phase(pt, ws, l, lds, tid);
#endif
        } else {
            ChainOrder S; S.base.init(TPAD, DM, G, bid); S.tstep = (size_t)256 * 1024 * 2;
            S.A[0] = (const char*)hb; S.A[1] = (const char*)(ws + WS_CB); S.A[2] = (const char*)hb; S.A[3] = (const char*)(ws + WS_Q);
            S.B[0] = (const char*)(wl + W_GC); S.B[1] = (const char*)(wl + W_OC); S.B[2] = (const char*)(wl + W_GA); S.B[3] = (const char*)(wl + W_OA);
            pg8::Gemm g{nullptr, nullptr, TPAD, DM, 1024};
            EpiMerge E{(bf16_t*)(ws + WS_Z), (u32x4*)(ws + WS_SCR + (size_t)bid * 131072), ssq, tid};
#ifndef NO_MERGE
            pg8::gemm_phase<EpiMerge, ChainOrder, true, true>(l3, g, S, E, tid);
#ifdef DUP_MERGE
            __syncthreads();
            pg8::gemm_phase<EpiMerge, ChainOrder, true, true>(l3, g, S, E, tid);
#endif
#endif
            if constexpr (l + 1 < NLAYER) {
                convert_dynamic(pt, ws, l + 1, l3, (unsigned*)(ws + WS_CTL) + 16 + 4 * l + 0, 0, CVT_ITEMS / 2, wave, lane);
                __syncthreads();
            }
        }
    }
}
template <int STEP>
__device__ __forceinline__ void run_from(const PT pt, unsigned char* lds, cg::grid_group& grid, XcdBarrier& bar, const int ph_lo, const int ph_hi) {
    run_step<STEP>(pt, lds, grid, bar, ph_lo, ph_hi);
    if constexpr (STEP + 1 < NSTEPS) run_from<STEP + 1>(pt, lds, grid, bar, ph_lo, ph_hi);
}

__global__ void __launch_bounds__(NWAVES * 64, 2) mega_fwd(Args args) {
    extern __shared__ __attribute__((aligned(16))) unsigned char lds[];
    cg::grid_group grid = cg::this_grid();
    PT pt; pt.t = (volatile LAS unsigned long long*)((LAS unsigned char*)lds + PTAB_OFF);
    if (threadIdx.x == 0) {
#pragma unroll
        for (int i = 0; i < 21; ++i) pt.t[i] = (unsigned long long)args.in[i];
        pt.t[21] = (unsigned long long)args.out; pt.t[22] = (unsigned long long)args.ws;
    }
    if (threadIdx.x < 8) ((volatile LAS unsigned*)((LAS unsigned char*)lds + MISC_OFF + 32))[threadIdx.x] = 0u;
    const int ph_lo = args.ph_lo, ph_hi = args.ph_hi;
    if (blockIdx.x == 0) { unsigned* bw = (unsigned*)(args.ws + WS_CTL) + CW_BAR; for (int i = threadIdx.x; i < XCD_BAR_WORDS; i += NWAVES * 64) bw[i] = 0u; }
    __syncthreads();
    XcdBarrier bar; bar.bar = nullptr; bar.x = 0; bar.st = nullptr;
    run_from<0>(pt, lds, grid, bar, ph_lo, ph_hi);
}

#ifndef LAUNCH_PER_STEP
#define LAUNCH_PER_STEP 0
#endif
extern "C" void kernel_launch(void* const* d_in, const int* in_sizes, int n_in, void* d_out, int out_size, void* d_ws, size_t ws_size, hipStream_t stream) {
    static int grid = 0;
    if (grid == 0) {
        if (n_in != 21 || ws_size < WS_END) { fprintf(stderr, "kernel_launch: need 21 inputs and >= %zu bytes of workspace; got %d, %zu\n", (size_t)WS_END, n_in, ws_size); grid = -1; return; }
        int dev = 0, cus = 0, per_cu = 0;
        hipGetDevice(&dev); hipDeviceGetAttribute(&cus, hipDeviceAttributeMultiprocessorCount, dev);
        if (hipFuncSetAttribute((const void*)mega_fwd, hipFuncAttributeMaxDynamicSharedMemorySize, LDS_BYTES) != hipSuccess) { fprintf(stderr, "kernel_launch: hipFuncSetAttribute failed\n"); grid = -1; return; }
        if (hipOccupancyMaxActiveBlocksPerMultiprocessor(&per_cu, (const void*)mega_fwd, NWAVES * 64, LDS_BYTES) != hipSuccess || per_cu < 1) per_cu = 1;
        (void)hipGetLastError();
        grid = cus * per_cu;
    }
    if (grid < 0) return;
    Args a{};
    for (int i = 0; i < 21; ++i) a.in[i] = (const float*)d_in[i];
    a.out = (float*)d_out; a.ws = (unsigned char*)d_ws;
#if LAUNCH_PER_STEP
    for (int s = 0; s < NSTEPS; ++s) { a.ph_lo = s; a.ph_hi = s + 1; void* kargs[] = {&a}; hipLaunchCooperativeKernel((void*)mega_fwd, dim3(grid), dim3(NWAVES * 64), kargs, LDS_BYTES, stream); }
#else
    a.ph_lo = 0; a.ph_hi = NSTEPS; void* kargs[] = {&a};
    hipError_t e = hipLaunchCooperativeKernel((void*)mega_fwd, dim3(grid), dim3(NWAVES * 64), kargs, LDS_BYTES, stream);
    if (e != hipSuccess) fprintf(stderr, "cooperative launch failed: %s (grid %d)\n", hipGetErrorString(e), grid);
#endif
}
```

```cpp
#include <hip/hip_runtime.h>
#include <hip/hip_cooperative_groups.h>
#include <hip/hip_bf16.h>
#include <cstdio>
#include <cstdint>
#include <cmath>
namespace cg = cooperative_groups;
namespace pg8 {
#define PG8_LAS __attribute__((address_space(3)))
typedef unsigned short bf16_t;
typedef short bf16x8 __attribute__((ext_vector_type(8)));
typedef float f32x4 __attribute__((ext_vector_type(4)));
typedef unsigned u32x4 __attribute__((ext_vector_type(4)));
constexpr int BM = 256, BK = 64, HALF = 128, HTB = HALF * BK * 2  , STAGE_BYTES = 8 * HTB, NXCD = 8, WGM = 8;

__host__ __device__ __forceinline__ int lds_byte(int r, int c) { const int st = (r >> 4) * 2 + (c >> 5), rr = r & 15, cc = c & 31, ob = rr * 64 + cc * 2; return st * 1024 + (ob ^ (((ob >> 9) & 1) << 5)); }
__host__ __device__ __forceinline__ void stage_rc(int b, int& R, int& C) { const int st = b / 1024, sb = b % 1024, swz = sb ^ (((sb >> 9) & 1) << 5); R = (st >> 1) * 16 + swz / 64; C = (st & 1) * 32 + (swz % 64) / 2; }
__host__ __device__ __forceinline__ int perm32(int rho) { const int n = rho >> 4, i = rho & 15; return 8 * (i >> 2) + 4 * n + (i & 3); }

struct Unit { int pm, pn, sub; };
struct Gemm { const bf16_t* A; const bf16_t* Bt; int M, N, K; };

struct StaticOrder {
    int nM, nN, nwg, G, c;
    __host__ __device__ void init(int M, int N, int G_, int c_) { nM = M / BM; nN = N / BM; nwg = nM * nN; G = G_; c = c_; }
    __host__ __device__ bool next(int i, Unit& u) const {
        const long L = (long)i * G + c; if (L >= nwg) return false;
        int wgid = (int)L; { const int q = nwg / NXCD, r = nwg % NXCD, xcd = wgid % NXCD, off = wgid / NXCD; wgid = (xcd < r ? xcd * (q + 1) : r * (q + 1) + (xcd - r) * q) + off; }
        const int nig = WGM * nN, gid = wgid / nig, fm = gid * WGM, gsz = (nM - fm) < WGM ? (nM - fm) : WGM;
        u.pm = fm + ((wgid % nig) % gsz); u.pn = (wgid % nig) / gsz; u.sub = 0; return true;
    }
    __device__ __forceinline__ void a_ready(const Unit&) const {}
    __device__ __forceinline__ void done(const Unit&) const {}
};

__device__ __forceinline__ unsigned cvt_pk_bf16(float lo, float hi) { unsigned r; asm volatile("v_cvt_pk_bf16_f32 %0, %1, %2" : "=v"(r) : "v"(lo), "v"(hi)); return r; }
typedef float f32x2 __attribute__((ext_vector_type(2)));
template <class Epi, class Sched, bool ALIGN_EPI = false, bool SP2 = false>
__device__ __forceinline__ void gemm_phase(PG8_LAS unsigned char* lds, const Gemm g, const Sched& S, const Epi& E, const int tid) {
    const int wid = __builtin_amdgcn_readfirstlane(tid >> 6), lane = tid & 63, wr = wid >> 2, wc = wid & 3, fr = lane & 15, fq = lane >> 4;
    const int K = g.K, nt = K / BK;
    unsigned voffA[2], voffB[2];
#pragma unroll
    for (int i = 0; i < 2; ++i) { int R, C; stage_rc(tid * 16 + i * 8192, R, C); const int Rb = Epi::PERM ? ((R & ~31) + perm32(R & 31)) : R;
        voffA[i] = (unsigned)(R * K + C) * 2u; voffB[i] = (unsigned)(Rb * K + C) * 2u; }
    const size_t kstep = (size_t)(BK * 2);
    const size_t hstep = (size_t)HALF * K * 2;
        const unsigned ldsw = (unsigned)wid * 1024u;
    const int aoff = lds_byte(wr * 64 + fr, fq * 8), boff = lds_byte(wc * 32 + fr, fq * 8);
#define PG8_SA(b, h) (((b) * 2 + (h)) * HTB)
#define PG8_SB(b, h) ((4 + (b) * 2 + (h)) * HTB)
#define PG8_STAGE(bufoff, gbase, voff) do { _Pragma("unroll") for (int _i = 0; _i < 2; ++_i) \
        __builtin_amdgcn_global_load_lds((const unsigned*)((const char*)(gbase) + (voff)[_i]), (PG8_LAS unsigned*)(lds + (bufoff) + ldsw + _i * 8192), 16, 0, 0); } while (0)
#define PG8_LDA(dst, b, h) do { _Pragma("unroll") for (int m = 0; m < 4; ++m) _Pragma("unroll") for (int k = 0; k < 2; ++k) dst[m][k] = *(const PG8_LAS bf16x8*)(lds + PG8_SA(b, h) + aoff + m * 2048 + k * 1024); } while (0)
#define PG8_LDB(dst, b, h) do { _Pragma("unroll") for (int n = 0; n < 2; ++n) _Pragma("unroll") for (int k = 0; k < 2; ++k) dst[n][k] = *(const PG8_LAS bf16x8*)(lds + PG8_SB(b, h) + boff + n * 2048 + k * 1024); } while (0)
#define PG8_MMA(ai, bj, At, Bt) do { __builtin_amdgcn_s_setprio(1); _Pragma("unroll") for (int m = 0; m < 4; ++m) _Pragma("unroll") for (int n = 0; n < 2; ++n) _Pragma("unroll") for (int k = 0; k < 2; ++k) \
        acc[ai][bj][m][n] = __builtin_amdgcn_mfma_f32_16x16x32_bf16(Bt[n][k], At[m][k], acc[ai][bj][m][n], 0, 0, 0); __builtin_amdgcn_s_setprio(0); } while (0)
#define PG8_WAIT_V(n) asm volatile("s_waitcnt vmcnt(" #n ")" ::: "memory")
#define PG8_WAIT_L(n) asm volatile("s_waitcnt lgkmcnt(" #n ")" ::: "memory")
#define PG8_BAR __builtin_amdgcn_s_barrier()
#define PG8_SCHED __builtin_amdgcn_sched_barrier(0)
    Unit cur, nxt; int ui = 0;
    if (!S.next(0, cur)) return;
    f32x4 acc[2][2][4][2];
#pragma unroll
    for (int a = 0; a < 2; ++a)
#pragma unroll
        for (int b = 0; b < 2; ++b)
#pragma unroll
            for (int m = 0; m < 4; ++m)
#pragma unroll
                for (int n = 0; n < 2; ++n) acc[a][b][m][n] = (f32x4){0.f, 0.f, 0.f, 0.f};
    bf16x8 At[4][2], B0[2][2], B1[2][2];
    const char* cA = S.aptr(cur); const char* cB = S.bptr(cur);
    S.a_ready(cur);
    if constexpr (SP2) {
        PG8_STAGE(PG8_SB(0, 0), cB, voffB); PG8_STAGE(PG8_SB(0, 1), cB + hstep, voffB); PG8_STAGE(PG8_SA(0, 0), cA, voffA); PG8_STAGE(PG8_SA(0, 1), cA + hstep, voffA);
        if (wr == 1) PG8_BAR;
        PG8_WAIT_V(2); PG8_BAR;
        PG8_STAGE(PG8_SB(1, 0), cB + kstep, voffB); PG8_STAGE(PG8_SA(1, 0), cA + kstep, voffA); PG8_STAGE(PG8_SB(1, 1), cB + hstep + kstep, voffB);
        PG8_WAIT_V(6); PG8_BAR;
    } else {
        PG8_STAGE(PG8_SB(0, 0), cB, voffB); PG8_STAGE(PG8_SA(0, 0), cA, voffA); PG8_STAGE(PG8_SB(0, 1), cB + hstep, voffB); PG8_STAGE(PG8_SA(0, 1), cA + hstep, voffA);
        if (wr == 1) PG8_BAR;
        PG8_WAIT_V(4); PG8_BAR;
        PG8_STAGE(PG8_SB(1, 0), cB + kstep, voffB); PG8_STAGE(PG8_SA(1, 0), cA + kstep, voffA); PG8_STAGE(PG8_SB(1, 1), cB + hstep + kstep, voffB);
        PG8_WAIT_V(6); PG8_BAR;
    }
    for (;;) {
        const bool has_next = S.next(ui + 1, nxt);
        const char* nA = has_next ? S.aptr(nxt) : cA; const char* nB = has_next ? S.bptr(nxt) : cB;
        for (int t = 0; t < nt; t += 2) {
            const bool last = (t == nt - 2);
            const char* a1 = cA + (size_t)(t + 1) * kstep;
            const char* a2 = last ? nA : cA + (size_t)(t + 2) * kstep; const char* b2 = last ? nB : cB + (size_t)(t + 2) * kstep;
            const char* a3 = a2 + kstep; const char* b3 = b2 + kstep;
            if (last && has_next) S.a_ready(nxt);
            if constexpr (SP2) {
            PG8_LDB(B0, 0, 0); PG8_LDB(B1, 0, 1); PG8_SCHED; PG8_LDA(At, 0, 0); PG8_STAGE(PG8_SA(1, 1), a1 + hstep, voffA);
            PG8_WAIT_V(8); PG8_WAIT_L(0); PG8_BAR; PG8_MMA(0, 0, At, B0); PG8_MMA(0, 1, At, B1); PG8_BAR; PG8_SCHED;
            PG8_LDA(At, 0, 1); PG8_STAGE(PG8_SB(0, 0), b2, voffB); PG8_STAGE(PG8_SB(0, 1), b2 + hstep, voffB); PG8_STAGE(PG8_SA(0, 0), a2, voffA);
            PG8_WAIT_V(8); PG8_WAIT_L(0); PG8_BAR; PG8_MMA(1, 0, At, B0); PG8_MMA(1, 1, At, B1); PG8_BAR; PG8_SCHED;
            PG8_LDB(B0, 1, 0); PG8_LDB(B1, 1, 1); PG8_SCHED; PG8_LDA(At, 1, 0); PG8_STAGE(PG8_SA(0, 1), a2 + hstep, voffA);
            PG8_WAIT_V(8); PG8_WAIT_L(0); PG8_BAR; PG8_MMA(0, 0, At, B0); PG8_MMA(0, 1, At, B1); PG8_BAR; PG8_SCHED;
            PG8_LDA(At, 1, 1); PG8_STAGE(PG8_SB(1, 0), b3, voffB); PG8_STAGE(PG8_SB(1, 1), b3 + hstep, voffB); PG8_STAGE(PG8_SA(1, 0), a3, voffA);
            PG8_WAIT_V(8); PG8_WAIT_L(0); PG8_BAR; PG8_MMA(1, 0, At, B0); PG8_MMA(1, 1, At, B1); PG8_BAR; PG8_SCHED;
            } else {
            PG8_LDB(B0, 0, 0); PG8_SCHED; PG8_LDA(At, 0, 0); PG8_STAGE(PG8_SA(1, 1), a1 + hstep, voffA);
            PG8_WAIT_L(8); PG8_BAR; PG8_WAIT_L(0); PG8_MMA(0, 0, At, B0); PG8_BAR; PG8_SCHED;
            PG8_LDB(B1, 0, 1); PG8_STAGE(PG8_SB(0, 0), b2, voffB);
            PG8_BAR; PG8_WAIT_L(0); PG8_MMA(0, 1, At, B1); PG8_BAR;
            PG8_LDA(At, 0, 1); PG8_STAGE(PG8_SA(0, 0), a2, voffA);
            PG8_BAR; PG8_WAIT_L(0); PG8_MMA(1, 0, At, B0); PG8_BAR; PG8_SCHED;
            PG8_STAGE(PG8_SB(0, 1), b2 + hstep, voffB);
            PG8_WAIT_V(6); PG8_BAR; PG8_MMA(1, 1, At, B1); PG8_BAR;
            PG8_LDB(B0, 1, 0); PG8_SCHED; PG8_LDA(At, 1, 0); PG8_STAGE(PG8_SA(0, 1), a2 + hstep, voffA);
            PG8_WAIT_L(8); PG8_BAR; PG8_WAIT_L(0); PG8_MMA(0, 0, At, B0); PG8_BAR; PG8_SCHED;
            PG8_LDB(B1, 1, 1); PG8_STAGE(PG8_SB(1, 0), b3, voffB);
            PG8_BAR; PG8_WAIT_L(0); PG8_MMA(0, 1, At, B1); PG8_BAR;
            PG8_LDA(At, 1, 1); PG8_STAGE(PG8_SA(1, 0), a3, voffA);
            PG8_BAR; PG8_WAIT_L(0); PG8_MMA(1, 0, At, B0); PG8_BAR; PG8_SCHED;
            PG8_STAGE(PG8_SB(1, 1), b3 + hstep, voffB);
            PG8_WAIT_V(6); PG8_BAR; PG8_MMA(1, 1, At, B1); PG8_BAR;
            }
        }
        if constexpr (ALIGN_EPI) { if (wr == 0) PG8_BAR; }
        if constexpr (!Epi::AFTER_DRAIN) { E(acc, cur, wr, wc, fr, fq); S.done(cur); }
        if (!has_next) break;
#pragma unroll
        for (int a = 0; a < 2; ++a)
#pragma unroll
            for (int b = 0; b < 2; ++b)
#pragma unroll
                for (int m = 0; m < 4; ++m)
#pragma unroll
                    for (int n = 0; n < 2; ++n) acc[a][b][m][n] = (f32x4){0.f, 0.f, 0.f, 0.f};
        cur = nxt; cA = nA; cB = nB; ++ui;
        if constexpr (ALIGN_EPI) { if (wr == 1) PG8_BAR; }
    }
    PG8_WAIT_V(0);
    if constexpr (!ALIGN_EPI) { if (wr == 0) PG8_BAR; }
    PG8_BAR;
    if constexpr (Epi::AFTER_DRAIN) { E.fused(acc, cur, wr, wc, fr, fq, lds, wid, lane); S.done(cur); }
#undef PG8_SA
#undef PG8_SB
#undef PG8_STAGE
#undef PG8_LDA
#undef PG8_LDB
#undef PG8_MMA
#undef PG8_WAIT_V
#undef PG8_WAIT_L
#undef PG8_BAR
#undef PG8_SCHED
}
}
namespace attn_body {
using bf16=__hip_bfloat16;
using bf16x8=__attribute__((ext_vector_type(8)))short;
using s16x4=__attribute__((ext_vector_type(4)))short;
using f32x16=__attribute__((ext_vector_type(16)))float;
using u32x4=__attribute__((ext_vector_type(4)))unsigned;
constexpr int D=64,QP=1024,KP=256;
constexpr int NW=8,QBLK=32,KVBLK=64;
__device__ __forceinline__ int crow(int r,int hi){return (r&3)+8*(r>>2)+4*hi;}
#define SBAR() __builtin_amdgcn_sched_barrier(0)
__device__ __forceinline__ void kmask(f32x16&p0,f32x16&p1,int rem,int hi){
  const float NEG=-INFINITY;
  #pragma unroll
  for(int r=0;r<16;++r){int kv=4*hi+(r&3)+8*(r>>2); if(kv>=rem)p0[r]=NEG; if(kv+32>=rem)p1[r]=NEG;}
}

constexpr int NSLOT=3, SLOTB=8192;
constexpr int LDS_K=0, LDS_V=NSLOT*SLOTB, LDS_WS=2*NSLOT*SLOTB, LDS_OST=LDS_WS+NW*64*4, LDS_BYTES=LDS_OST+NW*4096;
constexpr float C2=0.125f*1.4426950408889634f;
__device__ __forceinline__ void glds16(const void*gsrc,unsigned lds_dst){unsigned keep;
  asm volatile("s_mov_b32 %0, m0\n\ts_mov_b32 m0, %2\n\ts_nop 0\n\tglobal_load_lds_dwordx4 %1, off\n\ts_mov_b32 m0, %0":"=&s"(keep):"v"(gsrc),"s"(lds_dst):"memory");}
__device__ __forceinline__ float max3f(float a,float b,float c){float r;asm("v_max3_f32 %0, %1, %2, %3":"=v"(r):"v"(a),"v"(b),"v"(c));return r;}
__device__ __forceinline__ float max2f(float a,float b){float r;asm("v_max_f32_e32 %0, %1, %2":"=v"(r):"v"(a),"v"(b));return r;}
__device__ __forceinline__ float fadd_s(float a,float b){float r;asm("v_add_f32_e32 %0, %1, %2":"=v"(r):"v"(a),"v"(b));return r;}
__device__ __forceinline__ float fsub_s(float a,float b){float r;asm("v_sub_f32_e32 %0, %1, %2":"=v"(r):"v"(a),"v"(b));return r;}
typedef float f32x2_t __attribute__((ext_vector_type(2))); typedef __bf16 bf16x2_t __attribute__((ext_vector_type(2)));
__device__ __forceinline__ unsigned cvtpk_s(float lo,float hi){f32x2_t v={lo,hi};bf16x2_t b=__builtin_convertvector(v,bf16x2_t);return __builtin_bit_cast(unsigned,b);}
#define WAIT_BAR(N) asm volatile("s_waitcnt vmcnt(" #N ") lgkmcnt(0)\n\ts_barrier":::"memory")

__device__ __forceinline__ void qkt(f32x16&p0,f32x16&p1,const char*Kslot,const bf16x8*qr,const f32x16&negm,int r32,int hi){
  const char*kb=Kslot+hi*1024+r32*16;
  #pragma unroll
  for(int d0=0;d0<4;++d0){
    const bf16x8 b0=*reinterpret_cast<const bf16x8*>(kb+d0*2048);
    const bf16x8 b1=*reinterpret_cast<const bf16x8*>(kb+d0*2048+512);
    if(d0==0){p0=__builtin_amdgcn_mfma_f32_32x32x16_bf16(b0,qr[0],negm,0,0,0);p1=__builtin_amdgcn_mfma_f32_32x32x16_bf16(b1,qr[0],negm,0,0,0);}
    else{p0=__builtin_amdgcn_mfma_f32_32x32x16_bf16(b0,qr[d0],p0,0,0,0);p1=__builtin_amdgcn_mfma_f32_32x32x16_bf16(b1,qr[d0],p1,0,0,0);}}
}
typedef __attribute__((address_space(3))) const char* lds_cptr;
typedef short v4i16_t __attribute__((ext_vector_type(4)));
__device__ __forceinline__ void kload8(bf16x8*kf,lds_cptr kp){
  kf[0]=*(const __attribute__((address_space(3))) bf16x8*)(kp);      kf[1]=*(const __attribute__((address_space(3))) bf16x8*)(kp+512);
  kf[2]=*(const __attribute__((address_space(3))) bf16x8*)(kp+2048); kf[3]=*(const __attribute__((address_space(3))) bf16x8*)(kp+2560);
  kf[4]=*(const __attribute__((address_space(3))) bf16x8*)(kp+4096); kf[5]=*(const __attribute__((address_space(3))) bf16x8*)(kp+4608);
  kf[6]=*(const __attribute__((address_space(3))) bf16x8*)(kp+6144); kf[7]=*(const __attribute__((address_space(3))) bf16x8*)(kp+6656);
}
__device__ __forceinline__ void kload2(bf16x8*kf,lds_cptr kp,int j){ kf[2*j]=*(const __attribute__((address_space(3))) bf16x8*)(kp+j*2048); kf[2*j+1]=*(const __attribute__((address_space(3))) bf16x8*)(kp+j*2048+512); }
__device__ __forceinline__ s16x4 vtr(lds_cptr p){ return __builtin_bit_cast(s16x4,__builtin_amdgcn_ds_read_tr16_b64_v4i16((__attribute__((address_space(3))) v4i16_t*)p)); }
__device__ __forceinline__ float rowmax(const f32x16&p0,const f32x16&p1){
  float a=max3f(p0[0],p0[1],p1[0]),b=max3f(p0[2],p0[3],p1[1]);a=max3f(a,p1[2],p1[3]);
  #pragma unroll
  for(int r=4;r<16;r+=4){a=max3f(a,p0[r],p0[r+1]);b=max3f(b,p0[r+2],p0[r+3]);a=max3f(a,p1[r],p1[r+1]);b=max3f(b,p1[r+2],p1[r+3]);}
  const float m=max2f(a,b);
  auto rr=__builtin_amdgcn_permlane32_swap(__float_as_uint(m),__float_as_uint(m),false,false);
  return max2f(__uint_as_float(rr[0]),__uint_as_float(rr[1]));
}
__device__ __forceinline__ void pv(f32x16*o,int vb,bf16x8 pa0,bf16x8 pa1,bf16x8 pa2,bf16x8 pa3){
  #pragma unroll
  for(int d0=0;d0<2;++d0){s16x4 lo[4],hi[4];
    #pragma unroll
    for(int ks=0;ks<4;++ks){
      asm volatile("ds_read_b64_tr_b16 %0,%1 offset:%c2":"=&v"(lo[ks]):"v"(vb),"i"(d0*4096+ks*1024):"memory");
      asm volatile("ds_read_b64_tr_b16 %0,%1 offset:%c2":"=&v"(hi[ks]):"v"(vb),"i"(d0*4096+ks*1024+512):"memory");}
    asm volatile("s_waitcnt lgkmcnt(0)":::"memory");SBAR();
    #define PK(k) (bf16x8){lo[k][0],lo[k][1],lo[k][2],lo[k][3],hi[k][0],hi[k][1],hi[k][2],hi[k][3]}
    o[d0]=__builtin_amdgcn_mfma_f32_32x32x16_bf16(pa0,PK(0),o[d0],0,0,0);
    o[d0]=__builtin_amdgcn_mfma_f32_32x32x16_bf16(pa1,PK(1),o[d0],0,0,0);
    o[d0]=__builtin_amdgcn_mfma_f32_32x32x16_bf16(pa2,PK(2),o[d0],0,0,0);
    o[d0]=__builtin_amdgcn_mfma_f32_32x32x16_bf16(pa3,PK(3),o[d0],0,0,0);
    #undef PK
  }
}

#ifndef ATTN_STORE16
#define ATTN_STORE16(p,v) (*(u32x4*)(p)=(v))
#endif
template<int THRL,int L,int NT> __device__ __forceinline__ void attn_unit(long rowbase,int kvh,int qblk,const bf16*Q,const bf16*__restrict__ K,const bf16*__restrict__ V,bf16*O,char*shm,const int tid){
  const int lane=tid&63,r32=lane&31,hi=lane>>5; const int wid=__builtin_amdgcn_readfirstlane(tid>>6);
  const int q0=qblk*64, qh=wid>>1, rh=wid&1;
  const bf16*Qw=Q+(rowbase+q0+rh*QBLK)*QP+(4*kvh+qh)*D;
  const bf16*Kh=K+rowbase*KP+kvh*D,*Vh=V+rowbase*KP+kvh*D;
  const unsigned lds0=(unsigned)(uintptr_t)shm;
  float*wsf=(float*)(shm+LDS_WS)+wid*64;
  const bf16*ksrc=Kh+(long)lane*KP+wid*8;
  const bf16*vsrc=Vh+(long)(16*(wid&3)+(lane>>2))*KP+(wid>>2)*32+(lane&3)*8;
  const unsigned kdst=lds0+LDS_K+wid*1024, vdst=lds0+LDS_V+wid*1024;
  #define DMA_K(t,slot) glds16(ksrc+(long)(t)*KVBLK*KP,(unsigned)__builtin_amdgcn_readfirstlane(kdst+(slot)))
  #define DMA_V(t,slot) glds16(vsrc+(long)(t)*KVBLK*KP,(unsigned)__builtin_amdgcn_readfirstlane(vdst+(slot)))
  const int vb0=(int)(lds0+LDS_V)+((lane>>4)&1)*32+(lane&3)*8+(4*hi+((lane&15)>>2))*64;
  const char*Kbase=shm+LDS_K; bf16x8 kf[8];
  const lds_cptr shm3=(lds_cptr)shm; const lds_cptr kp0=shm3+LDS_K+hi*1024+r32*16; const lds_cptr vp0=shm3+LDS_V+((lane>>4)&1)*32+(lane&3)*8+(4*hi+((lane&15)>>2))*64;
  DMA_K(0,0);DMA_V(0,0);DMA_K(1,SLOTB);
  bf16x8 qr[4];
  #pragma unroll
  for(int d0=0;d0<4;++d0)qr[d0]=*reinterpret_cast<const bf16x8*>(&Qw[(long)r32*QP+d0*16+hi*8]);
  if(q0+rh*QBLK+r32>=L){
    #pragma unroll
    for(int d0=0;d0<4;++d0)qr[d0]=bf16x8{0,0,0,0,0,0,0,0}; }
  float mhat=0.f,l_reg=0.f;f32x16 o[2];o[0]=f32x16{};o[1]=f32x16{};f32x16 negm=f32x16{};asm volatile("":"+v"(negm));
  #define CMASK(P0,P1,t) do{ if((t)>=NT-2)kmask(P0,P1,L-64*(t),hi);}while(0)
  bool resc=false;
  #define START(P0,P1) do{ const float rm=rowmax(P0,P1); resc=false; \
    { const float dl=rm; mhat=fadd_s(mhat,dl); \
      _Pragma("unroll") for(int r=0;r<16;++r){P0[r]=fsub_s(P0[r],dl);P1[r]=fsub_s(P1[r],dl);} \
      _Pragma("unroll") for(int r=0;r<16;++r)negm[r]=-mhat; asm volatile("":"+v"(negm)); } \
    _Pragma("unroll") for(int r=0;r<16;++r)P0[r]=__builtin_amdgcn_exp2f(P0[r]); }while(0)
  #define RESC() do{ if(resc){ asm volatile("s_waitcnt lgkmcnt(0)":::"memory"); \
      _Pragma("unroll") for(int d_=0;d_<2;++d_) _Pragma("unroll") for(int r=0;r<16;++r)o[d_][r]*=wsf[crow(r,hi)]; } }while(0)
  f32x16 pA0,pA1,pB0,pB1;
  int sl_prev=0,sl_cur=0,sl_next=SLOTB;
  #define ROT() do{sl_prev=sl_cur;sl_cur=sl_next;sl_next=(sl_next==(NSLOT-1)*SLOTB)?0:sl_next+SLOTB;}while(0)
  DMA_K(2,2*SLOTB);
  WAIT_BAR(3);
  qkt(pA0,pA1,Kbase,qr,negm,r32,hi);asm volatile("s_nop 15\n\ts_nop 7":"+v"(pA0),"+v"(pA1));CMASK(pA0,pA1,0);
  START(pA0,pA1);
  _Pragma("unroll") for(int r=0;r<16;++r)pA1[r]=__builtin_amdgcn_exp2f(pA1[r]);
  WAIT_BAR(0);
  DMA_K(3,0);DMA_V(1,SLOTB);
  ROT();
  kload8(kf,kp0+sl_cur);
  WAIT_BAR(2);
  s16x4 vlo[8],vhi[8]; u32x4 pw0,pw1,pw2,pw3;
  #define PKW(P,B) cvtpk_s(P[B],P[B+1])
  #define PAF(k) __builtin_bit_cast(bf16x8,pw##k)
  #define VFR(i) (bf16x8){vlo[i][0],vlo[i][1],vlo[i][2],vlo[i][3],vhi[i][0],vhi[i][1],vhi[i][2],vhi[i][3]}
  #define PIN(x) asm volatile("":"+v"(x))
  #define MX3(a,b,c) __builtin_fmaxf(__builtin_fmaxf((a),(b)),(c))
  #define GAPA(MF,A0,A1,A2,A3,W0,W1,PW) do{ MF; sacc+=A0; sacc+=A1; sacc+=A2; sacc+=A3; PIN(sacc); W0; W1; PIN(PW); SBAR(); }while(0)
  #define EX(v) __builtin_amdgcn_exp2f(v)
  #define GAPB(MF,X,B) do{ MF; X[B]=EX(X[B]); X[B+1]=EX(X[B+1]); X[B+2]=EX(X[B+2]); X[B+3]=EX(X[B+3]); PIN(X); SBAR(); }while(0)
  #define VRD(i) do{ vlo[i]=vtr(vp_+(((i)>>2)*4096+((i)&3)*1024)); vhi[i]=vtr(vp_+(((i)>>2)*4096+((i)&3)*1024+512)); }while(0)
  #define KRD(G,j) do{ if(G){ kload2(kf,kp0+sl_next,j); SBAR(); } }while(0)
  #define STEP(C0,C1,P0,P1,t,GK,GV,GL) do{ SBAR(); \
    const lds_cptr vp_=vp0+sl_prev; \
    VRD(0); SBAR(); float sacc=(P0[0]+P0[1]); \
    GAPA(C0=__builtin_amdgcn_mfma_f32_32x32x16_bf16(kf[0],qr[0],negm,0,0,0), P0[2],P0[3],P0[4],P0[5],     pw0[0]=PKW(P0,0), pw0[1]=PKW(P0,2), pw0); \
    VRD(4); SBAR(); GAPA(C1=__builtin_amdgcn_mfma_f32_32x32x16_bf16(kf[1],qr[0],negm,0,0,0), P0[6],P0[7],P0[8],P0[9],     pw0[2]=PKW(P0,4), pw0[3]=PKW(P0,6), pw0); \
    VRD(1); SBAR(); GAPA(C0=__builtin_amdgcn_mfma_f32_32x32x16_bf16(kf[2],qr[1],C0,0,0,0),   P0[10],P0[11],P0[12],P0[13], pw1[0]=PKW(P0,8), pw1[1]=PKW(P0,10), pw1); \
    VRD(5); SBAR(); GAPA(C1=__builtin_amdgcn_mfma_f32_32x32x16_bf16(kf[3],qr[1],C1,0,0,0),   P0[14],P0[15],P1[0],P1[1],   pw1[2]=PKW(P0,12),pw1[3]=PKW(P0,14), pw1); \
    VRD(2); SBAR(); GAPA(C0=__builtin_amdgcn_mfma_f32_32x32x16_bf16(kf[4],qr[2],C0,0,0,0),   P1[2],P1[3],P1[4],P1[5],     pw2[0]=PKW(P1,0), pw2[1]=PKW(P1,2), pw2); \
    VRD(6); SBAR(); GAPA(C1=__builtin_amdgcn_mfma_f32_32x32x16_bf16(kf[5],qr[2],C1,0,0,0),   P1[6],P1[7],P1[8],P1[9],     pw2[2]=PKW(P1,4), pw2[3]=PKW(P1,6), pw2); \
    VRD(3); SBAR(); GAPA(C0=__builtin_amdgcn_mfma_f32_32x32x16_bf16(kf[6],qr[3],C0,0,0,0),   P1[10],P1[11],P1[12],P1[13], pw3[0]=PKW(P1,8), pw3[1]=PKW(P1,10), pw3); \
    VRD(7); SBAR(); GAPA(C1=__builtin_amdgcn_mfma_f32_32x32x16_bf16(kf[7],qr[3],C1,0,0,0),   P1[14],P1[15],0.f,0.f,       pw3[2]=PKW(P1,12),pw3[3]=PKW(P1,14), pw3); \
    l_reg+=sacc; \
    if(GK){DMA_K((t)+3,sl_cur);} if(GV){DMA_V((t)+1,sl_next);} \
    CMASK(C0,C1,t); \
    { float a=MX3(C0[0],C0[1],C1[0]),b=MX3(C0[2],C0[3],C1[1]); a=MX3(a,C1[2],C1[3]); \
      _Pragma("unroll") for(int r=4;r<16;r+=4){a=MX3(a,C0[r],C0[r+1]);b=MX3(b,C0[r+2],C0[r+3]);a=MX3(a,C1[r],C1[r+1]);b=MX3(b,C1[r+2],C1[r+3]);} \
      float rm=__builtin_fmaxf(a,b); { auto rr=__builtin_amdgcn_permlane32_swap(__float_as_uint(rm),__float_as_uint(rm),false,false); rm=__builtin_fmaxf(__uint_as_float(rr[0]),__uint_as_float(rr[1])); } \
      resc=false; \
      if(__builtin_expect(__any(rm>(float)THRL),0)){ const float dl=__builtin_fmaxf(rm,0.f); mhat+=dl; \
        _Pragma("unroll") for(int r=0;r<16;++r){C0[r]-=dl;C1[r]-=dl;} \
        _Pragma("unroll") for(int r=0;r<16;++r)negm[r]=-mhat; asm volatile("":"+v"(negm)); \
        const float f=__builtin_amdgcn_exp2f(-dl); l_reg*=f; if(hi==0)wsf[r32]=f; resc=true; } } \
    SBAR(); \
    GAPB(o[0]=__builtin_amdgcn_mfma_f32_32x32x16_bf16(PAF(0),VFR(0),o[0],0,0,0), C0,0); \
    GAPB(o[1]=__builtin_amdgcn_mfma_f32_32x32x16_bf16(PAF(0),VFR(4),o[1],0,0,0), C0,4); \
    KRD(GL,0); GAPB(o[0]=__builtin_amdgcn_mfma_f32_32x32x16_bf16(PAF(1),VFR(1),o[0],0,0,0), C0,8); \
    KRD(GL,1); GAPB(o[1]=__builtin_amdgcn_mfma_f32_32x32x16_bf16(PAF(1),VFR(5),o[1],0,0,0), C0,12); \
    KRD(GL,2); GAPB(o[0]=__builtin_amdgcn_mfma_f32_32x32x16_bf16(PAF(2),VFR(2),o[0],0,0,0), C1,0); \
    KRD(GL,3); GAPB(o[1]=__builtin_amdgcn_mfma_f32_32x32x16_bf16(PAF(2),VFR(6),o[1],0,0,0), C1,4); \
    GAPB(o[0]=__builtin_amdgcn_mfma_f32_32x32x16_bf16(PAF(3),VFR(3),o[0],0,0,0), C1,8); \
    GAPB(o[1]=__builtin_amdgcn_mfma_f32_32x32x16_bf16(PAF(3),VFR(7),o[1],0,0,0), C1,12); \
    }while(0)
  int t=1;
  #undef CMASK
  #define CMASK(P0,P1,t) do{}while(0)
  for(;t+5<NT;t+=2){
    STEP(pB0,pB1,pA0,pA1,t,true,true,true);     WAIT_BAR(2); RESC(); ROT();
    STEP(pA0,pA1,pB0,pB1,t+1,true,true,true);   WAIT_BAR(2); RESC(); ROT();
  }
  #undef CMASK
  #define CMASK(P0,P1,t) do{ if((t)>=NT-2)kmask(P0,P1,L-64*(t),hi);}while(0)
  #define ENDW(tt) do{ if((tt)+3<NT){WAIT_BAR(2);} else if((tt)+2<NT){WAIT_BAR(1);} else {WAIT_BAR(0);} }while(0)
  for(;t+1<NT;t+=2){
    STEP(pB0,pB1,pA0,pA1,t,(t+3<NT),(t+1<NT),(t+1<NT));       ENDW(t);   RESC(); ROT();
    STEP(pA0,pA1,pB0,pB1,t+1,(t+4<NT),(t+2<NT),(t+2<NT));     ENDW(t+1); RESC(); ROT();
  }
  STEP(pB0,pB1,pA0,pA1,NT-1,false,false,false); RESC();
  { float sacc=pB0[0]+pB0[1]; _Pragma("unroll") for(int r=2;r<16;++r)sacc+=pB0[r]; _Pragma("unroll") for(int r=0;r<16;++r)sacc+=pB1[r]; l_reg+=sacc;
    pw0=(u32x4){PKW(pB0,0),PKW(pB0,2),PKW(pB0,4),PKW(pB0,6)};pw1=(u32x4){PKW(pB0,8),PKW(pB0,10),PKW(pB0,12),PKW(pB0,14)};pw2=(u32x4){PKW(pB1,0),PKW(pB1,2),PKW(pB1,4),PKW(pB1,6)};pw3=(u32x4){PKW(pB1,8),PKW(pB1,10),PKW(pB1,12),PKW(pB1,14)};
    SBAR(); pv(o,vb0+sl_cur,PAF(0),PAF(1),PAF(2),PAF(3)); }
  #undef PKW
  #undef PAF
  #undef VFR
  #undef PIN
  #undef MX3
  #undef GAPA
  #undef GAPB
  #undef EX
  #undef VRD
  #undef KRD
  #undef STEP
  #undef ENDW
  {auto rr=__builtin_amdgcn_permlane32_swap(__float_as_uint(l_reg),__float_as_uint(l_reg),false,false);l_reg=__uint_as_float(rr[0])+__uint_as_float(rr[1]);}
  if(hi==0)wsf[32+r32]=l_reg;asm volatile("s_waitcnt lgkmcnt(0)":::"memory");
  float rli[16];
  #pragma unroll
  for(int r=0;r<16;++r)rli[r]=__builtin_amdgcn_rcpf(wsf[32+crow(r,hi)]);
  bf16*Ow=O+(rowbase+q0+rh*QBLK)*QP+(4*kvh+qh)*D;
  { bf16*stg=(bf16*)(shm+LDS_OST)+wid*2048;
    #pragma unroll
    for(int r=0;r<16;++r){const int orow=crow(r,hi);
      #pragma unroll
      for(int d0=0;d0<2;++d0)stg[orow*64+d0*32+r32]=__float2bfloat16(o[d0][r]*rli[r]);}
    asm volatile("s_waitcnt lgkmcnt(0)":::"memory");
    #pragma unroll
    for(int i=0;i<4;++i){const int row=i*8+(lane>>3),ch=lane&7; const u32x4 v=*(const u32x4*)(stg+row*64+ch*8); if(q0+rh*QBLK+row<L)ATTN_STORE16(Ow+(long)row*QP+ch*8,v);} }
  asm volatile("s_waitcnt lgkmcnt(0)\n\ts_barrier":::"memory");
  #undef DMA_K
  #undef DMA_V
  #undef CMASK
  #undef START
  #undef RESC
  #undef ROT
}
constexpr int ATTN_LDS_BYTES=LDS_BYTES;
#undef SBAR
#undef WAIT_BAR
}
constexpr int DM = 1024, FF = 2816, NLAYER = 4;
constexpr int LP = 4112, LS = 2064, NSEQ_P = 4, NSEQ_S = 16, ROWS_P = NSEQ_P * LP  , T_ROWS = ROWS_P + NSEQ_S * LS  ;
constexpr int TPAD = 49664, NMT = TPAD / 256;
constexpr int NWIN = 4608;
constexpr float NORM_EPS = 1e-6f;
constexpr float QSCALE = 0.125f * 1.4426950408889634f;
constexpr int ATT_UNITS_P = NSEQ_P * 4 * 65, ATT_UNITS_S = NSEQ_S * 4 * 33, ATT_UNITS = ATT_UNITS_P + ATT_UNITS_S;

constexpr size_t MiB = 1u << 20;
constexpr int CW_BAR = 4096;
constexpr size_t WS_CTL = 0;
constexpr size_t WS_ROPE = MiB / 4;
constexpr size_t WS_HMETA = 3 * MiB / 2;
constexpr size_t WS_SSQ = 3 * MiB;
constexpr size_t WS_W = 8 * MiB;
constexpr size_t W_GU1 = 0, W_D1 = W_GU1 + (size_t)5632 * 1024 * 2, W_IN = W_D1 + (size_t)1024 * 2816 * 2, W_GC = W_IN + (size_t)NWIN * 1024 * 2, W_OC = W_GC + 2 * MiB,
                 W_GA = W_OC + 2 * MiB, W_OA = W_GA + 2 * MiB, W_M = W_OA + 2 * MiB, W_GU2 = W_M + 2 * MiB, W_D2 = W_GU2 + (size_t)5632 * 1024 * 2, W_END = W_D2 + (size_t)1024 * 2816 * 2;
constexpr size_t WBUF = 56 * MiB;
constexpr size_t WS_HB = 120 * MiB;
constexpr size_t ROWB = (size_t)TPAD * 1024 * 2;
constexpr size_t WS_BIG = WS_HB + 98 * MiB;
constexpr size_t WS_Q = WS_BIG, WS_K = WS_Q + ROWB, WS_V = WS_K + ROWB / 4, WS_CB = WS_V + ROWB / 4, WS_Z = WS_CB + ROWB, WS_END = WS_Z + ROWB;
constexpr size_t WS_HID = WS_BIG;
constexpr size_t WS_SCR = WS_K;
static_assert((CW_BAR + 3456) * 4 <= (int)WS_ROPE && WS_ROPE + (size_t)LP * 64 * 4 <= WS_HMETA && WS_HMETA + (size_t)20 * 16 * 1024 * 4 <= WS_SSQ && WS_SSQ + (size_t)TPAD * 16 * 4 <= WS_W, "d_ws map (small regions)");
static_assert(W_END <= 56 * MiB && ROWB <= 98 * MiB && (size_t)TPAD * FF * 2 <= WS_END - WS_BIG && 256 * 131072 <= ROWB / 2, "d_ws map");

constexpr int RING_BYTES = 131072, MISC_OFF = RING_BYTES + 320, PTAB_OFF = RING_BYTES + 1024, LDS_BYTES = 147456;
constexpr int NWAVES = 8;

#define GAS __attribute__((address_space(1)))
#define LAS __attribute__((address_space(3)))
typedef unsigned short bf16;
typedef unsigned v4u __attribute__((ext_vector_type(4)));
typedef float f32x4 __attribute__((ext_vector_type(4)));
__device__ __forceinline__ unsigned f2bf(float f) { unsigned u = __builtin_bit_cast(unsigned, f); return (u + 0x7fffu + ((u >> 16) & 1u)) >> 16; }
__device__ __forceinline__ unsigned pk2(float lo, float hi) { return pg8::cvt_pk_bf16(lo, hi); }
__device__ __forceinline__ float bflo(unsigned u) { return __builtin_bit_cast(float, u << 16); }
__device__ __forceinline__ float bfhi(unsigned u) { return __builtin_bit_cast(float, u & 0xffff0000u); }
__device__ __forceinline__ float wave_sum(float v) {
#pragma unroll
    for (int o = 1; o < 64; o <<= 1) v += __shfl_xor(v, o);
    return v;
}
__device__ __forceinline__ void rowinfo(int r, int& pos, int& L) {
    if (r < ROWS_P) { L = LP; pos = r % LP; } else if (r < T_ROWS) { L = LS; pos = (r - ROWS_P) % LS; } else { L = 1 << 30; pos = 0; }
}
__device__ __forceinline__ float sigmoidf_(float x) { return __builtin_amdgcn_rcpf(1.0f + __builtin_amdgcn_exp2f(-1.4426950408889634f * x)); }

struct PlainOrder : pg8::StaticOrder {
    const char* A; const char* Bt; size_t tstep;
    __device__ __forceinline__ const char* aptr(const pg8::Unit& u) const { return A + (size_t)u.pm * tstep; }
    __device__ __forceinline__ const char* bptr(const pg8::Unit& u) const { return Bt + (size_t)u.pn * tstep; }
};
struct ChainOrder {
    pg8::StaticOrder base; const char* A[4]; const char* B[4]; size_t tstep;
    __device__ __forceinline__ bool next(int i, pg8::Unit& u) const { if (!base.next(i >> 2, u)) return false; u.sub = i & 3; return true; }
    __device__ __forceinline__ const char* aptr(const pg8::Unit& u) const { const char* p = u.sub == 0 ? A[0] : u.sub == 1 ? A[1] : u.sub == 2 ? A[2] : A[3]; return p + (size_t)u.pm * tstep; }
    __device__ __forceinline__ const char* bptr(const pg8::Unit& u) const { const char* p = u.sub == 0 ? B[0] : u.sub == 1 ? B[1] : u.sub == 2 ? B[2] : B[3]; return p + (size_t)u.pn * tstep; }
    __device__ __forceinline__ void a_ready(const pg8::Unit&) const {}
    __device__ __forceinline__ void done(const pg8::Unit&) const {}
};

using pg8::f32x4; using pg8::u32x4; using pg8::Unit; using pg8::bf16_t;
typedef f32x4 Acc[2][2][4][2];
__device__ __forceinline__ u32x4 pack8(const f32x4 a, const f32x4 b) { u32x4 w; w.x = pk2(a[0], a[1]); w.y = pk2(a[2], a[3]); w.z = pk2(b[0], b[1]); w.w = pk2(b[2], b[3]); return w; }
__device__ __forceinline__ void unpack8(const u32x4 w, f32x4& a, f32x4& b) { a = (f32x4){bflo(w.x), bfhi(w.x), bflo(w.y), bfhi(w.y)}; b = (f32x4){bflo(w.z), bfhi(w.z), bflo(w.w), bfhi(w.w)}; }
__device__ __forceinline__ float rstd_of(const float* ssq, int row) { const f32x4* p = (const f32x4*)(ssq + (size_t)row * 16); const f32x4 a = p[0], b = p[1], c = p[2], d = p[3];
    const float s = (((a[0] + a[1]) + (a[2] + a[3])) + ((b[0] + b[1]) + (b[2] + b[3]))) + (((c[0] + c[1]) + (c[2] + c[3])) + ((d[0] + d[1]) + (d[2] + d[3])));
    return __builtin_amdgcn_rsqf(s * (1.0f / DM) + NORM_EPS); }

__device__ __forceinline__ void rstd8(const float* ssq, int row0, int fq, float (&rs)[8]) {
    f32x4 pr[8];
#pragma unroll
    for (int i = 0; i < 8; ++i) pr[i] = *(const f32x4*)(ssq + (size_t)(row0 + (i >> 2) * 128 + (i & 3) * 16) * 16 + 4 * fq);
#pragma unroll
    for (int i = 0; i < 8; ++i) { float s = (pr[i][0] + pr[i][1]) + (pr[i][2] + pr[i][3]); s += __shfl_xor(s, 16); s += __shfl_xor(s, 32); rs[i] = __builtin_amdgcn_rsqf(s * (1.0f / DM) + NORM_EPS); }
}
struct EpiSwiGLU {
    static constexpr bool PERM = true, AFTER_DRAIN = false;
    bf16_t* hid; const float* ssq;
    __device__ __forceinline__ void operator()(const Acc& acc, const Unit& u, int wr, int wc, int fr, int fq) const {
        const int row0 = u.pm * 256 + wr * 64 + fr;
        float rs[8]; rstd8(ssq, row0, fq, rs);
#pragma unroll
        for (int ai = 0; ai < 2; ++ai)
#pragma unroll
            for (int m = 0; m < 4; ++m) {
                const int row = row0 + ai * 128 + m * 16; const float r1 = rs[ai * 4 + m];
                f32x4 o[2];
#pragma unroll
                for (int n = 0; n < 2; ++n) {
                    const f32x4 gs = acc[ai][0][m][n] * r1, us = acc[ai][1][m][n] * r1, t = gs * -1.4426950408889634f;
                    f32x4 d; d[0] = __builtin_amdgcn_exp2f(t[0]); d[1] = __builtin_amdgcn_exp2f(t[1]); d[2] = __builtin_amdgcn_exp2f(t[2]); d[3] = __builtin_amdgcn_exp2f(t[3]);
                    d = d + 1.0f;
                    f32x4 r; r[0] = __builtin_amdgcn_rcpf(d[0]); r[1] = __builtin_amdgcn_rcpf(d[1]); r[2] = __builtin_amdgcn_rcpf(d[2]); r[3] = __builtin_amdgcn_rcpf(d[3]);
                    o[n] = (gs * us) * r;
                }
                *(u32x4*)(hid + (size_t)row * FF + u.pn * 128 + wc * 32 + 8 * fq) = pack8(o[0], o[1]);
            }
    }
};
struct EpiResid {
    static constexpr bool PERM = true, AFTER_DRAIN = false;
    bf16_t* hb; float* ssq_out; float scale;
    __device__ __forceinline__ void operator()(const Acc& acc, const Unit& u, int wr, int wc, int fr, int fq) const {
        const int row0 = u.pm * 256 + wr * 64 + fr;
#pragma unroll
        for (int ai = 0; ai < 2; ++ai) {
            u32x4 old[4][2];
#pragma unroll
            for (int m = 0; m < 4; ++m) { const int row = row0 + ai * 128 + m * 16; const bf16_t* bp = hb + (size_t)row * DM + u.pn * 256 + wc * 32 + 8 * fq;
#pragma unroll
                for (int bj = 0; bj < 2; ++bj) old[m][bj] = row < T_ROWS ? *(const u32x4*)(bp + bj * 128) : (u32x4){0u, 0u, 0u, 0u}; }
#pragma unroll
            for (int m = 0; m < 4; ++m) {
                const int row = row0 + ai * 128 + m * 16; const bool ok = row < T_ROWS; bf16_t* bp = hb + (size_t)row * DM + u.pn * 256 + wc * 32 + 8 * fq;
                float ss = 0.f;
#pragma unroll
                for (int bj = 0; bj < 2; ++bj) {
                    f32x4 a, b; unpack8(old[m][bj], a, b);
                    a = a + acc[ai][bj][m][0] * scale; b = b + acc[ai][bj][m][1] * scale;
                    const u32x4 w = pack8(a, b); if (ok) *(u32x4*)(bp + bj * 128) = w;
                    unpack8(w, a, b);
                    ss += (a[0] * a[0] + a[1] * a[1]) + (a[2] * a[2] + a[3] * a[3]) + (b[0] * b[0] + b[1] * b[1]) + (b[2] * b[2] + b[3] * b[3]);
                }
                ss += __shfl_xor(ss, 16); ss += __shfl_xor(ss, 32);
                if (ok && fq == 0) ssq_out[(size_t)row * 16 + u.pn * 4 + wc] = ss;
            }
            asm volatile("" ::: "memory");
        }
    }
};
struct EpiWin {
    static constexpr bool PERM = true, AFTER_DRAIN = false;
    bf16_t *q, *k, *v, *cb, *z; const float* ssq; const float* rope; const float* qg; const float* kg;
    __device__ __forceinline__ void operator()(const Acc& acc, const Unit& u, int wr, int wc, int fr, int fq) const {
        const int pn = u.pn; const int row0 = u.pm * 256 + wr * 64 + fr;
        float rs[8]; rstd8(ssq, row0, fq, rs);
        if (pn <= 4) {
            const float* g = pn < 4 ? qg : kg; const float osc = pn < 4 ? QSCALE : 1.0f;
            f32x4 G[2][2];
#pragma unroll
            for (int bj = 0; bj < 2; ++bj)
#pragma unroll
                for (int n = 0; n < 2; ++n) G[bj][n] = *(const f32x4*)(g + 32 * bj + 16 * n + 4 * fq) * osc;
#pragma unroll
            for (int ai = 0; ai < 2; ++ai)
#pragma unroll
                for (int mp = 0; mp < 2; ++mp) {
                    f32x4 cs[2][2][2];
#pragma unroll
                    for (int mm = 0; mm < 2; ++mm) { int pos, L; rowinfo(row0 + ai * 128 + (2 * mp + mm) * 16, pos, L);
#pragma unroll
                        for (int bj = 0; bj < 2; ++bj) { cs[mm][bj][0] = *(const f32x4*)(rope + ((pos * 2 + bj) * 2 + 0) * 16 + 4 * fq); cs[mm][bj][1] = *(const f32x4*)(rope + ((pos * 2 + bj) * 2 + 1) * 16 + 4 * fq); } }
#pragma unroll
                    for (int mm = 0; mm < 2; ++mm) {
                        const int m = 2 * mp + mm; const int row = row0 + ai * 128 + m * 16; const float r1 = rs[ai * 4 + m];
                        f32x4 x[2][2]; float ss = 0.f;
#pragma unroll
                        for (int bj = 0; bj < 2; ++bj)
#pragma unroll
                            for (int n = 0; n < 2; ++n) { x[bj][n] = acc[ai][bj][m][n] * r1; const f32x4 t = x[bj][n] * x[bj][n]; ss += (t[0] + t[1]) + (t[2] + t[3]); }
                        ss += __shfl_xor(ss, 16); ss += __shfl_xor(ss, 32);
                        const float rn = __builtin_amdgcn_rsqf(ss * (1.0f / 64.0f) + NORM_EPS);
                        bf16_t* dst = pn < 4 ? q + (size_t)row * 1024 + (4 * pn + wc) * 64 + 8 * fq : k + (size_t)row * 256 + wc * 64 + 8 * fq;
#pragma unroll
                        for (int bj = 0; bj < 2; ++bj) {
                            const f32x4 c4 = cs[mm][bj][0], s4 = cs[mm][bj][1];
                            const f32x4 y1 = x[bj][0] * rn * G[bj][0], y2 = x[bj][1] * rn * G[bj][1];
                            const f32x4 o1 = y1 * c4 - y2 * s4, o2 = y2 * c4 + y1 * s4;
                            *(u32x4*)(dst + 32 * bj) = pack8(o1, o2);
                        }
                    }
                    asm volatile("" ::: "memory");
                }
        } else if (pn < 10) {
            bf16_t* base; int pitch, c0;
            if (pn == 5) { base = v; pitch = 256; c0 = 0; } else { base = cb; pitch = 1024; c0 = 256 * (pn - 6); }
#pragma unroll
            for (int ai = 0; ai < 2; ++ai)
#pragma unroll
                for (int m = 0; m < 4; ++m) {
                    const int row = row0 + ai * 128 + m * 16; const float r1 = rs[ai * 4 + m];
#pragma unroll
                    for (int bj = 0; bj < 2; ++bj) *(u32x4*)(base + (size_t)row * pitch + c0 + 128 * bj + wc * 32 + 8 * fq) = pack8(acc[ai][bj][m][0] * r1, acc[ai][bj][m][1] * r1);
                }
        } else {
#pragma unroll
            for (int ai = 0; ai < 2; ++ai)
#pragma unroll
                for (int m = 0; m < 4; ++m) {
                    const int row = row0 + ai * 128 + m * 16; const float r1 = rs[ai * 4 + m], rs2 = r1 * r1;
                    *(u32x4*)(z + (size_t)row * 1024 + 128 * (pn - 10) + wc * 32 + 8 * fq) = pack8(acc[ai][0][m][0] * acc[ai][1][m][0] * rs2, acc[ai][0][m][1] * acc[ai][1][m][1] * rs2);
                }
        }
    }
};
struct EpiMerge {
    static constexpr bool PERM = true, AFTER_DRAIN = false;
    bf16_t* merged; u32x4* scr; const float* ssq; int tid;
    __device__ __forceinline__ void operator()(const Acc& acc, const Unit& u, int wr, int wc, int fr, int fq) const {
        const int sub = u.sub; const int row0 = u.pm * 256 + wr * 64 + fr;
        char* mb = (char*)(merged + (size_t)row0 * DM + u.pn * 256 + wc * 32 + 8 * fq); asm volatile("" : "+v"(mb));
        char* sb = (char*)(scr + tid); asm volatile("" : "+v"(sb));
#define MP(ai, m, bj) ((u32x4*)(mb + ((ai) * 128 + (m) * 16) * (DM * 2) + (bj) * 256))
#define SP(ai, m, bj) ((u32x4*)(sb + ((((ai) * 4 + (m)) * 2 + (bj)) * 512) * 16))
        if ((sub & 1) == 0) {
            float rs[8]; rstd8(ssq, row0, fq, rs);
#pragma unroll
            for (int ai = 0; ai < 2; ++ai)
#pragma unroll
                for (int m = 0; m < 4; ++m) {
                    const float r1 = rs[ai * 4 + m];
#pragma unroll
                    for (int bj = 0; bj < 2; ++bj) {
                        f32x4 s0, s1; const f32x4 v0 = acc[ai][bj][m][0], v1 = acc[ai][bj][m][1];
#pragma unroll
                        for (int e = 0; e < 4; ++e) { s0[e] = sigmoidf_(v0[e] * r1); s1[e] = sigmoidf_(v1[e] * r1); }
                        if (sub == 0) *MP(ai, m, bj) = pack8(s0, s1); else *SP(ai, m, bj) = pack8(s0, s1);
                    }
                }
        } else if (sub == 1) {
#pragma unroll
            for (int ai = 0; ai < 2; ++ai) {
                u32x4 g[4][2];
#pragma unroll
                for (int m = 0; m < 4; ++m)
#pragma unroll
                    for (int bj = 0; bj < 2; ++bj) g[m][bj] = *MP(ai, m, bj);
#pragma unroll
                for (int m = 0; m < 4; ++m)
#pragma unroll
                    for (int bj = 0; bj < 2; ++bj) { f32x4 g0, g1; unpack8(g[m][bj], g0, g1); *MP(ai, m, bj) = pack8(g0 * acc[ai][bj][m][0], g1 * acc[ai][bj][m][1]); }
                asm volatile("" ::: "memory");
            }
        } else {
#pragma unroll
            for (int ai = 0; ai < 2; ++ai)
#pragma unroll
                for (int mp = 0; mp < 2; ++mp) {
                    u32x4 c[2][2], s[2][2];
#pragma unroll
                    for (int mm = 0; mm < 2; ++mm)
#pragma unroll
                        for (int bj = 0; bj < 2; ++bj) { c[mm][bj] = *MP(ai, 2 * mp + mm, bj); s[mm][bj] = *SP(ai, 2 * mp + mm, bj); }
#pragma unroll
                    for (int mm = 0; mm < 2; ++mm)
#pragma unroll
                        for (int bj = 0; bj < 2; ++bj) { const int m = 2 * mp + mm; f32x4 c0, c1, s0, s1; unpack8(c[mm][bj], c0, c1); unpack8(s[mm][bj], s0, s1);
                            *MP(ai, m, bj) = pack8(c0 + s0 * acc[ai][bj][m][0], c1 + s1 * acc[ai][bj][m][1]); }
                    asm volatile("" ::: "memory");
                }
        }
#undef MP
#undef SP
    }
};

__device__ __forceinline__ void cvt_item(const float* W, int Nsrc, int n0src, const float* gain, bool permqk, bf16* WT, int K, int nrow0, int k0, LAS float* scr, int lane) {
#pragma unroll 8
    for (int i = 0; i < 32; ++i) { const int kk = 2 * i + (lane >> 5); float w = W[(size_t)(k0 + kk) * Nsrc + n0src + (lane & 31)]; if (gain) w *= gain[k0 + kk]; scr[kk * 33 + (lane & 31)] = w; }
    asm volatile("s_waitcnt lgkmcnt(0)" ::: "memory");
    const int c = lane & 7;
#pragma unroll
    for (int j = 0; j < 4; ++j) { const int n = (lane >> 3) + 8 * j; const int ns = permqk ? (16 * ((n >> 2) & 1) + 4 * (n >> 3) + (n & 3)) : n; const LAS float* s = scr + (8 * c) * 33 + ns;
        v4u o; o.x = pk2(s[0 * 33], s[1 * 33]); o.y = pk2(s[2 * 33], s[3 * 33]); o.z = pk2(s[4 * 33], s[5 * 33]); o.w = pk2(s[6 * 33], s[7 * 33]);
        *(GAS v4u*)(WT + (size_t)(nrow0 + n) * K + k0 + 8 * c) = o; }
    asm volatile("s_waitcnt lgkmcnt(0)" ::: "memory");
}
#define RLX_AGENT __ATOMIC_RELAXED, __HIP_MEMORY_SCOPE_AGENT
#define XB_TMO      128
#define XB_XCNT(j)  (256  + 64 * (j))
#define XB_XSUB(j)  (1280 + 64 * (j))
#define XB_XGEN(j)  (2304 + 64 * (j))
#define XB_TOP      3328
#define XB_TOPGEN   3392
#define XCD_BAR_WORDS 3456
#define XB_SPIN_CAP (1u << 18)

__device__ __forceinline__ unsigned xb_ld(unsigned* p)              { return __hip_atomic_load(p, __ATOMIC_RELAXED, __HIP_MEMORY_SCOPE_AGENT); }
__device__ __forceinline__ unsigned xb_add(unsigned* p, unsigned v) { return __hip_atomic_fetch_add(p, v, __ATOMIC_RELAXED, __HIP_MEMORY_SCOPE_AGENT); }
__device__ __forceinline__ unsigned xb_xcc_id() { return (unsigned)__builtin_amdgcn_s_getreg((3 << 11) | 20) & 0xFu; }
#define XB_SPIN(cond, bar) do { unsigned _sp = 0; while (cond) { __builtin_amdgcn_s_sleep(1); \
    if ((++_sp & 255u) == 0u) { if (xb_ld(&(bar)[XB_TMO])) break; if (_sp > XB_SPIN_CAP) { atomicAdd(&(bar)[XB_TMO], 1u); break; } } } } while (0)

struct XcdBarrier {
    unsigned* bar; unsigned x;
    volatile LAS unsigned* st;
};

__device__ __forceinline__ XcdBarrier xcd_barrier_post(unsigned* bar, volatile LAS unsigned* st) {
    XcdBarrier b; b.bar = bar; b.x = xb_xcc_id(); b.st = st;
    if (threadIdx.x == 0) st[2] = xb_add(&bar[XB_XCNT(b.x)], 1u);
    return b;
}
__device__ __forceinline__ void xcd_barrier_complete(unsigned* bar, unsigned x, unsigned& nloc, unsigned& nx, unsigned& uni) {
    const unsigned G = gridDim.x * gridDim.y * gridDim.z;
    unsigned sum, cnt, mine, sp = 0u, bad = 0u;
    for (;;) {
        sum = 0u; cnt = 0u; mine = 0u; bad = 0u;
#pragma unroll
        for (unsigned j = 0; j < 16; ++j) { const unsigned c = xb_ld(&bar[XB_XCNT(j)]); sum += c; cnt += (c > 0u) ? 1u : 0u; mine = (j == x) ? c : mine; bad |= (j < 8u) ? (c * 8u != G) : (c != 0u); }
        if (sum == G) break;
        __builtin_amdgcn_s_sleep(1);
        if ((++sp & 255u) == 0u) { if (xb_ld(&bar[XB_TMO])) break; if (sp > XB_SPIN_CAP) { atomicAdd(&bar[XB_TMO], 1u); break; } }
    }
    nloc = mine > 0u ? mine : 1u; nx = cnt > 0u ? cnt : 1u; uni = (bad == 0u && sum == G) ? 1u : 0u;
}

__device__ __forceinline__ void xcd_barrier(const XcdBarrier& b) {
    asm volatile("s_waitcnt vmcnt(0)" ::: "memory");
    __syncthreads();
    if (threadIdx.x == 0) {
        unsigned* bar = b.bar;
        __builtin_amdgcn_s_waitcnt(0);
        unsigned nloc = b.st[0], nx = b.st[1];
        if (nloc == 0u) { unsigned uni = 0u; xcd_barrier_complete(bar, b.x, nloc, nx, uni); b.st[0] = nloc; b.st[1] = nx; b.st[3] = uni; }
        const unsigned old = xb_add(&bar[XB_XSUB(b.x)], 1u);
        const unsigned gen = old / nloc;
        if (old + 1u == (gen + 1u) * nloc) {
            __builtin_amdgcn_fence(__ATOMIC_RELEASE, "agent");
            asm volatile("s_waitcnt vmcnt(0)" ::: "memory");
            const unsigned og = xb_add(&bar[XB_TOP], 1u);
            const unsigned tg = og / nx;
            if (og + 1u == (tg + 1u) * nx) xb_add(&bar[XB_TOPGEN], 1u);
            else XB_SPIN(xb_ld(&bar[XB_TOPGEN]) == tg, bar);
            __builtin_amdgcn_fence(__ATOMIC_ACQUIRE, "agent");
            xb_add(&bar[XB_XGEN(b.x)], 1u);
            asm volatile("s_waitcnt vmcnt(0)" ::: "memory");
        } else {
            XB_SPIN(xb_ld(&bar[XB_XGEN(b.x)]) == gen, bar);
            __builtin_amdgcn_fence(__ATOMIC_ACQUIRE, "agent");
            asm volatile("s_waitcnt vmcnt(0)" ::: "memory");
        }
    }
    __syncthreads();
}
struct Args { const float* in[21]; float* out; unsigned char* ws; int ph_lo, ph_hi; };
struct PT {
    volatile LAS unsigned long long* t;
    __device__ __forceinline__ unsigned long long get(int i) const { const unsigned long long v = t[i]; const unsigned lo = __builtin_amdgcn_readfirstlane((unsigned)v), hi = __builtin_amdgcn_readfirstlane((unsigned)(v >> 32)); return ((unsigned long long)hi << 32) | lo; }
    __device__ __forceinline__ const float* in(int i) const { return (const float*)(const GAS float*)get(i); }
    __device__ __forceinline__ float* out() const { return (float*)(GAS float*)get(21); }
    __device__ __forceinline__ unsigned char* ws() const { return (unsigned char*)(GAS unsigned char*)get(22); }
};

__device__ __forceinline__ void cvt_one(const PT a, unsigned char* ws, int l, LAS unsigned char* lds, int it, int wave, int lane) {
    LAS float* scr = (LAS float*)(lds + wave * 16384);
    bf16* W = (bf16*)(ws + WS_W + (size_t)(l & 1) * WBUF);
    const size_t ffo = (size_t)l * DM * FF, sqo = (size_t)l * DM * DM;
    const float* win = a.in(8) + (size_t)l * DM * 6656; const float* mixg = a.in(7) + l * DM;
    {
        int r = it;
        if (r < 2816) { const int kb = r / 176, nb = r % 176, pn = nb >> 3, t = nb & 7; const float* src = (t >> 2) ? a.in(5) + ffo : a.in(4) + ffo;
            cvt_item(src, FF, 128 * pn + 32 * (t & 3), a.in(3) + l * DM, false, (bf16*)((char*)W + W_GU1), 1024, nb * 32, kb * 64, scr, lane); return; } r -= 2816;
        if (r < 1408) { const int kb = r / 32, nb = r % 32; cvt_item(a.in(6) + ffo, DM, nb * 32, nullptr, false, (bf16*)((char*)W + W_D1), FF, nb * 32, kb * 64, scr, lane); return; } r -= 1408;
        if (r < 2304) { const int kb = r / 144, nb = r % 144, pn = nb >> 3, t = nb & 7; int n0; bool pq = false;
            if (pn < 4) { n0 = 64 * (4 * pn + (t & 3)) + 32 * (t >> 2); pq = true; }
            else if (pn == 4) { n0 = 1024 + 64 * (t & 3) + 32 * (t >> 2); pq = true; }
            else if (pn == 5) n0 = 1280 + 32 * t;
            else if (pn < 10) n0 = 1536 + 256 * (pn - 6) + 32 * t;
            else n0 = ((t >> 2) ? 3584 : 2560) + 128 * (pn - 10) + 32 * (t & 3);
            cvt_item(win, 6656, n0, mixg, pq, (bf16*)((char*)W + W_IN), 1024, nb * 32, kb * 64, scr, lane); return; } r -= 2304;
        if (r < 2560) { const int seg = r / 512, q = r % 512, kb = q / 32, nb = q % 32;
            const float* src; int ns, n0; const float* gn = nullptr; size_t dst;
            if (seg == 0) { src = win; ns = 6656; n0 = 5632 + nb * 32; gn = mixg; dst = W_GC; }
            else if (seg == 1) { src = a.in(14) + sqo; ns = DM; n0 = nb * 32; dst = W_OC; }
            else if (seg == 2) { src = win; ns = 6656; n0 = 4608 + nb * 32; gn = mixg; dst = W_GA; }
            else if (seg == 3) { src = a.in(13) + sqo; ns = DM; n0 = nb * 32; dst = W_OA; }
            else { src = a.in(15) + sqo; ns = DM; n0 = nb * 32; dst = W_M; }
            cvt_item(src, ns, n0, gn, false, (bf16*)((char*)W + dst), 1024, nb * 32, kb * 64, scr, lane); return; } r -= 2560;
        if (r < 2816) { const int kb = r / 176, nb = r % 176, pn = nb >> 3, t = nb & 7; const float* src = (t >> 2) ? a.in(18) + ffo : a.in(17) + ffo;
            cvt_item(src, FF, 128 * pn + 32 * (t & 3), a.in(16) + l * DM, false, (bf16*)((char*)W + W_GU2), 1024, nb * 32, kb * 64, scr, lane); return; } r -= 2816;
        { const int kb = r / 32, nb = r % 32; cvt_item(a.in(19) + ffo, DM, nb * 32, nullptr, false, (bf16*)((char*)W + W_D2), FF, nb * 32, kb * 64, scr, lane); }
    }
}

constexpr int CVT_ITEMS = 13312;
__device__ __forceinline__ void convert_static(const PT a, unsigned char* ws, int l, LAS unsigned char* lds, int gw, int NGW, int wave, int lane) {
    for (int it = gw; it < CVT_ITEMS; it += NGW) cvt_one(a, ws, l, lds, it, wave, lane);
}
__device__ __forceinline__ void convert_dynamic(const PT a, unsigned char* ws, int l, LAS unsigned char* lds, unsigned* ctr, int lo, int hi, int wave, int lane) {
    for (;;) {
        unsigned b = 0; if (lane == 0) b = atomicAdd(ctr, 4u);
        const int base = lo + (int)__builtin_amdgcn_readfirstlane(b);
        if (base >= hi) break;
        for (int k = 0; k < 4; ++k) { if (base + k < hi) cvt_one(a, ws, l, lds, base + k, wave, lane); }
    }
}
__device__ __forceinline__ void prologue(const PT a, unsigned char* ws, int tid, int wave, int lane, int bid, int G) {
    const int gtid = bid * 512 + tid, GT = G * 512, gw = bid * NWAVES + wave, NGW = G * NWAVES;
    float* ssq = (float*)(ws + WS_SSQ); bf16* hb = (bf16*)(ws + WS_HB); float* rope = (float*)(ws + WS_ROPE);
    for (int i = gtid; i < (TPAD - T_ROWS) * 16; i += GT) ssq[(size_t)T_ROWS * 16 + i] = 0.f;
    for (int i = gtid; i < (TPAD - T_ROWS) * DM / 8; i += GT) ((v4u*)(hb + (size_t)T_ROWS * DM))[i] = (v4u){0u, 0u, 0u, 0u};
    if (gtid < 64) ((unsigned*)(ws + WS_CTL))[gtid] = 0u;
    for (int i = gtid; i < LP * 32; i += GT) {
        const int pos = i >> 5, axis = (i >> 4) & 1, f = i & 15;
        float coord; if (pos < 16) coord = axis ? (float)pos : -1.0f; else { const int t = pos - 16; coord = axis ? (float)(t & 63) : (float)(t >> 6); }
        const float inv = powf(10000.0f, -(float)f * (1.0f / 16.0f)); const float ang = coord * inv;
        float s, c; sincosf(ang, &s, &c);
        rope[((pos * 2 + axis) * 2 + 0) * 16 + f] = c; rope[((pos * 2 + axis) * 2 + 1) * 16 + f] = s;
    }
    for (int r = gw; r < T_ROWS; r += NGW) {
        int pos, L; rowinfo(r, pos, L);
        const float* src;
        if (pos < 16) src = a.in(2) + (size_t)pos * DM;
        else if (r < ROWS_P) src = a.in(0) + ((size_t)(r / LP) * 4096 + pos - 16) * DM;
        else src = a.in(1) + ((size_t)((r - ROWS_P) / LS) * 2048 + pos - 16) * DM;
        f32x4 v[4]; float s = 0.f;
        unsigned long long* o8 = (unsigned long long*)(hb + (size_t)r * DM) + lane;
#pragma unroll
        for (int j = 0; j < 4; ++j) { v[j] = ((const f32x4*)src)[lane + 64 * j];
            const unsigned lo = pk2(v[j][0], v[j][1]), hi = pk2(v[j][2], v[j][3]); o8[64 * j] = (unsigned long long)lo | ((unsigned long long)hi << 32);
            const float a0 = bflo(lo), a1 = bfhi(lo), a2 = bflo(hi), a3 = bfhi(hi); s += (a0 * a0 + a1 * a1) + (a2 * a2 + a3 * a3); }
        s = wave_sum(s);
        if (lane < 16) ssq[(size_t)r * 16 + lane] = lane == 0 ? s : 0.f;
    }
}

constexpr int NSTRIP = (T_ROWS + 63) / 64;
__device__ __forceinline__ void conv_strip(const PT a, unsigned char* ws, int l, int tid, int strip) {
    bf16* cb = (bf16*)(ws + WS_CB); const bf16* z = (const bf16*)(ws + WS_Z);
    const float* cw = a.in(9) + (size_t)l * 3 * DM; const float* cbias = a.in(10) + (size_t)l * DM;
    const int chunk = tid & 127, sub = tid >> 7, c0 = chunk * 8;
    f32x4 w0[2], w1[2], w2[2], bb[2];
#pragma unroll
    for (int h = 0; h < 2; ++h) { w0[h] = *(const f32x4*)(cw + c0 + 4 * h); w1[h] = *(const f32x4*)(cw + DM + c0 + 4 * h); w2[h] = *(const f32x4*)(cw + 2 * DM + c0 + 4 * h); bb[h] = *(const f32x4*)(cbias + c0 + 4 * h); }
    const int r0 = strip * 64 + sub * 16;
#pragma unroll 4
    for (int i = 0; i < 16; ++i) {
        const int r = r0 + i; if (r >= T_ROWS) break;
        int pos, L; rowinfo(r, pos, L);
        const u32x4 zero = (u32x4){0u, 0u, 0u, 0u};
        const u32x4 zc = *(const u32x4*)(z + (size_t)r * DM + c0);
        const u32x4 zp = pos > 0 ? *(const u32x4*)(z + (size_t)(r - 1) * DM + c0) : zero;
        const u32x4 zn = pos < L - 1 ? *(const u32x4*)(z + (size_t)(r + 1) * DM + c0) : zero;
        u32x4* cp = (u32x4*)(cb + (size_t)r * DM + c0); const u32x4 cv = *cp;
        f32x4 p0, p1, c0v, c1v, n0, n1, b0, b1; unpack8(zp, p0, p1); unpack8(zc, c0v, c1v); unpack8(zn, n0, n1); unpack8(cv, b0, b1);
        const f32x4 o0 = b0 * (w0[0] * p0 + w1[0] * c0v + w2[0] * n0 + bb[0]), o1 = b1 * (w0[1] * p1 + w1[1] * c1v + w2[1] * n1 + bb[1]);
        *cp = pack8(o0, o1);
    }
}

__device__ __forceinline__ void attention_phase(const PT a, unsigned char* ws, int l, unsigned char* lds_generic, int tid, bool dry = false) {
    using abf = attn_body::bf16;
    const abf* Q = (const abf*)(ws + WS_Q); const abf* K = (const abf*)(ws + WS_K); const abf* V = (const abf*)(ws + WS_V); abf* O = dry ? (abf*)(ws + WS_END + MiB) : (abf*)(ws + WS_Q);
    unsigned* ctr = (unsigned*)(ws + WS_CTL) + l + (dry ? 8 : 0);
    volatile unsigned* slot = (volatile unsigned*)(lds_generic + MISC_OFF);
    unsigned pre = 0u; if (tid == 0) pre = atomicAdd(ctr, 1u);
    for (;;) {
        if (tid == 0) { *slot = pre; pre = atomicAdd(ctr, 1u); }
        __syncthreads();
        const int idx = (int)__builtin_amdgcn_readfirstlane(*slot);
        if (idx >= ATT_UNITS + NSTRIP) break;
        int u;
        if (idx < 5 * NSTRIP) { if (idx % 5 == 0) { int tidc = tid; asm volatile("" : "+v"(tidc)); conv_strip(a, ws, l, tidc, idx / 5); __syncthreads(); continue; } u = idx - (idx + 4) / 5; }
        else u = idx - NSTRIP;
        int tidu = tid; asm volatile("" : "+v"(tidu));
        if (u < ATT_UNITS_P) { const int s = u / 260, rem = u - s * 260, kvh = rem / 65, qblk = rem - kvh * 65;
            attn_body::attn_unit<8, LP, 66>((long)s * LP, kvh, qblk, Q, K, V, O, (char*)lds_generic, tidu); }
        else { const int u2 = u - ATT_UNITS_P, s = u2 / 132, rem = u2 - s * 132, kvh = rem / 33, qblk = rem - kvh * 33;
            attn_body::attn_unit<8, LS, 34>((long)ROWS_P + (long)s * LS, kvh, qblk, Q, K, V, O, (char*)lds_generic, tidu); }
    }
}

__device__ __forceinline__ void final_phase(const PT a, unsigned char* ws, int wave, int lane, int bid, int G) {
    const int gw = bid * NWAVES + wave, NGW = G * NWAVES;
    const float* ssq = (const float*)(ws + WS_SSQ); const bf16* hb = (const bf16*)(ws + WS_HB); float* out = a.out();
    f32x4 g[4];
#pragma unroll
    for (int j = 0; j < 4; ++j) g[j] = ((const f32x4*)a.in(20))[lane + 64 * j];
    for (int r = gw; r < T_ROWS; r += NGW) {
        int pos, L; rowinfo(r, pos, L); if (pos < 16) continue;
        float* p = r < ROWS_P ? out + ((size_t)(r / LP) * 4096 + pos - 16) * DM : out + (size_t)NSEQ_P * 4096 * DM + ((size_t)((r - ROWS_P) / LS) * 2048 + pos - 16) * DM;
        const float rs = rstd_of(ssq, r);
        const unsigned long long* i8 = (const unsigned long long*)(hb + (size_t)r * DM) + lane;
#pragma unroll
        for (int j = 0; j < 4; ++j) { const unsigned long long w = i8[64 * j]; const unsigned lo = (unsigned)w, hi = (unsigned)(w >> 32);
            const f32x4 v = (f32x4){bflo(lo), bfhi(lo), bflo(hi), bfhi(hi)}; ((f32x4*)p)[lane + 64 * j] = v * rs * g[j]; }
    }
}

constexpr int NSTEPS = 2 + 8 * NLAYER;

template <int STEP>
__device__ __forceinline__ void run_step(const PT pt, unsigned char* lds, cg::grid_group& grid, XcdBarrier& bar, const int ph_lo, const int ph_hi) {
#ifdef MAX_STEP
    if (STEP >= MAX_STEP && STEP != NSTEPS - 1) return;
#endif
    if (STEP < ph_lo || STEP >= ph_hi) return;
    if (STEP > ph_lo) {
        if (STEP == ph_lo + 1) {
            asm volatile("s_waitcnt vmcnt(0)" ::: "memory"); grid.sync();
            bar = xcd_barrier_post((unsigned*)(pt.ws() + WS_CTL) + CW_BAR, (volatile LAS unsigned*)((LAS unsigned char*)lds + MISC_OFF + 32));
        } else xcd_barrier(bar);
#ifdef DUP_SYNC
        xcd_barrier(bar); xcd_barrier(bar);
#endif
    }
    LAS unsigned char* l3 = (LAS unsigned char*)lds;
    int tid = threadIdx.x; asm volatile("" : "+v"(tid));
    int bid = blockIdx.x;
    if (STEP >= ph_lo + 3) {
        volatile LAS unsigned* st = (volatile LAS unsigned*)((LAS unsigned char*)lds + MISC_OFF + 32);
        const unsigned uni = __builtin_amdgcn_readfirstlane(st[3]), rank = __builtin_amdgcn_readfirstlane(st[2]);
        if (uni) bid = (int)(rank * 8u + bar.x);
    }
    asm volatile("" : "+s"(bid));
    int G = gridDim.x; asm volatile("" : "+s"(G));
    unsigned char* ws = pt.ws();
    const int lane = tid & 63, wave = __builtin_amdgcn_readfirstlane(tid >> 6);
    const int gw = bid * NWAVES + wave, NGW = G * NWAVES;
    float* ssq = (float*)(ws + WS_SSQ);
    bf16_t* hb = (bf16_t*)(ws + WS_HB);
    if constexpr (STEP == 0) { prologue(pt, ws, tid, wave, lane, bid, G); convert_static(pt, ws, 0, l3, gw, NGW, wave, lane); __syncthreads(); }
    else if constexpr (STEP == NSTEPS - 1) { final_phase(pt, ws, wave, lane, bid, G); }
    else {
        constexpr int l = (STEP - 1) / 8, ph = (STEP - 1) % 8 + 1;
        unsigned char* wl = ws + WS_W + (size_t)(l & 1) * WBUF;
        if constexpr (ph == 0) {
        } else if constexpr (ph == 1 || ph == 7) {
            constexpr int f = ph == 7;
            PlainOrder S; S.init(TPAD, 2 * FF, G, bid); S.A = (const char*)hb; S.Bt = (const char*)(wl + (f ? W_GU2 : W_GU1)); S.tstep = (size_t)256 * 1024 * 2;
            pg8::Gemm g{nullptr, nullptr, TPAD, 2 * FF, 1024};
            EpiSwiGLU E{(bf16_t*)(ws + WS_HID), ssq};
#ifndef NO_GU
            pg8::gemm_phase<EpiSwiGLU, PlainOrder, true, true>(l3, g, S, E, tid);
#ifdef DUP_GU
            __syncthreads();
            pg8::gemm_phase<EpiSwiGLU, PlainOrder, true, true>(l3, g, S, E, tid);
#endif
#endif
        } else if constexpr (ph == 2 || ph == 6 || ph == 8) {
            constexpr int f = ph == 8; constexpr int K = ph == 6 ? 1024 : FF;
            PlainOrder S; S.init(TPAD, DM, G, bid);
            S.A = ph == 6 ? (const char*)(ws + WS_Z) : (const char*)(ws + WS_HID);
            S.Bt = (const char*)(wl + (ph == 6 ? W_M : (f ? W_D2 : W_D1))); S.tstep = (size_t)256 * K * 2;
            pg8::Gemm g{nullptr, nullptr, TPAD, DM, K};
#ifdef DUP_DOWN
            EpiResid E{hb, ssq, ph == 6 ? 0.5f : 0.25f};
            pg8::gemm_phase<EpiResid, PlainOrder, true, true>(l3, g, S, E, tid); __syncthreads();
#else
            EpiResid E{hb, ssq, ph == 6 ? 1.0f : 0.5f};
#endif
#ifndef NO_RES
            pg8::gemm_phase<EpiResid, PlainOrder, true, true>(l3, g, S, E, tid);
#endif
            if constexpr (l + 1 < NLAYER && ph != 6) {
                constexpr int part = ph == 2 ? 1 : 2; constexpr int lo = part == 1 ? CVT_ITEMS / 2 : 3 * (CVT_ITEMS / 4), hi = part == 1 ? 3 * (CVT_ITEMS / 4) : CVT_ITEMS;
                convert_dynamic(pt, ws, l + 1, l3, (unsigned*)(ws + WS_CTL) + 16 + 4 * l + part, lo, hi, wave, lane);
                __syncthreads();
            }
        } else if constexpr (ph == 3) {
            PlainOrder S; S.init(TPAD, NWIN, G, bid); S.A = (const char*)hb; S.Bt = (const char*)(wl + W_IN); S.tstep = (size_t)256 * 1024 * 2;
            pg8::Gemm g{nullptr, nullptr, TPAD, NWIN, 1024};
            EpiWin E{(bf16_t*)(ws + WS_Q), (bf16_t*)(ws + WS_K), (bf16_t*)(ws + WS_V), (bf16_t*)(ws + WS_CB), (bf16_t*)(ws + WS_Z), ssq,
                     (const float*)(ws + WS_ROPE), pt.in(11) + l * 64, pt.in(12) + l * 64};
#ifndef NO_WIN
            pg8::gemm_phase<EpiWin, PlainOrder, true, true>(l3, g, S, E, tid);
#ifdef DUP_WIN
            __syncthreads();
            pg8::gemm_phase<EpiWin, PlainOrder, true, true>(l3, g, S, E, tid);
#endif
#endif
        } else if constexpr (ph == 4) {
#ifdef DUP_ATT
            attention_phase(pt, ws, l, lds, tid, true); __syncthreads();
#endif
#ifndef NO_ATT
            attention_phase(pt, ws, l, lds, tid);
#endif
        } else {
            ChainOrder S; S.base.init(TPAD, DM, G, bid); S.tstep = (size_t)256 * 1024 * 2;
            S.A[0] = (const char*)hb; S.A[1] = (const char*)(ws + WS_CB); S.A[2] = (const char*)hb; S.A[3] = (const char*)(ws + WS_Q);
            S.B[0] = (const char*)(wl + W_GC); S.B[1] = (const char*)(wl + W_OC); S.B[2] = (const char*)(wl + W_GA); S.B[3] = (const char*)(wl + W_OA);
            pg8::Gemm g{nullptr, nullptr, TPAD, DM, 1024};
            EpiMerge E{(bf16_t*)(ws + WS_Z), (u32x4*)(ws + WS_SCR + (size_t)bid * 131072), ssq, tid};
#ifndef NO_MERGE
            pg8::gemm_phase<EpiMerge, ChainOrder, true, true>(l3, g, S, E, tid);
#ifdef DUP_MERGE
            __syncthreads();
            pg8::gemm_phase<EpiMerge, ChainOrder, true, true>(l3, g, S, E, tid);
#endif
#endif
            if constexpr (l + 1 < NLAYER) {
                convert_dynamic(pt, ws, l + 1, l3, (unsigned*)(ws + WS_CTL) + 16 + 4 * l + 0, 0, CVT_ITEMS / 2, wave, lane);
                __syncthreads();
            }
        }
    }
}
template <int STEP>
__device__ __forceinline__ void run_from(const PT pt, unsigned char* lds, cg::grid_group& grid, XcdBarrier& bar, const int ph_lo, const int ph_hi) {
    run_step<STEP>(pt, lds, grid, bar, ph_lo, ph_hi);
    if constexpr (STEP + 1 < NSTEPS) run_from<STEP + 1>(pt, lds, grid, bar, ph_lo, ph_hi);
}

__global__ void __launch_bounds__(NWAVES * 64, 2) mega_fwd(Args args) {
    extern __shared__ __attribute__((aligned(16))) unsigned char lds[];
    cg::grid_group grid = cg::this_grid();
    PT pt; pt.t = (volatile LAS unsigned long long*)((LAS unsigned char*)lds + PTAB_OFF);
    if (threadIdx.x == 0) {
#pragma unroll
        for (int i = 0; i < 21; ++i) pt.t[i] = (unsigned long long)args.in[i];
        pt.t[21] = (unsigned long long)args.out; pt.t[22] = (unsigned long long)args.ws;
    }
    if (threadIdx.x < 8) ((volatile LAS unsigned*)((LAS unsigned char*)lds + MISC_OFF + 32))[threadIdx.x] = 0u;
    const int ph_lo = args.ph_lo, ph_hi = args.ph_hi;
    if (blockIdx.x == 0) { unsigned* bw = (unsigned*)(args.ws + WS_CTL) + CW_BAR; for (int i = threadIdx.x; i < XCD_BAR_WORDS; i += NWAVES * 64) bw[i] = 0u; }
    __syncthreads();
    XcdBarrier bar; bar.bar = nullptr; bar.x = 0; bar.st = nullptr;
    run_from<0>(pt, lds, grid, bar, ph_lo, ph_hi);
}

#ifndef LAUNCH_PER_STEP
#define LAUNCH_PER_STEP 0
#endif
extern "C" void kernel_launch(void* const* d_in, const int* in_sizes, int n_in, void* d_out, int out_size, void* d_ws, size_t ws_size, hipStream_t stream) {
    static int grid = 0;
    if (grid == 0) {
        if (n_in != 21 || ws_size < WS_END) { fprintf(stderr, "kernel_launch: need 21 inputs and >= %zu bytes of workspace; got %d, %zu\n", (size_t)WS_END, n_in, ws_size); grid = -1; return; }
        int dev = 0, cus = 0, per_cu = 0;
        hipGetDevice(&dev); hipDeviceGetAttribute(&cus, hipDeviceAttributeMultiprocessorCount, dev);
        if (hipFuncSetAttribute((const void*)mega_fwd, hipFuncAttributeMaxDynamicSharedMemorySize, LDS_BYTES) != hipSuccess) { fprintf(stderr, "kernel_launch: hipFuncSetAttribute failed\n"); grid = -1; return; }
        if (hipOccupancyMaxActiveBlocksPerMultiprocessor(&per_cu, (const void*)mega_fwd, NWAVES * 64, LDS_BYTES) != hipSuccess || per_cu < 1) per_cu = 1;
        (void)hipGetLastError();
        grid = cus * per_cu;
    }
    if (grid < 0) return;
    Args a{};
    for (int i = 0; i < 21; ++i) a.in[i] = (const float*)d_in[i];
    a.out = (float*)d_out; a.ws = (unsigned char*)d_ws;
#if LAUNCH_PER_STEP
    for (int s = 0; s < NSTEPS; ++s) { a.ph_lo = s; a.ph_hi = s + 1; void* kargs[] = {&a}; hipLaunchCooperativeKernel((void*)mega_fwd, dim3(grid), dim3(NWAVES * 64), kargs, LDS_BYTES, stream); }
#else
    a.ph_lo = 0; a.ph_hi = NSTEPS; void* kargs[] = {&a};
    hipError_t e = hipLaunchCooperativeKernel((void*)mega_fwd, dim3(grid), dim3(NWAVES * 64), kargs, LDS_BYTES, stream);
    if (e != hipSuccess) fprintf(stderr, "cooperative launch failed: %s (grid %d)\n", hipGetErrorString(e), grid);
#endif
}
```

```cpp
#include <hip/hip_runtime.h>
#include <hip/hip_cooperative_groups.h>
#include <hip/hip_bf16.h>
#include <cstdio>
#include <cstdint>
#include <cmath>
namespace cg = cooperative_groups;
namespace pg8 {
#define PG8_LAS __attribute__((address_space(3)))
typedef unsigned short bf16_t;
typedef short bf16x8 __attribute__((ext_vector_type(8)));
typedef float f32x4 __attribute__((ext_vector_type(4)));
typedef unsigned u32x4 __attribute__((ext_vector_type(4)));
constexpr int BM = 256, BK = 64, HALF = 128, HTB = HALF * BK * 2  , STAGE_BYTES = 8 * HTB, NXCD = 8, WGM = 8;

__host__ __device__ __forceinline__ int lds_byte(int r, int c) { const int st = (r >> 4) * 2 + (c >> 5), rr = r & 15, cc = c & 31, ob = rr * 64 + cc * 2; return st * 1024 + (ob ^ (((ob >> 9) & 1) << 5)); }
__host__ __device__ __forceinline__ void stage_rc(int b, int& R, int& C) { const int st = b / 1024, sb = b % 1024, swz = sb ^ (((sb >> 9) & 1) << 5); R = (st >> 1) * 16 + swz / 64; C = (st & 1) * 32 + (swz % 64) / 2; }
__host__ __device__ __forceinline__ int perm32(int rho) { const int n = rho >> 4, i = rho & 15; return 8 * (i >> 2) + 4 * n + (i & 3); }

struct Unit { int pm, pn, sub; };
struct Gemm { const bf16_t* A; const bf16_t* Bt; int M, N, K; };

struct StaticOrder {
    int nM, nN, nwg, G, c;
    __host__ __device__ void init(int M, int N, int G_, int c_) { nM = M / BM; nN = N / BM; nwg = nM * nN; G = G_; c = c_; }
    __host__ __device__ bool next(int i, Unit& u) const {
        const long L = (long)i * G + c; if (L >= nwg) return false;
        int wgid = (int)L; { const int q = nwg / NXCD, r = nwg % NXCD, xcd = wgid % NXCD, off = wgid / NXCD; wgid = (xcd < r ? xcd * (q + 1) : r * (q + 1) + (xcd - r) * q) + off; }
        const int nig = WGM * nN, gid = wgid / nig, fm = gid * WGM, gsz = (nM - fm) < WGM ? (nM - fm) : WGM;
        u.pm = fm + ((wgid % nig) % gsz); u.pn = (wgid % nig) / gsz; u.sub = 0; return true;
    }
    __device__ __forceinline__ void a_ready(const Unit&) const {}
    __device__ __forceinline__ void done(const Unit&) const {}
};

__device__ __forceinline__ unsigned cvt_pk_bf16(float lo, float hi) { unsigned r; asm volatile("v_cvt_pk_bf16_f32 %0, %1, %2" : "=v"(r) : "v"(lo), "v"(hi)); return r; }
typedef float f32x2 __attribute__((ext_vector_type(2)));
template <class Epi, class Sched, bool ALIGN_EPI = false, bool SP2 = false>
__device__ __forceinline__ void gemm_phase(PG8_LAS unsigned char* lds, const Gemm g, const Sched& S, const Epi& E, const int tid) {
    const int wid = __builtin_amdgcn_readfirstlane(tid >> 6), lane = tid & 63, wr = wid >> 2, wc = wid & 3, fr = lane & 15, fq = lane >> 4;
    const int K = g.K, nt = K / BK;
    unsigned voffA[2], voffB[2];
#pragma unroll
    for (int i = 0; i < 2; ++i) { int R, C; stage_rc(tid * 16 + i * 8192, R, C); const int Rb = Epi::PERM ? ((R & ~31) + perm32(R & 31)) : R;
        voffA[i] = (unsigned)(R * K + C) * 2u; voffB[i] = (unsigned)(Rb * K + C) * 2u; }
    const size_t kstep = (size_t)(BK * 2);
    const size_t hstep = (size_t)HALF * K * 2;
        const unsigned ldsw = (unsigned)wid * 1024u;
    const int aoff = lds_byte(wr * 64 + fr, fq * 8), boff = lds_byte(wc * 32 + fr, fq * 8);
#define PG8_SA(b, h) (((b) * 2 + (h)) * HTB)
#define PG8_SB(b, h) ((4 + (b) * 2 + (h)) * HTB)
#define PG8_STAGE(bufoff, gbase, voff) do { _Pragma("unroll") for (int _i = 0; _i < 2; ++_i) \
        __builtin_amdgcn_global_load_lds((const unsigned*)((const char*)(gbase) + (voff)[_i]), (PG8_LAS unsigned*)(lds + (bufoff) + ldsw + _i * 8192), 16, 0, 0); } while (0)
#define PG8_LDA(dst, b, h) do { _Pragma("unroll") for (int m = 0; m < 4; ++m) _Pragma("unroll") for (int k = 0; k < 2; ++k) dst[m][k] = *(const PG8_LAS bf16x8*)(lds + PG8_SA(b, h) + aoff + m * 2048 + k * 1024); } while (0)
#define PG8_LDB(dst, b, h) do { _Pragma("unroll") for (int n = 0; n < 2; ++n) _Pragma("unroll") for (int k = 0; k < 2; ++k) dst[n][k] = *(const PG8_LAS bf16x8*)(lds + PG8_SB(b, h) + boff + n * 2048 + k * 1024); } while (0)
#define PG8_MMA(ai, bj, At, Bt) do { __builtin_amdgcn_s_setprio(1); _Pragma("unroll") for (int m = 0; m < 4; ++m) _Pragma("unroll") for (int n = 0; n < 2; ++n) _Pragma("unroll") for (int k = 0; k < 2; ++k) \
        acc[ai][bj][m][n] = __builtin_amdgcn_mfma_f32_16x16x32_bf16(Bt[n][k], At[m][k], acc[ai][bj][m][n], 0, 0, 0); __builtin_amdgcn_s_setprio(0); } while (0)
#define PG8_WAIT_V(n) asm volatile("s_waitcnt vmcnt(" #n ")" ::: "memory")
#define PG8_WAIT_L(n) asm volatile("s_waitcnt lgkmcnt(" #n ")" ::: "memory")
#define PG8_BAR __builtin_amdgcn_s_barrier()
#define PG8_SCHED __builtin_amdgcn_sched_barrier(0)
    Unit cur, nxt; int ui = 0;
    if (!S.next(0, cur)) return;
    f32x4 acc[2][2][4][2];
#pragma unroll
    for (int a = 0; a < 2; ++a)
#pragma unroll
        for (int b = 0; b < 2; ++b)
#pragma unroll
            for (int m = 0; m < 4; ++m)
#pragma unroll
                for (int n = 0; n < 2; ++n) acc[a][b][m][n] = (f32x4){0.f, 0.f, 0.f, 0.f};
    bf16x8 At[4][2], B0[2][2], B1[2][2];
    const char* cA = S.aptr(cur); const char* cB = S.bptr(cur);
    S.a_ready(cur);
    if constexpr (SP2) {
        PG8_STAGE(PG8_SB(0, 0), cB, voffB); PG8_STAGE(PG8_SB(0, 1), cB + hstep, voffB); PG8_STAGE(PG8_SA(0, 0), cA, voffA); PG8_STAGE(PG8_SA(0, 1), cA + hstep, voffA);
        if (wr == 1) PG8_BAR;
        PG8_WAIT_V(2); PG8_BAR;
        PG8_STAGE(PG8_SB(1, 0), cB + kstep, voffB); PG8_STAGE(PG8_SA(1, 0), cA + kstep, voffA); PG8_STAGE(PG8_SB(1, 1), cB + hstep + kstep, voffB);
        PG8_WAIT_V(6); PG8_BAR;
    } else {
        PG8_STAGE(PG8_SB(0, 0), cB, voffB); PG8_STAGE(PG8_SA(0, 0), cA, voffA); PG8_STAGE(PG8_SB(0, 1), cB + hstep, voffB); PG8_STAGE(PG8_SA(0, 1), cA + hstep, voffA);
        if (wr == 1) PG8_BAR;
        PG8_WAIT_V(4); PG8_BAR;
        PG8_STAGE(PG8_SB(1, 0), cB + kstep, voffB); PG8_STAGE(PG8_SA(1, 0), cA + kstep, voffA); PG8_STAGE(PG8_SB(1, 1), cB + hstep + kstep, voffB);
        PG8_WAIT_V(6); PG8_BAR;
    }
    for (;;) {
        const bool has_next = S.next(ui + 1, nxt);
        const char* nA = has_next ? S.aptr(nxt) : cA; const char* nB = has_next ? S.bptr(nxt) : cB;
        for (int t = 0; t < nt; t += 2) {
            const bool last = (t == nt - 2);
            const char* a1 = cA + (size_t)(t + 1) * kstep;
            const char* a2 = last ? nA : cA + (size_t)(t + 2) * kstep; const char* b2 = last ? nB : cB + (size_t)(t + 2) * kstep;
            const char* a3 = a2 + kstep; const char* b3 = b2 + kstep;
            if (last && has_next) S.a_ready(nxt);
            if constexpr (SP2) {
            PG8_LDB(B0, 0, 0); PG8_LDB(B1, 0, 1); PG8_SCHED; PG8_LDA(At, 0, 0); PG8_STAGE(PG8_SA(1, 1), a1 + hstep, voffA);
            PG8_WAIT_V(8); PG8_WAIT_L(0); PG8_BAR; PG8_MMA(0, 0, At, B0); PG8_MMA(0, 1, At, B1); PG8_BAR; PG8_SCHED;
            PG8_LDA(At, 0, 1); PG8_STAGE(PG8_SB(0, 0), b2, voffB); PG8_STAGE(PG8_SB(0, 1), b2 + hstep, voffB); PG8_STAGE(PG8_SA(0, 0), a2, voffA);
            PG8_WAIT_V(8); PG8_WAIT_L(0); PG8_BAR; PG8_MMA(1, 0, At, B0); PG8_MMA(1, 1, At, B1); PG8_BAR; PG8_SCHED;
            PG8_LDB(B0, 1, 0); PG8_LDB(B1, 1, 1); PG8_SCHED; PG8_LDA(At, 1, 0); PG8_STAGE(PG8_SA(0, 1), a2 + hstep, voffA);
            PG8_WAIT_V(8); PG8_WAIT_L(0); PG8_BAR; PG8_MMA(0, 0, At, B0); PG8_MMA(0, 1, At, B1); PG8_BAR; PG8_SCHED;
            PG8_LDA(At, 1, 1); PG8_STAGE(PG8_SB(1, 0), b3, voffB); PG8_STAGE(PG8_SB(1, 1), b3 + hstep, voffB); PG8_STAGE(PG8_SA(1, 0), a3, voffA);
            PG8_WAIT_V(8); PG8_WAIT_L(0); PG8_BAR; PG8_MMA(1, 0, At, B0); PG8_MMA(1, 1, At, B1); PG8_BAR; PG8_SCHED;
            } else {
            PG8_LDB(B0, 0, 0); PG8_SCHED; PG8_LDA(At, 0, 0); PG8_STAGE(PG8_SA(1, 1), a1 + hstep, voffA);
            PG8_WAIT_L(8); PG8_BAR; PG8_WAIT_L(0); PG8_MMA(0, 0, At, B0); PG8_BAR; PG8_SCHED;
            PG8_LDB(B1, 0, 1); PG8_STAGE(PG8_SB(0, 0), b2, voffB);
            PG8_BAR; PG8_WAIT_L(0); PG8_MMA(0, 1, At, B1); PG8_BAR;
            PG8_LDA(At, 0, 1); PG8_STAGE(PG8_SA(0, 0), a2, voffA);
            PG8_BAR; PG8_WAIT_L(0); PG8_MMA(1, 0, At, B0); PG8_BAR; PG8_SCHED;
            PG8_STAGE(PG8_SB(0, 1), b2 + hstep, voffB);
            PG8_WAIT_V(6); PG8_BAR; PG8_MMA(1, 1, At, B1); PG8_BAR;
            PG8_LDB(B0, 1, 0); PG8_SCHED; PG8_LDA(At, 1, 0); PG8_STAGE(PG8_SA(0, 1), a2 + hstep, voffA);
            PG8_WAIT_L(8); PG8_BAR; PG8_WAIT_L(0); PG8_MMA(0, 0, At, B0); PG8_BAR; PG8_SCHED;
            PG8_LDB(B1, 1, 1); PG8_STAGE(PG8_SB(1, 0), b3, voffB);
            PG8_BAR; PG8_WAIT_L(0); PG8_MMA(0, 1, At, B1); PG8_BAR;
            PG8_LDA(At, 1, 1); PG8_STAGE(PG8_SA(1, 0), a3, voffA);
            PG8_BAR; PG8_WAIT_L(0); PG8_MMA(1, 0, At, B0); PG8_BAR; PG8_SCHED;
            PG8_STAGE(PG8_SB(1, 1), b3 + hstep, voffB);
            PG8_WAIT_V(6); PG8_BAR; PG8_MMA(1, 1, At, B1); PG8_BAR;
            }
        }
        if constexpr (ALIGN_EPI) { if (wr == 0) PG8_BAR; }
        if constexpr (!Epi::AFTER_DRAIN) { E(acc, cur, wr, wc, fr, fq); S.done(cur); }
        if (!has_next) break;
#pragma unroll
        for (int a = 0; a < 2; ++a)
#pragma unroll
            for (int b = 0; b < 2; ++b)
#pragma unroll
                for (int m = 0; m < 4; ++m)
#pragma unroll
                    for (int n = 0; n < 2; ++n) acc[a][b][m][n] = (f32x4){0.f, 0.f, 0.f, 0.f};
        cur = nxt; cA = nA; cB = nB; ++ui;
        if constexpr (ALIGN_EPI) { if (wr == 1) PG8_BAR; }
    }
    PG8_WAIT_V(0);
    if constexpr (!ALIGN_EPI) { if (wr == 0) PG8_BAR; }
    PG8_BAR;
    if constexpr (Epi::AFTER_DRAIN) { E.fused(acc, cur, wr, wc, fr, fq, lds, wid, lane); S.done(cur); }
#undef PG8_SA
#undef PG8_SB
#undef PG8_STAGE
#undef PG8_LDA
#undef PG8_LDB
#undef PG8_MMA
#undef PG8_WAIT_V
#undef PG8_WAIT_L
#undef PG8_BAR
#undef PG8_SCHED
}
}
namespace attn_body {
using bf16=__hip_bfloat16;
using bf16x8=__attribute__((ext_vector_type(8)))short;
using s16x4=__attribute__((ext_vector_type(4)))short;
using f32x16=__attribute__((ext_vector_type(16)))float;
using u32x4=__attribute__((ext_vector_type(4)))unsigned;
constexpr int D=64,QP=1024,KP=256;
constexpr int NW=8,QBLK=32,KVBLK=64;
__device__ __forceinline__ int crow(int r,int hi){return (r&3)+8*(r>>2)+4*hi;}
#define SBAR() __builtin_amdgcn_sched_barrier(0)
__device__ __forceinline__ void kmask(f32x16&p0,f32x16&p1,int rem,int hi){
  const float NEG=-INFINITY;
  #pragma unroll
  for(int r=0;r<16;++r){int kv=4*hi+(r&3)+8*(r>>2); if(kv>=rem)p0[r]=NEG; if(kv+32>=rem)p1[r]=NEG;}
}

constexpr int NSLOT=3, SLOTB=8192;
constexpr int LDS_K=0, LDS_V=NSLOT*SLOTB, LDS_WS=2*NSLOT*SLOTB, LDS_OST=LDS_WS+NW*64*4, LDS_BYTES=LDS_OST+NW*4096;
constexpr float C2=0.125f*1.4426950408889634f;
__device__ __forceinline__ void glds16(const void*gsrc,unsigned lds_dst){unsigned keep;
  asm volatile("s_mov_b32 %0, m0\n\ts_mov_b32 m0, %2\n\ts_nop 0\n\tglobal_load_lds_dwordx4 %1, off\n\ts_mov_b32 m0, %0":"=&s"(keep):"v"(gsrc),"s"(lds_dst):"memory");}
__device__ __forceinline__ float max3f(float a,float b,float c){float r;asm("v_max3_f32 %0, %1, %2, %3":"=v"(r):"v"(a),"v"(b),"v"(c));return r;}
__device__ __forceinline__ float max2f(float a,float b){float r;asm("v_max_f32_e32 %0, %1, %2":"=v"(r):"v"(a),"v"(b));return r;}
__device__ __forceinline__ float fadd_s(float a,float b){float r;asm("v_add_f32_e32 %0, %1, %2":"=v"(r):"v"(a),"v"(b));return r;}
__device__ __forceinline__ float fsub_s(float a,float b){float r;asm("v_sub_f32_e32 %0, %1, %2":"=v"(r):"v"(a),"v"(b));return r;}
typedef float f32x2_t __attribute__((ext_vector_type(2))); typedef __bf16 bf16x2_t __attribute__((ext_vector_type(2)));
__device__ __forceinline__ unsigned cvtpk_s(float lo,float hi){f32x2_t v={lo,hi};bf16x2_t b=__builtin_convertvector(v,bf16x2_t);return __builtin_bit_cast(unsigned,b);}
#define WAIT_BAR(N) asm volatile("s_waitcnt vmcnt(" #N ") lgkmcnt(0)\n\ts_barrier":::"memory")

__device__ __forceinline__ void qkt(f32x16&p0,f32x16&p1,const char*Kslot,const bf16x8*qr,const f32x16&negm,int r32,int hi){
  const char*kb=Kslot+hi*1024+r32*16;
  #pragma unroll
  for(int d0=0;d0<4;++d0){
    const bf16x8 b0=*reinterpret_cast<const bf16x8*>(kb+d0*2048);
    const bf16x8 b1=*reinterpret_cast<const bf16x8*>(kb+d0*2048+512);
    if(d0==0){p0=__builtin_amdgcn_mfma_f32_32x32x16_bf16(b0,qr[0],negm,0,0,0);p1=__builtin_amdgcn_mfma_f32_32x32x16_bf16(b1,qr[0],negm,0,0,0);}
    else{p0=__builtin_amdgcn_mfma_f32_32x32x16_bf16(b0,qr[d0],p0,0,0,0);p1=__builtin_amdgcn_mfma_f32_32x32x16_bf16(b1,qr[d0],p1,0,0,0);}}
}
typedef __attribute__((address_space(3))) const char* lds_cptr;
typedef short v4i16_t __attribute__((ext_vector_type(4)));
__device__ __forceinline__ void kload8(bf16x8*kf,lds_cptr kp){
  kf[0]=*(const __attribute__((address_space(3))) bf16x8*)(kp);      kf[1]=*(const __attribute__((address_space(3))) bf16x8*)(kp+512);
  kf[2]=*(const __attribute__((address_space(3))) bf16x8*)(kp+2048); kf[3]=*(const __attribute__((address_space(3))) bf16x8*)(kp+2560);
  kf[4]=*(const __attribute__((address_space(3))) bf16x8*)(kp+4096); kf[5]=*(const __attribute__((address_space(3))) bf16x8*)(kp+4608);
  kf[6]=*(const __attribute__((address_space(3))) bf16x8*)(kp+6144); kf[7]=*(const __attribute__((address_space(3))) bf16x8*)(kp+6656);
}
__device__ __forceinline__ void kload2(bf16x8*kf,lds_cptr kp,int j){ kf[2*j]=*(const __attribute__((address_space(3))) bf16x8*)(kp+j*2048); kf[2*j+1]=*(const __attribute__((address_space(3))) bf16x8*)(kp+j*2048+512); }
__device__ __forceinline__ s16x4 vtr(lds_cptr p){ return __builtin_bit_cast(s16x4,__builtin_amdgcn_ds_read_tr16_b64_v4i16((__attribute__((address_space(3))) v4i16_t*)p)); }
__device__ __forceinline__ float rowmax(const f32x16&p0,const f32x16&p1){
  float a=max3f(p0[0],p0[1],p1[0]),b=max3f(p0[2],p0[3],p1[1]);a=max3f(a,p1[2],p1[3]);
  #pragma unroll
  for(int r=4;r<16;r+=4){a=max3f(a,p0[r],p0[r+1]);b=max3f(b,p0[r+2],p0[r+3]);a=max3f(a,p1[r],p1[r+1]);b=max3f(b,p1[r+2],p1[r+3]);}
  const float m=max2f(a,b);
  auto rr=__builtin_amdgcn_permlane32_swap(__float_as_uint(m),__float_as_uint(m),false,false);
  return max2f(__uint_as_float(rr[0]),__uint_as_float(rr[1]));
}
__device__ __forceinline__ void pv(f32x16*o,int vb,bf16x8 pa0,bf16x8 pa1,bf16x8 pa2,bf16x8 pa3){
  #pragma unroll
  for(int d0=0;d0<2;++d0){s16x4 lo[4],hi[4];
    #pragma unroll
    for(int ks=0;ks<4;++ks){
      asm volatile("ds_read_b64_tr_b16 %0,%1 offset:%c2":"=&v"(lo[ks]):"v"(vb),"i"(d0*4096+ks*1024):"memory");
      asm volatile("ds_read_b64_tr_b16 %0,%1 offset:%c2":"=&v"(hi[ks]):"v"(vb),"i"(d0*4096+ks*1024+512):"memory");}
    asm volatile("s_waitcnt lgkmcnt(0)":::"memory");SBAR();
    #define PK(k) (bf16x8){lo[k][0],lo[k][1],lo[k][2],lo[k][3],hi[k][0],hi[k][1],hi[k][2],hi[k][3]}
    o[d0]=__builtin_amdgcn_mfma_f32_32x32x16_bf16(pa0,PK(0),o[d0],0,0,0);
    o[d0]=__builtin_amdgcn_mfma_f32_32x32x16_bf16(pa1,PK(1),o[d0],0,0,0);
    o[d0]=__builtin_amdgcn_mfma_f32_32x32x16_bf16(pa2,PK(2),o[d0],0,0,0);
    o[d0]=__builtin_amdgcn_mfma_f32_32x32x16_bf16(pa3,PK(3),o[d0],0,0,0);
    #undef PK
  }
}

#ifndef ATTN_STORE16
#define ATTN_STORE16(p,v) (*(u32x4*)(p)=(v))
#endif
template<int THRL,int L,int NT> __device__ __forceinline__ void attn_unit(long rowbase,int kvh,int qblk,const bf16*Q,const bf16*__restrict__ K,const bf16*__restrict__ V,bf16*O,char*shm,const int tid){
  const int lane=tid&63,r32=lane&31,hi=lane>>5; const int wid=__builtin_amdgcn_readfirstlane(tid>>6);
  const int q0=qblk*64, qh=wid>>1, rh=wid&1;
  const bf16*Qw=Q+(rowbase+q0+rh*QBLK)*QP+(4*kvh+qh)*D;
  const bf16*Kh=K+rowbase*KP+kvh*D,*Vh=V+rowbase*KP+kvh*D;
  const unsigned lds0=(unsigned)(uintptr_t)shm;
  float*wsf=(float*)(shm+LDS_WS)+wid*64;
  const bf16*ksrc=Kh+(long)lane*KP+wid*8;
  const bf16*vsrc=Vh+(long)(16*(wid&3)+(lane>>2))*KP+(wid>>2)*32+(lane&3)*8;
  const unsigned kdst=lds0+LDS_K+wid*1024, vdst=lds0+LDS_V+wid*1024;
  #define DMA_K(t,slot) glds16(ksrc+(long)(t)*KVBLK*KP,(unsigned)__builtin_amdgcn_readfirstlane(kdst+(slot)))
  #define DMA_V(t,slot) glds16(vsrc+(long)(t)*KVBLK*KP,(unsigned)__builtin_amdgcn_readfirstlane(vdst+(slot)))
  const int vb0=(int)(lds0+LDS_V)+((lane>>4)&1)*32+(lane&3)*8+(4*hi+((lane&15)>>2))*64;
  const char*Kbase=shm+LDS_K; bf16x8 kf[8];
  const lds_cptr shm3=(lds_cptr)shm; const lds_cptr kp0=shm3+LDS_K+hi*1024+r32*16; const lds_cptr vp0=shm3+LDS_V+((lane>>4)&1)*32+(lane&3)*8+(4*hi+((lane&15)>>2))*64;
  DMA_K(0,0);DMA_V(0,0);DMA_K(1,SLOTB);
  bf16x8 qr[4];
  #pragma unroll
  for(int d0=0;d0<4;++d0)qr[d0]=*reinterpret_cast<const bf16x8*>(&Qw[(long)r32*QP+d0*16+hi*8]);
  if(q0+rh*QBLK+r32>=L){
    #pragma unroll
    for(int d0=0;d0<4;++d0)qr[d0]=bf16x8{0,0,0,0,0,0,0,0}; }
  float mhat=0.f,l_reg=0.f;f32x16 o[2];o[0]=f32x16{};o[1]=f32x16{};f32x16 negm=f32x16{};asm volatile("":"+v"(negm));
  #define CMASK(P0,P1,t) do{ if((t)>=NT-2)kmask(P0,P1,L-64*(t),hi);}while(0)
  bool resc=false;
  #define START(P0,P1) do{ const float rm=rowmax(P0,P1); resc=false; \
    { const float dl=rm; mhat=fadd_s(mhat,dl); \
      _Pragma("unroll") for(int r=0;r<16;++r){P0[r]=fsub_s(P0[r],dl);P1[r]=fsub_s(P1[r],dl);} \
      _Pragma("unroll") for(int r=0;r<16;++r)negm[r]=-mhat; asm volatile("":"+v"(negm)); } \
    _Pragma("unroll") for(int r=0;r<16;++r)P0[r]=__builtin_amdgcn_exp2f(P0[r]); }while(0)
  #define RESC() do{ if(resc){ asm volatile("s_waitcnt lgkmcnt(0)":::"memory"); \
      _Pragma("unroll") for(int d_=0;d_<2;++d_) _Pragma("unroll") for(int r=0;r<16;++r)o[d_][r]*=wsf[crow(r,hi)]; } }while(0)
  f32x16 pA0,pA1,pB0,pB1;
  int sl_prev=0,sl_cur=0,sl_next=SLOTB;
  #define ROT() do{sl_prev=sl_cur;sl_cur=sl_next;sl_next=(sl_next==(NSLOT-1)*SLOTB)?0:sl_next+SLOTB;}while(0)
  DMA_K(2,2*SLOTB);
  WAIT_BAR(3);
  qkt(pA0,pA1,Kbase,qr,negm,r32,hi);asm volatile("s_nop 15\n\ts_nop 7":"+v"(pA0),"+v"(pA1));CMASK(pA0,pA1,0);
  START(pA0,pA1);
  _Pragma("unroll") for(int r=0;r<16;++r)pA1[r]=__builtin_amdgcn_exp2f(pA1[r]);
  WAIT_BAR(0);
  DMA_K(3,0);DMA_V(1,SLOTB);
  ROT();
  kload8(kf,kp0+sl_cur);
  WAIT_BAR(2);
  s16x4 vlo[8],vhi[8]; u32x4 pw0,pw1,pw2,pw3;
  #define PKW(P,B) cvtpk_s(P[B],P[B+1])
  #define PAF(k) __builtin_bit_cast(bf16x8,pw##k)
  #define VFR(i) (bf16x8){vlo[i][0],vlo[i][1],vlo[i][2],vlo[i][3],vhi[i][0],vhi[i][1],vhi[i][2],vhi[i][3]}
  #define PIN(x) asm volatile("":"+v"(x))
  #define MX3(a,b,c) __builtin_fmaxf(__builtin_fmaxf((a),(b)),(c))
  #define GAPA(MF,A0,A1,A2,A3,W0,W1,PW) do{ MF; sacc+=A0; sacc+=A1; sacc+=A2; sacc+=A3; PIN(sacc); W0; W1; PIN(PW); SBAR(); }while(0)
  #define EX(v) __builtin_amdgcn_exp2f(v)
  #define GAPB(MF,X,B) do{ MF; X[B]=EX(X[B]); X[B+1]=EX(X[B+1]); X[B+2]=EX(X[B+2]); X[B+3]=EX(X[B+3]); PIN(X); SBAR(); }while(0)
  #define VRD(i) do{ vlo[i]=vtr(vp_+(((i)>>2)*4096+((i)&3)*1024)); vhi[i]=vtr(vp_+(((i)>>2)*4096+((i)&3)*1024+512)); }while(0)
  #define KRD(G,j) do{ if(G){ kload2(kf,kp0+sl_next,j); SBAR(); } }while(0)
  #define STEP(C0,C1,P0,P1,t,GK,GV,GL) do{ SBAR(); \
    const lds_cptr vp_=vp0+sl_prev; \
    VRD(0); SBAR(); float sacc=(P0[0]+P0[1]); \
    GAPA(C0=__builtin_amdgcn_mfma_f32_32x32x16_bf16(kf[0],qr[0],negm,0,0,0), P0[2],P0[3],P0[4],P0[5],     pw0[0]=PKW(P0,0), pw0[1]=PKW(P0,2), pw0); \
    VRD(4); SBAR(); GAPA(C1=__builtin_amdgcn_mfma_f32_32x32x16_bf16(kf[1],qr[0],negm,0,0,0), P0[6],P0[7],P0[8],P0[9],     pw0[2]=PKW(P0,4), pw0[3]=PKW(P0,6), pw0); \
    VRD(1); SBAR(); GAPA(C0=__builtin_amdgcn_mfma_f32_32x32x16_bf16(kf[2],qr[1],C0,0,0,0),   P0[10],P0[11],P0[12],P0[13], pw1[0]=PKW(P0,8), pw1[1]=PKW(P0,10), pw1); \
    VRD(5); SBAR(); GAPA(C1=__builtin_amdgcn_mfma_f32_32x32x16_bf16(kf[3],qr[1],C1,0,0,0),   P0[14],P0[15],P1[0],P1[1],   pw1[2]=PKW(P0,12),pw1[3]=PKW(P0,14), pw1); \
    VRD(2); SBAR(); GAPA(C0=__builtin_amdgcn_mfma_f32_32x32x16_bf16(kf[4],qr[2],C0,0,0,0),   P1[2],P1[3],P1[4],P1[5],     pw2[0]=PKW(P1,0), pw2[1]=PKW(P1,2), pw2); \
    VRD(6); SBAR(); GAPA(C1=__builtin_amdgcn_mfma_f32_32x32x16_bf16(kf[5],qr[2],C1,0,0,0),   P1[6],P1[7],P1[8],P1[9],     pw2[2]=PKW(P1,4), pw2[3]=PKW(P1,6), pw2); \
    VRD(3); SBAR(); GAPA(C0=__builtin_amdgcn_mfma_f32_32x32x16_bf16(kf[6],qr[3],C0,0,0,0),   P1[10],P1[11],P1[12],P1[13], pw3[0]=PKW(P1,8), pw3[1]=PKW(P1,10), pw3); \
    VRD(7); SBAR(); GAPA(C1=__builtin_amdgcn_mfma_f32_32x32x16_bf16(kf[7],qr[3],C1,0,0,0),   P1[14],P1[15],0.f,0.f,       pw3[2]=PKW(P1,12),pw3[3]=PKW(P1,14), pw3); \
    l_reg+=sacc; \
    if(GK){DMA_K((t)+3,sl_cur);} if(GV){DMA_V((t)+1,sl_next);} \
    CMASK(C0,C1,t); \
    { float a=MX3(C0[0],C0[1],C1[0]),b=MX3(C0[2],C0[3],C1[1]); a=MX3(a,C1[2],C1[3]); \
      _Pragma("unroll") for(int r=4;r<16;r+=4){a=MX3(a,C0[r],C0[r+1]);b=MX3(b,C0[r+2],C0[r+3]);a=MX3(a,C1[r],C1[r+1]);b=MX3(b,C1[r+2],C1[r+3]);} \
      float rm=__builtin_fmaxf(a,b); { auto rr=__builtin_amdgcn_permlane32_swap(__float_as_uint(rm),__float_as_uint(rm),false,false); rm=__builtin_fmaxf(__uint_as_float(rr[0]),__uint_as_float(rr[1])); } \
      resc=false; \
      if(__builtin_expect(__any(rm>(float)THRL),0)){ const float dl=__builtin_fmaxf(rm,0.f); mhat+=dl; \
        _Pragma("unroll") for(int r=0;r<16;++r){C0[r]-=dl;C1[r]-=dl;} \
        _Pragma("unroll") for(int r=0;r<16;++r)negm[r]=-mhat; asm volatile("":"+v"(negm)); \
        const float f=__builtin_amdgcn_exp2f(-dl); l_reg*=f; if(hi==0)wsf[r32]=f; resc=true; } } \
    SBAR(); \
    GAPB(o[0]=__builtin_amdgcn_mfma_f32_32x32x16_bf16(PAF(0),VFR(0),o[0],0,0,0), C0,0); \
    GAPB(o[1]=__builtin_amdgcn_mfma_f32_32x32x16_bf16(PAF(0),VFR(4),o[1],0,0,0), C0,4); \
    KRD(GL,0); GAPB(o[0]=__builtin_amdgcn_mfma_f32_32x32x16_bf16(PAF(1),VFR(1),o[0],0,0,0), C0,8); \
    KRD(GL,1); GAPB(o[1]=__builtin_amdgcn_mfma_f32_32x32x16_bf16(PAF(1),VFR(5),o[1],0,0,0), C0,12); \
    KRD(GL,2); GAPB(o[0]=__builtin_amdgcn_mfma_f32_32x32x16_bf16(PAF(2),VFR(2),o[0],0,0,0), C1,0); \
    KRD(GL,3); GAPB(o[1]=__builtin_amdgcn_mfma_f32_32x32x16_bf16(PAF(2),VFR(6),o[1],0,0,0), C1,4); \
    GAPB(o[0]=__builtin_amdgcn_mfma_f32_32x32x16_bf16(PAF(3),VFR(3),o[0],0,0,0), C1,8); \
    GAPB(o[1]=__builtin_amdgcn_mfma_f32_32x32x16_bf16(PAF(3),VFR(7),o[1],0,0,0), C1,12); \
    }while(0)
  int t=1;
  #undef CMASK
  #define CMASK(P0,P1,t) do{}while(0)
  for(;t+5<NT;t+=2){
    STEP(pB0,pB1,pA0,pA1,t,true,true,true);     WAIT_BAR(2); RESC(); ROT();
    STEP(pA0,pA1,pB0,pB1,t+1,true,true,true);   WAIT_BAR(2); RESC(); ROT();
  }
  #undef CMASK
  #define CMASK(P0,P1,t) do{ if((t)>=NT-2)kmask(P0,P1,L-64*(t),hi);}while(0)
  #define ENDW(tt) do{ if((tt)+3<NT){WAIT_BAR(2);} else if((tt)+2<NT){WAIT_BAR(1);} else {WAIT_BAR(0);} }while(0)
  for(;t+1<NT;t+=2){
    STEP(pB0,pB1,pA0,pA1,t,(t+3<NT),(t+1<NT),(t+1<NT));       ENDW(t);   RESC(); ROT();
    STEP(pA0,pA1,pB0,pB1,t+1,(t+4<NT),(t+2<NT),(t+2<NT));     ENDW(t+1); RESC(); ROT();
  }
  #define DRAIN(P0,P1,SL) do{ float sacc=P0[0]+P0[1]; _Pragma("unroll") for(int r=2;r<16;++r)sacc+=P0[r]; _Pragma("unroll") for(int r=0;r<16;++r)sacc+=P1[r]; l_reg+=sacc; \
    pw0=(u32x4){PKW(P0,0),PKW(P0,2),PKW(P0,4),PKW(P0,6)};pw1=(u32x4){PKW(P0,8),PKW(P0,10),PKW(P0,12),PKW(P0,14)};pw2=(u32x4){PKW(P1,0),PKW(P1,2),PKW(P1,4),PKW(P1,6)};pw3=(u32x4){PKW(P1,8),PKW(P1,10),PKW(P1,12),PKW(P1,14)}; \
    SBAR(); pv(o,vb0+(SL),PAF(0),PAF(1),PAF(2),PAF(3)); }while(0)
  if constexpr((NT&1)==0){
    STEP(pB0,pB1,pA0,pA1,NT-1,false,false,false); RESC();
    DRAIN(pB0,pB1,sl_cur);
  } else {
    DRAIN(pA0,pA1,sl_prev);
  }
  #undef DRAIN
  #undef PKW
  #undef PAF
  #undef VFR
  #undef PIN
  #undef MX3
  #undef GAPA
  #undef GAPB
  #undef EX
  #undef VRD
  #undef KRD
  #undef STEP
  #undef ENDW
  {auto rr=__builtin_amdgcn_permlane32_swap(__float_as_uint(l_reg),__float_as_uint(l_reg),false,false);l_reg=__uint_as_float(rr[0])+__uint_as_float(rr[1]);}
  if(hi==0)wsf[32+r32]=l_reg;asm volatile("s_waitcnt lgkmcnt(0)":::"memory");
  float rli[16];
  #pragma unroll
  for(int r=0;r<16;++r)rli[r]=__builtin_amdgcn_rcpf(wsf[32+crow(r,hi)]);
  bf16*Ow=O+(rowbase+q0+rh*QBLK)*QP+(4*kvh+qh)*D;
  { bf16*stg=(bf16*)(shm+LDS_OST)+wid*2048;
    #pragma unroll
    for(int r=0;r<16;++r){const int orow=crow(r,hi);
      #pragma unroll
      for(int d0=0;d0<2;++d0)stg[orow*64+d0*32+r32]=__float2bfloat16(o[d0][r]*rli[r]);}
    asm volatile("s_waitcnt lgkmcnt(0)":::"memory");
    #pragma unroll
    for(int i=0;i<4;++i){const int row=i*8+(lane>>3),ch=lane&7; const u32x4 v=*(const u32x4*)(stg+row*64+ch*8); if(q0+rh*QBLK+row<L)ATTN_STORE16(Ow+(long)row*QP+ch*8,v);} }
  asm volatile("s_waitcnt lgkmcnt(0)\n\ts_barrier":::"memory");
  #undef DMA_K
  #undef DMA_V
  #undef CMASK
  #undef START
  #undef RESC
  #undef ROT
}
constexpr int ATTN_LDS_BYTES=LDS_BYTES;
#undef SBAR
#undef WAIT_BAR
}
constexpr int DM = 1024, FF = 2816, NLAYER = 4;
constexpr int LP = 4112, LS = 2064, NSEQ_P = 4, NSEQ_S = 16, ROWS_P = NSEQ_P * LP  , T_ROWS = ROWS_P + NSEQ_S * LS  ;
constexpr int TPAD = 49664, NMT = TPAD / 256;
constexpr int NWIN = 4608;
constexpr float NORM_EPS = 1e-6f;
constexpr float QSCALE = 0.125f * 1.4426950408889634f;
constexpr int ATT_UNITS_P = NSEQ_P * 4 * 65, ATT_UNITS_S = NSEQ_S * 4 * 33, ATT_UNITS = ATT_UNITS_P + ATT_UNITS_S;

constexpr size_t MiB = 1u << 20;
constexpr int CW_BAR = 4096;
constexpr size_t WS_CTL = 0;
constexpr size_t WS_ROPE = MiB / 4;
constexpr size_t WS_HMETA = 3 * MiB / 2;
constexpr size_t WS_SSQ = 3 * MiB;
constexpr size_t WS_W = 8 * MiB;
constexpr size_t W_GU1 = 0, W_D1 = W_GU1 + (size_t)5632 * 1024 * 2, W_IN = W_D1 + (size_t)1024 * 2816 * 2, W_GC = W_IN + (size_t)NWIN * 1024 * 2, W_OC = W_GC + 2 * MiB,
                 W_GA = W_OC + 2 * MiB, W_OA = W_GA + 2 * MiB, W_M = W_OA + 2 * MiB, W_GU2 = W_M + 2 * MiB, W_D2 = W_GU2 + (size_t)5632 * 1024 * 2, W_END = W_D2 + (size_t)1024 * 2816 * 2;
constexpr size_t WBUF = 56 * MiB;
constexpr size_t WS_HB = 120 * MiB;
constexpr size_t ROWB = (size_t)TPAD * 1024 * 2;
constexpr size_t WS_BIG = WS_HB + 98 * MiB;
constexpr size_t WS_Q = WS_BIG, WS_K = WS_Q + ROWB, WS_V = WS_K + ROWB / 4, WS_CB = WS_V + ROWB / 4, WS_Z = WS_CB + ROWB, WS_END = WS_Z + ROWB;
constexpr size_t WS_HID = WS_BIG;
constexpr size_t WS_SCR = WS_K;
static_assert((CW_BAR + 3456) * 4 <= (int)WS_ROPE && WS_ROPE + (size_t)LP * 64 * 4 <= WS_HMETA && WS_HMETA + (size_t)20 * 16 * 1024 * 4 <= WS_SSQ && WS_SSQ + (size_t)TPAD * 16 * 4 <= WS_W, "d_ws map (small regions)");
static_assert(W_END <= 56 * MiB && ROWB <= 98 * MiB && (size_t)TPAD * FF * 2 <= WS_END - WS_BIG && 256 * 131072 <= ROWB / 2, "d_ws map");

constexpr int RING_BYTES = 131072, MISC_OFF = RING_BYTES + 320, PTAB_OFF = RING_BYTES + 1024, LDS_BYTES = 147456;
constexpr int NWAVES = 8;

#define GAS __attribute__((address_space(1)))
#define LAS __attribute__((address_space(3)))
typedef unsigned short bf16;
typedef unsigned v4u __attribute__((ext_vector_type(4)));
typedef float f32x4 __attribute__((ext_vector_type(4)));
__device__ __forceinline__ unsigned f2bf(float f) { unsigned u = __builtin_bit_cast(unsigned, f); return (u + 0x7fffu + ((u >> 16) & 1u)) >> 16; }
__device__ __forceinline__ unsigned pk2(float lo, float hi) { return pg8::cvt_pk_bf16(lo, hi); }
__device__ __forceinline__ float bflo(unsigned u) { return __builtin_bit_cast(float, u << 16); }
__device__ __forceinline__ float bfhi(unsigned u) { return __builtin_bit_cast(float, u & 0xffff0000u); }
__device__ __forceinline__ float wave_sum(float v) {
#pragma unroll
    for (int o = 1; o < 64; o <<= 1) v += __shfl_xor(v, o);
    return v;
}
__device__ __forceinline__ void rowinfo(int r, int& pos, int& L) {
    if (r < ROWS_P) { L = LP; pos = r % LP; } else if (r < T_ROWS) { L = LS; pos = (r - ROWS_P) % LS; } else { L = 1 << 30; pos = 0; }
}
__device__ __forceinline__ float sigmoidf_(float x) { return __builtin_amdgcn_rcpf(1.0f + __builtin_amdgcn_exp2f(-1.4426950408889634f * x)); }

struct PlainOrder : pg8::StaticOrder {
    const char* A; const char* Bt; size_t tstep;
    __device__ __forceinline__ const char* aptr(const pg8::Unit& u) const { return A + (size_t)u.pm * tstep; }
    __device__ __forceinline__ const char* bptr(const pg8::Unit& u) const { return Bt + (size_t)u.pn * tstep; }
};
struct ChainOrder {
    pg8::StaticOrder base; const char* A[4]; const char* B[4]; size_t tstep;
    __device__ __forceinline__ bool next(int i, pg8::Unit& u) const { if (!base.next(i >> 2, u)) return false; u.sub = i & 3; return true; }
    __device__ __forceinline__ const char* aptr(const pg8::Unit& u) const { const char* p = u.sub == 0 ? A[0] : u.sub == 1 ? A[1] : u.sub == 2 ? A[2] : A[3]; return p + (size_t)u.pm * tstep; }
    __device__ __forceinline__ const char* bptr(const pg8::Unit& u) const { const char* p = u.sub == 0 ? B[0] : u.sub == 1 ? B[1] : u.sub == 2 ? B[2] : B[3]; return p + (size_t)u.pn * tstep; }
    __device__ __forceinline__ void a_ready(const pg8::Unit&) const {}
    __device__ __forceinline__ void done(const pg8::Unit&) const {}
};

using pg8::f32x4; using pg8::u32x4; using pg8::Unit; using pg8::bf16_t;
typedef f32x4 Acc[2][2][4][2];
__device__ __forceinline__ u32x4 pack8(const f32x4 a, const f32x4 b) { u32x4 w; w.x = pk2(a[0], a[1]); w.y = pk2(a[2], a[3]); w.z = pk2(b[0], b[1]); w.w = pk2(b[2], b[3]); return w; }
__device__ __forceinline__ void unpack8(const u32x4 w, f32x4& a, f32x4& b) { a = (f32x4){bflo(w.x), bfhi(w.x), bflo(w.y), bfhi(w.y)}; b = (f32x4){bflo(w.z), bfhi(w.z), bflo(w.w), bfhi(w.w)}; }
__device__ __forceinline__ float rstd_of(const float* ssq, int row) { const f32x4* p = (const f32x4*)(ssq + (size_t)row * 16); const f32x4 a = p[0], b = p[1], c = p[2], d = p[3];
    const float s = (((a[0] + a[1]) + (a[2] + a[3])) + ((b[0] + b[1]) + (b[2] + b[3]))) + (((c[0] + c[1]) + (c[2] + c[3])) + ((d[0] + d[1]) + (d[2] + d[3])));
    return __builtin_amdgcn_rsqf(s * (1.0f / DM) + NORM_EPS); }

__device__ __forceinline__ void rstd8(const float* ssq, int row0, int fq, float (&rs)[8]) {
    f32x4 pr[8];
#pragma unroll
    for (int i = 0; i < 8; ++i) pr[i] = *(const f32x4*)(ssq + (size_t)(row0 + (i >> 2) * 128 + (i & 3) * 16) * 16 + 4 * fq);
#pragma unroll
    for (int i = 0; i < 8; ++i) { float s = (pr[i][0] + pr[i][1]) + (pr[i][2] + pr[i][3]); s += __shfl_xor(s, 16); s += __shfl_xor(s, 32); rs[i] = __builtin_amdgcn_rsqf(s * (1.0f / DM) + NORM_EPS); }
}
struct EpiSwiGLU {
    static constexpr bool PERM = true, AFTER_DRAIN = false;
    bf16_t* hid; const float* ssq;
    __device__ __forceinline__ void operator()(const Acc& acc, const Unit& u, int wr, int wc, int fr, int fq) const {
        const int row0 = u.pm * 256 + wr * 64 + fr;
        float rs[8]; rstd8(ssq, row0, fq, rs);
#pragma unroll
        for (int ai = 0; ai < 2; ++ai)
#pragma unroll
            for (int m = 0; m < 4; ++m) {
                const int row = row0 + ai * 128 + m * 16; const float r1 = rs[ai * 4 + m];
                f32x4 o[2];
#pragma unroll
                for (int n = 0; n < 2; ++n) {
                    const f32x4 gs = acc[ai][0][m][n] * r1, us = acc[ai][1][m][n] * r1, t = gs * -1.4426950408889634f;
                    f32x4 d; d[0] = __builtin_amdgcn_exp2f(t[0]); d[1] = __builtin_amdgcn_exp2f(t[1]); d[2] = __builtin_amdgcn_exp2f(t[2]); d[3] = __builtin_amdgcn_exp2f(t[3]);
                    d = d + 1.0f;
                    f32x4 r; r[0] = __builtin_amdgcn_rcpf(d[0]); r[1] = __builtin_amdgcn_rcpf(d[1]); r[2] = __builtin_amdgcn_rcpf(d[2]); r[3] = __builtin_amdgcn_rcpf(d[3]);
                    o[n] = (gs * us) * r;
                }
                *(u32x4*)(hid + (size_t)row * FF + u.pn * 128 + wc * 32 + 8 * fq) = pack8(o[0], o[1]);
            }
    }
};
struct EpiResid {
    static constexpr bool PERM = true, AFTER_DRAIN = false;
    bf16_t* hb; float* ssq_out; float scale;
    __device__ __forceinline__ void operator()(const Acc& acc, const Unit& u, int wr, int wc, int fr, int fq) const {
        const int row0 = u.pm * 256 + wr * 64 + fr;
#pragma unroll
        for (int ai = 0; ai < 2; ++ai) {
            u32x4 old[4][2];
#pragma unroll
            for (int m = 0; m < 4; ++m) { const int row = row0 + ai * 128 + m * 16; const bf16_t* bp = hb + (size_t)row * DM + u.pn * 256 + wc * 32 + 8 * fq;
#pragma unroll
                for (int bj = 0; bj < 2; ++bj) old[m][bj] = row < T_ROWS ? *(const u32x4*)(bp + bj * 128) : (u32x4){0u, 0u, 0u, 0u}; }
#pragma unroll
            for (int m = 0; m < 4; ++m) {
                const int row = row0 + ai * 128 + m * 16; const bool ok = row < T_ROWS; bf16_t* bp = hb + (size_t)row * DM + u.pn * 256 + wc * 32 + 8 * fq;
                float ss = 0.f;
#pragma unroll
                for (int bj = 0; bj < 2; ++bj) {
                    f32x4 a, b; unpack8(old[m][bj], a, b);
                    a = a + acc[ai][bj][m][0] * scale; b = b + acc[ai][bj][m][1] * scale;
                    const u32x4 w = pack8(a, b); if (ok) *(u32x4*)(bp + bj * 128) = w;
                    unpack8(w, a, b);
                    ss += (a[0] * a[0] + a[1] * a[1]) + (a[2] * a[2] + a[3] * a[3]) + (b[0] * b[0] + b[1] * b[1]) + (b[2] * b[2] + b[3] * b[3]);
                }
                ss += __shfl_xor(ss, 16); ss += __shfl_xor(ss, 32);
                if (ok && fq == 0) ssq_out[(size_t)row * 16 + u.pn * 4 + wc] = ss;
            }
            asm volatile("" ::: "memory");
        }
    }
};
struct EpiWin {
    static constexpr bool PERM = true, AFTER_DRAIN = false;
    bf16_t *q, *k, *v, *cb, *z; const float* ssq; const float* rope; const float* qg; const float* kg;
    __device__ __forceinline__ void operator()(const Acc& acc, const Unit& u, int wr, int wc, int fr, int fq) const {
        const int pn = u.pn; const int row0 = u.pm * 256 + wr * 64 + fr;
        float rs[8]; rstd8(ssq, row0, fq, rs);
        if (pn <= 4) {
            const float* g = pn < 4 ? qg : kg; const float osc = pn < 4 ? QSCALE : 1.0f;
            f32x4 G[2][2];
#pragma unroll
            for (int bj = 0; bj < 2; ++bj)
#pragma unroll
                for (int n = 0; n < 2; ++n) G[bj][n] = *(const f32x4*)(g + 32 * bj + 16 * n + 4 * fq) * osc;
#pragma unroll
            for (int ai = 0; ai < 2; ++ai)
#pragma unroll
                for (int mp = 0; mp < 2; ++mp) {
                    f32x4 cs[2][2][2];
#pragma unroll
                    for (int mm = 0; mm < 2; ++mm) { int pos, L; rowinfo(row0 + ai * 128 + (2 * mp + mm) * 16, pos, L);
#pragma unroll
                        for (int bj = 0; bj < 2; ++bj) { cs[mm][bj][0] = *(const f32x4*)(rope + ((pos * 2 + bj) * 2 + 0) * 16 + 4 * fq); cs[mm][bj][1] = *(const f32x4*)(rope + ((pos * 2 + bj) * 2 + 1) * 16 + 4 * fq); } }
#pragma unroll
                    for (int mm = 0; mm < 2; ++mm) {
                        const int m = 2 * mp + mm; const int row = row0 + ai * 128 + m * 16; const float r1 = rs[ai * 4 + m];
                        f32x4 x[2][2]; float ss = 0.f;
#pragma unroll
                        for (int bj = 0; bj < 2; ++bj)
#pragma unroll
                            for (int n = 0; n < 2; ++n) { x[bj][n] = acc[ai][bj][m][n] * r1; const f32x4 t = x[bj][n] * x[bj][n]; ss += (t[0] + t[1]) + (t[2] + t[3]); }
                        ss += __shfl_xor(ss, 16); ss += __shfl_xor(ss, 32);
                        const float rn = __builtin_amdgcn_rsqf(ss * (1.0f / 64.0f) + NORM_EPS);
                        bf16_t* dst = pn < 4 ? q + (size_t)row * 1024 + (4 * pn + wc) * 64 + 8 * fq : k + (size_t)row * 256 + wc * 64 + 8 * fq;
#pragma unroll
                        for (int bj = 0; bj < 2; ++bj) {
                            const f32x4 c4 = cs[mm][bj][0], s4 = cs[mm][bj][1];
                            const f32x4 y1 = x[bj][0] * rn * G[bj][0], y2 = x[bj][1] * rn * G[bj][1];
                            const f32x4 o1 = y1 * c4 - y2 * s4, o2 = y2 * c4 + y1 * s4;
                            *(u32x4*)(dst + 32 * bj) = pack8(o1, o2);
                        }
                    }
                    asm volatile("" ::: "memory");
                }
        } else if (pn < 10) {
            bf16_t* base; int pitch, c0;
            if (pn == 5) { base = v; pitch = 256; c0 = 0; } else { base = cb; pitch = 1024; c0 = 256 * (pn - 6); }
#pragma unroll
            for (int ai = 0; ai < 2; ++ai)
#pragma unroll
                for (int m = 0; m < 4; ++m) {
                    const int row = row0 + ai * 128 + m * 16; const float r1 = rs[ai * 4 + m];
#pragma unroll
                    for (int bj = 0; bj < 2; ++bj) *(u32x4*)(base + (size_t)row * pitch + c0 + 128 * bj + wc * 32 + 8 * fq) = pack8(acc[ai][bj][m][0] * r1, acc[ai][bj][m][1] * r1);
                }
        } else {
#pragma unroll
            for (int ai = 0; ai < 2; ++ai)
#pragma unroll
                for (int m = 0; m < 4; ++m) {
                    const int row = row0 + ai * 128 + m * 16; const float r1 = rs[ai * 4 + m], rs2 = r1 * r1;
                    *(u32x4*)(z + (size_t)row * 1024 + 128 * (pn - 10) + wc * 32 + 8 * fq) = pack8(acc[ai][0][m][0] * acc[ai][1][m][0] * rs2, acc[ai][0][m][1] * acc[ai][1][m][1] * rs2);
                }
        }
    }
};
struct EpiMerge {
    static constexpr bool PERM = true, AFTER_DRAIN = false;
    bf16_t* merged; u32x4* scr; const float* ssq; int tid;
    __device__ __forceinline__ void operator()(const Acc& acc, const Unit& u, int wr, int wc, int fr, int fq) const {
        const int sub = u.sub; const int row0 = u.pm * 256 + wr * 64 + fr;
        char* mb = (char*)(merged + (size_t)row0 * DM + u.pn * 256 + wc * 32 + 8 * fq); asm volatile("" : "+v"(mb));
        char* sb = (char*)(scr + tid); asm volatile("" : "+v"(sb));
#define MP(ai, m, bj) ((u32x4*)(mb + ((ai) * 128 + (m) * 16) * (DM * 2) + (bj) * 256))
#define SP(ai, m, bj) ((u32x4*)(sb + ((((ai) * 4 + (m)) * 2 + (bj)) * 512) * 16))
        if ((sub & 1) == 0) {
            float rs[8]; rstd8(ssq, row0, fq, rs);
#pragma unroll
            for (int ai = 0; ai < 2; ++ai)
#pragma unroll
                for (int m = 0; m < 4; ++m) {
                    const float r1 = rs[ai * 4 + m];
#pragma unroll
                    for (int bj = 0; bj < 2; ++bj) {
                        f32x4 s0, s1; const f32x4 v0 = acc[ai][bj][m][0], v1 = acc[ai][bj][m][1];
#pragma unroll
                        for (int e = 0; e < 4; ++e) { s0[e] = sigmoidf_(v0[e] * r1); s1[e] = sigmoidf_(v1[e] * r1); }
                        if (sub == 0) *MP(ai, m, bj) = pack8(s0, s1); else *SP(ai, m, bj) = pack8(s0, s1);
                    }
                }
        } else if (sub == 1) {
#pragma unroll
            for (int ai = 0; ai < 2; ++ai) {
                u32x4 g[4][2];
#pragma unroll
                for (int m = 0; m < 4; ++m)
#pragma unroll
                    for (int bj = 0; bj < 2; ++bj) g[m][bj] = *MP(ai, m, bj);
#pragma unroll
                for (int m = 0; m < 4; ++m)
#pragma unroll
                    for (int bj = 0; bj < 2; ++bj) { f32x4 g0, g1; unpack8(g[m][bj], g0, g1); *MP(ai, m, bj) = pack8(g0 * acc[ai][bj][m][0], g1 * acc[ai][bj][m][1]); }
                asm volatile("" ::: "memory");
            }
        } else {
#pragma unroll
            for (int ai = 0; ai < 2; ++ai)
#pragma unroll
                for (int mp = 0; mp < 2; ++mp) {
                    u32x4 c[2][2], s[2][2];
#pragma unroll
                    for (int mm = 0; mm < 2; ++mm)
#pragma unroll
                        for (int bj = 0; bj < 2; ++bj) { c[mm][bj] = *MP(ai, 2 * mp + mm, bj); s[mm][bj] = *SP(ai, 2 * mp + mm, bj); }
#pragma unroll
                    for (int mm = 0; mm < 2; ++mm)
#pragma unroll
                        for (int bj = 0; bj < 2; ++bj) { const int m = 2 * mp + mm; f32x4 c0, c1, s0, s1; unpack8(c[mm][bj], c0, c1); unpack8(s[mm][bj], s0, s1);
                            *MP(ai, m, bj) = pack8(c0 + s0 * acc[ai][bj][m][0], c1 + s1 * acc[ai][bj][m][1]); }
                    asm volatile("" ::: "memory");
                }
        }
#undef MP
#undef SP
    }
};

__device__ __forceinline__ void cvt_item(const float* W, int Nsrc, int n0src, const float* gain, bool permqk, bf16* WT, int K, int nrow0, int k0, LAS float* scr, int lane) {
#pragma unroll 8
    for (int i = 0; i < 32; ++i) { const int kk = 2 * i + (lane >> 5); float w = W[(size_t)(k0 + kk) * Nsrc + n0src + (lane & 31)]; if (gain) w *= gain[k0 + kk]; scr[kk * 33 + (lane & 31)] = w; }
    asm volatile("s_waitcnt lgkmcnt(0)" ::: "memory");
    const int c = lane & 7;
#pragma unroll
    for (int j = 0; j < 4; ++j) { const int n = (lane >> 3) + 8 * j; const int ns = permqk ? (16 * ((n >> 2) & 1) + 4 * (n >> 3) + (n & 3)) : n; const LAS float* s = scr + (8 * c) * 33 + ns;
        v4u o; o.x = pk2(s[0 * 33], s[1 * 33]); o.y = pk2(s[2 * 33], s[3 * 33]); o.z = pk2(s[4 * 33], s[5 * 33]); o.w = pk2(s[6 * 33], s[7 * 33]);
        *(GAS v4u*)(WT + (size_t)(nrow0 + n) * K + k0 + 8 * c) = o; }
    asm volatile("s_waitcnt lgkmcnt(0)" ::: "memory");
}
#define RLX_AGENT __ATOMIC_RELAXED, __HIP_MEMORY_SCOPE_AGENT
#define XB_TMO      128
#define XB_XCNT(j)  (256  + 64 * (j))
#define XB_XSUB(j)  (1280 + 64 * (j))
#define XB_XGEN(j)  (2304 + 64 * (j))
#define XB_TOP      3328
#define XB_TOPGEN   3392
#define XCD_BAR_WORDS 3456
#define XB_SPIN_CAP (1u << 18)

__device__ __forceinline__ unsigned xb_ld(unsigned* p)              { return __hip_atomic_load(p, __ATOMIC_RELAXED, __HIP_MEMORY_SCOPE_AGENT); }
__device__ __forceinline__ unsigned xb_add(unsigned* p, unsigned v) { return __hip_atomic_fetch_add(p, v, __ATOMIC_RELAXED, __HIP_MEMORY_SCOPE_AGENT); }
__device__ __forceinline__ unsigned xb_xcc_id() { return (unsigned)__builtin_amdgcn_s_getreg((3 << 11) | 20) & 0xFu; }
#define XB_SPIN(cond, bar) do { unsigned _sp = 0; while (cond) { __builtin_amdgcn_s_sleep(1); \
    if ((++_sp & 255u) == 0u) { if (xb_ld(&(bar)[XB_TMO])) break; if (_sp > XB_SPIN_CAP) { atomicAdd(&(bar)[XB_TMO], 1u); break; } } } } while (0)

struct XcdBarrier {
    unsigned* bar; unsigned x;
    volatile LAS unsigned* st;
};

__device__ __forceinline__ XcdBarrier xcd_barrier_post(unsigned* bar, volatile LAS unsigned* st) {
    XcdBarrier b; b.bar = bar; b.x = xb_xcc_id(); b.st = st;
    if (threadIdx.x == 0) (void)xb_add(&bar[XB_XCNT(b.x)], 1u);
    return b;
}
__device__ __forceinline__ void xcd_barrier_complete(unsigned* bar, unsigned x, unsigned& nloc, unsigned& nx) {
    const unsigned G = gridDim.x * gridDim.y * gridDim.z;
    unsigned sum, cnt, mine, sp = 0u;
    for (;;) {
        sum = 0u; cnt = 0u; mine = 0u;
#pragma unroll
        for (unsigned j = 0; j < 16; ++j) { const unsigned c = xb_ld(&bar[XB_XCNT(j)]); sum += c; cnt += (c > 0u) ? 1u : 0u; mine = (j == x) ? c : mine; }
        if (sum == G) break;
        __builtin_amdgcn_s_sleep(1);
        if ((++sp & 255u) == 0u) { if (xb_ld(&bar[XB_TMO])) break; if (sp > XB_SPIN_CAP) { atomicAdd(&bar[XB_TMO], 1u); break; } }
    }
    nloc = mine > 0u ? mine : 1u; nx = cnt > 0u ? cnt : 1u;
}

__device__ __forceinline__ void xcd_barrier(const XcdBarrier& b) {
    asm volatile("s_waitcnt vmcnt(0)" ::: "memory");
    __syncthreads();
    if (threadIdx.x == 0) {
        unsigned* bar = b.bar;
        __builtin_amdgcn_s_waitcnt(0);
        unsigned nloc = b.st[0], nx = b.st[1];
        if (nloc == 0u) { xcd_barrier_complete(bar, b.x, nloc, nx); b.st[0] = nloc; b.st[1] = nx; }
        const unsigned old = xb_add(&bar[XB_XSUB(b.x)], 1u);
        const unsigned gen = old / nloc;
        if (old + 1u == (gen + 1u) * nloc) {
            __builtin_amdgcn_fence(__ATOMIC_RELEASE, "agent");
            asm volatile("s_waitcnt vmcnt(0)" ::: "memory");
            const unsigned og = xb_add(&bar[XB_TOP], 1u);
            const unsigned tg = og / nx;
            if (og + 1u == (tg + 1u) * nx) xb_add(&bar[XB_TOPGEN], 1u);
            else XB_SPIN(xb_ld(&bar[XB_TOPGEN]) == tg, bar);
            __builtin_amdgcn_fence(__ATOMIC_ACQUIRE, "agent");
            xb_add(&bar[XB_XGEN(b.x)], 1u);
            asm volatile("s_waitcnt vmcnt(0)" ::: "memory");
        } else {
            XB_SPIN(xb_ld(&bar[XB_XGEN(b.x)]) == gen, bar);
            __builtin_amdgcn_fence(__ATOMIC_ACQUIRE, "agent");
            asm volatile("s_waitcnt vmcnt(0)" ::: "memory");
        }
    }
    __syncthreads();
}
struct Args { const float* in[21]; float* out; unsigned char* ws; int ph_lo, ph_hi; };
struct PT {
    volatile LAS unsigned long long* t;
    __device__ __forceinline__ unsigned long long get(int i) const { const unsigned long long v = t[i]; const unsigned lo = __builtin_amdgcn_readfirstlane((unsigned)v), hi = __builtin_amdgcn_readfirstlane((unsigned)(v >> 32)); return ((unsigned long long)hi << 32) | lo; }
    __device__ __forceinline__ const float* in(int i) const { return (const float*)(const GAS float*)get(i); }
    __device__ __forceinline__ float* out() const { return (float*)(GAS float*)get(21); }
    __device__ __forceinline__ unsigned char* ws() const { return (unsigned char*)(GAS unsigned char*)get(22); }
};

__device__ __forceinline__ void cvt_one(const PT a, unsigned char* ws, int l, LAS unsigned char* lds, int it, int wave, int lane) {
    LAS float* scr = (LAS float*)(lds + wave * 16384);
    bf16* W = (bf16*)(ws + WS_W + (size_t)(l & 1) * WBUF);
    const size_t ffo = (size_t)l * DM * FF, sqo = (size_t)l * DM * DM;
    const float* win = a.in(8) + (size_t)l * DM * 6656; const float* mixg = a.in(7) + l * DM;
    {
        int r = it;
        if (r < 2816) { const int kb = r / 176, nb = r % 176, pn = nb >> 3, t = nb & 7; const float* src = (t >> 2) ? a.in(5) + ffo : a.in(4) + ffo;
            cvt_item(src, FF, 128 * pn + 32 * (t & 3), a.in(3) + l * DM, false, (bf16*)((char*)W + W_GU1), 1024, nb * 32, kb * 64, scr, lane); return; } r -= 2816;
        if (r < 1408) { const int kb = r / 32, nb = r % 32; cvt_item(a.in(6) + ffo, DM, nb * 32, nullptr, false, (bf16*)((char*)W + W_D1), FF, nb * 32, kb * 64, scr, lane); return; } r -= 1408;
        if (r < 2304) { const int kb = r / 144, nb = r % 144, pn = nb >> 3, t = nb & 7; int n0; bool pq = false;
            if (pn < 4) { n0 = 64 * (4 * pn + (t & 3)) + 32 * (t >> 2); pq = true; }
            else if (pn == 4) { n0 = 1024 + 64 * (t & 3) + 32 * (t >> 2); pq = true; }
            else if (pn == 5) n0 = 1280 + 32 * t;
            else if (pn < 10) n0 = 1536 + 256 * (pn - 6) + 32 * t;
            else n0 = ((t >> 2) ? 3584 : 2560) + 128 * (pn - 10) + 32 * (t & 3);
            cvt_item(win, 6656, n0, mixg, pq, (bf16*)((char*)W + W_IN), 1024, nb * 32, kb * 64, scr, lane); return; } r -= 2304;
        if (r < 2560) { const int seg = r / 512, q = r % 512, kb = q / 32, nb = q % 32;
            const float* src; int ns, n0; const float* gn = nullptr; size_t dst;
            if (seg == 0) { src = win; ns = 6656; n0 = 5632 + nb * 32; gn = mixg; dst = W_GC; }
            else if (seg == 1) { src = a.in(14) + sqo; ns = DM; n0 = nb * 32; dst = W_OC; }
            else if (seg == 2) { src = win; ns = 6656; n0 = 4608 + nb * 32; gn = mixg; dst = W_GA; }
            else if (seg == 3) { src = a.in(13) + sqo; ns = DM; n0 = nb * 32; dst = W_OA; }
            else { src = a.in(15) + sqo; ns = DM; n0 = nb * 32; dst = W_M; }
            cvt_item(src, ns, n0, gn, false, (bf16*)((char*)W + dst), 1024, nb * 32, kb * 64, scr, lane); return; } r -= 2560;
        if (r < 2816) { const int kb = r / 176, nb = r % 176, pn = nb >> 3, t = nb & 7; const float* src = (t >> 2) ? a.in(18) + ffo : a.in(17) + ffo;
            cvt_item(src, FF, 128 * pn + 32 * (t & 3), a.in(16) + l * DM, false, (bf16*)((char*)W + W_GU2), 1024, nb * 32, kb * 64, scr, lane); return; } r -= 2816;
        { const int kb = r / 32, nb = r % 32; cvt_item(a.in(19) + ffo, DM, nb * 32, nullptr, false, (bf16*)((char*)W + W_D2), FF, nb * 32, kb * 64, scr, lane); }
    }
}

constexpr int CVT_ITEMS = 13312;
__device__ __forceinline__ void convert_static(const PT a, unsigned char* ws, int l, LAS unsigned char* lds, int gw, int NGW, int wave, int lane) {
    for (int it = gw; it < CVT_ITEMS; it += NGW) cvt_one(a, ws, l, lds, it, wave, lane);
}
__device__ __forceinline__ void convert_dynamic(const PT a, unsigned char* ws, int l, LAS unsigned char* lds, unsigned* ctr, int lo, int hi, int wave, int lane) {
    for (;;) {
        unsigned b = 0; if (lane == 0) b = atomicAdd(ctr, 4u);
        const int base = lo + (int)__builtin_amdgcn_readfirstlane(b);
        if (base >= hi) break;
        for (int k = 0; k < 4; ++k) { if (base + k < hi) cvt_one(a, ws, l, lds, base + k, wave, lane); }
    }
}
__device__ __forceinline__ void prologue(const PT a, unsigned char* ws, int tid, int wave, int lane, int bid, int G) {
    const int gtid = bid * 512 + tid, GT = G * 512, gw = bid * NWAVES + wave, NGW = G * NWAVES;
    float* ssq = (float*)(ws + WS_SSQ); bf16* hb = (bf16*)(ws + WS_HB); float* rope = (float*)(ws + WS_ROPE);
    for (int i = gtid; i < (TPAD - T_ROWS) * 16; i += GT) ssq[(size_t)T_ROWS * 16 + i] = 0.f;
    for (int i = gtid; i < (TPAD - T_ROWS) * DM / 8; i += GT) ((v4u*)(hb + (size_t)T_ROWS * DM))[i] = (v4u){0u, 0u, 0u, 0u};
    if (gtid < 64) ((unsigned*)(ws + WS_CTL))[gtid] = 0u;
    for (int i = gtid; i < LP * 32; i += GT) {
        const int pos = i >> 5, axis = (i >> 4) & 1, f = i & 15;
        float coord; if (pos < 16) coord = axis ? (float)pos : -1.0f; else { const int t = pos - 16; coord = axis ? (float)(t & 63) : (float)(t >> 6); }
        const float inv = powf(10000.0f, -(float)f * (1.0f / 16.0f)); const float ang = coord * inv;
        float s, c; sincosf(ang, &s, &c);
        rope[((pos * 2 + axis) * 2 + 0) * 16 + f] = c; rope[((pos * 2 + axis) * 2 + 1) * 16 + f] = s;
    }
    for (int r = gw; r < T_ROWS; r += NGW) {
        int pos, L; rowinfo(r, pos, L);
        const float* src;
        if (pos < 16) src = a.in(2) + (size_t)pos * DM;
        else if (r < ROWS_P) src = a.in(0) + ((size_t)(r / LP) * 4096 + pos - 16) * DM;
        else src = a.in(1) + ((size_t)((r - ROWS_P) / LS) * 2048 + pos - 16) * DM;
        f32x4 v[4]; float s = 0.f;
        unsigned long long* o8 = (unsigned long long*)(hb + (size_t)r * DM) + lane;
#pragma unroll
        for (int j = 0; j < 4; ++j) { v[j] = ((const f32x4*)src)[lane + 64 * j];
            const unsigned lo = pk2(v[j][0], v[j][1]), hi = pk2(v[j][2], v[j][3]); o8[64 * j] = (unsigned long long)lo | ((unsigned long long)hi << 32);
            const float a0 = bflo(lo), a1 = bfhi(lo), a2 = bflo(hi), a3 = bfhi(hi); s += (a0 * a0 + a1 * a1) + (a2 * a2 + a3 * a3); }
        s = wave_sum(s);
        if (lane < 16) ssq[(size_t)r * 16 + lane] = lane == 0 ? s : 0.f;
    }
}

constexpr int NSTRIP = (T_ROWS + 63) / 64;
__device__ __forceinline__ void conv_strip(const PT a, unsigned char* ws, int l, int tid, int strip) {
    bf16* cb = (bf16*)(ws + WS_CB); const bf16* z = (const bf16*)(ws + WS_Z);
    const float* cw = a.in(9) + (size_t)l * 3 * DM; const float* cbias = a.in(10) + (size_t)l * DM;
    const int chunk = tid & 127, sub = tid >> 7, c0 = chunk * 8;
    f32x4 w0[2], w1[2], w2[2], bb[2];
#pragma unroll
    for (int h = 0; h < 2; ++h) { w0[h] = *(const f32x4*)(cw + c0 + 4 * h); w1[h] = *(const f32x4*)(cw + DM + c0 + 4 * h); w2[h] = *(const f32x4*)(cw + 2 * DM + c0 + 4 * h); bb[h] = *(const f32x4*)(cbias + c0 + 4 * h); }
    const int r0 = strip * 64 + sub * 16;
#pragma unroll 4
    for (int i = 0; i < 16; ++i) {
        const int r = r0 + i; if (r >= T_ROWS) break;
        int pos, L; rowinfo(r, pos, L);
        const u32x4 zero = (u32x4){0u, 0u, 0u, 0u};
        const u32x4 zc = *(const u32x4*)(z + (size_t)r * DM + c0);
        const u32x4 zp = pos > 0 ? *(const u32x4*)(z + (size_t)(r - 1) * DM + c0) : zero;
        const u32x4 zn = pos < L - 1 ? *(const u32x4*)(z + (size_t)(r + 1) * DM + c0) : zero;
        u32x4* cp = (u32x4*)(cb + (size_t)r * DM + c0); const u32x4 cv = *cp;
        f32x4 p0, p1, c0v, c1v, n0, n1, b0, b1; unpack8(zp, p0, p1); unpack8(zc, c0v, c1v); unpack8(zn, n0, n1); unpack8(cv, b0, b1);
        const f32x4 o0 = b0 * (w0[0] * p0 + w1[0] * c0v + w2[0] * n0 + bb[0]), o1 = b1 * (w0[1] * p1 + w1[1] * c1v + w2[1] * n1 + bb[1]);
        *cp = pack8(o0, o1);
    }
}

__device__ __forceinline__ void attention_phase(const PT a, unsigned char* ws, int l, unsigned char* lds_generic, int tid, bool dry = false) {
    using abf = attn_body::bf16;
    const abf* Q = (const abf*)(ws + WS_Q); const abf* K = (const abf*)(ws + WS_K); const abf* V = (const abf*)(ws + WS_V); abf* O = dry ? (abf*)(ws + WS_END + MiB) : (abf*)(ws + WS_Q);
    unsigned* ctr = (unsigned*)(ws + WS_CTL) + l + (dry ? 8 : 0);
    volatile unsigned* slot = (volatile unsigned*)(lds_generic + MISC_OFF);
    unsigned pre = 0u; if (tid == 0) pre = atomicAdd(ctr, 1u);
    for (;;) {
        if (tid == 0) { *slot = pre; pre = atomicAdd(ctr, 1u); }
        __syncthreads();
        const int idx = (int)__builtin_amdgcn_readfirstlane(*slot);
        if (idx >= ATT_UNITS + NSTRIP) break;
        int u;
        if (idx < 5 * NSTRIP) { if (idx % 5 == 0) { int tidc = tid; asm volatile("" : "+v"(tidc)); conv_strip(a, ws, l, tidc, idx / 5); __syncthreads(); continue; } u = idx - (idx + 4) / 5; }
        else u = idx - NSTRIP;
        int tidu = tid; asm volatile("" : "+v"(tidu));
        if (u < ATT_UNITS_P) { const int s = u / 260, rem = u - s * 260, kvh = rem / 65, qblk = rem - kvh * 65;
            attn_body::attn_unit<8, LP, 65>((long)s * LP, kvh, qblk, Q, K, V, O, (char*)lds_generic, tidu); }
        else { const int u2 = u - ATT_UNITS_P, s = u2 / 132, rem = u2 - s * 132, kvh = rem / 33, qblk = rem - kvh * 33;
            attn_body::attn_unit<8, LS, 33>((long)ROWS_P + (long)s * LS, kvh, qblk, Q, K, V, O, (char*)lds_generic, tidu); }
    }
}

__device__ __forceinline__ void final_phase(const PT a, unsigned char* ws, int wave, int lane, int bid, int G) {
    const int gw = bid * NWAVES + wave, NGW = G * NWAVES;
    const float* ssq = (const float*)(ws + WS_SSQ); const bf16* hb = (const bf16*)(ws + WS_HB); float* out = a.out();
    f32x4 g[4];
#pragma unroll
    for (int j = 0; j < 4; ++j) g[j] = ((const f32x4*)a.in(20))[lane + 64 * j];
    for (int r = gw; r < T_ROWS; r += NGW) {
        int pos, L; rowinfo(r, pos, L); if (pos < 16) continue;
        float* p = r < ROWS_P ? out + ((size_t)(r / LP) * 4096 + pos - 16) * DM : out + (size_t)NSEQ_P * 4096 * DM + ((size_t)((r - ROWS_P) / LS) * 2048 + pos - 16) * DM;
        const float rs = rstd_of(ssq, r);
        const unsigned long long* i8 = (const unsigned long long*)(hb + (size_t)r * DM) + lane;
#pragma unroll
        for (int j = 0; j < 4; ++j) { const unsigned long long w = i8[64 * j]; const unsigned lo = (unsigned)w, hi = (unsigned)(w >> 32);
            const f32x4 v = (f32x4){bflo(lo), bfhi(lo), bflo(hi), bfhi(hi)}; ((f32x4*)p)[lane + 64 * j] = v * rs * g[j]; }
    }
}

constexpr int NSTEPS = 2 + 8 * NLAYER;

template <int STEP>
__device__ __forceinline__ void run_step(const PT pt, unsigned char* lds, cg::grid_group& grid, XcdBarrier& bar, const int ph_lo, const int ph_hi) {
#ifdef MAX_STEP
    if (STEP >= MAX_STEP && STEP != NSTEPS - 1) return;
#endif
    if (STEP < ph_lo || STEP >= ph_hi) return;
    if (STEP > ph_lo) {
        if (STEP == ph_lo + 1) {
            asm volatile("s_waitcnt vmcnt(0)" ::: "memory"); grid.sync();
            bar = xcd_barrier_post((unsigned*)(pt.ws() + WS_CTL) + CW_BAR, (volatile LAS unsigned*)((LAS unsigned char*)lds + MISC_OFF + 32));
        } else xcd_barrier(bar);
#ifdef DUP_SYNC
        xcd_barrier(bar); xcd_barrier(bar);
#endif
    }
    LAS unsigned char* l3 = (LAS unsigned char*)lds;
    int tid = threadIdx.x; asm volatile("" : "+v"(tid));
    int bid = blockIdx.x; asm volatile("" : "+s"(bid));
    int G = gridDim.x; asm volatile("" : "+s"(G));
    unsigned char* ws = pt.ws();
    const int lane = tid & 63, wave = __builtin_amdgcn_readfirstlane(tid >> 6);
    const int gw = bid * NWAVES + wave, NGW = G * NWAVES;
    float* ssq = (float*)(ws + WS_SSQ);
    bf16_t* hb = (bf16_t*)(ws + WS_HB);
    if constexpr (STEP == 0) { prologue(pt, ws, tid, wave, lane, bid, G); convert_static(pt, ws, 0, l3, gw, NGW, wave, lane); __syncthreads(); }
    else if constexpr (STEP == NSTEPS - 1) { final_phase(pt, ws, wave, lane, bid, G); }
    else {
        constexpr int l = (STEP - 1) / 8, ph = (STEP - 1) % 8 + 1;
        unsigned char* wl = ws + WS_W + (size_t)(l & 1) * WBUF;
        if constexpr (ph == 0) {
        } else if constexpr (ph == 1 || ph == 7) {
            constexpr int f = ph == 7;
            PlainOrder S; S.init(TPAD, 2 * FF, G, bid); S.A = (const char*)hb; S.Bt = (const char*)(wl + (f ? W_GU2 : W_GU1)); S.tstep = (size_t)256 * 1024 * 2;
            pg8::Gemm g{nullptr, nullptr, TPAD, 2 * FF, 1024};
            EpiSwiGLU E{(bf16_t*)(ws + WS_HID), ssq};
#ifndef NO_GU
            pg8::gemm_phase<EpiSwiGLU, PlainOrder, true, true>(l3, g, S, E, tid);
#ifdef DUP_GU
            __syncthreads();
            pg8::gemm_phase<EpiSwiGLU, PlainOrder, true, true>(l3, g, S, E, tid);
#endif
#endif
        } else if constexpr (ph == 2 || ph == 6 || ph == 8) {
            constexpr int f = ph == 8; constexpr int K = ph == 6 ? 1024 : FF;
            PlainOrder S; S.init(TPAD, DM, G, bid);
            S.A = ph == 6 ? (const char*)(ws + WS_Z) : (const char*)(ws + WS_HID);
            S.Bt = (const char*)(wl + (ph == 6 ? W_M : (f ? W_D2 : W_D1))); S.tstep = (size_t)256 * K * 2;
            pg8::Gemm g{nullptr, nullptr, TPAD, DM, K};
#ifdef DUP_DOWN
            EpiResid E{hb, ssq, ph == 6 ? 0.5f : 0.25f};
            pg8::gemm_phase<EpiResid, PlainOrder, true, true>(l3, g, S, E, tid); __syncthreads();
#else
            EpiResid E{hb, ssq, ph == 6 ? 1.0f : 0.5f};
#endif
#ifndef NO_RES
            pg8::gemm_phase<EpiResid, PlainOrder, true, true>(l3, g, S, E, tid);
#endif
            if constexpr (l + 1 < NLAYER && ph != 6) {
                constexpr int part = ph == 2 ? 1 : 2; constexpr int lo = part == 1 ? CVT_ITEMS / 2 : 3 * (CVT_ITEMS / 4), hi = part == 1 ? 3 * (CVT_ITEMS / 4) : CVT_ITEMS;
                convert_dynamic(pt, ws, l + 1, l3, (unsigned*)(ws + WS_CTL) + 16 + 4 * l + part, lo, hi, wave, lane);
                __syncthreads();
            }
        } else if constexpr (ph == 3) {
            PlainOrder S; S.init(TPAD, NWIN, G, bid); S.A = (const char*)hb; S.Bt = (const char*)(wl + W_IN); S.tstep = (size_t)256 * 1024 * 2;
            pg8::Gemm g{nullptr, nullptr, TPAD, NWIN, 1024};
            EpiWin E{(bf16_t*)(ws + WS_Q), (bf16_t*)(ws + WS_K), (bf16_t*)(ws + WS_V), (bf16_t*)(ws + WS_CB), (bf16_t*)(ws + WS_Z), ssq,
                     (const float*)(ws + WS_ROPE), pt.in(11) + l * 64, pt.in(12) + l * 64};
#ifndef NO_WIN
            pg8::gemm_phase<EpiWin, PlainOrder, true, true>(l3, g, S, E, tid);
#ifdef DUP_WIN
            __syncthreads();
            pg8::gemm_phase<EpiWin, PlainOrder, true, true>(l3, g, S, E, tid);
#endif
#endif
        } else if constexpr (ph == 4) {
#ifdef DUP_ATT
            attention_phase(pt, ws, l, lds, tid, true); __syncthreads();
#endif
#ifndef NO_ATT
            attention_phase(pt, ws, l, lds, tid);
#endif
        } else {
            ChainOrder S; S.base.init(TPAD, DM, G, bid); S.tstep = (size_t)256 * 1024 * 2;
            S.A[0] = (const char*)hb; S.A[1] = (const char*)(ws + WS_CB); S.A[2] = (const char*)hb; S.A[3] = (const char*)(ws + WS_Q);
            S.B[0] = (const char*)(wl + W_GC); S.B[1] = (const char*)(wl + W_OC); S.B[2] = (const char*)(wl + W_GA); S.B[3] = (const char*)(wl + W_OA);
            pg8::Gemm g{nullptr, nullptr, TPAD, DM, 1024};
            EpiMerge E{(bf16_t*)(ws + WS_Z), (u32x4*)(ws + WS_SCR + (size_t)bid * 131072), ssq, tid};
#ifndef NO_MERGE
            pg8::gemm_phase<EpiMerge, ChainOrder, true, true>(l3, g, S, E, tid);
#ifdef DUP_MERGE
            __syncthreads();
            pg8::gemm_phase<EpiMerge, ChainOrder, true, true>(l3, g, S, E, tid);
#endif
#endif
            if constexpr (l + 1 < NLAYER) {
                convert_dynamic(pt, ws, l + 1, l3, (unsigned*)(ws + WS_CTL) + 16 + 4 * l + 0, 0, CVT_ITEMS / 2, wave, lane);
                __syncthreads();
            }
        }
    }
}
template <int STEP>
__device__ __forceinline__ void run_from(const PT pt, unsigned char* lds, cg::grid_group& grid, XcdBarrier& bar, const int ph_lo, const int ph_hi) {
    run_step<STEP>(pt, lds, grid, bar, ph_lo, ph_hi);
    if constexpr (STEP + 1 < NSTEPS) run_from<STEP + 1>(pt, lds, grid, bar, ph_lo, ph_hi);
}

__global__ void __launch_bounds__(NWAVES * 64, 2) mega_fwd(Args args) {
    extern __shared__ __attribute__((aligned(16))) unsigned char lds[];
    cg::grid_group grid = cg::this_grid();
    PT pt; pt.t = (volatile LAS unsigned long long*)((LAS unsigned char*)lds + PTAB_OFF);
    if (threadIdx.x == 0) {
#pragma unroll
        for (int i = 0; i < 21; ++i) pt.t[i] = (unsigned long long)args.in[i];
        pt.t[21] = (unsigned long long)args.out; pt.t[22] = (unsigned long long)args.ws;
    }
    if (threadIdx.x < 8) ((volatile LAS unsigned*)((LAS unsigned char*)lds + MISC_OFF + 32))[threadIdx.x] = 0u;
    const int ph_lo = args.ph_lo, ph_hi = args.ph_hi;
    if (blockIdx.x == 0) { unsigned* bw = (unsigned*)(args.ws + WS_CTL) + CW_BAR; for (int i = threadIdx.x; i < XCD_BAR_WORDS; i += NWAVES * 64) bw[i] = 0u; }
    __syncthreads();
    XcdBarrier bar; bar.bar = nullptr; bar.x = 0; bar.st = nullptr;
    run_from<0>(pt, lds, grid, bar, ph_lo, ph_hi);
}

#ifndef LAUNCH_PER_STEP
#define LAUNCH_PER_STEP 0
#endif
extern "C" void kernel_launch(void* const* d_in, const int* in_sizes, int n_in, void* d_out, int out_size, void* d_ws, size_t ws_size, hipStream_t stream) {
    static int grid = 0;
    if (grid == 0) {
        if (n_in != 21 || ws_size < WS_END) { fprintf(stderr, "kernel_launch: need 21 inputs and >= %zu bytes of workspace; got %d, %zu\n", (size_t)WS_END, n_in, ws_size); grid = -1; return; }
        int dev = 0, cus = 0, per_cu = 0;
        hipGetDevice(&dev); hipDeviceGetAttribute(&cus, hipDeviceAttributeMultiprocessorCount, dev);
        if (hipFuncSetAttribute((const void*)mega_fwd, hipFuncAttributeMaxDynamicSharedMemorySize, LDS_BYTES) != hipSuccess) { fprintf(stderr, "kernel_launch: hipFuncSetAttribute failed\n"); grid = -1; return; }
        if (hipOccupancyMaxActiveBlocksPerMultiprocessor(&per_cu, (const void*)mega_fwd, NWAVES * 64, LDS_BYTES) != hipSuccess || per_cu < 1) per_cu = 1;
        (void)hipGetLastError();
        grid = cus * per_cu;
    }
    if (grid < 0) return;
    Args a{};
    for (int i = 0; i < 21; ++i) a.in[i] = (const float*)d_in[i];
    a.out = (float*)d_out; a.ws = (unsigned char*)d_ws;
#if LAUNCH_PER_STEP
    for (int s = 0; s < NSTEPS; ++s) { a.ph_lo = s; a.ph_hi = s + 1; void* kargs[] = {&a}; hipLaunchCooperativeKernel((void*)mega_fwd, dim3(grid), dim3(NWAVES * 64), kargs, LDS_BYTES, stream); }
#else
    a.ph_lo = 0; a.ph_hi = NSTEPS; void* kargs[] = {&a};
    hipError_t e = hipLaunchCooperativeKernel((void*)mega_fwd, dim3(grid), dim3(NWAVES * 64), kargs, LDS_BYTES, stream);
    if (e != hipSuccess) fprintf(stderr, "cooperative launch failed: %s (grid %d)\n", hipGetErrorString(e), grid);
#endif
}
```

```cpp
#include <hip/hip_runtime.h>
#include <hip/hip_cooperative_groups.h>
#include <hip/hip_bf16.h>
#include <cstdio>
#include <cstdint>
#include <cmath>
namespace cg = cooperative_groups;
namespace pg8 {
#define PG8_LAS __attribute__((address_space(3)))
typedef unsigned short bf16_t;
typedef short bf16x8 __attribute__((ext_vector_type(8)));
typedef float f32x4 __attribute__((ext_vector_type(4)));
typedef unsigned u32x4 __attribute__((ext_vector_type(4)));
constexpr int BM = 256, BK = 64, HALF = 128, HTB = HALF * BK * 2  , STAGE_BYTES = 8 * HTB, NXCD = 8, WGM = 8;

__host__ __device__ __forceinline__ int lds_byte(int r, int c) { const int st = (r >> 4) * 2 + (c >> 5), rr = r & 15, cc = c & 31, ob = rr * 64 + cc * 2; return st * 1024 + (ob ^ (((ob >> 9) & 1) << 5)); }
__host__ __device__ __forceinline__ void stage_rc(int b, int& R, int& C) { const int st = b / 1024, sb = b % 1024, swz = sb ^ (((sb >> 9) & 1) << 5); R = (st >> 1) * 16 + swz / 64; C = (st & 1) * 32 + (swz % 64) / 2; }
__host__ __device__ __forceinline__ int perm32(int rho) { const int n = rho >> 4, i = rho & 15; return 8 * (i >> 2) + 4 * n + (i & 3); }

struct Unit { int pm, pn, sub; };
struct Gemm { const bf16_t* A; const bf16_t* Bt; int M, N, K; };

struct StaticOrder {
    int nM, nN, nwg, G, c;
    __host__ __device__ void init(int M, int N, int G_, int c_) { nM = M / BM; nN = N / BM; nwg = nM * nN; G = G_; c = c_; }
    __host__ __device__ bool next(int i, Unit& u) const {
        const long L = (long)i * G + c; if (L >= nwg) return false;
        int wgid = (int)L; { const int q = nwg / NXCD, r = nwg % NXCD, xcd = wgid % NXCD, off = wgid / NXCD; wgid = (xcd < r ? xcd * (q + 1) : r * (q + 1) + (xcd - r) * q) + off; }
        const int nig = WGM * nN, gid = wgid / nig, fm = gid * WGM, gsz = (nM - fm) < WGM ? (nM - fm) : WGM;
        u.pm = fm + ((wgid % nig) % gsz); u.pn = (wgid % nig) / gsz; u.sub = 0; return true;
    }
    __device__ __forceinline__ void a_ready(const Unit&) const {}
    __device__ __forceinline__ void done(const Unit&) const {}
};

__device__ __forceinline__ unsigned cvt_pk_bf16(float lo, float hi) { unsigned r; asm volatile("v_cvt_pk_bf16_f32 %0, %1, %2" : "=v"(r) : "v"(lo), "v"(hi)); return r; }
typedef float f32x2 __attribute__((ext_vector_type(2)));
template <class Epi, class Sched, bool ALIGN_EPI = false, bool SP2 = false>
__device__ __forceinline__ void gemm_phase(PG8_LAS unsigned char* lds, const Gemm g, const Sched& S, const Epi& E, const int tid) {
    const int wid = __builtin_amdgcn_readfirstlane(tid >> 6), lane = tid & 63, wr = wid >> 2, wc = wid & 3, fr = lane & 15, fq = lane >> 4;
    const int K = g.K, nt = K / BK;
    unsigned voffA[2], voffB[2];
#pragma unroll
    for (int i = 0; i < 2; ++i) { int R, C; stage_rc(tid * 16 + i * 8192, R, C); const int Rb = Epi::PERM ? ((R & ~31) + perm32(R & 31)) : R;
        voffA[i] = (unsigned)(R * K + C) * 2u; voffB[i] = (unsigned)(Rb * K + C) * 2u; }
    const size_t kstep = (size_t)(BK * 2);
    const size_t hstep = (size_t)HALF * K * 2;
        const unsigned ldsw = (unsigned)wid * 1024u;
    const int aoff = lds_byte(wr * 64 + fr, fq * 8), boff = lds_byte(wc * 32 + fr, fq * 8);
#define PG8_SA(b, h) (((b) * 2 + (h)) * HTB)
#define PG8_SB(b, h) ((4 + (b) * 2 + (h)) * HTB)
#define PG8_STAGE(bufoff, gbase, voff) do { _Pragma("unroll") for (int _i = 0; _i < 2; ++_i) \
        __builtin_amdgcn_global_load_lds((const unsigned*)((const char*)(gbase) + (voff)[_i]), (PG8_LAS unsigned*)(lds + (bufoff) + ldsw + _i * 8192), 16, 0, 0); } while (0)
#define PG8_LDA(dst, b, h) do { _Pragma("unroll") for (int m = 0; m < 4; ++m) _Pragma("unroll") for (int k = 0; k < 2; ++k) dst[m][k] = *(const PG8_LAS bf16x8*)(lds + PG8_SA(b, h) + aoff + m * 2048 + k * 1024); } while (0)
#define PG8_LDB(dst, b, h) do { _Pragma("unroll") for (int n = 0; n < 2; ++n) _Pragma("unroll") for (int k = 0; k < 2; ++k) dst[n][k] = *(const PG8_LAS bf16x8*)(lds + PG8_SB(b, h) + boff + n * 2048 + k * 1024); } while (0)
#define PG8_MMA(ai, bj, At, Bt) do { __builtin_amdgcn_s_setprio(1); _Pragma("unroll") for (int m = 0; m < 4; ++m) _Pragma("unroll") for (int n = 0; n < 2; ++n) _Pragma("unroll") for (int k = 0; k < 2; ++k) \
        acc[ai][bj][m][n] = __builtin_amdgcn_mfma_f32_16x16x32_bf16(Bt[n][k], At[m][k], acc[ai][bj][m][n], 0, 0, 0); __builtin_amdgcn_s_setprio(0); } while (0)
#define PG8_WAIT_V(n) asm volatile("s_waitcnt vmcnt(" #n ")" ::: "memory")
#define PG8_WAIT_L(n) asm volatile("s_waitcnt lgkmcnt(" #n ")" ::: "memory")
#define PG8_BAR __builtin_amdgcn_s_barrier()
#define PG8_SCHED __builtin_amdgcn_sched_barrier(0)
    Unit cur, nxt; int ui = 0;
    if (!S.next(0, cur)) return;
    f32x4 acc[2][2][4][2];
#pragma unroll
    for (int a = 0; a < 2; ++a)
#pragma unroll
        for (int b = 0; b < 2; ++b)
#pragma unroll
            for (int m = 0; m < 4; ++m)
#pragma unroll
                for (int n = 0; n < 2; ++n) acc[a][b][m][n] = (f32x4){0.f, 0.f, 0.f, 0.f};
    bf16x8 At[4][2], B0[2][2], B1[2][2];
    const char* cA = S.aptr(cur); const char* cB = S.bptr(cur);
    S.a_ready(cur);
    if constexpr (SP2) {
        PG8_STAGE(PG8_SB(0, 0), cB, voffB); PG8_STAGE(PG8_SB(0, 1), cB + hstep, voffB); PG8_STAGE(PG8_SA(0, 0), cA, voffA); PG8_STAGE(PG8_SA(0, 1), cA + hstep, voffA);
        if (wr == 1) PG8_BAR;
        PG8_WAIT_V(2); PG8_BAR;
        PG8_STAGE(PG8_SB(1, 0), cB + kstep, voffB); PG8_STAGE(PG8_SA(1, 0), cA + kstep, voffA); PG8_STAGE(PG8_SB(1, 1), cB + hstep + kstep, voffB);
        PG8_WAIT_V(6); PG8_BAR;
    } else {
        PG8_STAGE(PG8_SB(0, 0), cB, voffB); PG8_STAGE(PG8_SA(0, 0), cA, voffA); PG8_STAGE(PG8_SB(0, 1), cB + hstep, voffB); PG8_STAGE(PG8_SA(0, 1), cA + hstep, voffA);
        if (wr == 1) PG8_BAR;
        PG8_WAIT_V(4); PG8_BAR;
        PG8_STAGE(PG8_SB(1, 0), cB + kstep, voffB); PG8_STAGE(PG8_SA(1, 0), cA + kstep, voffA); PG8_STAGE(PG8_SB(1, 1), cB + hstep + kstep, voffB);
        PG8_WAIT_V(6); PG8_BAR;
    }
    for (;;) {
        const bool has_next = S.next(ui + 1, nxt);
        const char* nA = has_next ? S.aptr(nxt) : cA; const char* nB = has_next ? S.bptr(nxt) : cB;
        for (int t = 0; t < nt; t += 2) {
            const bool last = (t == nt - 2);
            const char* a1 = cA + (size_t)(t + 1) * kstep;
            const char* a2 = last ? nA : cA + (size_t)(t + 2) * kstep; const char* b2 = last ? nB : cB + (size_t)(t + 2) * kstep;
            const char* a3 = a2 + kstep; const char* b3 = b2 + kstep;
            if (last && has_next) S.a_ready(nxt);
            if constexpr (SP2) {
            PG8_LDB(B0, 0, 0); PG8_LDB(B1, 0, 1); PG8_SCHED; PG8_LDA(At, 0, 0); PG8_STAGE(PG8_SA(1, 1), a1 + hstep, voffA);
            PG8_WAIT_V(8); PG8_WAIT_L(0); PG8_BAR; PG8_MMA(0, 0, At, B0); PG8_MMA(0, 1, At, B1); PG8_BAR; PG8_SCHED;
            PG8_LDA(At, 0, 1); PG8_STAGE(PG8_SB(0, 0), b2, voffB); PG8_STAGE(PG8_SB(0, 1), b2 + hstep, voffB); PG8_STAGE(PG8_SA(0, 0), a2, voffA);
            PG8_WAIT_V(8); PG8_WAIT_L(0); PG8_BAR; PG8_MMA(1, 0, At, B0); PG8_MMA(1, 1, At, B1); PG8_BAR; PG8_SCHED;
            PG8_LDB(B0, 1, 0); PG8_LDB(B1, 1, 1); PG8_SCHED; PG8_LDA(At, 1, 0); PG8_STAGE(PG8_SA(0, 1), a2 + hstep, voffA);
            PG8_WAIT_V(8); PG8_WAIT_L(0); PG8_BAR; PG8_MMA(0, 0, At, B0); PG8_MMA(0, 1, At, B1); PG8_BAR; PG8_SCHED;
            PG8_LDA(At, 1, 1); PG8_STAGE(PG8_SB(1, 0), b3, voffB); PG8_STAGE(PG8_SB(1, 1), b3 + hstep, voffB); PG8_STAGE(PG8_SA(1, 0), a3, voffA);
            PG8_WAIT_V(8); PG8_WAIT_L(0); PG8_BAR; PG8_MMA(1, 0, At, B0); PG8_MMA(1, 1, At, B1); PG8_BAR; PG8_SCHED;
            } else {
            PG8_LDB(B0, 0, 0); PG8_SCHED; PG8_LDA(At, 0, 0); PG8_STAGE(PG8_SA(1, 1), a1 + hstep, voffA);
            PG8_WAIT_L(8); PG8_BAR; PG8_WAIT_L(0); PG8_MMA(0, 0, At, B0); PG8_BAR; PG8_SCHED;
            PG8_LDB(B1, 0, 1); PG8_STAGE(PG8_SB(0, 0), b2, voffB);
            PG8_BAR; PG8_WAIT_L(0); PG8_MMA(0, 1, At, B1); PG8_BAR;
            PG8_LDA(At, 0, 1); PG8_STAGE(PG8_SA(0, 0), a2, voffA);
            PG8_BAR; PG8_WAIT_L(0); PG8_MMA(1, 0, At, B0); PG8_BAR; PG8_SCHED;
            PG8_STAGE(PG8_SB(0, 1), b2 + hstep, voffB);
            PG8_WAIT_V(6); PG8_BAR; PG8_MMA(1, 1, At, B1); PG8_BAR;
            PG8_LDB(B0, 1, 0); PG8_SCHED; PG8_LDA(At, 1, 0); PG8_STAGE(PG8_SA(0, 1), a2 + hstep, voffA);
            PG8_WAIT_L(8); PG8_BAR; PG8_WAIT_L(0); PG8_MMA(0, 0, At, B0); PG8_BAR; PG8_SCHED;
            PG8_LDB(B1, 1, 1); PG8_STAGE(PG8_SB(1, 0), b3, voffB);
            PG8_BAR; PG8_WAIT_L(0); PG8_MMA(0, 1, At, B1); PG8_BAR;
            PG8_LDA(At, 1, 1); PG8_STAGE(PG8_SA(1, 0), a3, voffA);
            PG8_BAR; PG8_WAIT_L(0); PG8_MMA(1, 0, At, B0); PG8_BAR; PG8_SCHED;
            PG8_STAGE(PG8_SB(1, 1), b3 + hstep, voffB);
            PG8_WAIT_V(6); PG8_BAR; PG8_MMA(1, 1, At, B1); PG8_BAR;
            }
        }
        if constexpr (ALIGN_EPI) { if (wr == 0) PG8_BAR; }
        if constexpr (!Epi::AFTER_DRAIN) { E(acc, cur, wr, wc, fr, fq); S.done(cur); }
        if (!has_next) break;
#pragma unroll
        for (int a = 0; a < 2; ++a)
#pragma unroll
            for (int b = 0; b < 2; ++b)
#pragma unroll
                for (int m = 0; m < 4; ++m)
#pragma unroll
                    for (int n = 0; n < 2; ++n) acc[a][b][m][n] = (f32x4){0.f, 0.f, 0.f, 0.f};
        cur = nxt; cA = nA; cB = nB; ++ui;
        if constexpr (ALIGN_EPI) { if (wr == 1) PG8_BAR; }
    }
    PG8_WAIT_V(0);
    if constexpr (!ALIGN_EPI) { if (wr == 0) PG8_BAR; }
    PG8_BAR;
    if constexpr (Epi::AFTER_DRAIN) { E.fused(acc, cur, wr, wc, fr, fq, lds, wid, lane); S.done(cur); }
#undef PG8_SA
#undef PG8_SB
#undef PG8_STAGE
#undef PG8_LDA
#undef PG8_LDB
#undef PG8_MMA
#undef PG8_WAIT_V
#undef PG8_WAIT_L
#undef PG8_BAR
#undef PG8_SCHED
}
}
namespace attn_body {
using bf16=__hip_bfloat16;
using bf16x8=__attribute__((ext_vector_type(8)))short;
using s16x4=__attribute__((ext_vector_type(4)))short;
using f32x16=__attribute__((ext_vector_type(16)))float;
using u32x4=__attribute__((ext_vector_type(4)))unsigned;
constexpr int D=64,QP=1024,KP=256;
constexpr int NW=8,QBLK=32,KVBLK=64;
__device__ __forceinline__ int crow(int r,int hi){return (r&3)+8*(r>>2)+4*hi;}
#define SBAR() __builtin_amdgcn_sched_barrier(0)
__device__ __forceinline__ void kmask(f32x16&p0,f32x16&p1,int rem,int hi){
  const float NEG=-INFINITY;
  #pragma unroll
  for(int r=0;r<16;++r){int kv=4*hi+(r&3)+8*(r>>2); if(kv>=rem)p0[r]=NEG; if(kv+32>=rem)p1[r]=NEG;}
}

constexpr int NSLOT=3, SLOTB=8192;
constexpr int LDS_K=0, LDS_V=NSLOT*SLOTB, LDS_WS=2*NSLOT*SLOTB, LDS_OST=LDS_WS+NW*64*4, LDS_BYTES=LDS_OST+NW*4096;
constexpr float C2=0.125f*1.4426950408889634f;
__device__ __forceinline__ void glds16(const void*gsrc,unsigned lds_dst){unsigned keep;
  asm volatile("s_mov_b32 %0, m0\n\ts_mov_b32 m0, %2\n\ts_nop 0\n\tglobal_load_lds_dwordx4 %1, off\n\ts_mov_b32 m0, %0":"=&s"(keep):"v"(gsrc),"s"(lds_dst):"memory");}
__device__ __forceinline__ float max3f(float a,float b,float c){float r;asm("v_max3_f32 %0, %1, %2, %3":"=v"(r):"v"(a),"v"(b),"v"(c));return r;}
__device__ __forceinline__ float max2f(float a,float b){float r;asm("v_max_f32_e32 %0, %1, %2":"=v"(r):"v"(a),"v"(b));return r;}
__device__ __forceinline__ float fadd_s(float a,float b){float r;asm("v_add_f32_e32 %0, %1, %2":"=v"(r):"v"(a),"v"(b));return r;}
__device__ __forceinline__ float fsub_s(float a,float b){float r;asm("v_sub_f32_e32 %0, %1, %2":"=v"(r):"v"(a),"v"(b));return r;}
typedef float f32x2_t __attribute__((ext_vector_type(2))); typedef __bf16 bf16x2_t __attribute__((ext_vector_type(2)));
__device__ __forceinline__ unsigned cvtpk_s(float lo,float hi){f32x2_t v={lo,hi};bf16x2_t b=__builtin_convertvector(v,bf16x2_t);return __builtin_bit_cast(unsigned,b);}
#define WAIT_BAR(N) asm volatile("s_waitcnt vmcnt(" #N ") lgkmcnt(0)\n\ts_barrier":::"memory")

__device__ __forceinline__ void qkt(f32x16&p0,f32x16&p1,const char*Kslot,const bf16x8*qr,const f32x16&negm,int r32,int hi){
  const char*kb=Kslot+hi*1024+r32*16;
  #pragma unroll
  for(int d0=0;d0<4;++d0){
    const bf16x8 b0=*reinterpret_cast<const bf16x8*>(kb+d0*2048);
    const bf16x8 b1=*reinterpret_cast<const bf16x8*>(kb+d0*2048+512);
    if(d0==0){p0=__builtin_amdgcn_mfma_f32_32x32x16_bf16(b0,qr[0],negm,0,0,0);p1=__builtin_amdgcn_mfma_f32_32x32x16_bf16(b1,qr[0],negm,0,0,0);}
    else{p0=__builtin_amdgcn_mfma_f32_32x32x16_bf16(b0,qr[d0],p0,0,0,0);p1=__builtin_amdgcn_mfma_f32_32x32x16_bf16(b1,qr[d0],p1,0,0,0);}}
}
typedef __attribute__((address_space(3))) const char* lds_cptr;
typedef short v4i16_t __attribute__((ext_vector_type(4)));
__device__ __forceinline__ void kload8(bf16x8*kf,lds_cptr kp){
  kf[0]=*(const __attribute__((address_space(3))) bf16x8*)(kp);      kf[1]=*(const __attribute__((address_space(3))) bf16x8*)(kp+512);
  kf[2]=*(const __attribute__((address_space(3))) bf16x8*)(kp+2048); kf[3]=*(const __attribute__((address_space(3))) bf16x8*)(kp+2560);
  kf[4]=*(const __attribute__((address_space(3))) bf16x8*)(kp+4096); kf[5]=*(const __attribute__((address_space(3))) bf16x8*)(kp+4608);
  kf[6]=*(const __attribute__((address_space(3))) bf16x8*)(kp+6144); kf[7]=*(const __attribute__((address_space(3))) bf16x8*)(kp+6656);
}
__device__ __forceinline__ void kload2(bf16x8*kf,lds_cptr kp,int j){ kf[2*j]=*(const __attribute__((address_space(3))) bf16x8*)(kp+j*2048); kf[2*j+1]=*(const __attribute__((address_space(3))) bf16x8*)(kp+j*2048+512); }
__device__ __forceinline__ s16x4 vtr(lds_cptr p){ return __builtin_bit_cast(s16x4,__builtin_amdgcn_ds_read_tr16_b64_v4i16((__attribute__((address_space(3))) v4i16_t*)p)); }
__device__ __forceinline__ float rowmax(const f32x16&p0,const f32x16&p1){
  float a=max3f(p0[0],p0[1],p1[0]),b=max3f(p0[2],p0[3],p1[1]);a=max3f(a,p1[2],p1[3]);
  #pragma unroll
  for(int r=4;r<16;r+=4){a=max3f(a,p0[r],p0[r+1]);b=max3f(b,p0[r+2],p0[r+3]);a=max3f(a,p1[r],p1[r+1]);b=max3f(b,p1[r+2],p1[r+3]);}
  const float m=max2f(a,b);
  auto rr=__builtin_amdgcn_permlane32_swap(__float_as_uint(m),__float_as_uint(m),false,false);
  return max2f(__uint_as_float(rr[0]),__uint_as_float(rr[1]));
}
__device__ __forceinline__ void pv(f32x16*o,int vb,bf16x8 pa0,bf16x8 pa1,bf16x8 pa2,bf16x8 pa3){
  #pragma unroll
  for(int d0=0;d0<2;++d0){s16x4 lo[4],hi[4];
    #pragma unroll
    for(int ks=0;ks<4;++ks){
      asm volatile("ds_read_b64_tr_b16 %0,%1 offset:%c2":"=&v"(lo[ks]):"v"(vb),"i"(d0*4096+ks*1024):"memory");
      asm volatile("ds_read_b64_tr_b16 %0,%1 offset:%c2":"=&v"(hi[ks]):"v"(vb),"i"(d0*4096+ks*1024+512):"memory");}
    asm volatile("s_waitcnt lgkmcnt(0)":::"memory");SBAR();
    #define PK(k) (bf16x8){lo[k][0],lo[k][1],lo[k][2],lo[k][3],hi[k][0],hi[k][1],hi[k][2],hi[k][3]}
    o[d0]=__builtin_amdgcn_mfma_f32_32x32x16_bf16(pa0,PK(0),o[d0],0,0,0);
    o[d0]=__builtin_amdgcn_mfma_f32_32x32x16_bf16(pa1,PK(1),o[d0],0,0,0);
    o[d0]=__builtin_amdgcn_mfma_f32_32x32x16_bf16(pa2,PK(2),o[d0],0,0,0);
    o[d0]=__builtin_amdgcn_mfma_f32_32x32x16_bf16(pa3,PK(3),o[d0],0,0,0);
    #undef PK
  }
}

#ifndef ATTN_STORE16
#define ATTN_STORE16(p,v) (*(u32x4*)(p)=(v))
#endif
template<int THRL,int L,int NT> __device__ __forceinline__ void attn_unit(long rowbase,int kvh,int qblk,const bf16*Q,const bf16*__restrict__ K,const bf16*__restrict__ V,bf16*O,char*shm,const int tid){
  const int lane=tid&63,r32=lane&31,hi=lane>>5; const int wid=__builtin_amdgcn_readfirstlane(tid>>6);
  const int q0=qblk*64, qh=wid>>1, rh=wid&1;
  const bf16*Qw=Q+(rowbase+q0+rh*QBLK)*QP+(4*kvh+qh)*D;
  const bf16*Kh=K+rowbase*KP+kvh*D,*Vh=V+rowbase*KP+kvh*D;
  const unsigned lds0=(unsigned)(uintptr_t)shm;
  float*wsf=(float*)(shm+LDS_WS)+wid*64;
  const bf16*ksrc=Kh+(long)lane*KP+wid*8;
  const bf16*vsrc=Vh+(long)(16*(wid&3)+(lane>>2))*KP+(wid>>2)*32+(lane&3)*8;
  const unsigned kdst=lds0+LDS_K+wid*1024, vdst=lds0+LDS_V+wid*1024;
  #define DMA_K(t,slot) glds16(ksrc+(long)(t)*KVBLK*KP,(unsigned)__builtin_amdgcn_readfirstlane(kdst+(slot)))
  #define DMA_V(t,slot) glds16(vsrc+(long)(t)*KVBLK*KP,(unsigned)__builtin_amdgcn_readfirstlane(vdst+(slot)))
  const int vb0=(int)(lds0+LDS_V)+((lane>>4)&1)*32+(lane&3)*8+(4*hi+((lane&15)>>2))*64;
  const char*Kbase=shm+LDS_K; bf16x8 kf[8];
  const lds_cptr shm3=(lds_cptr)shm; const lds_cptr kp0=shm3+LDS_K+hi*1024+r32*16; const lds_cptr vp0=shm3+LDS_V+((lane>>4)&1)*32+(lane&3)*8+(4*hi+((lane&15)>>2))*64;
  DMA_K(0,0);DMA_V(0,0);DMA_K(1,SLOTB);
  bf16x8 qr[4];
  #pragma unroll
  for(int d0=0;d0<4;++d0)qr[d0]=*reinterpret_cast<const bf16x8*>(&Qw[(long)r32*QP+d0*16+hi*8]);
  if(q0+rh*QBLK+r32>=L){
    #pragma unroll
    for(int d0=0;d0<4;++d0)qr[d0]=bf16x8{0,0,0,0,0,0,0,0}; }
  float mhat=0.f,l_reg=0.f;f32x16 o[2];o[0]=f32x16{};o[1]=f32x16{};f32x16 negm=f32x16{};asm volatile("":"+v"(negm));
  #define CMASK(P0,P1,t) do{ if((t)>=NT-2)kmask(P0,P1,L-64*(t),hi);}while(0)
  bool resc=false;
  #define START(P0,P1) do{ const float rm=rowmax(P0,P1); resc=false; \
    { const float dl=rm; mhat=fadd_s(mhat,dl); \
      _Pragma("unroll") for(int r=0;r<16;++r){P0[r]=fsub_s(P0[r],dl);P1[r]=fsub_s(P1[r],dl);} \
      _Pragma("unroll") for(int r=0;r<16;++r)negm[r]=-mhat; asm volatile("":"+v"(negm)); } \
    _Pragma("unroll") for(int r=0;r<16;++r)P0[r]=__builtin_amdgcn_exp2f(P0[r]); }while(0)
  #define RESC() do{ if(resc){ asm volatile("s_waitcnt lgkmcnt(0)":::"memory"); \
      _Pragma("unroll") for(int d_=0;d_<2;++d_) _Pragma("unroll") for(int r=0;r<16;++r)o[d_][r]*=wsf[crow(r,hi)]; } }while(0)
  f32x16 pA0,pA1,pB0,pB1;
  int sl_prev=0,sl_cur=0,sl_next=SLOTB;
  #define ROT() do{sl_prev=sl_cur;sl_cur=sl_next;sl_next=(sl_next==(NSLOT-1)*SLOTB)?0:sl_next+SLOTB;}while(0)
  DMA_K(2,2*SLOTB);
  WAIT_BAR(3);
  qkt(pA0,pA1,Kbase,qr,negm,r32,hi);asm volatile("s_nop 15\n\ts_nop 7":"+v"(pA0),"+v"(pA1));CMASK(pA0,pA1,0);
  START(pA0,pA1);
  _Pragma("unroll") for(int r=0;r<16;++r)pA1[r]=__builtin_amdgcn_exp2f(pA1[r]);
  WAIT_BAR(0);
  DMA_K(3,0);DMA_V(1,SLOTB);
  ROT();
  kload8(kf,kp0+sl_cur);
  WAIT_BAR(2);
  s16x4 vlo[8],vhi[8]; u32x4 pw0,pw1,pw2,pw3;
  #define PKW(P,B) cvtpk_s(P[B],P[B+1])
  #define PAF(k) __builtin_bit_cast(bf16x8,pw##k)
  #define VFR(i) (bf16x8){vlo[i][0],vlo[i][1],vlo[i][2],vlo[i][3],vhi[i][0],vhi[i][1],vhi[i][2],vhi[i][3]}
  #define PIN(x) asm volatile("":"+v"(x))
  #define MX3(a,b,c) __builtin_fmaxf(__builtin_fmaxf((a),(b)),(c))
  #define GAPA(MF,A0,A1,A2,A3,W0,W1,PW) do{ MF; sacc+=A0; sacc+=A1; sacc+=A2; sacc+=A3; PIN(sacc); W0; W1; PIN(PW); SBAR(); }while(0)
  #define EX(v) __builtin_amdgcn_exp2f(v)
  #define GAPB(MF,X,B) do{ MF; X[B]=EX(X[B]); X[B+1]=EX(X[B+1]); X[B+2]=EX(X[B+2]); X[B+3]=EX(X[B+3]); PIN(X); SBAR(); }while(0)
  #define VRD(i) do{ vlo[i]=vtr(vp_+(((i)>>2)*4096+((i)&3)*1024)); vhi[i]=vtr(vp_+(((i)>>2)*4096+((i)&3)*1024+512)); }while(0)
  #define KRD(G,j) do{ if(G){ kload2(kf,kp0+sl_next,j); SBAR(); } }while(0)
  #define STEP(C0,C1,P0,P1,t,GK,GV,GL) do{ SBAR(); \
    const lds_cptr vp_=vp0+sl_prev; \
    VRD(0); SBAR(); float sacc=(P0[0]+P0[1]); \
    GAPA(C0=__builtin_amdgcn_mfma_f32_32x32x16_bf16(kf[0],qr[0],negm,0,0,0), P0[2],P0[3],P0[4],P0[5],     pw0[0]=PKW(P0,0), pw0[1]=PKW(P0,2), pw0); \
    VRD(4); SBAR(); GAPA(C1=__builtin_amdgcn_mfma_f32_32x32x16_bf16(kf[1],qr[0],negm,0,0,0), P0[6],P0[7],P0[8],P0[9],     pw0[2]=PKW(P0,4), pw0[3]=PKW(P0,6), pw0); \
    VRD(1); SBAR(); GAPA(C0=__builtin_amdgcn_mfma_f32_32x32x16_bf16(kf[2],qr[1],C0,0,0,0),   P0[10],P0[11],P0[12],P0[13], pw1[0]=PKW(P0,8), pw1[1]=PKW(P0,10), pw1); \
    VRD(5); SBAR(); GAPA(C1=__builtin_amdgcn_mfma_f32_32x32x16_bf16(kf[3],qr[1],C1,0,0,0),   P0[14],P0[15],P1[0],P1[1],   pw1[2]=PKW(P0,12),pw1[3]=PKW(P0,14), pw1); \
    VRD(2); SBAR(); GAPA(C0=__builtin_amdgcn_mfma_f32_32x32x16_bf16(kf[4],qr[2],C0,0,0,0),   P1[2],P1[3],P1[4],P1[5],     pw2[0]=PKW(P1,0), pw2[1]=PKW(P1,2), pw2); \
    VRD(6); SBAR(); GAPA(C1=__builtin_amdgcn_mfma_f32_32x32x16_bf16(kf[5],qr[2],C1,0,0,0),   P1[6],P1[7],P1[8],P1[9],     pw2[2]=PKW(P1,4), pw2[3]=PKW(P1,6), pw2); \
    VRD(3); SBAR(); GAPA(C0=__builtin_amdgcn_mfma_f32_32x32x16_bf16(kf[6],qr[3],C0,0,0,0),   P1[10],P1[11],P1[12],P1[13], pw3[0]=PKW(P1,8), pw3[1]=PKW(P1,10), pw3); \
    VRD(7); SBAR(); GAPA(C1=__builtin_amdgcn_mfma_f32_32x32x16_bf16(kf[7],qr[3],C1,0,0,0),   P1[14],P1[15],0.f,0.f,       pw3[2]=PKW(P1,12),pw3[3]=PKW(P1,14), pw3); \
    l_reg+=sacc; \
    if(GK){DMA_K((t)+3,sl_cur);} if(GV){DMA_V((t)+1,sl_next);} \
    CMASK(C0,C1,t); \
    { float a=MX3(C0[0],C0[1],C1[0]),b=MX3(C0[2],C0[3],C1[1]); a=MX3(a,C1[2],C1[3]); \
      _Pragma("unroll") for(int r=4;r<16;r+=4){a=MX3(a,C0[r],C0[r+1]);b=MX3(b,C0[r+2],C0[r+3]);a=MX3(a,C1[r],C1[r+1]);b=MX3(b,C1[r+2],C1[r+3]);} \
      float rm=__builtin_fmaxf(a,b); { auto rr=__builtin_amdgcn_permlane32_swap(__float_as_uint(rm),__float_as_uint(rm),false,false); rm=__builtin_fmaxf(__uint_as_float(rr[0]),__uint_as_float(rr[1])); } \
      resc=false; \
      if(__builtin_expect(__any(rm>(float)THRL),0)){ const float dl=__builtin_fmaxf(rm,0.f); mhat+=dl; \
        _Pragma("unroll") for(int r=0;r<16;++r){C0[r]-=dl;C1[r]-=dl;} \
        _Pragma("unroll") for(int r=0;r<16;++r)negm[r]=-mhat; asm volatile("":"+v"(negm)); \
        const float f=__builtin_amdgcn_exp2f(-dl); l_reg*=f; if(hi==0)wsf[r32]=f; resc=true; } } \
    SBAR(); \
    GAPB(o[0]=__builtin_amdgcn_mfma_f32_32x32x16_bf16(PAF(0),VFR(0),o[0],0,0,0), C0,0); \
    GAPB(o[1]=__builtin_amdgcn_mfma_f32_32x32x16_bf16(PAF(0),VFR(4),o[1],0,0,0), C0,4); \
    KRD(GL,0); GAPB(o[0]=__builtin_amdgcn_mfma_f32_32x32x16_bf16(PAF(1),VFR(1),o[0],0,0,0), C0,8); \
    KRD(GL,1); GAPB(o[1]=__builtin_amdgcn_mfma_f32_32x32x16_bf16(PAF(1),VFR(5),o[1],0,0,0), C0,12); \
    KRD(GL,2); GAPB(o[0]=__builtin_amdgcn_mfma_f32_32x32x16_bf16(PAF(2),VFR(2),o[0],0,0,0), C1,0); \
    KRD(GL,3); GAPB(o[1]=__builtin_amdgcn_mfma_f32_32x32x16_bf16(PAF(2),VFR(6),o[1],0,0,0), C1,4); \
    GAPB(o[0]=__builtin_amdgcn_mfma_f32_32x32x16_bf16(PAF(3),VFR(3),o[0],0,0,0), C1,8); \
    GAPB(o[1]=__builtin_amdgcn_mfma_f32_32x32x16_bf16(PAF(3),VFR(7),o[1],0,0,0), C1,12); \
    }while(0)
  int t=1;
  #undef CMASK
  #define CMASK(P0,P1,t) do{}while(0)
  for(;t+5<NT;t+=2){
    STEP(pB0,pB1,pA0,pA1,t,true,true,true);     WAIT_BAR(2); RESC(); ROT();
    STEP(pA0,pA1,pB0,pB1,t+1,true,true,true);   WAIT_BAR(2); RESC(); ROT();
  }
  #undef CMASK
  #define CMASK(P0,P1,t) do{ if((t)>=NT-2)kmask(P0,P1,L-64*(t),hi);}while(0)
  #define ENDW(tt) do{ if((tt)+3<NT){WAIT_BAR(2);} else if((tt)+2<NT){WAIT_BAR(1);} else {WAIT_BAR(0);} }while(0)
  for(;t+1<NT;t+=2){
    STEP(pB0,pB1,pA0,pA1,t,(t+3<NT),(t+1<NT),(t+1<NT));       ENDW(t);   RESC(); ROT();
    STEP(pA0,pA1,pB0,pB1,t+1,(t+4<NT),(t+2<NT),(t+2<NT));     ENDW(t+1); RESC(); ROT();
  }
  #define DRAIN(P0,P1,SL) do{ float sacc=P0[0]+P0[1]; _Pragma("unroll") for(int r=2;r<16;++r)sacc+=P0[r]; _Pragma("unroll") for(int r=0;r<16;++r)sacc+=P1[r]; l_reg+=sacc; \
    pw0=(u32x4){PKW(P0,0),PKW(P0,2),PKW(P0,4),PKW(P0,6)};pw1=(u32x4){PKW(P0,8),PKW(P0,10),PKW(P0,12),PKW(P0,14)};pw2=(u32x4){PKW(P1,0),PKW(P1,2),PKW(P1,4),PKW(P1,6)};pw3=(u32x4){PKW(P1,8),PKW(P1,10),PKW(P1,12),PKW(P1,14)}; \
    SBAR(); pv(o,vb0+(SL),PAF(0),PAF(1),PAF(2),PAF(3)); }while(0)
  if constexpr((NT&1)==0){
    STEP(pB0,pB1,pA0,pA1,NT-1,false,false,false); RESC();
    DRAIN(pB0,pB1,sl_cur);
  } else {
    DRAIN(pA0,pA1,sl_prev);
  }
  #undef DRAIN
  #undef PKW
  #undef PAF
  #undef VFR
  #undef PIN
  #undef MX3
  #undef GAPA
  #undef GAPB
  #undef EX
  #undef VRD
  #undef KRD
  #undef STEP
  #undef ENDW
  {auto rr=__builtin_amdgcn_permlane32_swap(__float_as_uint(l_reg),__float_as_uint(l_reg),false,false);l_reg=__uint_as_float(rr[0])+__uint_as_float(rr[1]);}
  if(hi==0)wsf[32+r32]=l_reg;asm volatile("s_waitcnt lgkmcnt(0)":::"memory");
  float rli[16];
  #pragma unroll
  for(int r=0;r<16;++r)rli[r]=__builtin_amdgcn_rcpf(wsf[32+crow(r,hi)]);
  bf16*Ow=O+(rowbase+q0+rh*QBLK)*QP+(4*kvh+qh)*D;
  { bf16*stg=(bf16*)(shm+LDS_OST)+wid*2048;
    #pragma unroll
    for(int r=0;r<16;++r){const int orow=crow(r,hi);
      #pragma unroll
      for(int d0=0;d0<2;++d0)stg[orow*64+d0*32+r32]=__float2bfloat16(o[d0][r]*rli[r]);}
    asm volatile("s_waitcnt lgkmcnt(0)":::"memory");
    #pragma unroll
    for(int i=0;i<4;++i){const int row=i*8+(lane>>3),ch=lane&7; const u32x4 v=*(const u32x4*)(stg+row*64+ch*8); if(q0+rh*QBLK+row<L)ATTN_STORE16(Ow+(long)row*QP+ch*8,v);} }
  asm volatile("s_waitcnt lgkmcnt(0)\n\ts_barrier":::"memory");
  #undef DMA_K
  #undef DMA_V
  #undef CMASK
  #undef START
  #undef RESC
  #undef ROT
}
constexpr int ATTN_LDS_BYTES=LDS_BYTES;
#undef SBAR
#undef WAIT_BAR
}
constexpr int DM = 1024, FF = 2816, NLAYER = 4;
constexpr int LP = 4112, LS = 2064, NSEQ_P = 4, NSEQ_S = 16, ROWS_P = NSEQ_P * LP  , T_ROWS = ROWS_P + NSEQ_S * LS  ;
constexpr int TPAD = 49664, NMT = TPAD / 256;
constexpr int NWIN = 4608;
constexpr float NORM_EPS = 1e-6f;
constexpr float QSCALE = 0.125f * 1.4426950408889634f;
constexpr int ATT_UNITS_P = NSEQ_P * 4 * 65, ATT_UNITS_S = NSEQ_S * 4 * 33, ATT_UNITS = ATT_UNITS_P + ATT_UNITS_S;

constexpr size_t MiB = 1u << 20;
constexpr int CW_BAR = 4096;
constexpr size_t WS_CTL = 0;
constexpr size_t WS_ROPE = MiB / 4;
constexpr size_t WS_HMETA = 3 * MiB / 2;
constexpr size_t WS_SSQ = 3 * MiB;
constexpr size_t WS_W = 8 * MiB;
constexpr size_t W_GU1 = 0, W_D1 = W_GU1 + (size_t)5632 * 1024 * 2, W_IN = W_D1 + (size_t)1024 * 2816 * 2, W_GC = W_IN + (size_t)NWIN * 1024 * 2, W_OC = W_GC + 2 * MiB,
                 W_GA = W_OC + 2 * MiB, W_OA = W_GA + 2 * MiB, W_M = W_OA + 2 * MiB, W_GU2 = W_M + 2 * MiB, W_D2 = W_GU2 + (size_t)5632 * 1024 * 2, W_END = W_D2 + (size_t)1024 * 2816 * 2;
constexpr size_t WBUF = 56 * MiB;
constexpr size_t WS_HB = 120 * MiB;
constexpr size_t ROWB = (size_t)TPAD * 1024 * 2;
constexpr size_t WS_BIG = WS_HB + 98 * MiB;
constexpr size_t WS_Q = WS_BIG, WS_K = WS_Q + ROWB, WS_V = WS_K + ROWB / 4, WS_CB = WS_V + ROWB / 4, WS_Z = WS_CB + ROWB, WS_END = WS_Z + ROWB;
constexpr size_t WS_HID = WS_BIG;
constexpr size_t WS_SCR = WS_K;
static_assert((CW_BAR + 3456) * 4 <= (int)WS_ROPE && WS_ROPE + (size_t)LP * 64 * 4 <= WS_HMETA && WS_HMETA + (size_t)20 * 16 * 1024 * 4 <= WS_SSQ && WS_SSQ + (size_t)TPAD * 16 * 4 <= WS_W, "d_ws map (small regions)");
static_assert(W_END <= 56 * MiB && ROWB <= 98 * MiB && (size_t)TPAD * FF * 2 <= WS_END - WS_BIG && 256 * 131072 <= ROWB / 2, "d_ws map");

constexpr int RING_BYTES = 131072, MISC_OFF = RING_BYTES + 320, PTAB_OFF = RING_BYTES + 1024, LDS_BYTES = 147456;
constexpr int NWAVES = 8;

#define GAS __attribute__((address_space(1)))
#define LAS __attribute__((address_space(3)))
typedef unsigned short bf16;
typedef unsigned v4u __attribute__((ext_vector_type(4)));
typedef float f32x4 __attribute__((ext_vector_type(4)));
__device__ __forceinline__ unsigned f2bf(float f) { unsigned u = __builtin_bit_cast(unsigned, f); return (u + 0x7fffu + ((u >> 16) & 1u)) >> 16; }
__device__ __forceinline__ unsigned pk2(float lo, float hi) { return pg8::cvt_pk_bf16(lo, hi); }
__device__ __forceinline__ float bflo(unsigned u) { return __builtin_bit_cast(float, u << 16); }
__device__ __forceinline__ float bfhi(unsigned u) { return __builtin_bit_cast(float, u & 0xffff0000u); }
__device__ __forceinline__ float wave_sum(float v) {
#pragma unroll
    for (int o = 1; o < 64; o <<= 1) v += __shfl_xor(v, o);
    return v;
}
__device__ __forceinline__ void rowinfo(int r, int& pos, int& L) {
    if (r < ROWS_P) { L = LP; pos = r % LP; } else if (r < T_ROWS) { L = LS; pos = (r - ROWS_P) % LS; } else { L = 1 << 30; pos = 0; }
}
__device__ __forceinline__ float xsum16(float s) { const auto r = __builtin_amdgcn_permlane16_swap(__float_as_uint(s), __float_as_uint(s), false, false); return __uint_as_float(r[0]) + __uint_as_float(r[1]); }
__device__ __forceinline__ float xsum32(float s) { const auto r = __builtin_amdgcn_permlane32_swap(__float_as_uint(s), __float_as_uint(s), false, false); return __uint_as_float(r[0]) + __uint_as_float(r[1]); }
__device__ __forceinline__ float sigmoidf_(float x) { return __builtin_amdgcn_rcpf(1.0f + __builtin_amdgcn_exp2f(-1.4426950408889634f * x)); }

struct PlainOrder : pg8::StaticOrder {
    const char* A; const char* Bt; size_t tstep;
    __device__ __forceinline__ const char* aptr(const pg8::Unit& u) const { return A + (size_t)u.pm * tstep; }
    __device__ __forceinline__ const char* bptr(const pg8::Unit& u) const { return Bt + (size_t)u.pn * tstep; }
};
struct ChainOrder {
    pg8::StaticOrder base; const char* A[4]; const char* B[4]; size_t tstep;
    __device__ __forceinline__ bool next(int i, pg8::Unit& u) const { if (!base.next(i >> 2, u)) return false; u.sub = i & 3; return true; }
    __device__ __forceinline__ const char* aptr(const pg8::Unit& u) const { const char* p = u.sub == 0 ? A[0] : u.sub == 1 ? A[1] : u.sub == 2 ? A[2] : A[3]; return p + (size_t)u.pm * tstep; }
    __device__ __forceinline__ const char* bptr(const pg8::Unit& u) const { const char* p = u.sub == 0 ? B[0] : u.sub == 1 ? B[1] : u.sub == 2 ? B[2] : B[3]; return p + (size_t)u.pn * tstep; }
    __device__ __forceinline__ void a_ready(const pg8::Unit&) const {}
    __device__ __forceinline__ void done(const pg8::Unit&) const {}
};

using pg8::f32x4; using pg8::u32x4; using pg8::Unit; using pg8::bf16_t;
typedef f32x4 Acc[2][2][4][2];
__device__ __forceinline__ u32x4 pack8(const f32x4 a, const f32x4 b) { u32x4 w; w.x = pk2(a[0], a[1]); w.y = pk2(a[2], a[3]); w.z = pk2(b[0], b[1]); w.w = pk2(b[2], b[3]); return w; }
__device__ __forceinline__ void unpack8(const u32x4 w, f32x4& a, f32x4& b) { a = (f32x4){bflo(w.x), bfhi(w.x), bflo(w.y), bfhi(w.y)}; b = (f32x4){bflo(w.z), bfhi(w.z), bflo(w.w), bfhi(w.w)}; }
__device__ __forceinline__ float rstd_of(const float* ssq, int row) { const f32x4* p = (const f32x4*)(ssq + (size_t)row * 16); const f32x4 a = p[0], b = p[1], c = p[2], d = p[3];
    const float s = (((a[0] + a[1]) + (a[2] + a[3])) + ((b[0] + b[1]) + (b[2] + b[3]))) + (((c[0] + c[1]) + (c[2] + c[3])) + ((d[0] + d[1]) + (d[2] + d[3])));
    return __builtin_amdgcn_rsqf(s * (1.0f / DM) + NORM_EPS); }

__device__ __forceinline__ void rstd8(const float* ssq, int row0, int fq, float (&rs)[8]) {
    f32x4 pr[8];
#pragma unroll
    for (int i = 0; i < 8; ++i) pr[i] = *(const f32x4*)(ssq + (size_t)(row0 + (i >> 2) * 128 + (i & 3) * 16) * 16 + 4 * fq);
#pragma unroll
    for (int i = 0; i < 8; ++i) { float s = (pr[i][0] + pr[i][1]) + (pr[i][2] + pr[i][3]); s = xsum16(s); s = xsum32(s); rs[i] = __builtin_amdgcn_rsqf(s * (1.0f / DM) + NORM_EPS); }
}
struct EpiSwiGLU {
    static constexpr bool PERM = true, AFTER_DRAIN = false;
    bf16_t* hid; const float* ssq;
    __device__ __forceinline__ void operator()(const Acc& acc, const Unit& u, int wr, int wc, int fr, int fq) const {
        const int row0 = u.pm * 256 + wr * 64 + fr;
        float rs[8]; rstd8(ssq, row0, fq, rs);
#pragma unroll
        for (int ai = 0; ai < 2; ++ai)
#pragma unroll
            for (int m = 0; m < 4; ++m) {
                const int row = row0 + ai * 128 + m * 16; const float r1 = rs[ai * 4 + m];
                f32x4 o[2];
#pragma unroll
                for (int n = 0; n < 2; ++n) {
                    const f32x4 gs = acc[ai][0][m][n] * r1, us = acc[ai][1][m][n] * r1, t = gs * -1.4426950408889634f;
                    f32x4 d; d[0] = __builtin_amdgcn_exp2f(t[0]); d[1] = __builtin_amdgcn_exp2f(t[1]); d[2] = __builtin_amdgcn_exp2f(t[2]); d[3] = __builtin_amdgcn_exp2f(t[3]);
                    d = d + 1.0f;
                    f32x4 r; r[0] = __builtin_amdgcn_rcpf(d[0]); r[1] = __builtin_amdgcn_rcpf(d[1]); r[2] = __builtin_amdgcn_rcpf(d[2]); r[3] = __builtin_amdgcn_rcpf(d[3]);
                    o[n] = (gs * us) * r;
                }
                *(u32x4*)(hid + (size_t)row * FF + u.pn * 128 + wc * 32 + 8 * fq) = pack8(o[0], o[1]);
            }
    }
};
struct EpiResid {
    static constexpr bool PERM = true, AFTER_DRAIN = false;
    bf16_t* hb; float* ssq_out; float scale;
    __device__ __forceinline__ void operator()(const Acc& acc, const Unit& u, int wr, int wc, int fr, int fq) const {
        const int row0 = u.pm * 256 + wr * 64 + fr;
#pragma unroll
        for (int ai = 0; ai < 2; ++ai) {
            u32x4 old[4][2];
#pragma unroll
            for (int m = 0; m < 4; ++m) { const int row = row0 + ai * 128 + m * 16; const bf16_t* bp = hb + (size_t)row * DM + u.pn * 256 + wc * 32 + 8 * fq;
#pragma unroll
                for (int bj = 0; bj < 2; ++bj) old[m][bj] = row < T_ROWS ? *(const u32x4*)(bp + bj * 128) : (u32x4){0u, 0u, 0u, 0u}; }
#pragma unroll
            for (int m = 0; m < 4; ++m) {
                const int row = row0 + ai * 128 + m * 16; const bool ok = row < T_ROWS; bf16_t* bp = hb + (size_t)row * DM + u.pn * 256 + wc * 32 + 8 * fq;
                float ss = 0.f;
#pragma unroll
                for (int bj = 0; bj < 2; ++bj) {
                    f32x4 a, b; unpack8(old[m][bj], a, b);
                    a = a + acc[ai][bj][m][0] * scale; b = b + acc[ai][bj][m][1] * scale;
                    const u32x4 w = pack8(a, b); if (ok) *(u32x4*)(bp + bj * 128) = w;
                    unpack8(w, a, b);
                    ss += (a[0] * a[0] + a[1] * a[1]) + (a[2] * a[2] + a[3] * a[3]) + (b[0] * b[0] + b[1] * b[1]) + (b[2] * b[2] + b[3] * b[3]);
                }
                ss = xsum16(ss); ss = xsum32(ss);
                if (ok && fq == 0) ssq_out[(size_t)row * 16 + u.pn * 4 + wc] = ss;
            }
            asm volatile("" ::: "memory");
        }
    }
};
struct EpiWin {
    static constexpr bool PERM = true, AFTER_DRAIN = false;
    bf16_t *q, *k, *v, *cb, *z; const float* ssq; const float* rope; const float* qg; const float* kg;
    __device__ __forceinline__ void operator()(const Acc& acc, const Unit& u, int wr, int wc, int fr, int fq) const {
        const int pn = u.pn; const int row0 = u.pm * 256 + wr * 64 + fr;
        float rs[8]; rstd8(ssq, row0, fq, rs);
        if (pn <= 4) {
            const float* g = pn < 4 ? qg : kg; const float osc = pn < 4 ? QSCALE : 1.0f;
            f32x4 G[2][2];
#pragma unroll
            for (int bj = 0; bj < 2; ++bj)
#pragma unroll
                for (int n = 0; n < 2; ++n) G[bj][n] = *(const f32x4*)(g + 32 * bj + 16 * n + 4 * fq) * osc;
#pragma unroll
            for (int ai = 0; ai < 2; ++ai)
#pragma unroll
                for (int mp = 0; mp < 2; ++mp) {
                    f32x4 cs[2][2][2];
#pragma unroll
                    for (int mm = 0; mm < 2; ++mm) { int pos, L; rowinfo(row0 + ai * 128 + (2 * mp + mm) * 16, pos, L);
#pragma unroll
                        for (int bj = 0; bj < 2; ++bj) { cs[mm][bj][0] = *(const f32x4*)(rope + ((pos * 2 + bj) * 2 + 0) * 16 + 4 * fq); cs[mm][bj][1] = *(const f32x4*)(rope + ((pos * 2 + bj) * 2 + 1) * 16 + 4 * fq); } }
#pragma unroll
                    for (int mm = 0; mm < 2; ++mm) {
                        const int m = 2 * mp + mm; const int row = row0 + ai * 128 + m * 16; const float r1 = rs[ai * 4 + m];
                        f32x4 x[2][2]; float ss = 0.f;
#pragma unroll
                        for (int bj = 0; bj < 2; ++bj)
#pragma unroll
                            for (int n = 0; n < 2; ++n) { x[bj][n] = acc[ai][bj][m][n] * r1; const f32x4 t = x[bj][n] * x[bj][n]; ss += (t[0] + t[1]) + (t[2] + t[3]); }
                        ss = xsum16(ss); ss = xsum32(ss);
                        const float rn = __builtin_amdgcn_rsqf(ss * (1.0f / 64.0f) + NORM_EPS);
                        bf16_t* dst = pn < 4 ? q + (size_t)row * 1024 + (4 * pn + wc) * 64 + 8 * fq : k + (size_t)row * 256 + wc * 64 + 8 * fq;
#pragma unroll
                        for (int bj = 0; bj < 2; ++bj) {
                            const f32x4 c4 = cs[mm][bj][0], s4 = cs[mm][bj][1];
                            const f32x4 y1 = x[bj][0] * rn * G[bj][0], y2 = x[bj][1] * rn * G[bj][1];
                            const f32x4 o1 = y1 * c4 - y2 * s4, o2 = y2 * c4 + y1 * s4;
                            *(u32x4*)(dst + 32 * bj) = pack8(o1, o2);
                        }
                    }
                    asm volatile("" ::: "memory");
                }
        } else if (pn < 10) {
            bf16_t* base; int pitch, c0;
            if (pn == 5) { base = v; pitch = 256; c0 = 0; } else { base = cb; pitch = 1024; c0 = 256 * (pn - 6); }
#pragma unroll
            for (int ai = 0; ai < 2; ++ai)
#pragma unroll
                for (int m = 0; m < 4; ++m) {
                    const int row = row0 + ai * 128 + m * 16; const float r1 = rs[ai * 4 + m];
#pragma unroll
                    for (int bj = 0; bj < 2; ++bj) *(u32x4*)(base + (size_t)row * pitch + c0 + 128 * bj + wc * 32 + 8 * fq) = pack8(acc[ai][bj][m][0] * r1, acc[ai][bj][m][1] * r1);
                }
        } else {
#pragma unroll
            for (int ai = 0; ai < 2; ++ai)
#pragma unroll
                for (int m = 0; m < 4; ++m) {
                    const int row = row0 + ai * 128 + m * 16; const float r1 = rs[ai * 4 + m], rs2 = r1 * r1;
                    *(u32x4*)(z + (size_t)row * 1024 + 128 * (pn - 10) + wc * 32 + 8 * fq) = pack8(acc[ai][0][m][0] * acc[ai][1][m][0] * rs2, acc[ai][0][m][1] * acc[ai][1][m][1] * rs2);
                }
        }
    }
};
struct EpiMerge {
    static constexpr bool PERM = true, AFTER_DRAIN = false;
    bf16_t* merged; u32x4* scr; const float* ssq; int tid;
    __device__ __forceinline__ void operator()(const Acc& acc, const Unit& u, int wr, int wc, int fr, int fq) const {
        const int sub = u.sub; const int row0 = u.pm * 256 + wr * 64 + fr;
        char* mb = (char*)(merged + (size_t)row0 * DM + u.pn * 256 + wc * 32 + 8 * fq); asm volatile("" : "+v"(mb));
        char* sb = (char*)(scr + tid); asm volatile("" : "+v"(sb));
#define MP(ai, m, bj) ((u32x4*)(mb + ((ai) * 128 + (m) * 16) * (DM * 2) + (bj) * 256))
#define SP(ai, m, bj) ((u32x4*)(sb + ((((ai) * 4 + (m)) * 2 + (bj)) * 512) * 16))
        if ((sub & 1) == 0) {
            float rs[8]; rstd8(ssq, row0, fq, rs);
#pragma unroll
            for (int ai = 0; ai < 2; ++ai)
#pragma unroll
                for (int m = 0; m < 4; ++m) {
                    const float r1 = rs[ai * 4 + m];
#pragma unroll
                    for (int bj = 0; bj < 2; ++bj) {
                        f32x4 s0, s1; const f32x4 v0 = acc[ai][bj][m][0], v1 = acc[ai][bj][m][1];
#pragma unroll
                        for (int e = 0; e < 4; ++e) { s0[e] = sigmoidf_(v0[e] * r1); s1[e] = sigmoidf_(v1[e] * r1); }
                        if (sub == 0) *MP(ai, m, bj) = pack8(s0, s1); else *SP(ai, m, bj) = pack8(s0, s1);
                    }
                }
        } else if (sub == 1) {
#pragma unroll
            for (int ai = 0; ai < 2; ++ai) {
                u32x4 g[4][2];
#pragma unroll
                for (int m = 0; m < 4; ++m)
#pragma unroll
                    for (int bj = 0; bj < 2; ++bj) g[m][bj] = *MP(ai, m, bj);
#pragma unroll
                for (int m = 0; m < 4; ++m)
#pragma unroll
                    for (int bj = 0; bj < 2; ++bj) { f32x4 g0, g1; unpack8(g[m][bj], g0, g1); *MP(ai, m, bj) = pack8(g0 * acc[ai][bj][m][0], g1 * acc[ai][bj][m][1]); }
                asm volatile("" ::: "memory");
            }
        } else {
#pragma unroll
            for (int ai = 0; ai < 2; ++ai)
#pragma unroll
                for (int mp = 0; mp < 2; ++mp) {
                    u32x4 c[2][2], s[2][2];
#pragma unroll
                    for (int mm = 0; mm < 2; ++mm)
#pragma unroll
                        for (int bj = 0; bj < 2; ++bj) { c[mm][bj] = *MP(ai, 2 * mp + mm, bj); s[mm][bj] = *SP(ai, 2 * mp + mm, bj); }
#pragma unroll
                    for (int mm = 0; mm < 2; ++mm)
#pragma unroll
                        for (int bj = 0; bj < 2; ++bj) { const int m = 2 * mp + mm; f32x4 c0, c1, s0, s1; unpack8(c[mm][bj], c0, c1); unpack8(s[mm][bj], s0, s1);
                            *MP(ai, m, bj) = pack8(c0 + s0 * acc[ai][bj][m][0], c1 + s1 * acc[ai][bj][m][1]); }
                    asm volatile("" ::: "memory");
                }
        }
#undef MP
#undef SP
    }
};

__device__ __forceinline__ void cvt_item(const float* W, int Nsrc, int n0src, const float* gain, bool permqk, bf16* WT, int K, int nrow0, int k0, LAS float* scr, int lane) {
#pragma unroll 8
    for (int i = 0; i < 32; ++i) { const int kk = 2 * i + (lane >> 5); float w = W[(size_t)(k0 + kk) * Nsrc + n0src + (lane & 31)]; if (gain) w *= gain[k0 + kk]; scr[kk * 33 + (lane & 31)] = w; }
    asm volatile("s_waitcnt lgkmcnt(0)" ::: "memory");
    const int c = lane & 7;
#pragma unroll
    for (int j = 0; j < 4; ++j) { const int n = (lane >> 3) + 8 * j; const int ns = permqk ? (16 * ((n >> 2) & 1) + 4 * (n >> 3) + (n & 3)) : n; const LAS float* s = scr + (8 * c) * 33 + ns;
        v4u o; o.x = pk2(s[0 * 33], s[1 * 33]); o.y = pk2(s[2 * 33], s[3 * 33]); o.z = pk2(s[4 * 33], s[5 * 33]); o.w = pk2(s[6 * 33], s[7 * 33]);
        *(GAS v4u*)(WT + (size_t)(nrow0 + n) * K + k0 + 8 * c) = o; }
    asm volatile("s_waitcnt lgkmcnt(0)" ::: "memory");
}
#define RLX_AGENT __ATOMIC_RELAXED, __HIP_MEMORY_SCOPE_AGENT
#define XB_TMO      128
#define XB_XCNT(j)  (256  + 64 * (j))
#define XB_XSUB(j)  (1280 + 64 * (j))
#define XB_XGEN(j)  (2304 + 64 * (j))
#define XB_TOP      3328
#define XB_TOPGEN   3392
#define XCD_BAR_WORDS 3456
#define XB_SPIN_CAP (1u << 18)

__device__ __forceinline__ unsigned xb_ld(unsigned* p)              { return __hip_atomic_load(p, __ATOMIC_RELAXED, __HIP_MEMORY_SCOPE_AGENT); }
__device__ __forceinline__ unsigned xb_add(unsigned* p, unsigned v) { return __hip_atomic_fetch_add(p, v, __ATOMIC_RELAXED, __HIP_MEMORY_SCOPE_AGENT); }
__device__ __forceinline__ unsigned xb_xcc_id() { return (unsigned)__builtin_amdgcn_s_getreg((3 << 11) | 20) & 0xFu; }
#define XB_SPIN(cond, bar) do { unsigned _sp = 0; while (cond) { __builtin_amdgcn_s_sleep(1); \
    if ((++_sp & 255u) == 0u) { if (xb_ld(&(bar)[XB_TMO])) break; if (_sp > XB_SPIN_CAP) { atomicAdd(&(bar)[XB_TMO], 1u); break; } } } } while (0)

struct XcdBarrier {
    unsigned* bar; unsigned x;
    volatile LAS unsigned* st;
};

__device__ __forceinline__ XcdBarrier xcd_barrier_post(unsigned* bar, volatile LAS unsigned* st) {
    XcdBarrier b; b.bar = bar; b.x = xb_xcc_id(); b.st = st;
    if (threadIdx.x == 0) (void)xb_add(&bar[XB_XCNT(b.x)], 1u);
    return b;
}
__device__ __forceinline__ void xcd_barrier_complete(unsigned* bar, unsigned x, unsigned& nloc, unsigned& nx) {
    const unsigned G = gridDim.x * gridDim.y * gridDim.z;
    unsigned sum, cnt, mine, sp = 0u;
    for (;;) {
        sum = 0u; cnt = 0u; mine = 0u;
#pragma unroll
        for (unsigned j = 0; j < 16; ++j) { const unsigned c = xb_ld(&bar[XB_XCNT(j)]); sum += c; cnt += (c > 0u) ? 1u : 0u; mine = (j == x) ? c : mine; }
        if (sum == G) break;
        __builtin_amdgcn_s_sleep(1);
        if ((++sp & 255u) == 0u) { if (xb_ld(&bar[XB_TMO])) break; if (sp > XB_SPIN_CAP) { atomicAdd(&bar[XB_TMO], 1u); break; } }
    }
    nloc = mine > 0u ? mine : 1u; nx = cnt > 0u ? cnt : 1u;
}

__device__ __forceinline__ void xcd_barrier(const XcdBarrier& b) {
    asm volatile("s_waitcnt vmcnt(0)" ::: "memory");
    __syncthreads();
    if (threadIdx.x == 0) {
        unsigned* bar = b.bar;
        __builtin_amdgcn_s_waitcnt(0);
        unsigned nloc = b.st[0], nx = b.st[1];
        if (nloc == 0u) { xcd_barrier_complete(bar, b.x, nloc, nx); b.st[0] = nloc; b.st[1] = nx; }
        const unsigned old = xb_add(&bar[XB_XSUB(b.x)], 1u);
        const unsigned gen = old / nloc;
        if (old + 1u == (gen + 1u) * nloc) {
            __builtin_amdgcn_fence(__ATOMIC_RELEASE, "agent");
            asm volatile("s_waitcnt vmcnt(0)" ::: "memory");
            const unsigned og = xb_add(&bar[XB_TOP], 1u);
            const unsigned tg = og / nx;
            if (og + 1u == (tg + 1u) * nx) xb_add(&bar[XB_TOPGEN], 1u);
            else XB_SPIN(xb_ld(&bar[XB_TOPGEN]) == tg, bar);
            __builtin_amdgcn_fence(__ATOMIC_ACQUIRE, "agent");
            xb_add(&bar[XB_XGEN(b.x)], 1u);
            asm volatile("s_waitcnt vmcnt(0)" ::: "memory");
        } else {
            XB_SPIN(xb_ld(&bar[XB_XGEN(b.x)]) == gen, bar);
            __builtin_amdgcn_fence(__ATOMIC_ACQUIRE, "agent");
            asm volatile("s_waitcnt vmcnt(0)" ::: "memory");
        }
    }
    __syncthreads();
}
struct Args { const float* in[21]; float* out; unsigned char* ws; int ph_lo, ph_hi; };
struct PT {
    volatile LAS unsigned long long* t;
    __device__ __forceinline__ unsigned long long get(int i) const { const unsigned long long v = t[i]; const unsigned lo = __builtin_amdgcn_readfirstlane((unsigned)v), hi = __builtin_amdgcn_readfirstlane((unsigned)(v >> 32)); return ((unsigned long long)hi << 32) | lo; }
    __device__ __forceinline__ const float* in(int i) const { return (const float*)(const GAS float*)get(i); }
    __device__ __forceinline__ float* out() const { return (float*)(GAS float*)get(21); }
    __device__ __forceinline__ unsigned char* ws() const { return (unsigned char*)(GAS unsigned char*)get(22); }
};

__device__ __forceinline__ void cvt_one(const PT a, unsigned char* ws, int l, LAS unsigned char* lds, int it, int wave, int lane) {
    LAS float* scr = (LAS float*)(lds + wave * 16384);
    bf16* W = (bf16*)(ws + WS_W + (size_t)(l & 1) * WBUF);
    const size_t ffo = (size_t)l * DM * FF, sqo = (size_t)l * DM * DM;
    const float* win = a.in(8) + (size_t)l * DM * 6656; const float* mixg = a.in(7) + l * DM;
    {
        int r = it;
        if (r < 2816) { const int kb = r / 176, nb = r % 176, pn = nb >> 3, t = nb & 7; const float* src = (t >> 2) ? a.in(5) + ffo : a.in(4) + ffo;
            cvt_item(src, FF, 128 * pn + 32 * (t & 3), a.in(3) + l * DM, false, (bf16*)((char*)W + W_GU1), 1024, nb * 32, kb * 64, scr, lane); return; } r -= 2816;
        if (r < 1408) { const int kb = r / 32, nb = r % 32; cvt_item(a.in(6) + ffo, DM, nb * 32, nullptr, false, (bf16*)((char*)W + W_D1), FF, nb * 32, kb * 64, scr, lane); return; } r -= 1408;
        if (r < 2304) { const int kb = r / 144, nb = r % 144, pn = nb >> 3, t = nb & 7; int n0; bool pq = false;
            if (pn < 4) { n0 = 64 * (4 * pn + (t & 3)) + 32 * (t >> 2); pq = true; }
            else if (pn == 4) { n0 = 1024 + 64 * (t & 3) + 32 * (t >> 2); pq = true; }
            else if (pn == 5) n0 = 1280 + 32 * t;
            else if (pn < 10) n0 = 1536 + 256 * (pn - 6) + 32 * t;
            else n0 = ((t >> 2) ? 3584 : 2560) + 128 * (pn - 10) + 32 * (t & 3);
            cvt_item(win, 6656, n0, mixg, pq, (bf16*)((char*)W + W_IN), 1024, nb * 32, kb * 64, scr, lane); return; } r -= 2304;
        if (r < 2560) { const int seg = r / 512, q = r % 512, kb = q / 32, nb = q % 32;
            const float* src; int ns, n0; const float* gn = nullptr; size_t dst;
            if (seg == 0) { src = win; ns = 6656; n0 = 5632 + nb * 32; gn = mixg; dst = W_GC; }
            else if (seg == 1) { src = a.in(14) + sqo; ns = DM; n0 = nb * 32; dst = W_OC; }
            else if (seg == 2) { src = win; ns = 6656; n0 = 4608 + nb * 32; gn = mixg; dst = W_GA; }
            else if (seg == 3) { src = a.in(13) + sqo; ns = DM; n0 = nb * 32; dst = W_OA; }
            else { src = a.in(15) + sqo; ns = DM; n0 = nb * 32; dst = W_M; }
            cvt_item(src, ns, n0, gn, false, (bf16*)((char*)W + dst), 1024, nb * 32, kb * 64, scr, lane); return; } r -= 2560;
        if (r < 2816) { const int kb = r / 176, nb = r % 176, pn = nb >> 3, t = nb & 7; const float* src = (t >> 2) ? a.in(18) + ffo : a.in(17) + ffo;
            cvt_item(src, FF, 128 * pn + 32 * (t & 3), a.in(16) + l * DM, false, (bf16*)((char*)W + W_GU2), 1024, nb * 32, kb * 64, scr, lane); return; } r -= 2816;
        { const int kb = r / 32, nb = r % 32; cvt_item(a.in(19) + ffo, DM, nb * 32, nullptr, false, (bf16*)((char*)W + W_D2), FF, nb * 32, kb * 64, scr, lane); }
    }
}

constexpr int CVT_ITEMS = 13312;
__device__ __forceinline__ void convert_static(const PT a, unsigned char* ws, int l, LAS unsigned char* lds, int gw, int NGW, int wave, int lane) {
    for (int it = gw; it < CVT_ITEMS; it += NGW) cvt_one(a, ws, l, lds, it, wave, lane);
}
__device__ __forceinline__ void convert_dynamic(const PT a, unsigned char* ws, int l, LAS unsigned char* lds, unsigned* ctr, int lo, int hi, int wave, int lane) {
    for (;;) {
        unsigned b = 0; if (lane == 0) b = atomicAdd(ctr, 4u);
        const int base = lo + (int)__builtin_amdgcn_readfirstlane(b);
        if (base >= hi) break;
        for (int k = 0; k < 4; ++k) { if (base + k < hi) cvt_one(a, ws, l, lds, base + k, wave, lane); }
    }
}
__device__ __forceinline__ void prologue(const PT a, unsigned char* ws, int tid, int wave, int lane, int bid, int G) {
    const int gtid = bid * 512 + tid, GT = G * 512, gw = bid * NWAVES + wave, NGW = G * NWAVES;
    float* ssq = (float*)(ws + WS_SSQ); bf16* hb = (bf16*)(ws + WS_HB); float* rope = (float*)(ws + WS_ROPE);
    for (int i = gtid; i < (TPAD - T_ROWS) * 16; i += GT) ssq[(size_t)T_ROWS * 16 + i] = 0.f;
    for (int i = gtid; i < (TPAD - T_ROWS) * DM / 8; i += GT) ((v4u*)(hb + (size_t)T_ROWS * DM))[i] = (v4u){0u, 0u, 0u, 0u};
    if (gtid < 64) ((unsigned*)(ws + WS_CTL))[gtid] = 0u;
    for (int i = gtid; i < LP * 32; i += GT) {
        const int pos = i >> 5, axis = (i >> 4) & 1, f = i & 15;
        float coord; if (pos < 16) coord = axis ? (float)pos : -1.0f; else { const int t = pos - 16; coord = axis ? (float)(t & 63) : (float)(t >> 6); }
        const float inv = powf(10000.0f, -(float)f * (1.0f / 16.0f)); const float ang = coord * inv;
        float s, c; sincosf(ang, &s, &c);
        rope[((pos * 2 + axis) * 2 + 0) * 16 + f] = c; rope[((pos * 2 + axis) * 2 + 1) * 16 + f] = s;
    }
    for (int r = gw; r < T_ROWS; r += NGW) {
        int pos, L; rowinfo(r, pos, L);
        const float* src;
        if (pos < 16) src = a.in(2) + (size_t)pos * DM;
        else if (r < ROWS_P) src = a.in(0) + ((size_t)(r / LP) * 4096 + pos - 16) * DM;
        else src = a.in(1) + ((size_t)((r - ROWS_P) / LS) * 2048 + pos - 16) * DM;
        f32x4 v[4]; float s = 0.f;
        unsigned long long* o8 = (unsigned long long*)(hb + (size_t)r * DM) + lane;
#pragma unroll
        for (int j = 0; j < 4; ++j) { v[j] = ((const f32x4*)src)[lane + 64 * j];
            const unsigned lo = pk2(v[j][0], v[j][1]), hi = pk2(v[j][2], v[j][3]); o8[64 * j] = (unsigned long long)lo | ((unsigned long long)hi << 32);
            const float a0 = bflo(lo), a1 = bfhi(lo), a2 = bflo(hi), a3 = bfhi(hi); s += (a0 * a0 + a1 * a1) + (a2 * a2 + a3 * a3); }
        s = wave_sum(s);
        if (lane < 16) ssq[(size_t)r * 16 + lane] = lane == 0 ? s : 0.f;
    }
}

constexpr int NSTRIP = (T_ROWS + 63) / 64;
__device__ __forceinline__ void conv_strip(const PT a, unsigned char* ws, int l, int tid, int strip) {
    bf16* cb = (bf16*)(ws + WS_CB); const bf16* z = (const bf16*)(ws + WS_Z);
    const float* cw = a.in(9) + (size_t)l * 3 * DM; const float* cbias = a.in(10) + (size_t)l * DM;
    const int chunk = tid & 127, sub = tid >> 7, c0 = chunk * 8;
    f32x4 w0[2], w1[2], w2[2], bb[2];
#pragma unroll
    for (int h = 0; h < 2; ++h) { w0[h] = *(const f32x4*)(cw + c0 + 4 * h); w1[h] = *(const f32x4*)(cw + DM + c0 + 4 * h); w2[h] = *(const f32x4*)(cw + 2 * DM + c0 + 4 * h); bb[h] = *(const f32x4*)(cbias + c0 + 4 * h); }
    const int r0 = strip * 64 + sub * 16;
#pragma unroll 4
    for (int i = 0; i < 16; ++i) {
        const int r = r0 + i; if (r >= T_ROWS) break;
        int pos, L; rowinfo(r, pos, L);
        const u32x4 zero = (u32x4){0u, 0u, 0u, 0u};
        const u32x4 zc = *(const u32x4*)(z + (size_t)r * DM + c0);
        const u32x4 zp = pos > 0 ? *(const u32x4*)(z + (size_t)(r - 1) * DM + c0) : zero;
        const u32x4 zn = pos < L - 1 ? *(const u32x4*)(z + (size_t)(r + 1) * DM + c0) : zero;
        u32x4* cp = (u32x4*)(cb + (size_t)r * DM + c0); const u32x4 cv = *cp;
        f32x4 p0, p1, c0v, c1v, n0, n1, b0, b1; unpack8(zp, p0, p1); unpack8(zc, c0v, c1v); unpack8(zn, n0, n1); unpack8(cv, b0, b1);
        const f32x4 o0 = b0 * (w0[0] * p0 + w1[0] * c0v + w2[0] * n0 + bb[0]), o1 = b1 * (w0[1] * p1 + w1[1] * c1v + w2[1] * n1 + bb[1]);
        *cp = pack8(o0, o1);
    }
}

__device__ __forceinline__ void attention_phase(const PT a, unsigned char* ws, int l, unsigned char* lds_generic, int tid, bool dry = false) {
    using abf = attn_body::bf16;
    const abf* Q = (const abf*)(ws + WS_Q); const abf* K = (const abf*)(ws + WS_K); const abf* V = (const abf*)(ws + WS_V); abf* O = dry ? (abf*)(ws + WS_END + MiB) : (abf*)(ws + WS_Q);
    unsigned* ctr = (unsigned*)(ws + WS_CTL) + l + (dry ? 8 : 0);
    volatile unsigned* slot = (volatile unsigned*)(lds_generic + MISC_OFF);
    unsigned pre = 0u; if (tid == 0) pre = atomicAdd(ctr, 1u);
    for (;;) {
        if (tid == 0) { *slot = pre; pre = atomicAdd(ctr, 1u); }
        __syncthreads();
        const int idx = (int)__builtin_amdgcn_readfirstlane(*slot);
        if (idx >= ATT_UNITS + NSTRIP) break;
        int u;
        if (idx < 5 * NSTRIP) { if (idx % 5 == 0) { int tidc = tid; asm volatile("" : "+v"(tidc)); conv_strip(a, ws, l, tidc, idx / 5); __syncthreads(); continue; } u = idx - (idx + 4) / 5; }
        else u = idx - NSTRIP;
        int tidu = tid; asm volatile("" : "+v"(tidu));
        if (u < ATT_UNITS_P) { const int s = u / 260, rem = u - s * 260, kvh = rem / 65, qblk = rem - kvh * 65;
            attn_body::attn_unit<8, LP, 65>((long)s * LP, kvh, qblk, Q, K, V, O, (char*)lds_generic, tidu); }
        else { const int u2 = u - ATT_UNITS_P, s = u2 / 132, rem = u2 - s * 132, kvh = rem / 33, qblk = rem - kvh * 33;
            attn_body::attn_unit<8, LS, 33>((long)ROWS_P + (long)s * LS, kvh, qblk, Q, K, V, O, (char*)lds_generic, tidu); }
    }
}

__device__ __forceinline__ void final_phase(const PT a, unsigned char* ws, int wave, int lane, int bid, int G) {
    const int gw = bid * NWAVES + wave, NGW = G * NWAVES;
    const float* ssq = (const float*)(ws + WS_SSQ); const bf16* hb = (const bf16*)(ws + WS_HB); float* out = a.out();
    f32x4 g[4];
#pragma unroll
    for (int j = 0; j < 4; ++j) g[j] = ((const f32x4*)a.in(20))[lane + 64 * j];
    for (int r = gw; r < T_ROWS; r += NGW) {
        int pos, L; rowinfo(r, pos, L); if (pos < 16) continue;
        float* p = r < ROWS_P ? out + ((size_t)(r / LP) * 4096 + pos - 16) * DM : out + (size_t)NSEQ_P * 4096 * DM + ((size_t)((r - ROWS_P) / LS) * 2048 + pos - 16) * DM;
        const float rs = rstd_of(ssq, r);
        const unsigned long long* i8 = (const unsigned long long*)(hb + (size_t)r * DM) + lane;
#pragma unroll
        for (int j = 0; j < 4; ++j) { const unsigned long long w = i8[64 * j]; const unsigned lo = (unsigned)w, hi = (unsigned)(w >> 32);
            const f32x4 v = (f32x4){bflo(lo), bfhi(lo), bflo(hi), bfhi(hi)}; ((f32x4*)p)[lane + 64 * j] = v * rs * g[j]; }
    }
}

constexpr int NSTEPS = 2 + 8 * NLAYER;

template <int STEP>
__device__ __forceinline__ void run_step(const PT pt, unsigned char* lds, cg::grid_group& grid, XcdBarrier& bar, const int ph_lo, const int ph_hi) {
#ifdef MAX_STEP
    if (STEP >= MAX_STEP && STEP != NSTEPS - 1) return;
#endif
    if (STEP < ph_lo || STEP >= ph_hi) return;
    if (STEP > ph_lo) {
        if (STEP == ph_lo + 1) {
            asm volatile("s_waitcnt vmcnt(0)" ::: "memory"); grid.sync();
            bar = xcd_barrier_post((unsigned*)(pt.ws() + WS_CTL) + CW_BAR, (volatile LAS unsigned*)((LAS unsigned char*)lds + MISC_OFF + 32));
        } else xcd_barrier(bar);
#ifdef DUP_SYNC
        xcd_barrier(bar); xcd_barrier(bar);
#endif
    }
    LAS unsigned char* l3 = (LAS unsigned char*)lds;
    int tid = threadIdx.x; asm volatile("" : "+v"(tid));
    int bid = blockIdx.x; asm volatile("" : "+s"(bid));
    int G = gridDim.x; asm volatile("" : "+s"(G));
    unsigned char* ws = pt.ws();
    const int lane = tid & 63, wave = __builtin_amdgcn_readfirstlane(tid >> 6);
    const int gw = bid * NWAVES + wave, NGW = G * NWAVES;
    float* ssq = (float*)(ws + WS_SSQ);
    bf16_t* hb = (bf16_t*)(ws + WS_HB);
    if constexpr (STEP == 0) { prologue(pt, ws, tid, wave, lane, bid, G); convert_static(pt, ws, 0, l3, gw, NGW, wave, lane); __syncthreads(); }
    else if constexpr (STEP == NSTEPS - 1) { final_phase(pt, ws, wave, lane, bid, G); }
    else {
        constexpr int l = (STEP - 1) / 8, ph = (STEP - 1) % 8 + 1;
        unsigned char* wl = ws + WS_W + (size_t)(l & 1) * WBUF;
        if constexpr (ph == 0) {
        } else if constexpr (ph == 1 || ph == 7) {
            constexpr int f = ph == 7;
            PlainOrder S; S.init(TPAD, 2 * FF, G, bid); S.A = (const char*)hb; S.Bt = (const char*)(wl + (f ? W_GU2 : W_GU1)); S.tstep = (size_t)256 * 1024 * 2;
            pg8::Gemm g{nullptr, nullptr, TPAD, 2 * FF, 1024};
            EpiSwiGLU E{(bf16_t*)(ws + WS_HID), ssq};
#ifndef NO_GU
            pg8::gemm_phase<EpiSwiGLU, PlainOrder, true, true>(l3, g, S, E, tid);
#ifdef DUP_GU
            __syncthreads();
            pg8::gemm_phase<EpiSwiGLU, PlainOrder, true, true>(l3, g, S, E, tid);
#endif
#endif
        } else if constexpr (ph == 2 || ph == 6 || ph == 8) {
            constexpr int f = ph == 8; constexpr int K = ph == 6 ? 1024 : FF;
            PlainOrder S; S.init(TPAD, DM, G, bid);
            S.A = ph == 6 ? (const char*)(ws + WS_Z) : (const char*)(ws + WS_HID);
            S.Bt = (const char*)(wl + (ph == 6 ? W_M : (f ? W_D2 : W_D1))); S.tstep = (size_t)256 * K * 2;
            pg8::Gemm g{nullptr, nullptr, TPAD, DM, K};
#ifdef DUP_DOWN
            EpiResid E{hb, ssq, ph == 6 ? 0.5f : 0.25f};
            pg8::gemm_phase<EpiResid, PlainOrder, true, true>(l3, g, S, E, tid); __syncthreads();
#else
            EpiResid E{hb, ssq, ph == 6 ? 1.0f : 0.5f};
#endif
#ifndef NO_RES
            pg8::gemm_phase<EpiResid, PlainOrder, true, true>(l3, g, S, E, tid);
#endif
            if constexpr (l + 1 < NLAYER && ph != 6) {
                constexpr int part = ph == 2 ? 1 : 2; constexpr int lo = part == 1 ? CVT_ITEMS / 2 : 3 * (CVT_ITEMS / 4), hi = part == 1 ? 3 * (CVT_ITEMS / 4) : CVT_ITEMS;
                convert_dynamic(pt, ws, l + 1, l3, (unsigned*)(ws + WS_CTL) + 16 + 4 * l + part, lo, hi, wave, lane);
                __syncthreads();
            }
        } else if constexpr (ph == 3) {
            PlainOrder S; S.init(TPAD, NWIN, G, bid); S.A = (const char*)hb; S.Bt = (const char*)(wl + W_IN); S.tstep = (size_t)256 * 1024 * 2;
            pg8::Gemm g{nullptr, nullptr, TPAD, NWIN, 1024};
            EpiWin E{(bf16_t*)(ws + WS_Q), (bf16_t*)(ws + WS_K), (bf16_t*)(ws + WS_V), (bf16_t*)(ws + WS_CB), (bf16_t*)(ws + WS_Z), ssq,
                     (const float*)(ws + WS_ROPE), pt.in(11) + l * 64, pt.in(12) + l * 64};
#ifndef NO_WIN
            pg8::gemm_phase<EpiWin, PlainOrder, true, true>(l3, g, S, E, tid);
#ifdef DUP_WIN
            __syncthreads();
            pg8::gemm_phase<EpiWin, PlainOrder, true, true>(l3, g, S, E, tid);
#endif
#endif
        } else if constexpr (ph == 4) {
#ifdef DUP_ATT
            attention_phase(pt, ws, l, lds, tid, true); __syncthreads();
#endif
#ifndef NO_ATT
            attention_phase(pt, ws, l, lds, tid);
#endif
        } else {
            ChainOrder S; S.base.init(TPAD, DM, G, bid); S.tstep = (size_t)256 * 1024 * 2;
            S.A[0] = (const char*)hb; S.A[1] = (const char*)(ws + WS_CB); S.A[2] = (const char*)hb; S.A[3] = (const char*)(ws + WS_Q);
            S.B[0] = (const char*)(wl + W_GC); S.B[1] = (const char*)(wl + W_OC); S.B[2] = (const char*)(wl + W_GA); S.B[3] = (const char*)(wl + W_OA);
            pg8::Gemm g{nullptr, nullptr, TPAD, DM, 1024};
            EpiMerge E{(bf16_t*)(ws + WS_Z), (u32x4*)(ws + WS_SCR + (size_t)bid * 131072), ssq, tid};
#ifndef NO_MERGE
            pg8::gemm_phase<EpiMerge, ChainOrder, true, true>(l3, g, S, E, tid);
#ifdef DUP_MERGE
            __syncthreads();
            pg8::gemm_phase<EpiMerge, ChainOrder, true, true>(l3, g, S, E, tid);
#endif
#endif
            if constexpr (l + 1 < NLAYER) {
                convert_dynamic(pt, ws, l + 1, l3, (unsigned*)(ws + WS_CTL) + 16 + 4 * l + 0, 0, CVT_ITEMS / 2, wave, lane);
                __syncthreads();
            }
        }
    }
}
template <int STEP>
__device__ __forceinline__ void run_from(const PT pt, unsigned char* lds, cg::grid_group& grid, XcdBarrier& bar, const int ph_lo, const int ph_hi) {
    run_step<STEP>(pt, lds, grid, bar, ph_lo, ph_hi);
    if constexpr (STEP + 1 < NSTEPS) run_from<STEP + 1>(pt, lds, grid, bar, ph_lo, ph_hi);
}

__global__ void __launch_bounds__(NWAVES * 64, 2) mega_fwd(Args args) {
    extern __shared__ __attribute__((aligned(16))) unsigned char lds[];
    cg::grid_group grid = cg::this_grid();
    PT pt; pt.t = (volatile LAS unsigned long long*)((LAS unsigned char*)lds + PTAB_OFF);
    if (threadIdx.x == 0) {
#pragma unroll
        for (int i = 0; i < 21; ++i) pt.t[i] = (unsigned long long)args.in[i];
        pt.t[21] = (unsigned long long)args.out; pt.t[22] = (unsigned long long)args.ws;
    }
    if (threadIdx.x < 8) ((volatile LAS unsigned*)((LAS unsigned char*)lds + MISC_OFF + 32))[threadIdx.x] = 0u;
    const int ph_lo = args.ph_lo, ph_hi = args.ph_hi;
    if (blockIdx.x == 0) { unsigned* bw = (unsigned*)(args.ws + WS_CTL) + CW_BAR; for (int i = threadIdx.x; i < XCD_BAR_WORDS; i += NWAVES * 64) bw[i] = 0u; }
    __syncthreads();
    XcdBarrier bar; bar.bar = nullptr; bar.x = 0; bar.st = nullptr;
    run_from<0>(pt, lds, grid, bar, ph_lo, ph_hi);
}

#ifndef LAUNCH_PER_STEP
#define LAUNCH_PER_STEP 0
#endif
extern "C" void kernel_launch(void* const* d_in, const int* in_sizes, int n_in, void* d_out, int out_size, void* d_ws, size_t ws_size, hipStream_t stream) {
    static int grid = 0;
    if (grid == 0) {
        if (n_in != 21 || ws_size < WS_END) { fprintf(stderr, "kernel_launch: need 21 inputs and >= %zu bytes of workspace; got %d, %zu\n", (size_t)WS_END, n_in, ws_size); grid = -1; return; }
        int dev = 0, cus = 0, per_cu = 0;
        hipGetDevice(&dev); hipDeviceGetAttribute(&cus, hipDeviceAttributeMultiprocessorCount, dev);
        if (hipFuncSetAttribute((const void*)mega_fwd, hipFuncAttributeMaxDynamicSharedMemorySize, LDS_BYTES) != hipSuccess) { fprintf(stderr, "kernel_launch: hipFuncSetAttribute failed\n"); grid = -1; return; }
        if (hipOccupancyMaxActiveBlocksPerMultiprocessor(&per_cu, (const void*)mega_fwd, NWAVES * 64, LDS_BYTES) != hipSuccess || per_cu < 1) per_cu = 1;
        (void)hipGetLastError();
        grid = cus * per_cu;
    }
    if (grid < 0) return;
    Args a{};
    for (int i = 0; i < 21; ++i) a.in[i] = (const float*)d_in[i];
    a.out = (float*)d_out; a.ws = (unsigned char*)d_ws;
#if LAUNCH_PER_STEP
    for (int s = 0; s < NSTEPS; ++s) { a.ph_lo = s; a.ph_hi = s + 1; void* kargs[] = {&a}; hipLaunchCooperativeKernel((void*)mega_fwd, dim3(grid), dim3(NWAVES * 64), kargs, LDS_BYTES, stream); }
#else
    a.ph_lo = 0; a.ph_hi = NSTEPS; void* kargs[] = {&a};
    hipError_t e = hipLaunchCooperativeKernel((void*)mega_fwd, dim3(grid), dim3(NWAVES * 64), kargs, LDS_BYTES, stream);
    if (e != hipSuccess) fprintf(stderr, "cooperative launch failed: %s (grid %d)\n", hipGetErrorString(e), grid);
#endif
}
```

```cpp
#include <hip/hip_runtime.h>
#include <hip/hip_cooperative_groups.h>
#include <hip/hip_bf16.h>
#include <cstdio>
#include <cstdint>
#include <cmath>
namespace cg = cooperative_groups;
namespace pg8 {
#define PG8_LAS __attribute__((address_space(3)))
typedef unsigned short bf16_t;
typedef short bf16x8 __attribute__((ext_vector_type(8)));
typedef float f32x4 __attribute__((ext_vector_type(4)));
typedef unsigned u32x4 __attribute__((ext_vector_type(4)));
constexpr int BM = 256, BK = 64, HALF = 128, HTB = HALF * BK * 2  , STAGE_BYTES = 8 * HTB, NXCD = 8, WGM = 8;

__host__ __device__ __forceinline__ int lds_byte(int r, int c) { const int st = (r >> 4) * 2 + (c >> 5), rr = r & 15, cc = c & 31, ob = rr * 64 + cc * 2; return st * 1024 + (ob ^ (((ob >> 9) & 1) << 5)); }
__host__ __device__ __forceinline__ void stage_rc(int b, int& R, int& C) { const int st = b / 1024, sb = b % 1024, swz = sb ^ (((sb >> 9) & 1) << 5); R = (st >> 1) * 16 + swz / 64; C = (st & 1) * 32 + (swz % 64) / 2; }
__host__ __device__ __forceinline__ int perm32(int rho) { const int n = rho >> 4, i = rho & 15; return 8 * (i >> 2) + 4 * n + (i & 3); }

struct Unit { int pm, pn, sub; };
struct Gemm { const bf16_t* A; const bf16_t* Bt; int M, N, K; };

struct StaticOrder {
    int nM, nN, nwg, G, c;
    __host__ __device__ void init(int M, int N, int G_, int c_) { nM = M / BM; nN = N / BM; nwg = nM * nN; G = G_; c = c_; }
    __host__ __device__ bool next(int i, Unit& u) const {
        const long L = (long)i * G + c; if (L >= nwg) return false;
        int wgid = (int)L; { const int q = nwg / NXCD, r = nwg % NXCD, xcd = wgid % NXCD, off = wgid / NXCD; wgid = (xcd < r ? xcd * (q + 1) : r * (q + 1) + (xcd - r) * q) + off; }
        const int nig = WGM * nN, gid = wgid / nig, fm = gid * WGM, gsz = (nM - fm) < WGM ? (nM - fm) : WGM;
        u.pm = fm + ((wgid % nig) % gsz); u.pn = (wgid % nig) / gsz; u.sub = 0; return true;
    }
    __device__ __forceinline__ void a_ready(const Unit&) const {}
    __device__ __forceinline__ void done(const Unit&) const {}
};

__device__ __forceinline__ unsigned cvt_pk_bf16(float lo, float hi) { unsigned r; asm volatile("v_cvt_pk_bf16_f32 %0, %1, %2" : "=v"(r) : "v"(lo), "v"(hi)); return r; }
typedef float f32x2 __attribute__((ext_vector_type(2)));
template <class Epi, class Sched, bool ALIGN_EPI = false, bool SP2 = false>
__device__ __forceinline__ void gemm_phase(PG8_LAS unsigned char* lds, const Gemm g, const Sched& S, const Epi& E, const int tid) {
    const int wid = __builtin_amdgcn_readfirstlane(tid >> 6), lane = tid & 63, wr = wid >> 2, wc = wid & 3, fr = lane & 15, fq = lane >> 4;
    const int K = g.K, nt = K / BK;
    unsigned voffA[2], voffB[2];
#pragma unroll
    for (int i = 0; i < 2; ++i) { int R, C; stage_rc(tid * 16 + i * 8192, R, C); const int Rb = Epi::PERM ? ((R & ~31) + perm32(R & 31)) : R;
        voffA[i] = (unsigned)(R * K + C) * 2u; voffB[i] = (unsigned)(Rb * K + C) * 2u; }
    const size_t kstep = (size_t)(BK * 2);
    const size_t hstep = (size_t)HALF * K * 2;
        const unsigned ldsw = (unsigned)wid * 1024u;
    const int aoff = lds_byte(wr * 64 + fr, fq * 8), boff = lds_byte(wc * 32 + fr, fq * 8);
#define PG8_SA(b, h) (((b) * 2 + (h)) * HTB)
#define PG8_SB(b, h) ((4 + (b) * 2 + (h)) * HTB)
#define PG8_STAGE(bufoff, gbase, voff) do { _Pragma("unroll") for (int _i = 0; _i < 2; ++_i) \
        __builtin_amdgcn_global_load_lds((const unsigned*)((const char*)(gbase) + (voff)[_i]), (PG8_LAS unsigned*)(lds + (bufoff) + ldsw + _i * 8192), 16, 0, 0); } while (0)
#define PG8_LDA(dst, b, h) do { _Pragma("unroll") for (int m = 0; m < 4; ++m) _Pragma("unroll") for (int k = 0; k < 2; ++k) dst[m][k] = *(const PG8_LAS bf16x8*)(lds + PG8_SA(b, h) + aoff + m * 2048 + k * 1024); } while (0)
#define PG8_LDB(dst, b, h) do { _Pragma("unroll") for (int n = 0; n < 2; ++n) _Pragma("unroll") for (int k = 0; k < 2; ++k) dst[n][k] = *(const PG8_LAS bf16x8*)(lds + PG8_SB(b, h) + boff + n * 2048 + k * 1024); } while (0)
#define PG8_MMA(ai, bj, At, Bt) do { __builtin_amdgcn_s_setprio(1); _Pragma("unroll") for (int m = 0; m < 4; ++m) _Pragma("unroll") for (int n = 0; n < 2; ++n) _Pragma("unroll") for (int k = 0; k < 2; ++k) \
        acc[ai][bj][m][n] = __builtin_amdgcn_mfma_f32_16x16x32_bf16(Bt[n][k], At[m][k], acc[ai][bj][m][n], 0, 0, 0); __builtin_amdgcn_s_setprio(0); } while (0)
#define PG8_WAIT_V(n) asm volatile("s_waitcnt vmcnt(" #n ")" ::: "memory")
#define PG8_WAIT_L(n) asm volatile("s_waitcnt lgkmcnt(" #n ")" ::: "memory")
#define PG8_BAR __builtin_amdgcn_s_barrier()
#define PG8_SCHED __builtin_amdgcn_sched_barrier(0)
    Unit cur, nxt; int ui = 0;
    if (!S.next(0, cur)) return;
    f32x4 acc[2][2][4][2];
#pragma unroll
    for (int a = 0; a < 2; ++a)
#pragma unroll
        for (int b = 0; b < 2; ++b)
#pragma unroll
            for (int m = 0; m < 4; ++m)
#pragma unroll
                for (int n = 0; n < 2; ++n) acc[a][b][m][n] = (f32x4){0.f, 0.f, 0.f, 0.f};
    bf16x8 At[4][2], B0[2][2], B1[2][2];
    const char* cA = S.aptr(cur); const char* cB = S.bptr(cur);
    S.a_ready(cur);
    if constexpr (SP2) {
        PG8_STAGE(PG8_SB(0, 0), cB, voffB); PG8_STAGE(PG8_SB(0, 1), cB + hstep, voffB); PG8_STAGE(PG8_SA(0, 0), cA, voffA); PG8_STAGE(PG8_SA(0, 1), cA + hstep, voffA);
        if (wr == 1) PG8_BAR;
        PG8_WAIT_V(2); PG8_BAR;
        PG8_STAGE(PG8_SB(1, 0), cB + kstep, voffB); PG8_STAGE(PG8_SA(1, 0), cA + kstep, voffA); PG8_STAGE(PG8_SB(1, 1), cB + hstep + kstep, voffB);
        PG8_WAIT_V(6); PG8_BAR;
    } else {
        PG8_STAGE(PG8_SB(0, 0), cB, voffB); PG8_STAGE(PG8_SA(0, 0), cA, voffA); PG8_STAGE(PG8_SB(0, 1), cB + hstep, voffB); PG8_STAGE(PG8_SA(0, 1), cA + hstep, voffA);
        if (wr == 1) PG8_BAR;
        PG8_WAIT_V(4); PG8_BAR;
        PG8_STAGE(PG8_SB(1, 0), cB + kstep, voffB); PG8_STAGE(PG8_SA(1, 0), cA + kstep, voffA); PG8_STAGE(PG8_SB(1, 1), cB + hstep + kstep, voffB);
        PG8_WAIT_V(6); PG8_BAR;
    }
    for (;;) {
        const bool has_next = S.next(ui + 1, nxt);
        const char* nA = has_next ? S.aptr(nxt) : cA; const char* nB = has_next ? S.bptr(nxt) : cB;
        for (int t = 0; t < nt; t += 2) {
            const bool last = (t == nt - 2);
            const char* a1 = cA + (size_t)(t + 1) * kstep;
            const char* a2 = last ? nA : cA + (size_t)(t + 2) * kstep; const char* b2 = last ? nB : cB + (size_t)(t + 2) * kstep;
            const char* a3 = a2 + kstep; const char* b3 = b2 + kstep;
            if (last && has_next) S.a_ready(nxt);
            if constexpr (SP2) {
            PG8_LDB(B0, 0, 0); PG8_LDB(B1, 0, 1); PG8_SCHED; PG8_LDA(At, 0, 0); PG8_STAGE(PG8_SA(1, 1), a1 + hstep, voffA);
            PG8_WAIT_V(8); PG8_WAIT_L(0); PG8_BAR; PG8_MMA(0, 0, At, B0); PG8_MMA(0, 1, At, B1); PG8_BAR; PG8_SCHED;
            PG8_LDA(At, 0, 1); PG8_STAGE(PG8_SB(0, 0), b2, voffB); PG8_STAGE(PG8_SB(0, 1), b2 + hstep, voffB); PG8_STAGE(PG8_SA(0, 0), a2, voffA);
            PG8_WAIT_V(8); PG8_WAIT_L(0); PG8_BAR; PG8_MMA(1, 0, At, B0); PG8_MMA(1, 1, At, B1); PG8_BAR; PG8_SCHED;
            PG8_LDB(B0, 1, 0); PG8_LDB(B1, 1, 1); PG8_SCHED; PG8_LDA(At, 1, 0); PG8_STAGE(PG8_SA(0, 1), a2 + hstep, voffA);
            PG8_WAIT_V(8); PG8_WAIT_L(0); PG8_BAR; PG8_MMA(0, 0, At, B0); PG8_MMA(0, 1, At, B1); PG8_BAR; PG8_SCHED;
            PG8_LDA(At, 1, 1); PG8_STAGE(PG8_SB(1, 0), b3, voffB); PG8_STAGE(PG8_SB(1, 1), b3 + hstep, voffB); PG8_STAGE(PG8_SA(1, 0), a3, voffA);
            PG8_WAIT_V(8); PG8_WAIT_L(0); PG8_BAR; PG8_MMA(1, 0, At, B0); PG8_MMA(1, 1, At, B1); PG8_BAR; PG8_SCHED;
            } else {
            PG8_LDB(B0, 0, 0); PG8_SCHED; PG8_LDA(At, 0, 0); PG8_STAGE(PG8_SA(1, 1), a1 + hstep, voffA);
            PG8_WAIT_L(8); PG8_BAR; PG8_WAIT_L(0); PG8_MMA(0, 0, At, B0); PG8_BAR; PG8_SCHED;
            PG8_LDB(B1, 0, 1); PG8_STAGE(PG8_SB(0, 0), b2, voffB);
            PG8_BAR; PG8_WAIT_L(0); PG8_MMA(0, 1, At, B1); PG8_BAR;
            PG8_LDA(At, 0, 1); PG8_STAGE(PG8_SA(0, 0), a2, voffA);
            PG8_BAR; PG8_WAIT_L(0); PG8_MMA(1, 0, At, B0); PG8_BAR; PG8_SCHED;
            PG8_STAGE(PG8_SB(0, 1), b2 + hstep, voffB);
            PG8_WAIT_V(6); PG8_BAR; PG8_MMA(1, 1, At, B1); PG8_BAR;
            PG8_LDB(B0, 1, 0); PG8_SCHED; PG8_LDA(At, 1, 0); PG8_STAGE(PG8_SA(0, 1), a2 + hstep, voffA);
            PG8_WAIT_L(8); PG8_BAR; PG8_WAIT_L(0); PG8_MMA(0, 0, At, B0); PG8_BAR; PG8_SCHED;
            PG8_LDB(B1, 1, 1); PG8_STAGE(PG8_SB(1, 0), b3, voffB);
            PG8_BAR; PG8_WAIT_L(0); PG8_MMA(0, 1, At, B1); PG8_BAR;
            PG8_LDA(At, 1, 1); PG8_STAGE(PG8_SA(1, 0), a3, voffA);
            PG8_BAR; PG8_WAIT_L(0); PG8_MMA(1, 0, At, B0); PG8_BAR; PG8_SCHED;
            PG8_STAGE(PG8_SB(1, 1), b3 + hstep, voffB);
            PG8_WAIT_V(6); PG8_BAR; PG8_MMA(1, 1, At, B1); PG8_BAR;
            }
        }
        if constexpr (ALIGN_EPI) { if (wr == 0) PG8_BAR; }
        if constexpr (!Epi::AFTER_DRAIN) { E(acc, cur, wr, wc, fr, fq); S.done(cur); }
        if (!has_next) break;
#pragma unroll
        for (int a = 0; a < 2; ++a)
#pragma unroll
            for (int b = 0; b < 2; ++b)
#pragma unroll
                for (int m = 0; m < 4; ++m)
#pragma unroll
                    for (int n = 0; n < 2; ++n) acc[a][b][m][n] = (f32x4){0.f, 0.f, 0.f, 0.f};
        cur = nxt; cA = nA; cB = nB; ++ui;
        if constexpr (ALIGN_EPI) { if (wr == 1) PG8_BAR; }
    }
    PG8_WAIT_V(0);
    if constexpr (!ALIGN_EPI) { if (wr == 0) PG8_BAR; }
    PG8_BAR;
    if constexpr (Epi::AFTER_DRAIN) { E.fused(acc, cur, wr, wc, fr, fq, lds, wid, lane); S.done(cur); }
#undef PG8_SA
#undef PG8_SB
#undef PG8_STAGE
#undef PG8_LDA
#undef PG8_LDB
#undef PG8_MMA
#undef PG8_WAIT_V
#undef PG8_WAIT_L
#undef PG8_BAR
#undef PG8_SCHED
}
}
namespace attn_body {
using bf16=__hip_bfloat16;
using bf16x8=__attribute__((ext_vector_type(8)))short;
using s16x4=__attribute__((ext_vector_type(4)))short;
using f32x16=__attribute__((ext_vector_type(16)))float;
using u32x4=__attribute__((ext_vector_type(4)))unsigned;
constexpr int D=64,QP=1024,KP=256;
constexpr int NW=8,QBLK=32,KVBLK=64;
__device__ __forceinline__ int crow(int r,int hi){return (r&3)+8*(r>>2)+4*hi;}
#define SBAR() __builtin_amdgcn_sched_barrier(0)
__device__ __forceinline__ void kmask(f32x16&p0,f32x16&p1,int rem,int hi){
  const float NEG=-INFINITY;
  #pragma unroll
  for(int r=0;r<16;++r){int kv=4*hi+(r&3)+8*(r>>2); if(kv>=rem)p0[r]=NEG; if(kv+32>=rem)p1[r]=NEG;}
}

constexpr int NSLOT=3, SLOTB=8192;
constexpr int LDS_K=0, LDS_V=NSLOT*SLOTB, LDS_WS=2*NSLOT*SLOTB, LDS_OST=LDS_WS+NW*64*4, LDS_BYTES=LDS_OST+NW*4096;
constexpr float C2=0.125f*1.4426950408889634f;
__device__ __forceinline__ void glds16(const void*gsrc,unsigned lds_dst){unsigned keep;
  asm volatile("s_mov_b32 %0, m0\n\ts_mov_b32 m0, %2\n\ts_nop 0\n\tglobal_load_lds_dwordx4 %1, off\n\ts_mov_b32 m0, %0":"=&s"(keep):"v"(gsrc),"s"(lds_dst):"memory");}
__device__ __forceinline__ float max3f(float a,float b,float c){float r;asm("v_max3_f32 %0, %1, %2, %3":"=v"(r):"v"(a),"v"(b),"v"(c));return r;}
__device__ __forceinline__ float max2f(float a,float b){float r;asm("v_max_f32_e32 %0, %1, %2":"=v"(r):"v"(a),"v"(b));return r;}
__device__ __forceinline__ float fadd_s(float a,float b){float r;asm("v_add_f32_e32 %0, %1, %2":"=v"(r):"v"(a),"v"(b));return r;}
__device__ __forceinline__ float fsub_s(float a,float b){float r;asm("v_sub_f32_e32 %0, %1, %2":"=v"(r):"v"(a),"v"(b));return r;}
typedef float f32x2_t __attribute__((ext_vector_type(2))); typedef __bf16 bf16x2_t __attribute__((ext_vector_type(2)));
__device__ __forceinline__ unsigned cvtpk_s(float lo,float hi){f32x2_t v={lo,hi};bf16x2_t b=__builtin_convertvector(v,bf16x2_t);return __builtin_bit_cast(unsigned,b);}
#define WAIT_BAR(N) asm volatile("s_waitcnt vmcnt(" #N ") lgkmcnt(0)\n\ts_barrier":::"memory")

__device__ __forceinline__ void qkt(f32x16&p0,f32x16&p1,const char*Kslot,const bf16x8*qr,const f32x16&negm,int r32,int hi){
  const char*kb=Kslot+hi*1024+r32*16;
  #pragma unroll
  for(int d0=0;d0<4;++d0){
    const bf16x8 b0=*reinterpret_cast<const bf16x8*>(kb+d0*2048);
    const bf16x8 b1=*reinterpret_cast<const bf16x8*>(kb+d0*2048+512);
    if(d0==0){p0=__builtin_amdgcn_mfma_f32_32x32x16_bf16(b0,qr[0],negm,0,0,0);p1=__builtin_amdgcn_mfma_f32_32x32x16_bf16(b1,qr[0],negm,0,0,0);}
    else{p0=__builtin_amdgcn_mfma_f32_32x32x16_bf16(b0,qr[d0],p0,0,0,0);p1=__builtin_amdgcn_mfma_f32_32x32x16_bf16(b1,qr[d0],p1,0,0,0);}}
}
typedef __attribute__((address_space(3))) const char* lds_cptr;
typedef short v4i16_t __attribute__((ext_vector_type(4)));
__device__ __forceinline__ void kload8(bf16x8*kf,lds_cptr kp){
  kf[0]=*(const __attribute__((address_space(3))) bf16x8*)(kp);      kf[1]=*(const __attribute__((address_space(3))) bf16x8*)(kp+512);
  kf[2]=*(const __attribute__((address_space(3))) bf16x8*)(kp+2048); kf[3]=*(const __attribute__((address_space(3))) bf16x8*)(kp+2560);
  kf[4]=*(const __attribute__((address_space(3))) bf16x8*)(kp+4096); kf[5]=*(const __attribute__((address_space(3))) bf16x8*)(kp+4608);
  kf[6]=*(const __attribute__((address_space(3))) bf16x8*)(kp+6144); kf[7]=*(const __attribute__((address_space(3))) bf16x8*)(kp+6656);
}
__device__ __forceinline__ void kload2(bf16x8*kf,lds_cptr kp,int j){ kf[2*j]=*(const __attribute__((address_space(3))) bf16x8*)(kp+j*2048); kf[2*j+1]=*(const __attribute__((address_space(3))) bf16x8*)(kp+j*2048+512); }
__device__ __forceinline__ s16x4 vtr(lds_cptr p){ return __builtin_bit_cast(s16x4,__builtin_amdgcn_ds_read_tr16_b64_v4i16((__attribute__((address_space(3))) v4i16_t*)p)); }
__device__ __forceinline__ float rowmax(const f32x16&p0,const f32x16&p1){
  float a=max3f(p0[0],p0[1],p1[0]),b=max3f(p0[2],p0[3],p1[1]);a=max3f(a,p1[2],p1[3]);
  #pragma unroll
  for(int r=4;r<16;r+=4){a=max3f(a,p0[r],p0[r+1]);b=max3f(b,p0[r+2],p0[r+3]);a=max3f(a,p1[r],p1[r+1]);b=max3f(b,p1[r+2],p1[r+3]);}
  const float m=max2f(a,b);
  auto rr=__builtin_amdgcn_permlane32_swap(__float_as_uint(m),__float_as_uint(m),false,false);
  return max2f(__uint_as_float(rr[0]),__uint_as_float(rr[1]));
}
__device__ __forceinline__ void pv(f32x16*o,int vb,bf16x8 pa0,bf16x8 pa1,bf16x8 pa2,bf16x8 pa3){
  #pragma unroll
  for(int d0=0;d0<2;++d0){s16x4 lo[4],hi[4];
    #pragma unroll
    for(int ks=0;ks<4;++ks){
      asm volatile("ds_read_b64_tr_b16 %0,%1 offset:%c2":"=&v"(lo[ks]):"v"(vb),"i"(d0*4096+ks*1024):"memory");
      asm volatile("ds_read_b64_tr_b16 %0,%1 offset:%c2":"=&v"(hi[ks]):"v"(vb),"i"(d0*4096+ks*1024+512):"memory");}
    asm volatile("s_waitcnt lgkmcnt(0)":::"memory");SBAR();
    #define PK(k) (bf16x8){lo[k][0],lo[k][1],lo[k][2],lo[k][3],hi[k][0],hi[k][1],hi[k][2],hi[k][3]}
    o[d0]=__builtin_amdgcn_mfma_f32_32x32x16_bf16(pa0,PK(0),o[d0],0,0,0);
    o[d0]=__builtin_amdgcn_mfma_f32_32x32x16_bf16(pa1,PK(1),o[d0],0,0,0);
    o[d0]=__builtin_amdgcn_mfma_f32_32x32x16_bf16(pa2,PK(2),o[d0],0,0,0);
    o[d0]=__builtin_amdgcn_mfma_f32_32x32x16_bf16(pa3,PK(3),o[d0],0,0,0);
    #undef PK
  }
}

#ifndef ATTN_STORE16
#define ATTN_STORE16(p,v) (*(u32x4*)(p)=(v))
#endif
template<int THRL,int L,int NT> __device__ __forceinline__ void attn_unit(long rowbase,int kvh,int qblk,const bf16*Q,const bf16*__restrict__ K,const bf16*__restrict__ V,bf16*O,char*shm,const int tid){
  const int lane=tid&63,r32=lane&31,hi=lane>>5; const int wid=__builtin_amdgcn_readfirstlane(tid>>6);
  const int q0=qblk*64, qh=wid>>1, rh=wid&1;
  const bf16*Qw=Q+(rowbase+q0+rh*QBLK)*QP+(4*kvh+qh)*D;
  const bf16*Kh=K+rowbase*KP+kvh*D,*Vh=V+rowbase*KP+kvh*D;
  const unsigned lds0=(unsigned)(uintptr_t)shm;
  float*wsf=(float*)(shm+LDS_WS)+wid*64;
  const bf16*ksrc=Kh+(long)lane*KP+wid*8;
  const bf16*vsrc=Vh+(long)(16*(wid&3)+(lane>>2))*KP+(wid>>2)*32+(lane&3)*8;
  const unsigned kdst=lds0+LDS_K+wid*1024, vdst=lds0+LDS_V+wid*1024;
  #define DMA_K(t,slot) glds16(ksrc+(long)(t)*KVBLK*KP,(unsigned)__builtin_amdgcn_readfirstlane(kdst+(slot)))
  #define DMA_V(t,slot) glds16(vsrc+(long)(t)*KVBLK*KP,(unsigned)__builtin_amdgcn_readfirstlane(vdst+(slot)))
  const int vb0=(int)(lds0+LDS_V)+((lane>>4)&1)*32+(lane&3)*8+(4*hi+((lane&15)>>2))*64;
  const char*Kbase=shm+LDS_K; bf16x8 kf[8];
  const lds_cptr shm3=(lds_cptr)shm; const lds_cptr kp0=shm3+LDS_K+hi*1024+r32*16; const lds_cptr vp0=shm3+LDS_V+((lane>>4)&1)*32+(lane&3)*8+(4*hi+((lane&15)>>2))*64;
  DMA_K(0,0);DMA_V(0,0);DMA_K(1,SLOTB);
  bf16x8 qr[4];
  #pragma unroll
  for(int d0=0;d0<4;++d0)qr[d0]=*reinterpret_cast<const bf16x8*>(&Qw[(long)r32*QP+d0*16+hi*8]);
  if(q0+rh*QBLK+r32>=L){
    #pragma unroll
    for(int d0=0;d0<4;++d0)qr[d0]=bf16x8{0,0,0,0,0,0,0,0}; }
  float mhat=0.f,l_reg=0.f;f32x16 o[2];o[0]=f32x16{};o[1]=f32x16{};f32x16 negm=f32x16{};asm volatile("":"+v"(negm));
  #define CMASK(P0,P1,t) do{ if((t)>=NT-2)kmask(P0,P1,L-64*(t),hi);}while(0)
  bool resc=false;
  #define START(P0,P1) do{ const float rm=rowmax(P0,P1); resc=false; \
    { const float dl=rm; mhat=fadd_s(mhat,dl); \
      _Pragma("unroll") for(int r=0;r<16;++r){P0[r]=fsub_s(P0[r],dl);P1[r]=fsub_s(P1[r],dl);} \
      _Pragma("unroll") for(int r=0;r<16;++r)negm[r]=-mhat; asm volatile("":"+v"(negm)); } \
    _Pragma("unroll") for(int r=0;r<16;++r)P0[r]=__builtin_amdgcn_exp2f(P0[r]); }while(0)
  #define RESC() do{ if(resc){ asm volatile("s_waitcnt lgkmcnt(0)":::"memory"); \
      _Pragma("unroll") for(int d_=0;d_<2;++d_) _Pragma("unroll") for(int r=0;r<16;++r)o[d_][r]*=wsf[crow(r,hi)]; } }while(0)
  f32x16 pA0,pA1,pB0,pB1;
  int sl_prev=0,sl_cur=0,sl_next=SLOTB;
  #define ROT() do{sl_prev=sl_cur;sl_cur=sl_next;sl_next=(sl_next==(NSLOT-1)*SLOTB)?0:sl_next+SLOTB;}while(0)
  DMA_K(2,2*SLOTB);
  WAIT_BAR(3);
  qkt(pA0,pA1,Kbase,qr,negm,r32,hi);asm volatile("s_nop 15\n\ts_nop 7":"+v"(pA0),"+v"(pA1));CMASK(pA0,pA1,0);
  START(pA0,pA1);
  _Pragma("unroll") for(int r=0;r<16;++r)pA1[r]=__builtin_amdgcn_exp2f(pA1[r]);
  WAIT_BAR(0);
  DMA_K(3,0);DMA_V(1,SLOTB);
  ROT();
  kload8(kf,kp0+sl_cur);
  WAIT_BAR(2);
  s16x4 vlo[8],vhi[8]; u32x4 pw0,pw1,pw2,pw3;
  #define PKW(P,B) cvtpk_s(P[B],P[B+1])
  #define PAF(k) __builtin_bit_cast(bf16x8,pw##k)
  #define VFR(i) (bf16x8){vlo[i][0],vlo[i][1],vlo[i][2],vlo[i][3],vhi[i][0],vhi[i][1],vhi[i][2],vhi[i][3]}
  #define PIN(x) asm volatile("":"+v"(x))
  #define MX3(a,b,c) __builtin_fmaxf(__builtin_fmaxf((a),(b)),(c))
  #define GAPA(MF,A0,A1,A2,A3,W0,W1,PW) do{ MF; sacc+=A0; sacc+=A1; sacc+=A2; sacc+=A3; PIN(sacc); W0; W1; PIN(PW); SBAR(); }while(0)
  #define EX(v) __builtin_amdgcn_exp2f(v)
  #define GAPB(MF,X,B) do{ MF; X[B]=EX(X[B]); X[B+1]=EX(X[B+1]); X[B+2]=EX(X[B+2]); X[B+3]=EX(X[B+3]); PIN(X); SBAR(); }while(0)
  #define VRD(i) do{ vlo[i]=vtr(vp_+(((i)>>2)*4096+((i)&3)*1024)); vhi[i]=vtr(vp_+(((i)>>2)*4096+((i)&3)*1024+512)); }while(0)
  #define KRD(G,j) do{ if(G){ kload2(kf,kp0+sl_next,j); SBAR(); } }while(0)
  #define STEP(C0,C1,P0,P1,t,GK,GV,GL) do{ SBAR(); \
    const lds_cptr vp_=vp0+sl_prev; \
    VRD(0); SBAR(); float sacc=(P0[0]+P0[1]); \
    GAPA(C0=__builtin_amdgcn_mfma_f32_32x32x16_bf16(kf[0],qr[0],negm,0,0,0), P0[2],P0[3],P0[4],P0[5],     pw0[0]=PKW(P0,0), pw0[1]=PKW(P0,2), pw0); \
    VRD(4); SBAR(); GAPA(C1=__builtin_amdgcn_mfma_f32_32x32x16_bf16(kf[1],qr[0],negm,0,0,0), P0[6],P0[7],P0[8],P0[9],     pw0[2]=PKW(P0,4), pw0[3]=PKW(P0,6), pw0); \
    VRD(1); SBAR(); GAPA(C0=__builtin_amdgcn_mfma_f32_32x32x16_bf16(kf[2],qr[1],C0,0,0,0),   P0[10],P0[11],P0[12],P0[13], pw1[0]=PKW(P0,8), pw1[1]=PKW(P0,10), pw1); \
    VRD(5); SBAR(); GAPA(C1=__builtin_amdgcn_mfma_f32_32x32x16_bf16(kf[3],qr[1],C1,0,0,0),   P0[14],P0[15],P1[0],P1[1],   pw1[2]=PKW(P0,12),pw1[3]=PKW(P0,14), pw1); \
    VRD(2); SBAR(); GAPA(C0=__builtin_amdgcn_mfma_f32_32x32x16_bf16(kf[4],qr[2],C0,0,0,0),   P1[2],P1[3],P1[4],P1[5],     pw2[0]=PKW(P1,0), pw2[1]=PKW(P1,2), pw2); \
    VRD(6); SBAR(); GAPA(C1=__builtin_amdgcn_mfma_f32_32x32x16_bf16(kf[5],qr[2],C1,0,0,0),   P1[6],P1[7],P1[8],P1[9],     pw2[2]=PKW(P1,4), pw2[3]=PKW(P1,6), pw2); \
    VRD(3); SBAR(); GAPA(C0=__builtin_amdgcn_mfma_f32_32x32x16_bf16(kf[6],qr[3],C0,0,0,0),   P1[10],P1[11],P1[12],P1[13], pw3[0]=PKW(P1,8), pw3[1]=PKW(P1,10), pw3); \
    VRD(7); SBAR(); GAPA(C1=__builtin_amdgcn_mfma_f32_32x32x16_bf16(kf[7],qr[3],C1,0,0,0),   P1[14],P1[15],0.f,0.f,       pw3[2]=PKW(P1,12),pw3[3]=PKW(P1,14), pw3); \
    l_reg+=sacc; \
    if(GK){DMA_K((t)+3,sl_cur);} if(GV){DMA_V((t)+1,sl_next);} \
    CMASK(C0,C1,t); \
    { float a=MX3(C0[0],C0[1],C1[0]),b=MX3(C0[2],C0[3],C1[1]); a=MX3(a,C1[2],C1[3]); \
      _Pragma("unroll") for(int r=4;r<16;r+=4){a=MX3(a,C0[r],C0[r+1]);b=MX3(b,C0[r+2],C0[r+3]);a=MX3(a,C1[r],C1[r+1]);b=MX3(b,C1[r+2],C1[r+3]);} \
      float rm=__builtin_fmaxf(a,b); { auto rr=__builtin_amdgcn_permlane32_swap(__float_as_uint(rm),__float_as_uint(rm),false,false); rm=__builtin_fmaxf(__uint_as_float(rr[0]),__uint_as_float(rr[1])); } \
      resc=false; \
      if(__builtin_expect(__any(rm>(float)THRL),0)){ const float dl=__builtin_fmaxf(rm,0.f); mhat+=dl; \
        _Pragma("unroll") for(int r=0;r<16;++r){C0[r]-=dl;C1[r]-=dl;} \
        _Pragma("unroll") for(int r=0;r<16;++r)negm[r]=-mhat; asm volatile("":"+v"(negm)); \
        const float f=__builtin_amdgcn_exp2f(-dl); l_reg*=f; if(hi==0)wsf[r32]=f; resc=true; } } \
    SBAR(); \
    GAPB(o[0]=__builtin_amdgcn_mfma_f32_32x32x16_bf16(PAF(0),VFR(0),o[0],0,0,0), C0,0); \
    GAPB(o[1]=__builtin_amdgcn_mfma_f32_32x32x16_bf16(PAF(0),VFR(4),o[1],0,0,0), C0,4); \
    KRD(GL,0); GAPB(o[0]=__builtin_amdgcn_mfma_f32_32x32x16_bf16(PAF(1),VFR(1),o[0],0,0,0), C0,8); \
    KRD(GL,1); GAPB(o[1]=__builtin_amdgcn_mfma_f32_32x32x16_bf16(PAF(1),VFR(5),o[1],0,0,0), C0,12); \
    KRD(GL,2); GAPB(o[0]=__builtin_amdgcn_mfma_f32_32x32x16_bf16(PAF(2),VFR(2),o[0],0,0,0), C1,0); \
    KRD(GL,3); GAPB(o[1]=__builtin_amdgcn_mfma_f32_32x32x16_bf16(PAF(2),VFR(6),o[1],0,0,0), C1,4); \
    GAPB(o[0]=__builtin_amdgcn_mfma_f32_32x32x16_bf16(PAF(3),VFR(3),o[0],0,0,0), C1,8); \
    GAPB(o[1]=__builtin_amdgcn_mfma_f32_32x32x16_bf16(PAF(3),VFR(7),o[1],0,0,0), C1,12); \
    }while(0)
  int t=1;
  #undef CMASK
  #define CMASK(P0,P1,t) do{}while(0)
  for(;t+5<NT;t+=2){
    STEP(pB0,pB1,pA0,pA1,t,true,true,true);     WAIT_BAR(2); RESC(); ROT();
    STEP(pA0,pA1,pB0,pB1,t+1,true,true,true);   WAIT_BAR(2); RESC(); ROT();
  }
  #undef CMASK
  #define CMASK(P0,P1,t) do{ if((t)>=NT-2)kmask(P0,P1,L-64*(t),hi);}while(0)
  #define ENDW(tt) do{ if((tt)+3<NT){WAIT_BAR(2);} else if((tt)+2<NT){WAIT_BAR(1);} else {WAIT_BAR(0);} }while(0)
  for(;t+1<NT;t+=2){
    STEP(pB0,pB1,pA0,pA1,t,(t+3<NT),(t+1<NT),(t+1<NT));       ENDW(t);   RESC(); ROT();
    STEP(pA0,pA1,pB0,pB1,t+1,(t+4<NT),(t+2<NT),(t+2<NT));     ENDW(t+1); RESC(); ROT();
  }
  #define DRAIN(P0,P1,SL) do{ float sacc=P0[0]+P0[1]; _Pragma("unroll") for(int r=2;r<16;++r)sacc+=P0[r]; _Pragma("unroll") for(int r=0;r<16;++r)sacc+=P1[r]; l_reg+=sacc; \
    pw0=(u32x4){PKW(P0,0),PKW(P0,2),PKW(P0,4),PKW(P0,6)};pw1=(u32x4){PKW(P0,8),PKW(P0,10),PKW(P0,12),PKW(P0,14)};pw2=(u32x4){PKW(P1,0),PKW(P1,2),PKW(P1,4),PKW(P1,6)};pw3=(u32x4){PKW(P1,8),PKW(P1,10),PKW(P1,12),PKW(P1,14)}; \
    SBAR(); pv(o,vb0+(SL),PAF(0),PAF(1),PAF(2),PAF(3)); }while(0)
  if constexpr((NT&1)==0){
    STEP(pB0,pB1,pA0,pA1,NT-1,false,false,false); RESC();
    DRAIN(pB0,pB1,sl_cur);
  } else {
    DRAIN(pA0,pA1,sl_prev);
  }
  #undef DRAIN
  #undef PKW
  #undef PAF
  #undef VFR
  #undef PIN
  #undef MX3
  #undef GAPA
  #undef GAPB
  #undef EX
  #undef VRD
  #undef KRD
  #undef STEP
  #undef ENDW
  {auto rr=__builtin_amdgcn_permlane32_swap(__float_as_uint(l_reg),__float_as_uint(l_reg),false,false);l_reg=__uint_as_float(rr[0])+__uint_as_float(rr[1]);}
  if(hi==0)wsf[32+r32]=l_reg;asm volatile("s_waitcnt lgkmcnt(0)":::"memory");
  float rli[16];
  #pragma unroll
  for(int r=0;r<16;++r)rli[r]=__builtin_amdgcn_rcpf(wsf[32+crow(r,hi)]);
  bf16*Ow=O+(rowbase+q0+rh*QBLK)*QP+(4*kvh+qh)*D;
  { bf16*stg=(bf16*)(shm+LDS_OST)+wid*2048;
    #pragma unroll
    for(int r=0;r<16;++r){const int orow=crow(r,hi);
      #pragma unroll
      for(int d0=0;d0<2;++d0)stg[orow*64+d0*32+r32]=__float2bfloat16(o[d0][r]*rli[r]);}
    asm volatile("s_waitcnt lgkmcnt(0)":::"memory");
    #pragma unroll
    for(int i=0;i<4;++i){const int row=i*8+(lane>>3),ch=lane&7; const u32x4 v=*(const u32x4*)(stg+row*64+ch*8); if(q0+rh*QBLK+row<L)ATTN_STORE16(Ow+(long)row*QP+ch*8,v);} }
  asm volatile("s_waitcnt lgkmcnt(0)\n\ts_barrier":::"memory");
  #undef DMA_K
  #undef DMA_V
  #undef CMASK
  #undef START
  #undef RESC
  #undef ROT
}
constexpr int ATTN_LDS_BYTES=LDS_BYTES;
#undef SBAR
#undef WAIT_BAR
}
constexpr int DM = 1024, FF = 2816, NLAYER = 4;
constexpr int LP = 4112, LS = 2064, NSEQ_P = 4, NSEQ_S = 16, ROWS_P = NSEQ_P * LP  , T_ROWS = ROWS_P + NSEQ_S * LS  ;
constexpr int TPAD = 49664, NMT = TPAD / 256;
constexpr int NWIN = 4608;
constexpr float NORM_EPS = 1e-6f;
constexpr float QSCALE = 0.125f * 1.4426950408889634f;
constexpr int ATT_UNITS_P = NSEQ_P * 4 * 65, ATT_UNITS_S = NSEQ_S * 4 * 33, ATT_UNITS = ATT_UNITS_P + ATT_UNITS_S;

constexpr size_t MiB = 1u << 20;
constexpr int CW_BAR = 4096;
constexpr size_t WS_CTL = 0;
constexpr size_t WS_ROPE = MiB / 4;
constexpr size_t WS_HMETA = 3 * MiB / 2;
constexpr size_t WS_SSQ = 3 * MiB;
constexpr size_t WS_W = 8 * MiB;
constexpr size_t W_GU1 = 0, W_D1 = W_GU1 + (size_t)5632 * 1024 * 2, W_IN = W_D1 + (size_t)1024 * 2816 * 2, W_GC = W_IN + (size_t)NWIN * 1024 * 2, W_OC = W_GC + 2 * MiB,
                 W_GA = W_OC + 2 * MiB, W_OA = W_GA + 2 * MiB, W_M = W_OA + 2 * MiB, W_GU2 = W_M + 2 * MiB, W_D2 = W_GU2 + (size_t)5632 * 1024 * 2, W_END = W_D2 + (size_t)1024 * 2816 * 2;
constexpr size_t WBUF = 56 * MiB;
constexpr size_t WS_HB = 120 * MiB;
constexpr size_t ROWB = (size_t)TPAD * 1024 * 2;
constexpr size_t WS_BIG = WS_HB + 98 * MiB;
constexpr size_t WS_Q = WS_BIG, WS_K = WS_Q + ROWB, WS_V = WS_K + ROWB / 4, WS_CB = WS_V + ROWB / 4, WS_Z = WS_CB + ROWB, WS_END = WS_Z + ROWB;
constexpr size_t WS_HID = WS_BIG;
constexpr size_t WS_SCR = WS_K;
static_assert((CW_BAR + 3456) * 4 <= (int)WS_ROPE && WS_ROPE + (size_t)LP * 64 * 4 <= WS_HMETA && WS_HMETA + (size_t)20 * 16 * 1024 * 4 <= WS_SSQ && WS_SSQ + (size_t)TPAD * 16 * 4 <= WS_W, "d_ws map (small regions)");
static_assert(W_END <= 56 * MiB && ROWB <= 98 * MiB && (size_t)TPAD * FF * 2 <= WS_END - WS_BIG && 256 * 131072 <= ROWB / 2, "d_ws map");

constexpr int RING_BYTES = 131072, MISC_OFF = RING_BYTES + 320, PTAB_OFF = RING_BYTES + 1024, LDS_BYTES = 147456;
constexpr int NWAVES = 8;

#define GAS __attribute__((address_space(1)))
#define LAS __attribute__((address_space(3)))
typedef unsigned short bf16;
typedef unsigned v4u __attribute__((ext_vector_type(4)));
typedef float f32x4 __attribute__((ext_vector_type(4)));
__device__ __forceinline__ unsigned f2bf(float f) { unsigned u = __builtin_bit_cast(unsigned, f); return (u + 0x7fffu + ((u >> 16) & 1u)) >> 16; }
__device__ __forceinline__ unsigned pk2(float lo, float hi) { return pg8::cvt_pk_bf16(lo, hi); }
__device__ __forceinline__ float bflo(unsigned u) { return __builtin_bit_cast(float, u << 16); }
__device__ __forceinline__ float bfhi(unsigned u) { return __builtin_bit_cast(float, u & 0xffff0000u); }
__device__ __forceinline__ float wave_sum(float v) {
#pragma unroll
    for (int o = 1; o < 64; o <<= 1) v += __shfl_xor(v, o);
    return v;
}
__device__ __forceinline__ void rowinfo(int r, int& pos, int& L) {
    if (r < ROWS_P) { L = LP; pos = r % LP; } else if (r < T_ROWS) { L = LS; pos = (r - ROWS_P) % LS; } else { L = 1 << 30; pos = 0; }
}
__device__ __forceinline__ float xsum16(float s) { const auto r = __builtin_amdgcn_permlane16_swap(__float_as_uint(s), __float_as_uint(s), false, false); return __uint_as_float(r[0]) + __uint_as_float(r[1]); }
__device__ __forceinline__ float xsum32(float s) { const auto r = __builtin_amdgcn_permlane32_swap(__float_as_uint(s), __float_as_uint(s), false, false); return __uint_as_float(r[0]) + __uint_as_float(r[1]); }
__device__ __forceinline__ float sigmoidf_(float x) { return __builtin_amdgcn_rcpf(1.0f + __builtin_amdgcn_exp2f(-1.4426950408889634f * x)); }

struct PlainOrder : pg8::StaticOrder {
    const char* A; const char* Bt; size_t tstep;
    __device__ __forceinline__ const char* aptr(const pg8::Unit& u) const { return A + (size_t)u.pm * tstep; }
    __device__ __forceinline__ const char* bptr(const pg8::Unit& u) const { return Bt + (size_t)u.pn * tstep; }
};
struct ChainOrder {
    pg8::StaticOrder base; const char* A[4]; const char* B[4]; size_t tstep;
    __device__ __forceinline__ bool next(int i, pg8::Unit& u) const { if (!base.next(i >> 2, u)) return false; u.sub = i & 3; return true; }
    __device__ __forceinline__ const char* aptr(const pg8::Unit& u) const { const char* p = u.sub == 0 ? A[0] : u.sub == 1 ? A[1] : u.sub == 2 ? A[2] : A[3]; return p + (size_t)u.pm * tstep; }
    __device__ __forceinline__ const char* bptr(const pg8::Unit& u) const { const char* p = u.sub == 0 ? B[0] : u.sub == 1 ? B[1] : u.sub == 2 ? B[2] : B[3]; return p + (size_t)u.pn * tstep; }
    __device__ __forceinline__ void a_ready(const pg8::Unit&) const {}
    __device__ __forceinline__ void done(const pg8::Unit&) const {}
};

using pg8::f32x4; using pg8::u32x4; using pg8::Unit; using pg8::bf16_t;
typedef f32x4 Acc[2][2][4][2];
__device__ __forceinline__ u32x4 pack8(const f32x4 a, const f32x4 b) { u32x4 w; w.x = pk2(a[0], a[1]); w.y = pk2(a[2], a[3]); w.z = pk2(b[0], b[1]); w.w = pk2(b[2], b[3]); return w; }
__device__ __forceinline__ void unpack8(const u32x4 w, f32x4& a, f32x4& b) { a = (f32x4){bflo(w.x), bfhi(w.x), bflo(w.y), bfhi(w.y)}; b = (f32x4){bflo(w.z), bfhi(w.z), bflo(w.w), bfhi(w.w)}; }
__device__ __forceinline__ float rstd_of(const float* ssq, int row) { const f32x4* p = (const f32x4*)(ssq + (size_t)row * 16); const f32x4 a = p[0], b = p[1], c = p[2], d = p[3];
    const float s = (((a[0] + a[1]) + (a[2] + a[3])) + ((b[0] + b[1]) + (b[2] + b[3]))) + (((c[0] + c[1]) + (c[2] + c[3])) + ((d[0] + d[1]) + (d[2] + d[3])));
    return __builtin_amdgcn_rsqf(s * (1.0f / DM) + NORM_EPS); }

__device__ __forceinline__ void rstd8(const float* ssq, int row0, int fq, float (&rs)[8]) {
    f32x4 pr[8];
#pragma unroll
    for (int i = 0; i < 8; ++i) pr[i] = *(const f32x4*)(ssq + (size_t)(row0 + (i >> 2) * 128 + (i & 3) * 16) * 16 + 4 * fq);
#pragma unroll
    for (int i = 0; i < 8; ++i) { float s = (pr[i][0] + pr[i][1]) + (pr[i][2] + pr[i][3]); s = xsum16(s); s = xsum32(s); rs[i] = __builtin_amdgcn_rsqf(s * (1.0f / DM) + NORM_EPS); }
}
struct EpiSwiGLU {
    static constexpr bool PERM = true, AFTER_DRAIN = false;
    bf16_t* hid; const float* ssq;
    __device__ __forceinline__ void operator()(const Acc& acc, const Unit& u, int wr, int wc, int fr, int fq) const {
        const int row0 = u.pm * 256 + wr * 64 + fr;
        float rs[8]; rstd8(ssq, row0, fq, rs);
#pragma unroll
        for (int ai = 0; ai < 2; ++ai)
#pragma unroll
            for (int m = 0; m < 4; ++m) {
                const int row = row0 + ai * 128 + m * 16; const float r1 = rs[ai * 4 + m];
                f32x4 o[2];
#pragma unroll
                for (int n = 0; n < 2; ++n) {
                    const f32x4 gs = acc[ai][0][m][n] * r1, us = acc[ai][1][m][n] * r1, t = gs * -1.4426950408889634f;
                    f32x4 d; d[0] = __builtin_amdgcn_exp2f(t[0]); d[1] = __builtin_amdgcn_exp2f(t[1]); d[2] = __builtin_amdgcn_exp2f(t[2]); d[3] = __builtin_amdgcn_exp2f(t[3]);
                    d = d + 1.0f;
                    f32x4 r; r[0] = __builtin_amdgcn_rcpf(d[0]); r[1] = __builtin_amdgcn_rcpf(d[1]); r[2] = __builtin_amdgcn_rcpf(d[2]); r[3] = __builtin_amdgcn_rcpf(d[3]);
                    o[n] = (gs * us) * r;
                }
                *(u32x4*)(hid + (size_t)row * FF + u.pn * 128 + wc * 32 + 8 * fq) = pack8(o[0], o[1]);
            }
    }
};
struct EpiResid {
    static constexpr bool PERM = true, AFTER_DRAIN = false;
    bf16_t* hb; float* ssq_out; float scale;
    __device__ __forceinline__ void operator()(const Acc& acc, const Unit& u, int wr, int wc, int fr, int fq) const {
        const int row0 = u.pm * 256 + wr * 64 + fr;
#pragma unroll
        for (int ai = 0; ai < 2; ++ai) {
            u32x4 old[4][2];
#pragma unroll
            for (int m = 0; m < 4; ++m) { const int row = row0 + ai * 128 + m * 16; const bf16_t* bp = hb + (size_t)row * DM + u.pn * 256 + wc * 32 + 8 * fq;
#pragma unroll
                for (int bj = 0; bj < 2; ++bj) old[m][bj] = row < T_ROWS ? *(const u32x4*)(bp + bj * 128) : (u32x4){0u, 0u, 0u, 0u}; }
#pragma unroll
            for (int m = 0; m < 4; ++m) {
                const int row = row0 + ai * 128 + m * 16; const bool ok = row < T_ROWS; bf16_t* bp = hb + (size_t)row * DM + u.pn * 256 + wc * 32 + 8 * fq;
                float ss = 0.f;
#pragma unroll
                for (int bj = 0; bj < 2; ++bj) {
                    f32x4 a, b; unpack8(old[m][bj], a, b);
                    a = a + acc[ai][bj][m][0] * scale; b = b + acc[ai][bj][m][1] * scale;
                    const u32x4 w = pack8(a, b); if (ok) *(u32x4*)(bp + bj * 128) = w;
                    unpack8(w, a, b);
                    ss += (a[0] * a[0] + a[1] * a[1]) + (a[2] * a[2] + a[3] * a[3]) + (b[0] * b[0] + b[1] * b[1]) + (b[2] * b[2] + b[3] * b[3]);
                }
                ss = xsum16(ss); ss = xsum32(ss);
                if (ok && fq == 0) ssq_out[(size_t)row * 16 + u.pn * 4 + wc] = ss;
            }
            asm volatile("" ::: "memory");
        }
    }
};
struct EpiWin {
    static constexpr bool PERM = true, AFTER_DRAIN = false;
    bf16_t *q, *k, *v, *cb, *z; const float* ssq; const float* rope; const float* qg; const float* kg;
    __device__ __forceinline__ void operator()(const Acc& acc, const Unit& u, int wr, int wc, int fr, int fq) const {
        const int pn = u.pn; const int row0 = u.pm * 256 + wr * 64 + fr;
        float rs[8]; rstd8(ssq, row0, fq, rs);
        if (pn <= 4) {
            const float* g = pn < 4 ? qg : kg; const float osc = pn < 4 ? QSCALE : 1.0f;
            f32x4 G[2][2];
#pragma unroll
            for (int bj = 0; bj < 2; ++bj)
#pragma unroll
                for (int n = 0; n < 2; ++n) G[bj][n] = *(const f32x4*)(g + 32 * bj + 16 * n + 4 * fq) * osc;
#pragma unroll
            for (int ai = 0; ai < 2; ++ai)
#pragma unroll
                for (int mp = 0; mp < 2; ++mp) {
                    f32x4 cs[2][2][2];
#pragma unroll
                    for (int mm = 0; mm < 2; ++mm) { int pos, L; rowinfo(row0 + ai * 128 + (2 * mp + mm) * 16, pos, L);
#pragma unroll
                        for (int bj = 0; bj < 2; ++bj) { cs[mm][bj][0] = *(const f32x4*)(rope + ((pos * 2 + bj) * 2 + 0) * 16 + 4 * fq); cs[mm][bj][1] = *(const f32x4*)(rope + ((pos * 2 + bj) * 2 + 1) * 16 + 4 * fq); } }
#pragma unroll
                    for (int mm = 0; mm < 2; ++mm) {
                        const int m = 2 * mp + mm; const int row = row0 + ai * 128 + m * 16; const float r1 = rs[ai * 4 + m];
                        f32x4 x[2][2]; float ss = 0.f;
#pragma unroll
                        for (int bj = 0; bj < 2; ++bj)
#pragma unroll
                            for (int n = 0; n < 2; ++n) { x[bj][n] = acc[ai][bj][m][n] * r1; const f32x4 t = x[bj][n] * x[bj][n]; ss += (t[0] + t[1]) + (t[2] + t[3]); }
                        ss = xsum16(ss); ss = xsum32(ss);
                        const float rn = __builtin_amdgcn_rsqf(ss * (1.0f / 64.0f) + NORM_EPS);
                        bf16_t* dst = pn < 4 ? q + (size_t)row * 1024 + (4 * pn + wc) * 64 + 8 * fq : k + (size_t)row * 256 + wc * 64 + 8 * fq;
#pragma unroll
                        for (int bj = 0; bj < 2; ++bj) {
                            const f32x4 c4 = cs[mm][bj][0], s4 = cs[mm][bj][1];
                            const f32x4 y1 = x[bj][0] * rn * G[bj][0], y2 = x[bj][1] * rn * G[bj][1];
                            const f32x4 o1 = y1 * c4 - y2 * s4, o2 = y2 * c4 + y1 * s4;
                            *(u32x4*)(dst + 32 * bj) = pack8(o1, o2);
                        }
                    }
                    asm volatile("" ::: "memory");
                }
        } else if (pn < 10) {
            bf16_t* base; int pitch, c0;
            if (pn == 5) { base = v; pitch = 256; c0 = 0; } else { base = cb; pitch = 1024; c0 = 256 * (pn - 6); }
#pragma unroll
            for (int ai = 0; ai < 2; ++ai)
#pragma unroll
                for (int m = 0; m < 4; ++m) {
                    const int row = row0 + ai * 128 + m * 16; const float r1 = rs[ai * 4 + m];
#pragma unroll
                    for (int bj = 0; bj < 2; ++bj) *(u32x4*)(base + (size_t)row * pitch + c0 + 128 * bj + wc * 32 + 8 * fq) = pack8(acc[ai][bj][m][0] * r1, acc[ai][bj][m][1] * r1);
                }
        } else {
#pragma unroll
            for (int ai = 0; ai < 2; ++ai)
#pragma unroll
                for (int m = 0; m < 4; ++m) {
                    const int row = row0 + ai * 128 + m * 16; const float r1 = rs[ai * 4 + m], rs2 = r1 * r1;
                    *(u32x4*)(z + (size_t)row * 1024 + 128 * (pn - 10) + wc * 32 + 8 * fq) = pack8(acc[ai][0][m][0] * acc[ai][1][m][0] * rs2, acc[ai][0][m][1] * acc[ai][1][m][1] * rs2);
                }
        }
    }
};
struct EpiMerge {
    static constexpr bool PERM = true, AFTER_DRAIN = false;
    bf16_t* merged; u32x4* scr; const float* ssq; int tid;
    __device__ __forceinline__ void operator()(const Acc& acc, const Unit& u, int wr, int wc, int fr, int fq) const {
        const int sub = u.sub; const int row0 = u.pm * 256 + wr * 64 + fr;
        char* mb = (char*)(merged + (size_t)row0 * DM + u.pn * 256 + wc * 32 + 8 * fq); asm volatile("" : "+v"(mb));
        char* sb = (char*)(scr + tid); asm volatile("" : "+v"(sb));
#define MP(ai, m, bj) ((u32x4*)(mb + ((ai) * 128 + (m) * 16) * (DM * 2) + (bj) * 256))
#define SP(ai, m, bj) ((u32x4*)(sb + ((((ai) * 4 + (m)) * 2 + (bj)) * 512) * 16))
        if ((sub & 1) == 0) {
            float rs[8]; rstd8(ssq, row0, fq, rs);
#pragma unroll
            for (int ai = 0; ai < 2; ++ai)
#pragma unroll
                for (int m = 0; m < 4; ++m) {
                    const float r1 = rs[ai * 4 + m];
#pragma unroll
                    for (int bj = 0; bj < 2; ++bj) {
                        f32x4 s0, s1; const f32x4 v0 = acc[ai][bj][m][0], v1 = acc[ai][bj][m][1];
#pragma unroll
                        for (int e = 0; e < 4; ++e) { s0[e] = sigmoidf_(v0[e] * r1); s1[e] = sigmoidf_(v1[e] * r1); }
                        if (sub == 0) *MP(ai, m, bj) = pack8(s0, s1); else *SP(ai, m, bj) = pack8(s0, s1);
                    }
                }
        } else if (sub == 1) {
#pragma unroll
            for (int ai = 0; ai < 2; ++ai) {
                u32x4 g[4][2];
#pragma unroll
                for (int m = 0; m < 4; ++m)
#pragma unroll
                    for (int bj = 0; bj < 2; ++bj) g[m][bj] = *MP(ai, m, bj);
#pragma unroll
                for (int m = 0; m < 4; ++m)
#pragma unroll
                    for (int bj = 0; bj < 2; ++bj) { f32x4 g0, g1; unpack8(g[m][bj], g0, g1); *MP(ai, m, bj) = pack8(g0 * acc[ai][bj][m][0], g1 * acc[ai][bj][m][1]); }
                asm volatile("" ::: "memory");
            }
        } else {
#pragma unroll
            for (int ai = 0; ai < 2; ++ai)
#pragma unroll
                for (int mp = 0; mp < 2; ++mp) {
                    u32x4 c[2][2], s[2][2];
#pragma unroll
                    for (int mm = 0; mm < 2; ++mm)
#pragma unroll
                        for (int bj = 0; bj < 2; ++bj) { c[mm][bj] = *MP(ai, 2 * mp + mm, bj); s[mm][bj] = *SP(ai, 2 * mp + mm, bj); }
#pragma unroll
                    for (int mm = 0; mm < 2; ++mm)
#pragma unroll
                        for (int bj = 0; bj < 2; ++bj) { const int m = 2 * mp + mm; f32x4 c0, c1, s0, s1; unpack8(c[mm][bj], c0, c1); unpack8(s[mm][bj], s0, s1);
                            *MP(ai, m, bj) = pack8(c0 + s0 * acc[ai][bj][m][0], c1 + s1 * acc[ai][bj][m][1]); }
                    asm volatile("" ::: "memory");
                }
        }
#undef MP
#undef SP
    }
};

__device__ __forceinline__ void cvt_item(const float* W, int Nsrc, int n0src, const float* gain, bool permqk, bf16* WT, int K, int nrow0, int k0, LAS float* scr, int lane) {
#pragma unroll 8
    for (int i = 0; i < 32; ++i) { const int kk = 2 * i + (lane >> 5); float w = __builtin_nontemporal_load(&W[(size_t)(k0 + kk) * Nsrc + n0src + (lane & 31)]); if (gain) w *= gain[k0 + kk]; scr[kk * 33 + (lane & 31)] = w; }
    asm volatile("s_waitcnt lgkmcnt(0)" ::: "memory");
    const int c = lane & 7;
#pragma unroll
    for (int j = 0; j < 4; ++j) { const int n = (lane >> 3) + 8 * j; const int ns = permqk ? (16 * ((n >> 2) & 1) + 4 * (n >> 3) + (n & 3)) : n; const LAS float* s = scr + (8 * c) * 33 + ns;
        v4u o; o.x = pk2(s[0 * 33], s[1 * 33]); o.y = pk2(s[2 * 33], s[3 * 33]); o.z = pk2(s[4 * 33], s[5 * 33]); o.w = pk2(s[6 * 33], s[7 * 33]);
        *(GAS v4u*)(WT + (size_t)(nrow0 + n) * K + k0 + 8 * c) = o; }
    asm volatile("s_waitcnt lgkmcnt(0)" ::: "memory");
}
#define RLX_AGENT __ATOMIC_RELAXED, __HIP_MEMORY_SCOPE_AGENT
#define XB_TMO      128
#define XB_XCNT(j)  (256  + 64 * (j))
#define XB_XSUB(j)  (1280 + 64 * (j))
#define XB_XGEN(j)  (2304 + 64 * (j))
#define XB_TOP      3328
#define XB_TOPGEN   3392
#define XCD_BAR_WORDS 3456
#define XB_SPIN_CAP (1u << 18)

__device__ __forceinline__ unsigned xb_ld(unsigned* p)              { return __hip_atomic_load(p, __ATOMIC_RELAXED, __HIP_MEMORY_SCOPE_AGENT); }
__device__ __forceinline__ unsigned xb_add(unsigned* p, unsigned v) { return __hip_atomic_fetch_add(p, v, __ATOMIC_RELAXED, __HIP_MEMORY_SCOPE_AGENT); }
__device__ __forceinline__ unsigned xb_xcc_id() { return (unsigned)__builtin_amdgcn_s_getreg((3 << 11) | 20) & 0xFu; }
#define XB_SPIN(cond, bar) do { unsigned _sp = 0; while (cond) { __builtin_amdgcn_s_sleep(1); \
    if ((++_sp & 255u) == 0u) { if (xb_ld(&(bar)[XB_TMO])) break; if (_sp > XB_SPIN_CAP) { atomicAdd(&(bar)[XB_TMO], 1u); break; } } } } while (0)

struct XcdBarrier {
    unsigned* bar; unsigned x;
    volatile LAS unsigned* st;
};

__device__ __forceinline__ XcdBarrier xcd_barrier_post(unsigned* bar, volatile LAS unsigned* st) {
    XcdBarrier b; b.bar = bar; b.x = xb_xcc_id(); b.st = st;
    if (threadIdx.x == 0) (void)xb_add(&bar[XB_XCNT(b.x)], 1u);
    return b;
}
__device__ __forceinline__ void xcd_barrier_complete(unsigned* bar, unsigned x, unsigned& nloc, unsigned& nx) {
    const unsigned G = gridDim.x * gridDim.y * gridDim.z;
    unsigned sum, cnt, mine, sp = 0u;
    for (;;) {
        sum = 0u; cnt = 0u; mine = 0u;
#pragma unroll
        for (unsigned j = 0; j < 16; ++j) { const unsigned c = xb_ld(&bar[XB_XCNT(j)]); sum += c; cnt += (c > 0u) ? 1u : 0u; mine = (j == x) ? c : mine; }
        if (sum == G) break;
        __builtin_amdgcn_s_sleep(1);
        if ((++sp & 255u) == 0u) { if (xb_ld(&bar[XB_TMO])) break; if (sp > XB_SPIN_CAP) { atomicAdd(&bar[XB_TMO], 1u); break; } }
    }
    nloc = mine > 0u ? mine : 1u; nx = cnt > 0u ? cnt : 1u;
}

__device__ __forceinline__ void xcd_barrier(const XcdBarrier& b) {
    asm volatile("s_waitcnt vmcnt(0)" ::: "memory");
    __syncthreads();
    if (threadIdx.x == 0) {
        unsigned* bar = b.bar;
        __builtin_amdgcn_s_waitcnt(0);
        unsigned nloc = b.st[0], nx = b.st[1];
        if (nloc == 0u) { xcd_barrier_complete(bar, b.x, nloc, nx); b.st[0] = nloc; b.st[1] = nx; }
        const unsigned old = xb_add(&bar[XB_XSUB(b.x)], 1u);
        const unsigned gen = old / nloc;
        if (old + 1u == (gen + 1u) * nloc) {
            __builtin_amdgcn_fence(__ATOMIC_RELEASE, "agent");
            asm volatile("s_waitcnt vmcnt(0)" ::: "memory");
            const unsigned og = xb_add(&bar[XB_TOP], 1u);
            const unsigned tg = og / nx;
            if (og + 1u == (tg + 1u) * nx) xb_add(&bar[XB_TOPGEN], 1u);
            else XB_SPIN(xb_ld(&bar[XB_TOPGEN]) == tg, bar);
            __builtin_amdgcn_fence(__ATOMIC_ACQUIRE, "agent");
            xb_add(&bar[XB_XGEN(b.x)], 1u);
            asm volatile("s_waitcnt vmcnt(0)" ::: "memory");
        } else {
            XB_SPIN(xb_ld(&bar[XB_XGEN(b.x)]) == gen, bar);
            __builtin_amdgcn_fence(__ATOMIC_ACQUIRE, "agent");
            asm volatile("s_waitcnt vmcnt(0)" ::: "memory");
        }
    }
    __syncthreads();
}
struct Args { const float* in[21]; float* out; unsigned char* ws; int ph_lo, ph_hi; };
struct PT {
    volatile LAS unsigned long long* t;
    __device__ __forceinline__ unsigned long long get(int i) const { const unsigned long long v = t[i]; const unsigned lo = __builtin_amdgcn_readfirstlane((unsigned)v), hi = __builtin_amdgcn_readfirstlane((unsigned)(v >> 32)); return ((unsigned long long)hi << 32) | lo; }
    __device__ __forceinline__ const float* in(int i) const { return (const float*)(const GAS float*)get(i); }
    __device__ __forceinline__ float* out() const { return (float*)(GAS float*)get(21); }
    __device__ __forceinline__ unsigned char* ws() const { return (unsigned char*)(GAS unsigned char*)get(22); }
};

__device__ __forceinline__ void cvt_one(const PT a, unsigned char* ws, int l, LAS unsigned char* lds, int it, int wave, int lane) {
    LAS float* scr = (LAS float*)(lds + wave * 16384);
    bf16* W = (bf16*)(ws + WS_W + (size_t)(l & 1) * WBUF);
    const size_t ffo = (size_t)l * DM * FF, sqo = (size_t)l * DM * DM;
    const float* win = a.in(8) + (size_t)l * DM * 6656; const float* mixg = a.in(7) + l * DM;
    {
        int r = it;
        if (r < 2816) { const int kb = r / 176, nb = r % 176, pn = nb >> 3, t = nb & 7; const float* src = (t >> 2) ? a.in(5) + ffo : a.in(4) + ffo;
            cvt_item(src, FF, 128 * pn + 32 * (t & 3), a.in(3) + l * DM, false, (bf16*)((char*)W + W_GU1), 1024, nb * 32, kb * 64, scr, lane); return; } r -= 2816;
        if (r < 1408) { const int kb = r / 32, nb = r % 32; cvt_item(a.in(6) + ffo, DM, nb * 32, nullptr, false, (bf16*)((char*)W + W_D1), FF, nb * 32, kb * 64, scr, lane); return; } r -= 1408;
        if (r < 2304) { const int kb = r / 144, nb = r % 144, pn = nb >> 3, t = nb & 7; int n0; bool pq = false;
            if (pn < 4) { n0 = 64 * (4 * pn + (t & 3)) + 32 * (t >> 2); pq = true; }
            else if (pn == 4) { n0 = 1024 + 64 * (t & 3) + 32 * (t >> 2); pq = true; }
            else if (pn == 5) n0 = 1280 + 32 * t;
            else if (pn < 10) n0 = 1536 + 256 * (pn - 6) + 32 * t;
            else n0 = ((t >> 2) ? 3584 : 2560) + 128 * (pn - 10) + 32 * (t & 3);
            cvt_item(win, 6656, n0, mixg, pq, (bf16*)((char*)W + W_IN), 1024, nb * 32, kb * 64, scr, lane); return; } r -= 2304;
        if (r < 2560) { const int seg = r / 512, q = r % 512, kb = q / 32, nb = q % 32;
            const float* src; int ns, n0; const float* gn = nullptr; size_t dst;
            if (seg == 0) { src = win; ns = 6656; n0 = 5632 + nb * 32; gn = mixg; dst = W_GC; }
            else if (seg == 1) { src = a.in(14) + sqo; ns = DM; n0 = nb * 32; dst = W_OC; }
            else if (seg == 2) { src = win; ns = 6656; n0 = 4608 + nb * 32; gn = mixg; dst = W_GA; }
            else if (seg == 3) { src = a.in(13) + sqo; ns = DM; n0 = nb * 32; dst = W_OA; }
            else { src = a.in(15) + sqo; ns = DM; n0 = nb * 32; dst = W_M; }
            cvt_item(src, ns, n0, gn, false, (bf16*)((char*)W + dst), 1024, nb * 32, kb * 64, scr, lane); return; } r -= 2560;
        if (r < 2816) { const int kb = r / 176, nb = r % 176, pn = nb >> 3, t = nb & 7; const float* src = (t >> 2) ? a.in(18) + ffo : a.in(17) + ffo;
            cvt_item(src, FF, 128 * pn + 32 * (t & 3), a.in(16) + l * DM, false, (bf16*)((char*)W + W_GU2), 1024, nb * 32, kb * 64, scr, lane); return; } r -= 2816;
        { const int kb = r / 32, nb = r % 32; cvt_item(a.in(19) + ffo, DM, nb * 32, nullptr, false, (bf16*)((char*)W + W_D2), FF, nb * 32, kb * 64, scr, lane); }
    }
}

constexpr int CVT_ITEMS = 13312;
__device__ __forceinline__ void convert_static(const PT a, unsigned char* ws, int l, LAS unsigned char* lds, int gw, int NGW, int wave, int lane) {
    for (int it = gw; it < CVT_ITEMS; it += NGW) cvt_one(a, ws, l, lds, it, wave, lane);
}
__device__ __forceinline__ void convert_dynamic(const PT a, unsigned char* ws, int l, LAS unsigned char* lds, unsigned* ctr, int lo, int hi, int wave, int lane) {
    for (;;) {
        unsigned b = 0; if (lane == 0) b = atomicAdd(ctr, 4u);
        const int base = lo + (int)__builtin_amdgcn_readfirstlane(b);
        if (base >= hi) break;
        for (int k = 0; k < 4; ++k) { if (base + k < hi) cvt_one(a, ws, l, lds, base + k, wave, lane); }
    }
}
__device__ __forceinline__ void prologue(const PT a, unsigned char* ws, int tid, int wave, int lane, int bid, int G) {
    const int gtid = bid * 512 + tid, GT = G * 512, gw = bid * NWAVES + wave, NGW = G * NWAVES;
    float* ssq = (float*)(ws + WS_SSQ); bf16* hb = (bf16*)(ws + WS_HB); float* rope = (float*)(ws + WS_ROPE);
    for (int i = gtid; i < (TPAD - T_ROWS) * 16; i += GT) ssq[(size_t)T_ROWS * 16 + i] = 0.f;
    for (int i = gtid; i < (TPAD - T_ROWS) * DM / 8; i += GT) ((v4u*)(hb + (size_t)T_ROWS * DM))[i] = (v4u){0u, 0u, 0u, 0u};
    if (gtid < 64) ((unsigned*)(ws + WS_CTL))[gtid] = 0u;
    for (int i = gtid; i < LP * 32; i += GT) {
        const int pos = i >> 5, axis = (i >> 4) & 1, f = i & 15;
        float coord; if (pos < 16) coord = axis ? (float)pos : -1.0f; else { const int t = pos - 16; coord = axis ? (float)(t & 63) : (float)(t >> 6); }
        const float inv = powf(10000.0f, -(float)f * (1.0f / 16.0f)); const float ang = coord * inv;
        float s, c; sincosf(ang, &s, &c);
        rope[((pos * 2 + axis) * 2 + 0) * 16 + f] = c; rope[((pos * 2 + axis) * 2 + 1) * 16 + f] = s;
    }
    for (int r = gw; r < T_ROWS; r += NGW) {
        int pos, L; rowinfo(r, pos, L);
        const float* src;
        if (pos < 16) src = a.in(2) + (size_t)pos * DM;
        else if (r < ROWS_P) src = a.in(0) + ((size_t)(r / LP) * 4096 + pos - 16) * DM;
        else src = a.in(1) + ((size_t)((r - ROWS_P) / LS) * 2048 + pos - 16) * DM;
        f32x4 v[4]; float s = 0.f;
        unsigned long long* o8 = (unsigned long long*)(hb + (size_t)r * DM) + lane;
#pragma unroll
        for (int j = 0; j < 4; ++j) { v[j] = __builtin_nontemporal_load((const f32x4*)src + lane + 64 * j);
            const unsigned lo = pk2(v[j][0], v[j][1]), hi = pk2(v[j][2], v[j][3]); o8[64 * j] = (unsigned long long)lo | ((unsigned long long)hi << 32);
            const float a0 = bflo(lo), a1 = bfhi(lo), a2 = bflo(hi), a3 = bfhi(hi); s += (a0 * a0 + a1 * a1) + (a2 * a2 + a3 * a3); }
        s = wave_sum(s);
        if (lane < 16) ssq[(size_t)r * 16 + lane] = lane == 0 ? s : 0.f;
    }
}

constexpr int NSTRIP = (T_ROWS + 63) / 64;
__device__ __forceinline__ void conv_strip(const PT a, unsigned char* ws, int l, int tid, int strip) {
    bf16* cb = (bf16*)(ws + WS_CB); const bf16* z = (const bf16*)(ws + WS_Z);
    const float* cw = a.in(9) + (size_t)l * 3 * DM; const float* cbias = a.in(10) + (size_t)l * DM;
    const int chunk = tid & 127, sub = tid >> 7, c0 = chunk * 8;
    f32x4 w0[2], w1[2], w2[2], bb[2];
#pragma unroll
    for (int h = 0; h < 2; ++h) { w0[h] = *(const f32x4*)(cw + c0 + 4 * h); w1[h] = *(const f32x4*)(cw + DM + c0 + 4 * h); w2[h] = *(const f32x4*)(cw + 2 * DM + c0 + 4 * h); bb[h] = *(const f32x4*)(cbias + c0 + 4 * h); }
    const int r0 = strip * 64 + sub * 16;
#pragma unroll 4
    for (int i = 0; i < 16; ++i) {
        const int r = r0 + i; if (r >= T_ROWS) break;
        int pos, L; rowinfo(r, pos, L);
        const u32x4 zero = (u32x4){0u, 0u, 0u, 0u};
        const u32x4 zc = *(const u32x4*)(z + (size_t)r * DM + c0);
        const u32x4 zp = pos > 0 ? *(const u32x4*)(z + (size_t)(r - 1) * DM + c0) : zero;
        const u32x4 zn = pos < L - 1 ? *(const u32x4*)(z + (size_t)(r + 1) * DM + c0) : zero;
        u32x4* cp = (u32x4*)(cb + (size_t)r * DM + c0); const u32x4 cv = *cp;
        f32x4 p0, p1, c0v, c1v, n0, n1, b0, b1; unpack8(zp, p0, p1); unpack8(zc, c0v, c1v); unpack8(zn, n0, n1); unpack8(cv, b0, b1);
        const f32x4 o0 = b0 * (w0[0] * p0 + w1[0] * c0v + w2[0] * n0 + bb[0]), o1 = b1 * (w0[1] * p1 + w1[1] * c1v + w2[1] * n1 + bb[1]);
        *cp = pack8(o0, o1);
    }
}

__device__ __forceinline__ void attention_phase(const PT a, unsigned char* ws, int l, unsigned char* lds_generic, int tid, bool dry = false) {
    using abf = attn_body::bf16;
    const abf* Q = (const abf*)(ws + WS_Q); const abf* K = (const abf*)(ws + WS_K); const abf* V = (const abf*)(ws + WS_V); abf* O = dry ? (abf*)(ws + WS_END + MiB) : (abf*)(ws + WS_Q);
    unsigned* ctr = (unsigned*)(ws + WS_CTL) + l + (dry ? 8 : 0);
    volatile unsigned* slot = (volatile unsigned*)(lds_generic + MISC_OFF);
    unsigned pre = 0u; if (tid == 0) pre = atomicAdd(ctr, 1u);
    for (;;) {
        if (tid == 0) { *slot = pre; pre = atomicAdd(ctr, 1u); }
        __syncthreads();
        const int idx = (int)__builtin_amdgcn_readfirstlane(*slot);
        if (idx >= ATT_UNITS + NSTRIP) break;
        int u;
        if (idx < 5 * NSTRIP) { if (idx % 5 == 0) { int tidc = tid; asm volatile("" : "+v"(tidc)); conv_strip(a, ws, l, tidc, idx / 5); __syncthreads(); continue; } u = idx - (idx + 4) / 5; }
        else u = idx - NSTRIP;
        int tidu = tid; asm volatile("" : "+v"(tidu));
        if (u < ATT_UNITS_P) { const int s = u / 260, rem = u - s * 260, kvh = rem / 65, qblk = rem - kvh * 65;
            attn_body::attn_unit<8, LP, 65>((long)s * LP, kvh, qblk, Q, K, V, O, (char*)lds_generic, tidu); }
        else { const int u2 = u - ATT_UNITS_P, s = u2 / 132, rem = u2 - s * 132, kvh = rem / 33, qblk = rem - kvh * 33;
            attn_body::attn_unit<8, LS, 33>((long)ROWS_P + (long)s * LS, kvh, qblk, Q, K, V, O, (char*)lds_generic, tidu); }
    }
}

__device__ __forceinline__ void final_phase(const PT a, unsigned char* ws, int wave, int lane, int bid, int G) {
    const int gw = bid * NWAVES + wave, NGW = G * NWAVES;
    const float* ssq = (const float*)(ws + WS_SSQ); const bf16* hb = (const bf16*)(ws + WS_HB); float* out = a.out();
    f32x4 g[4];
#pragma unroll
    for (int j = 0; j < 4; ++j) g[j] = ((const f32x4*)a.in(20))[lane + 64 * j];
    for (int r = gw; r < T_ROWS; r += NGW) {
        int pos, L; rowinfo(r, pos, L); if (pos < 16) continue;
        float* p = r < ROWS_P ? out + ((size_t)(r / LP) * 4096 + pos - 16) * DM : out + (size_t)NSEQ_P * 4096 * DM + ((size_t)((r - ROWS_P) / LS) * 2048 + pos - 16) * DM;
        const float rs = rstd_of(ssq, r);
        const unsigned long long* i8 = (const unsigned long long*)(hb + (size_t)r * DM) + lane;
#pragma unroll
        for (int j = 0; j < 4; ++j) { const unsigned long long w = i8[64 * j]; const unsigned lo = (unsigned)w, hi = (unsigned)(w >> 32);
            const f32x4 v = (f32x4){bflo(lo), bfhi(lo), bflo(hi), bfhi(hi)}; __builtin_nontemporal_store(v * rs * g[j], (f32x4*)p + lane + 64 * j); }
    }
}

constexpr int NSTEPS = 2 + 8 * NLAYER;

template <int STEP>
__device__ __forceinline__ void run_step(const PT pt, unsigned char* lds, cg::grid_group& grid, XcdBarrier& bar, const int ph_lo, const int ph_hi) {
#ifdef MAX_STEP
    if (STEP >= MAX_STEP && STEP != NSTEPS - 1) return;
#endif
    if (STEP < ph_lo || STEP >= ph_hi) return;
    if (STEP > ph_lo) {
        if (STEP == ph_lo + 1) {
            asm volatile("s_waitcnt vmcnt(0)" ::: "memory"); grid.sync();
            bar = xcd_barrier_post((unsigned*)(pt.ws() + WS_CTL) + CW_BAR, (volatile LAS unsigned*)((LAS unsigned char*)lds + MISC_OFF + 32));
        } else xcd_barrier(bar);
#ifdef DUP_SYNC
        xcd_barrier(bar); xcd_barrier(bar);
#endif
    }
    LAS unsigned char* l3 = (LAS unsigned char*)lds;
    int tid = threadIdx.x; asm volatile("" : "+v"(tid));
    int bid = blockIdx.x; asm volatile("" : "+s"(bid));
    int G = gridDim.x; asm volatile("" : "+s"(G));
    unsigned char* ws = pt.ws();
    const int lane = tid & 63, wave = __builtin_amdgcn_readfirstlane(tid >> 6);
    const int gw = bid * NWAVES + wave, NGW = G * NWAVES;
    float* ssq = (float*)(ws + WS_SSQ);
    bf16_t* hb = (bf16_t*)(ws + WS_HB);
    if constexpr (STEP == 0) { prologue(pt, ws, tid, wave, lane, bid, G); convert_static(pt, ws, 0, l3, gw, NGW, wave, lane); __syncthreads(); }
    else if constexpr (STEP == NSTEPS - 1) { final_phase(pt, ws, wave, lane, bid, G); }
    else {
        constexpr int l = (STEP - 1) / 8, ph = (STEP - 1) % 8 + 1;
        unsigned char* wl = ws + WS_W + (size_t)(l & 1) * WBUF;
        if constexpr (ph == 0) {
        } else if constexpr (ph == 1 || ph == 7) {
            constexpr int f = ph == 7;
            PlainOrder S; S.init(TPAD, 2 * FF, G, bid); S.A = (const char*)hb; S.Bt = (const char*)(wl + (f ? W_GU2 : W_GU1)); S.tstep = (size_t)256 * 1024 * 2;
            pg8::Gemm g{nullptr, nullptr, TPAD, 2 * FF, 1024};
            EpiSwiGLU E{(bf16_t*)(ws + WS_HID), ssq};
#ifndef NO_GU
            pg8::gemm_phase<EpiSwiGLU, PlainOrder, true, true>(l3, g, S, E, tid);
#ifdef DUP_GU
            __syncthreads();
            pg8::gemm_phase<EpiSwiGLU, PlainOrder, true, true>(l3, g, S, E, tid);
#endif
#endif
        } else if constexpr (ph == 2 || ph == 6 || ph == 8) {
            constexpr int f = ph == 8; constexpr int K = ph == 6 ? 1024 : FF;
            PlainOrder S; S.init(TPAD, DM, G, bid);
            S.A = ph == 6 ? (const char*)(ws + WS_Z) : (const char*)(ws + WS_HID);
            S.Bt = (const char*)(wl + (ph == 6 ? W_M : (f ? W_D2 : W_D1))); S.tstep = (size_t)256 * K * 2;
            pg8::Gemm g{nullptr, nullptr, TPAD, DM, K};
#ifdef DUP_DOWN
            EpiResid E{hb, ssq, ph == 6 ? 0.5f : 0.25f};
            pg8::gemm_phase<EpiResid, PlainOrder, true, true>(l3, g, S, E, tid); __syncthreads();
#else
            EpiResid E{hb, ssq, ph == 6 ? 1.0f : 0.5f};
#endif
#ifndef NO_RES
            pg8::gemm_phase<EpiResid, PlainOrder, true, true>(l3, g, S, E, tid);
#endif
            if constexpr (l + 1 < NLAYER && ph != 6) {
                constexpr int part = ph == 2 ? 1 : 2; constexpr int lo = part == 1 ? CVT_ITEMS / 2 : 3 * (CVT_ITEMS / 4), hi = part == 1 ? 3 * (CVT_ITEMS / 4) : CVT_ITEMS;
                convert_dynamic(pt, ws, l + 1, l3, (unsigned*)(ws + WS_CTL) + 16 + 4 * l + part, lo, hi, wave, lane);
                __syncthreads();
            }
        } else if constexpr (ph == 3) {
            PlainOrder S; S.init(TPAD, NWIN, G, bid); S.A = (const char*)hb; S.Bt = (const char*)(wl + W_IN); S.tstep = (size_t)256 * 1024 * 2;
            pg8::Gemm g{nullptr, nullptr, TPAD, NWIN, 1024};
            EpiWin E{(bf16_t*)(ws + WS_Q), (bf16_t*)(ws + WS_K), (bf16_t*)(ws + WS_V), (bf16_t*)(ws + WS_CB), (bf16_t*)(ws + WS_Z), ssq,
                     (const float*)(ws + WS_ROPE), pt.in(11) + l * 64, pt.in(12) + l * 64};
#ifndef NO_WIN
            pg8::gemm_phase<EpiWin, PlainOrder, true, true>(l3, g, S, E, tid);
#ifdef DUP_WIN
            __syncthreads();
            pg8::gemm_phase<EpiWin, PlainOrder, true, true>(l3, g, S, E, tid);
#endif
#endif
        } else if constexpr (ph == 4) {
#ifdef DUP_ATT
            attention_phase(pt, ws, l, lds, tid, true); __syncthreads();
#endif
#ifndef NO_ATT
            attention_phase(pt, ws, l, lds, tid);
#endif
        } else {
            ChainOrder S; S.base.init(TPAD, DM, G, bid); S.tstep = (size_t)256 * 1024 * 2;
            S.A[0] = (const char*)hb; S.A[1] = (const char*)(ws + WS_CB); S.A[2] = (const char*)hb; S.A[3] = (const char*)(ws + WS_Q);
            S.B[0] = (const char*)(wl + W_GC); S.B[1] = (const char*)(wl + W_OC); S.B[2] = (const char*)(wl + W_GA); S.B[3] = (const char*)(wl + W_OA);
            pg8::Gemm g{nullptr, nullptr, TPAD, DM, 1024};
            EpiMerge E{(bf16_t*)(ws + WS_Z), (u32x4*)(ws + WS_SCR + (size_t)bid * 131072), ssq, tid};
#ifndef NO_MERGE
            pg8::gemm_phase<EpiMerge, ChainOrder, true, true>(l3, g, S, E, tid);
#ifdef DUP_MERGE
            __syncthreads();
            pg8::gemm_phase<EpiMerge, ChainOrder, true, true>(l3, g, S, E, tid);
#endif
#endif
            if constexpr (l + 1 < NLAYER) {
                convert_dynamic(pt, ws, l + 1, l3, (unsigned*)(ws + WS_CTL) + 16 + 4 * l + 0, 0, CVT_ITEMS / 2, wave, lane);
                __syncthreads();
            }
        }
    }
}
template <int STEP>
__device__ __forceinline__ void run_from(const PT pt, unsigned char* lds, cg::grid_group& grid, XcdBarrier& bar, const int ph_lo, const int ph_hi) {
    run_step<STEP>(pt, lds, grid, bar, ph_lo, ph_hi);
    if constexpr (STEP + 1 < NSTEPS) run_from<STEP + 1>(pt, lds, grid, bar, ph_lo, ph_hi);
}

__global__ void __launch_bounds__(NWAVES * 64, 2) mega_fwd(Args args) {
    extern __shared__ __attribute__((aligned(16))) unsigned char lds[];
    cg::grid_group grid = cg::this_grid();
    PT pt; pt.t = (volatile LAS unsigned long long*)((LAS unsigned char*)lds + PTAB_OFF);
    if (threadIdx.x == 0) {
#pragma unroll
        for (int i = 0; i < 21; ++i) pt.t[i] = (unsigned long long)args.in[i];
        pt.t[21] = (unsigned long long)args.out; pt.t[22] = (unsigned long long)args.ws;
    }
    if (threadIdx.x < 8) ((volatile LAS unsigned*)((LAS unsigned char*)lds + MISC_OFF + 32))[threadIdx.x] = 0u;
    const int ph_lo = args.ph_lo, ph_hi = args.ph_hi;
    if (blockIdx.x == 0) { unsigned* bw = (unsigned*)(args.ws + WS_CTL) + CW_BAR; for (int i = threadIdx.x; i < XCD_BAR_WORDS; i += NWAVES * 64) bw[i] = 0u; }
    __syncthreads();
    XcdBarrier bar; bar.bar = nullptr; bar.x = 0; bar.st = nullptr;
    run_from<0>(pt, lds, grid, bar, ph_lo, ph_hi);
}

#ifndef LAUNCH_PER_STEP
#define LAUNCH_PER_STEP 0
#endif
extern "C" void kernel_launch(void* const* d_in, const int* in_sizes, int n_in, void* d_out, int out_size, void* d_ws, size_t ws_size, hipStream_t stream) {
    static int grid = 0;
    if (grid == 0) {
        if (n_in != 21 || ws_size < WS_END) { fprintf(stderr, "kernel_launch: need 21 inputs and >= %zu bytes of workspace; got %d, %zu\n", (size_t)WS_END, n_in, ws_size); grid = -1; return; }
        int dev = 0, cus = 0, per_cu = 0;
        hipGetDevice(&dev); hipDeviceGetAttribute(&cus, hipDeviceAttributeMultiprocessorCount, dev);
        if (hipFuncSetAttribute((const void*)mega_fwd, hipFuncAttributeMaxDynamicSharedMemorySize, LDS_BYTES) != hipSuccess) { fprintf(stderr, "kernel_launch: hipFuncSetAttribute failed\n"); grid = -1; return; }
        if (hipOccupancyMaxActiveBlocksPerMultiprocessor(&per_cu, (const void*)mega_fwd, NWAVES * 64, LDS_BYTES) != hipSuccess || per_cu < 1) per_cu = 1;
        (void)hipGetLastError();
        grid = cus * per_cu;
    }
    if (grid < 0) return;
    Args a{};
    for (int i = 0; i < 21; ++i) a.in[i] = (const float*)d_in[i];
    a.out = (float*)d_out; a.ws = (unsigned char*)d_ws;
#if LAUNCH_PER_STEP
    for (int s = 0; s < NSTEPS; ++s) { a.ph_lo = s; a.ph_hi = s + 1; void* kargs[] = {&a}; hipLaunchCooperativeKernel((void*)mega_fwd, dim3(grid), dim3(NWAVES * 64), kargs, LDS_BYTES, stream); }
#else
    a.ph_lo = 0; a.ph_hi = NSTEPS; void* kargs[] = {&a};
    hipError_t e = hipLaunchCooperativeKernel((void*)mega_fwd, dim3(grid), dim3(NWAVES * 64), kargs, LDS_BYTES, stream);
    if (e != hipSuccess) fprintf(stderr, "cooperative launch failed: %s (grid %d)\n", hipGetErrorString(e), grid);
#endif
}
```
